# Optimizing an MI355X kernel written in HIP

```python
import math
import jax
import jax.numpy as jnp
from jax import lax
import numpy as np

D_MODEL = 1024
BATCH = 4
SEQ = 8192
DEPTH = 2

GRID_W = 64
CTX_LEN = 256
EPS = 1e-6
ROPE_BASE = 10000.0

A_HEADS = 8
A_DK = 64
A_DV = 64
A_CHUNK = 64
SHORT_CONV = 3
B_HEADS = 4
B_DH = 64
Q_BLOCK = 128
C_GROUPS = 4
PEER_HEADS = 8
PEER_NKEYS = 128
PEER_EXPERTS = PEER_NKEYS * PEER_NKEYS
PEER_DKEY = 256
PEER_TOPK = 16
PEER_BLOCK = 128

N_EVEN = (DEPTH + 1) // 2
N_ODD = DEPTH // 2

A_QK_W = A_HEADS * A_DK
A_V_W = A_HEADS * A_DV
B_QK_W = B_HEADS * 2 * B_DH
B_V_W = B_HEADS * 2 * B_DH
IN_SPLITS = (A_QK_W, A_QK_W, A_V_W, A_V_W, 2 * A_HEADS, 2 * A_HEADS, B_QK_W, B_QK_W, B_V_W)
IN_W = sum(IN_SPLITS)
MIX_W = A_V_W + B_V_W
CONV_CH = 2 * A_QK_W + A_V_W

kernel_name = 'hybrid_gdn_diffattn_fnet_peer_dit'


def rmsnorm(x, w):
    xf = x.astype(jnp.float32)
    y = xf * lax.rsqrt(jnp.mean(xf * xf, axis=-1, keepdims=True) + EPS)
    return (y * w.astype(jnp.float32)).astype(x.dtype)


def l2norm(x):
    return x * lax.rsqrt(jnp.sum(x * x, axis=-1, keepdims=True) + EPS)


def split_cols(p):
    idx, acc = [], 0
    for w in IN_SPLITS[:-1]:
        acc += w
        idx.append(acc)
    return jnp.split(p, idx, axis=-1)


def short_conv(x, w):
    pad = SHORT_CONV // 2
    return lax.conv_general_dilated(x, w[:, None, :].astype(x.dtype), (1,), [(pad, pad)],
                                    dimension_numbers=('NWC', 'WIO', 'NWC'),
                                    feature_group_count=x.shape[-1])


def axial_rope(n_tokens):
    rows = n_tokens // GRID_W
    row = jnp.repeat(jnp.arange(rows, dtype=jnp.float32), GRID_W)
    col = jnp.tile(jnp.arange(GRID_W, dtype=jnp.float32), rows)
    axis_dim = B_DH // 2
    inv = ROPE_BASE ** (-jnp.arange(0, axis_dim, 2, dtype=jnp.float32) / axis_dim)
    ang = jnp.concatenate([row[:, None] * inv, col[:, None] * inv], axis=-1)
    return jnp.cos(ang), jnp.sin(ang)


def apply_rope(x, cos, sin):
    x1, x2 = jnp.split(x, 2, axis=-1)
    c = cos[None, :, None, None, :]
    s = sin[None, :, None, None, :]
    return jnp.concatenate([x1 * c - x2 * s, x1 * s + x2 * c], axis=-1).astype(x.dtype)


def _to_chunks(t, n):
    t = t.reshape((t.shape[0], n, A_CHUNK) + t.shape[2:])
    return jnp.moveaxis(t, (1, 3), (0, 2))


def gated_delta_chunked(q, k, v, beta, g, s0):
    bsz, L, H, _ = k.shape
    n = L // A_CHUNK
    kc, vc, bc, gc = (_to_chunks(t, n) for t in (k, v, beta, g))
    gcum = jnp.cumsum(gc, axis=-1)
    lower = jnp.tril(jnp.ones((A_CHUNK, A_CHUNK), dtype=bool))
    strict = jnp.tril(jnp.ones((A_CHUNK, A_CHUNK), dtype=bool), -1)
    decay = jnp.exp(jnp.where(lower, gcum[..., :, None] - gcum[..., None, :], -jnp.inf))
    kb = kc * bc[..., None]
    m = jnp.where(strict, jnp.einsum('nbhid,nbhjd->nbhij', kb, kc) * decay, 0.0)
    eye = jnp.eye(A_CHUNK, dtype=jnp.float32)
    t_inv = lax.linalg.triangular_solve(eye + m, jnp.broadcast_to(eye, m.shape), left_side=True,
                                        lower=True, unit_diagonal=True)
    u = jnp.einsum('nbhij,nbhjd->nbhid', t_inv, vc * bc[..., None])
    w = jnp.einsum('nbhij,nbhjd->nbhid', t_inv, kb * jnp.exp(gcum)[..., None])
    k_tail = kc * jnp.exp(gcum[..., -1:] - gcum)[..., None]
    g_tot = jnp.exp(gcum[..., -1])

    def advance(S, u_i, w_i, kt_i, gt_i):
        v_new = u_i - jnp.einsum('bhcd,bhde->bhce', w_i, S)
        S_next = S * gt_i[..., None, None] + jnp.einsum('bhcd,bhce->bhde', kt_i, v_new)
        return S_next, v_new

    if q is None:
        def step_state(S, xs):
            S_next, _ = advance(S, *xs)
            return S_next, None
        S_fin, _ = lax.scan(step_state, s0, (u, w, k_tail, g_tot))
        return S_fin, None

    qc = _to_chunks(q, n)
    q_dec = qc * jnp.exp(gcum)[..., None]
    attn = jnp.einsum('nbhid,nbhjd->nbhij', qc, kc) * decay

    def step(S, xs):
        u_i, w_i, kt_i, gt_i, qd_i, at_i = xs
        S_next, v_new = advance(S, u_i, w_i, kt_i, gt_i)
        o = jnp.einsum('bhcd,bhde->bhce', qd_i, S) + jnp.einsum('bhij,bhje->bhie', at_i, v_new)
        return S_next, o

    S_fin, o = lax.scan(step, s0, (u, w, k_tail, g_tot, q_dec, attn))
    o = jnp.moveaxis(o, (0, 2), (1, 3)).reshape(bsz, L, H, v.shape[-1])
    return S_fin, o


def flip_if(t, rev):
    return jnp.flip(t, axis=1) if rev else t


def diff_softmax_mix(q, keys, vals, lam):
    s = jnp.einsum('bqhmd,bkhmd->bhmqk', q.astype(jnp.float32), keys.astype(jnp.float32)) * (B_DH ** -0.5)
    p = jax.nn.softmax(s, axis=-1)
    a = p[:, :, 0] - lam * p[:, :, 1]
    return jnp.einsum('bhqk,bkhe->bqhe', a, vals.astype(jnp.float32))


def mixer_ab(h, h_c, layer, w_in, conv_w, a_log, dt_bias, gdn_norm_w, lam_q1, lam_k1, lam_q2, lam_k2,
             subln_w, w_out, cos, sin, with_ctx_out):
    f32 = jnp.float32
    lam_init = 0.8 - 0.6 * math.exp(-0.3 * layer)
    lam = (jnp.exp(jnp.sum(lam_q1.astype(f32) * lam_k1.astype(f32)))
           - jnp.exp(jnp.sum(lam_q2.astype(f32) * lam_k2.astype(f32))) + lam_init)

    def project(t):
        bsz, n, _ = t.shape
        aq, ak, av, ag, a_beta, a_alpha, bq, bk, bv = split_cols(t @ w_in)
        qkv = jax.nn.silu(short_conv(jnp.concatenate([aq, ak, av], axis=-1), conv_w)).astype(f32)
        q, k, v = jnp.split(qkv, [A_QK_W, 2 * A_QK_W], axis=-1)
        q = l2norm(q.reshape(bsz, n, A_HEADS, A_DK)) * (A_DK ** -0.5)
        k = l2norm(k.reshape(bsz, n, A_HEADS, A_DK))
        v = v.reshape(bsz, n, A_HEADS, A_DV)
        beta = jax.nn.sigmoid(a_beta.astype(f32).reshape(bsz, n, 2, A_HEADS))
        g = -jnp.exp(a_log.astype(f32)) * jax.nn.softplus(
            a_alpha.astype(f32).reshape(bsz, n, 2, A_HEADS) + dt_bias.astype(f32))
        return (q, k, v, beta, g, ag,
                bq.reshape(bsz, n, B_HEADS, 2, B_DH), bk.reshape(bsz, n, B_HEADS, 2, B_DH),
                bv.reshape(bsz, n, B_HEADS, 2 * B_DH))

    ql, kl, vl, betal, gl, gate_l, bql, bkl, bvl = project(h)
    qc, kc, vc, betac, gc, gate_c, bqc, bkc, bvc = project(h_c)
    bsz, L = h.shape[0], h.shape[1]

    s0 = jnp.zeros((bsz, A_HEADS, A_DK, A_DV), f32)
    o_lat_dirs, o_ctx_dirs = [], []
    for d in range(2):
        rev = d == 1
        s_ctx, oc = gated_delta_chunked(flip_if(qc, rev) if with_ctx_out else None, flip_if(kc, rev),
                                        flip_if(vc, rev), flip_if(betac[:, :, d], rev),
                                        flip_if(gc[:, :, d], rev), s0)
        _, ol = gated_delta_chunked(flip_if(ql, rev), flip_if(kl, rev), flip_if(vl, rev),
                                    flip_if(betal[:, :, d], rev), flip_if(gl[:, :, d], rev), s_ctx)
        o_lat_dirs.append(flip_if(ol, rev))
        if with_ctx_out:
            o_ctx_dirs.append(flip_if(oc, rev))

    def gdn_out(o, gate):
        y = rmsnorm(o, gdn_norm_w) * jax.nn.silu(gate.astype(f32)).reshape(o.shape)
        return y.reshape(o.shape[0], o.shape[1], A_V_W)

    def diff_out(o):
        return (rmsnorm(o, subln_w) * (1.0 - lam_init)).reshape(o.shape[0], o.shape[1], B_V_W)

    bql_r = apply_rope(bql, cos, sin)
    bkl_r = apply_rope(bkl, cos, sin)
    keys = jnp.concatenate([bkl_r, bkc], axis=1)
    vals = jnp.concatenate([bvl, bvc], axis=1)
    nb = L // Q_BLOCK
    qb = jnp.moveaxis(bql_r.reshape(bsz, nb, Q_BLOCK, B_HEADS, 2, B_DH), 1, 0)
    ob = lax.map(lambda blk: diff_softmax_mix(blk, keys, vals, lam), qb)
    d_lat = jnp.moveaxis(ob, 0, 1).reshape(bsz, L, B_HEADS, 2 * B_DH)

    y_lat = jnp.concatenate([gdn_out(o_lat_dirs[0] + o_lat_dirs[1], gate_l), diff_out(d_lat)],
                            axis=-1).astype(h.dtype) @ w_out
    y_ctx = None
    if with_ctx_out:
        d_ctx = diff_softmax_mix(bqc, bkc, bvc, lam)
        y_ctx = jnp.concatenate([gdn_out(o_ctx_dirs[0] + o_ctx_dirs[1], gate_c), diff_out(d_ctx)],
                                axis=-1).astype(h_c.dtype) @ w_out
    return y_lat, y_ctx


def fourier_mix(h):
    bsz, L, D = h.shape
    hg = h.astype(jnp.float32).reshape(bsz, L, C_GROUPS, D // C_GROUPS)
    return jnp.fft.fft2(hg, axes=(1, 3), norm='ortho').real.reshape(bsz, L, D).astype(h.dtype)


def peer(h, w_q, sub_keys, u_tab, v_tab):
    bsz, L, D = h.shape
    blocks = h.reshape(-1, PEER_BLOCK, D)

    def block(hb):
        q = (hb @ w_q).astype(jnp.float32).reshape(PEER_BLOCK, PEER_HEADS, 2, PEER_DKEY // 2)
        s = jnp.einsum('thpd,hpnd->thpn', q, sub_keys.astype(jnp.float32))
        s1, i1 = lax.top_k(s[:, :, 0], PEER_TOPK)
        s2, i2 = lax.top_k(s[:, :, 1], PEER_TOPK)
        cand_s = (s1[..., :, None] + s2[..., None, :]).reshape(PEER_BLOCK, PEER_HEADS, PEER_TOPK * PEER_TOPK)
        cand_i = (i1[..., :, None] * PEER_NKEYS + i2[..., None, :]).reshape(PEER_BLOCK, PEER_HEADS, PEER_TOPK * PEER_TOPK)
        top_s, pos = lax.top_k(cand_s, PEER_TOPK)
        idx = jnp.take_along_axis(cand_i, pos, axis=-1)
        gate = jax.nn.softmax(top_s, axis=-1)
        act = jax.nn.gelu(jnp.einsum('td,thkd->thk', hb.astype(jnp.float32), u_tab[idx].astype(jnp.float32)))
        return jnp.einsum('thk,thkd->td', (gate * act).astype(v_tab.dtype), v_tab[idx])

    return lax.map(block, blocks).reshape(bsz, L, D).astype(h.dtype)


def setup_inputs(seed: int = 0) -> dict:
    key = jax.random.key(seed)
    ks = jax.random.split(key, 25)

    def nrm(k, shape, s):
        return jax.random.normal(k, shape, jnp.float32) * s

    dt = jnp.exp(jax.random.uniform(ks[11], (N_EVEN, 2, A_HEADS), jnp.float32,
                                    minval=math.log(1e-3), maxval=math.log(1e-1)))
    return {
        'x': nrm(ks[0], (BATCH, SEQ, D_MODEL), 1.0),
        'c': nrm(ks[1], (BATCH, D_MODEL), 1.0),
        'ctx': nrm(ks[2], (BATCH, CTX_LEN, D_MODEL), 1.0),
        'c_ctx': nrm(ks[3], (D_MODEL,), 1.0),
        'ada_w': nrm(ks[4], (DEPTH, D_MODEL, 6 * D_MODEL), 0.3 * D_MODEL ** -0.5),
        'ada_b': nrm(ks[5], (DEPTH, 6 * D_MODEL), 0.02),
        'norm1_w': 1.0 + nrm(ks[6], (DEPTH, D_MODEL), 0.02),
        'norm2_w': 1.0 + nrm(ks[7], (DEPTH, D_MODEL), 0.02),
        'w_in': nrm(ks[8], (N_EVEN, D_MODEL, IN_W), D_MODEL ** -0.5),
        'conv_w': nrm(ks[9], (N_EVEN, SHORT_CONV, CONV_CH), SHORT_CONV ** -0.5),
        'a_log': jnp.log(jax.random.uniform(ks[10], (N_EVEN, 2, A_HEADS), jnp.float32, minval=1.0, maxval=16.0)),
        'dt_bias': dt + jnp.log(-jnp.expm1(-dt)),
        'gdn_norm_w': 1.0 + nrm(ks[12], (N_EVEN, A_DV), 0.02),
        'lam_q1': nrm(ks[13], (N_EVEN, B_DH), 0.1),
        'lam_k1': nrm(ks[14], (N_EVEN, B_DH), 0.1),
        'lam_q2': nrm(ks[15], (N_EVEN, B_DH), 0.1),
        'lam_k2': nrm(ks[16], (N_EVEN, B_DH), 0.1),
        'subln_w': 1.0 + nrm(ks[17], (N_EVEN, 2 * B_DH), 0.02),
        'w_out_ab': nrm(ks[18], (N_EVEN, MIX_W, D_MODEL), MIX_W ** -0.5),
        'w_out_f': nrm(ks[19], (N_ODD, D_MODEL, D_MODEL), D_MODEL ** -0.5),
        'peer_wq': nrm(ks[20], (DEPTH, D_MODEL, PEER_HEADS * PEER_DKEY), D_MODEL ** -0.5),
        'peer_keys': nrm(ks[21], (DEPTH, PEER_HEADS, 2, PEER_NKEYS, PEER_DKEY // 2), (PEER_DKEY // 2) ** -0.5),
        'peer_u': nrm(ks[22], (DEPTH, PEER_EXPERTS, D_MODEL), D_MODEL ** -0.5),
        'peer_v': nrm(ks[23], (DEPTH, PEER_EXPERTS, D_MODEL), 1.0),
        'final_norm_w': 1.0 + nrm(ks[24], (D_MODEL,), 0.02),
    }


def reference(x, c, ctx, c_ctx, ada_w, ada_b, norm1_w, norm2_w, w_in, conv_w, a_log, dt_bias,
              gdn_norm_w, lam_q1, lam_k1, lam_q2, lam_k2, subln_w, w_out_ab, w_out_f, peer_wq,
              peer_keys, peer_u, peer_v, final_norm_w):
    bsz, n_lat = x.shape[0], x.shape[1]
    cos, sin = axial_rope(n_lat)
    last_ctx_reader = 2 * ((DEPTH - 1) // 2)
    c_act = jax.nn.silu(c)
    cc_act = jax.nn.silu(c_ctx)
    for i in range(DEPTH):
        ctx_in = i <= last_ctx_reader
        ctx_adv = i < last_ctx_reader
        mod = (c_act @ ada_w[i] + ada_b[i]).reshape(bsz, 6, 1, D_MODEL)
        sh1, sc1, g1, sh2, sc2, g2 = (mod[:, j] for j in range(6))
        h = rmsnorm(x, norm1_w[i]) * (1.0 + sc1) + sh1
        if ctx_in:
            mc = (cc_act @ ada_w[i] + ada_b[i]).reshape(6, 1, 1, D_MODEL)
            h_c = rmsnorm(ctx, norm1_w[i]) * (1.0 + mc[1]) + mc[0]
        j = i // 2
        if i % 2 == 0:
            y, y_c = mixer_ab(h, h_c, i, w_in[j], conv_w[j], a_log[j], dt_bias[j], gdn_norm_w[j],
                              lam_q1[j], lam_k1[j], lam_q2[j], lam_k2[j], subln_w[j], w_out_ab[j],
                              cos, sin, ctx_adv)
        else:
            y = fourier_mix(h) @ w_out_f[j]
            y_c = fourier_mix(h_c) @ w_out_f[j] if ctx_adv else None
        x = x + g1 * y
        x = x + g2 * peer(rmsnorm(x, norm2_w[i]) * (1.0 + sc2) + sh2,
                          peer_wq[i], peer_keys[i], peer_u[i], peer_v[i])
        if ctx_adv:
            ctx = ctx + mc[2] * y_c
            ctx = ctx + mc[5] * peer(rmsnorm(ctx, norm2_w[i]) * (1.0 + mc[4]) + mc[3],
                                     peer_wq[i], peer_keys[i], peer_u[i], peer_v[i])
    return rmsnorm(x, final_norm_w)
```

```cpp
#include <hip/hip_runtime.h>
#include <hip/hip_cooperative_groups.h>
#include <cstdio>
#include <cstdint>
namespace cg = cooperative_groups;

#define DI __device__ __forceinline__
typedef unsigned short bf16_t;
typedef short bf16x8 __attribute__((ext_vector_type(8)));
typedef short s16x4 __attribute__((ext_vector_type(4)));
typedef float f32x16 __attribute__((ext_vector_type(16)));
typedef float f32x4 __attribute__((ext_vector_type(4)));
typedef float f32x2_t __attribute__((ext_vector_type(2)));
typedef __bf16 bf16x2_t __attribute__((ext_vector_type(2)));
typedef unsigned u32x4 __attribute__((ext_vector_type(4)));
typedef unsigned u32x2 __attribute__((ext_vector_type(2)));

constexpr int NB = 4, SEQ = 8192, DM = 1024, CTXL = 256;
constexpr int TL = NB * SEQ;
constexpr int TC = NB * CTXL;
constexpr int TA = TL + TC;
constexpr int KVL = SEQ + CTXL;
constexpr int NIN = 3840;
constexpr int NCH = 132;
constexpr float EPS = 1e-6f;
constexpr int NT = 512;

constexpr size_t MiB = 1u << 20;
constexpr size_t WS_CTL = 0, WS_MOD = 64 * 1024, CTL_ZERO_BYTES = 512 * 1024;
constexpr size_t WS_ROPE = 1 * MiB, WS_WIN = 3 * MiB, WS_WOUT = 11 * MiB, WS_WF = 13 * MiB, WS_WEFF = 15 * MiB;
constexpr size_t WS_DFT0 = 23 * MiB, WS_DFT1 = 23 * MiB + 256 * 1024, WS_DFT3 = 23 * MiB + 512 * 1024;
constexpr size_t WS_BA = 24 * MiB, WS_GC = 29 * MiB;
constexpr size_t R0 = 32 * MiB, R1 = 98 * MiB, R2 = 197 * MiB, R3 = 329 * MiB, WS_END = 459 * MiB;
constexpr size_t WS_QN = R0, WS_KN = R0 + 33 * MiB;
constexpr size_t WS_QKVRAW = R1, WS_OBUF = R1;
constexpr size_t WS_UW = R2, WS_MIX = R2;
constexpr size_t WS_GATE = R3, WS_Q = R3 + 32 * MiB, WS_K = R3 + 64 * MiB, WS_VT = R3 + 97 * MiB;
constexpr size_t WS_TAB = R3 + 32 * MiB;
constexpr size_t WS_SC0 = R2, WS_EI0 = R1, WS_EG0 = R1 + 16 * MiB, WS_PART0 = 150 * MiB  , WS_W0 = R1 + 32 * MiB  ;
constexpr size_t WS_ZT = R1, WS_A2 = 226 * MiB, WS_FM = R1;
constexpr size_t WS_SC1 = 162 * MiB, WS_EI1 = 290 * MiB, WS_EG1 = 306 * MiB, WS_PART1 = 100 * MiB  , WS_W1 = 322 * MiB;

struct P {
  const float *x, *c, *ctx, *c_ctx, *ada_w, *ada_b, *norm1_w, *norm2_w, *w_in, *conv_w, *a_log, *dt_bias, *gdn_norm_w,
      *lam_q1, *lam_k1, *lam_q2, *lam_k2, *subln_w, *w_out_ab, *w_out_f, *peer_wq, *peer_keys, *peer_u, *peer_v, *final_norm_w;
  float* out; char* ws; int lo, hi;
};

DI unsigned f2bf(float f) { unsigned u = __float_as_uint(f); return (u + 0x7fffu + ((u >> 16) & 1u)) >> 16; }
DI unsigned pk2(float lo, float hi) { return f2bf(lo) | (f2bf(hi) << 16); }
DI unsigned cvtpk(float lo, float hi) { f32x2_t v = {lo, hi}; bf16x2_t b = __builtin_convertvector(v, bf16x2_t); return __builtin_bit_cast(unsigned, b); }
DI float bf2f(unsigned h) { return __uint_as_float(h << 16); }
DI float bflo(unsigned u) { return __uint_as_float(u << 16); }
DI float bfhi(unsigned u) { return __uint_as_float(u & 0xffff0000u); }
DI float wave_sum(float v) {
#pragma unroll
  for (int o = 32; o >= 1; o >>= 1) v += __shfl_xor(v, o, 64);
  return v;
}
DI int otid() { int t = threadIdx.x; asm volatile("" : "+v"(t)); return t; }
DI unsigned xb_ld(unsigned* p)              { return __hip_atomic_load(p, __ATOMIC_RELAXED, __HIP_MEMORY_SCOPE_AGENT); }
DI unsigned xb_add(unsigned* p, unsigned v) { return __hip_atomic_fetch_add(p, v, __ATOMIC_RELAXED, __HIP_MEMORY_SCOPE_AGENT); }
DI unsigned xb_xcc_id() { return (unsigned)__builtin_amdgcn_s_getreg((3 << 11) | 20) & 0xFu; }
DI float silu_f(float v) { return v / (1.f + __expf(-v)); }
DI float sigmoid_f(float v) { return 1.f / (1.f + __expf(-v)); }
DI float gelu_tanh(float v) {
  const float u = 0.7978845608028654f * (v + 0.044715f * v * v * v);
  const float e = __expf(2.f * u);
  const float t = 1.f - 2.f / (e + 1.f);
  return 0.5f * v * (1.f + t);
}
#define MFMA32(a, b, c) __builtin_amdgcn_mfma_f32_32x32x16_bf16((a), (b), (c), 0, 0, 0)

constexpr int GBM = 256, GBN = 128, GBK = 64, GLD = 72;
constexpr int G_A_BYTES = GBM * GLD * 2, G_B_BYTES = GBN * GLD * 2, G_STAGE = G_A_BYTES + G_B_BYTES;
constexpr int LDS_BYTES = 147456;

template <bool SWAP, class RowF, class Epi>
DI void gemm_tile(char* lds, const RowF& rowf, const bf16_t* __restrict__ Bt, const int K, const Epi& epi) {
  const int tid = otid(), lane = tid & 63, wave = tid >> 6, wm = wave >> 1, wn = wave & 1;
  const int lr = tid >> 3, lc = tid & 7;
  const bf16_t* ap0 = rowf(lr) + lc * 8;
  const bf16_t* ap1 = rowf(lr + 64) + lc * 8;
  const bf16_t* ap2 = rowf(lr + 128) + lc * 8;
  const bf16_t* ap3 = rowf(lr + 192) + lc * 8;
  const bf16_t* bp0 = Bt + (size_t)lr * K + lc * 8;
  const bf16_t* bp1 = Bt + (size_t)(lr + 64) * K + lc * 8;
  const int woff = (lr * GLD + lc * 8) * 2;
  u32x4 raX0, raX1, raX2, raX3, rbX0, rbX1, raY0, raY1, raY2, raY3, rbY0, rbY1;
  f32x16 acc[2][2];
#pragma unroll
  for (int i = 0; i < 2; ++i)
#pragma unroll
    for (int j = 0; j < 2; ++j)
#pragma unroll
      for (int r = 0; r < 16; ++r) acc[i][j][r] = 0.f;
  const int nk = K / GBK;
#define G_GLOAD(S, kt_) do { const int k0_ = ((kt_) < nk ? (kt_) : nk - 1) * GBK; \
    ra##S##0 = *(const u32x4*)(ap0 + k0_); ra##S##1 = *(const u32x4*)(ap1 + k0_); ra##S##2 = *(const u32x4*)(ap2 + k0_); ra##S##3 = *(const u32x4*)(ap3 + k0_); \
    rb##S##0 = *(const u32x4*)(bp0 + k0_); rb##S##1 = *(const u32x4*)(bp1 + k0_); } while (0)
#define G_LWRITE(S, st) do { char* b_ = lds + (st) * G_STAGE + woff; *(u32x4*)(b_) = ra##S##0; *(u32x4*)(b_ + 64 * GLD * 2) = ra##S##1; *(u32x4*)(b_ + 128 * GLD * 2) = ra##S##2; *(u32x4*)(b_ + 192 * GLD * 2) = ra##S##3; \
    *(u32x4*)(b_ + G_A_BYTES) = rb##S##0; *(u32x4*)(b_ + G_A_BYTES + 64 * GLD * 2) = rb##S##1; } while (0)
  const int aoff = ((wm * 64 + (lane & 31)) * GLD + (lane >> 5) * 8) * 2;
  const int boff = G_A_BYTES + ((wn * 64 + (lane & 31)) * GLD + (lane >> 5) * 8) * 2;
#define G_COMPUTE(st) do { const char* sb = lds + (st) * G_STAGE; \
    _Pragma("unroll") for (int kk = 0; kk < 4; ++kk) { \
      const bf16x8 a0 = *(const bf16x8*)(sb + aoff + kk * 32); \
      const bf16x8 a1 = *(const bf16x8*)(sb + aoff + 32 * GLD * 2 + kk * 32); \
      const bf16x8 b0 = *(const bf16x8*)(sb + boff + kk * 32); \
      const bf16x8 b1 = *(const bf16x8*)(sb + boff + 32 * GLD * 2 + kk * 32); \
      if (SWAP) { \
        acc[0][0] = MFMA32(b0, a0, acc[0][0]); acc[0][1] = MFMA32(b1, a0, acc[0][1]); \
        acc[1][0] = MFMA32(b0, a1, acc[1][0]); acc[1][1] = MFMA32(b1, a1, acc[1][1]); \
      } else { \
        acc[0][0] = MFMA32(a0, b0, acc[0][0]); acc[0][1] = MFMA32(a0, b1, acc[0][1]); \
        acc[1][0] = MFMA32(a1, b0, acc[1][0]); acc[1][1] = MFMA32(a1, b1, acc[1][1]); \
      } } } while (0)
  G_GLOAD(X, 0); G_GLOAD(Y, 1);
  __syncthreads();
  G_LWRITE(X, 0);
  __syncthreads();
#pragma unroll 1
  for (int kt = 0; kt < nk; kt += 2) {
    G_GLOAD(X, kt + 2);
    G_COMPUTE(0);
    G_LWRITE(Y, 1);
    __syncthreads();
    G_GLOAD(Y, kt + 3);
    G_COMPUTE(1);
    if (kt + 2 < nk) G_LWRITE(X, 0);
    __syncthreads();
  }
  epi(acc, wm, wn, lane);
#undef G_GLOAD
#undef G_LWRITE
#undef G_COMPUTE
}
DI int crow(int reg, int h) { return (reg & 3) + 8 * (reg >> 2) + 4 * h; }

struct RowLin { const bf16_t* base; size_t pitch; DI const bf16_t* operator()(int r) const { return base + (size_t)r * pitch; } };

namespace pg8 {
#define PG8_LAS __attribute__((address_space(3)))
typedef unsigned short bf16_t;
typedef short bf16x8 __attribute__((ext_vector_type(8)));
typedef float f32x4 __attribute__((ext_vector_type(4)));
typedef unsigned u32x4 __attribute__((ext_vector_type(4)));
constexpr int BM = 256, BK = 64, HALF = 128, HTB = HALF * BK * 2  , STAGE_BYTES = 8 * HTB, NXCD = 8, WGM = 8;

__host__ __device__ __forceinline__ int lds_byte(int r, int c) { const int st = (r >> 4) * 2 + (c >> 5), rr = r & 15, cc = c & 31, ob = rr * 64 + cc * 2; return st * 1024 + (ob ^ (((ob >> 9) & 1) << 5)); }
__host__ __device__ __forceinline__ void stage_rc(int b, int& R, int& C) { const int st = b / 1024, sb = b % 1024, swz = sb ^ (((sb >> 9) & 1) << 5); R = (st >> 1) * 16 + swz / 64; C = (st & 1) * 32 + (swz % 64) / 2; }
__host__ __device__ __forceinline__ int perm32(int rho) { const int n = rho >> 4, i = rho & 15; return 8 * (i >> 2) + 4 * n + (i & 3); }

struct Unit { int pm, pn; };
struct Gemm { const bf16_t* A; const bf16_t* Bt; int M, N, K; };

struct StaticOrder {
    int nM, nN, nwg, G, c;
    __host__ __device__ void init(int M, int N, int G_, int c_) { nM = M / BM; nN = N / BM; nwg = nM * nN; G = G_; c = c_; }
    __host__ __device__ bool next(int i, Unit& u) const {
        const long L = (long)i * G + c; if (L >= nwg) return false;
        int wgid = (int)L; { const int q = nwg / NXCD, r = nwg % NXCD, xcd = wgid % NXCD, off = wgid / NXCD; wgid = (xcd < r ? xcd * (q + 1) : r * (q + 1) + (xcd - r) * q) + off; }
        const int nig = WGM * nN, gid = wgid / nig, fm = gid * WGM, gsz = (nM - fm) < WGM ? (nM - fm) : WGM;
        u.pm = fm + ((wgid % nig) % gsz); u.pn = (wgid % nig) / gsz; return true;
    }
    __device__ __forceinline__ void a_ready(const Unit&) const {}
    __device__ __forceinline__ void done(const Unit&) const {}
};
template <class Epi, class Sched, bool ALIGN_EPI = false, bool SP2 = false>
__device__ __forceinline__ void gemm_phase(PG8_LAS unsigned char* lds, const Gemm g, const Sched& S, const Epi& E) {
    const int tid = otid(), wid = __builtin_amdgcn_readfirstlane(tid >> 6), lane = tid & 63, wr = wid >> 2, wc = wid & 3, fr = lane & 15, fq = lane >> 4;
    const int K = g.K, nt = K / BK;
    unsigned voffA[2], voffB[2];
#pragma unroll
    for (int i = 0; i < 2; ++i) { int R, C; stage_rc(tid * 16 + i * 8192, R, C); const int Rb = Epi::PERM ? ((R & ~31) + perm32(R & 31)) : R;
        voffA[i] = (unsigned)(R * K + C) * 2u; voffB[i] = (unsigned)(Rb * K + C) * 2u; }
    const size_t kstep = (size_t)(BK * 2);
    const size_t hstep = (size_t)HALF * K * 2;
    const size_t tstep = 2 * hstep;
    const unsigned ldsw = (unsigned)wid * 1024u;
    const int aoff = lds_byte(wr * 64 + fr, fq * 8), boff = lds_byte(wc * 32 + fr, fq * 8);
#define PG8_SA(b, h) (((b) * 2 + (h)) * HTB)
#define PG8_SB(b, h) ((4 + (b) * 2 + (h)) * HTB)
#define PG8_STAGE(bufoff, gbase, voff) do { _Pragma("unroll") for (int _i = 0; _i < 2; ++_i) \
        __builtin_amdgcn_global_load_lds((const unsigned*)((const char*)(gbase) + (voff)[_i]), (PG8_LAS unsigned*)(lds + (bufoff) + ldsw + _i * 8192), 16, 0, 0); } while (0)
#define PG8_LDA(dst, b, h) do { _Pragma("unroll") for (int m = 0; m < 4; ++m) _Pragma("unroll") for (int k = 0; k < 2; ++k) dst[m][k] = *(const PG8_LAS bf16x8*)(lds + PG8_SA(b, h) + aoff + m * 2048 + k * 1024); } while (0)
#define PG8_LDB(dst, b, h) do { _Pragma("unroll") for (int n = 0; n < 2; ++n) _Pragma("unroll") for (int k = 0; k < 2; ++k) dst[n][k] = *(const PG8_LAS bf16x8*)(lds + PG8_SB(b, h) + boff + n * 2048 + k * 1024); } while (0)
#define PG8_MMA(ai, bj, At, Bt) do { __builtin_amdgcn_s_setprio(1); _Pragma("unroll") for (int m = 0; m < 4; ++m) _Pragma("unroll") for (int n = 0; n < 2; ++n) _Pragma("unroll") for (int k = 0; k < 2; ++k) \
        acc[ai][bj][m][n] = __builtin_amdgcn_mfma_f32_16x16x32_bf16(Bt[n][k], At[m][k], acc[ai][bj][m][n], 0, 0, 0); __builtin_amdgcn_s_setprio(0); } while (0)
#define PG8_WAIT_V(n) asm volatile("s_waitcnt vmcnt(" #n ")" ::: "memory")
#define PG8_WAIT_L(n) asm volatile("s_waitcnt lgkmcnt(" #n ")" ::: "memory")
#define PG8_BAR __builtin_amdgcn_s_barrier()
#define PG8_SCHED __builtin_amdgcn_sched_barrier(0)
    Unit cur, nxt; int ui = 0;
    if (!S.next(0, cur)) return;
    f32x4 acc[2][2][4][2];
#pragma unroll
    for (int a = 0; a < 2; ++a)
#pragma unroll
        for (int b = 0; b < 2; ++b)
#pragma unroll
            for (int m = 0; m < 4; ++m)
#pragma unroll
                for (int n = 0; n < 2; ++n) acc[a][b][m][n] = (f32x4){0.f, 0.f, 0.f, 0.f};
    bf16x8 At[4][2], B0[2][2], B1[2][2];
    const char* cA = (const char*)g.A + (size_t)cur.pm * tstep; const char* cB = (const char*)g.Bt + (size_t)cur.pn * tstep;
    S.a_ready(cur);
    if constexpr (SP2) {
        PG8_STAGE(PG8_SB(0, 0), cB, voffB); PG8_STAGE(PG8_SB(0, 1), cB + hstep, voffB); PG8_STAGE(PG8_SA(0, 0), cA, voffA); PG8_STAGE(PG8_SA(0, 1), cA + hstep, voffA);
        if (wr == 1) PG8_BAR;
        PG8_WAIT_V(2); PG8_BAR;
        PG8_STAGE(PG8_SB(1, 0), cB + kstep, voffB); PG8_STAGE(PG8_SA(1, 0), cA + kstep, voffA); PG8_STAGE(PG8_SB(1, 1), cB + hstep + kstep, voffB);
        PG8_WAIT_V(6); PG8_BAR;
    } else {
        PG8_STAGE(PG8_SB(0, 0), cB, voffB); PG8_STAGE(PG8_SA(0, 0), cA, voffA); PG8_STAGE(PG8_SB(0, 1), cB + hstep, voffB); PG8_STAGE(PG8_SA(0, 1), cA + hstep, voffA);
        if (wr == 1) PG8_BAR;
        PG8_WAIT_V(4); PG8_BAR;
        PG8_STAGE(PG8_SB(1, 0), cB + kstep, voffB); PG8_STAGE(PG8_SA(1, 0), cA + kstep, voffA); PG8_STAGE(PG8_SB(1, 1), cB + hstep + kstep, voffB);
        PG8_WAIT_V(6); PG8_BAR;
    }
    for (;;) {
        const bool has_next = S.next(ui + 1, nxt);
        const char* nA = has_next ? (const char*)g.A + (size_t)nxt.pm * tstep : cA; const char* nB = has_next ? (const char*)g.Bt + (size_t)nxt.pn * tstep : cB;
        for (int t = 0; t < nt; t += 2) {
            const bool last = (t == nt - 2);
            const char* a1 = cA + (size_t)(t + 1) * kstep;
            const char* a2 = last ? nA : cA + (size_t)(t + 2) * kstep; const char* b2 = last ? nB : cB + (size_t)(t + 2) * kstep;
            const char* a3 = a2 + kstep; const char* b3 = b2 + kstep;
            if (last && has_next) S.a_ready(nxt);
            if constexpr (SP2) {
            PG8_LDB(B0, 0, 0); PG8_LDB(B1, 0, 1); PG8_SCHED; PG8_LDA(At, 0, 0); PG8_STAGE(PG8_SA(1, 1), a1 + hstep, voffA);
            PG8_WAIT_V(8); PG8_WAIT_L(0); PG8_BAR; PG8_MMA(0, 0, At, B0); PG8_MMA(0, 1, At, B1); PG8_BAR; PG8_SCHED;
            PG8_LDA(At, 0, 1); PG8_STAGE(PG8_SB(0, 0), b2, voffB); PG8_STAGE(PG8_SB(0, 1), b2 + hstep, voffB); PG8_STAGE(PG8_SA(0, 0), a2, voffA);
            PG8_WAIT_V(8); PG8_WAIT_L(0); PG8_BAR; PG8_MMA(1, 0, At, B0); PG8_MMA(1, 1, At, B1); PG8_BAR; PG8_SCHED;
            PG8_LDB(B0, 1, 0); PG8_LDB(B1, 1, 1); PG8_SCHED; PG8_LDA(At, 1, 0); PG8_STAGE(PG8_SA(0, 1), a2 + hstep, voffA);
            PG8_WAIT_V(8); PG8_WAIT_L(0); PG8_BAR; PG8_MMA(0, 0, At, B0); PG8_MMA(0, 1, At, B1); PG8_BAR; PG8_SCHED;
            PG8_LDA(At, 1, 1); PG8_STAGE(PG8_SB(1, 0), b3, voffB); PG8_STAGE(PG8_SB(1, 1), b3 + hstep, voffB); PG8_STAGE(PG8_SA(1, 0), a3, voffA);
            PG8_WAIT_V(8); PG8_WAIT_L(0); PG8_BAR; PG8_MMA(1, 0, At, B0); PG8_MMA(1, 1, At, B1); PG8_BAR; PG8_SCHED;
            } else {
            PG8_LDB(B0, 0, 0); PG8_SCHED; PG8_LDA(At, 0, 0); PG8_STAGE(PG8_SA(1, 1), a1 + hstep, voffA);
            PG8_WAIT_L(8); PG8_BAR; PG8_WAIT_L(0); PG8_MMA(0, 0, At, B0); PG8_BAR; PG8_SCHED;
            PG8_LDB(B1, 0, 1); PG8_STAGE(PG8_SB(0, 0), b2, voffB);
            PG8_BAR; PG8_WAIT_L(0); PG8_MMA(0, 1, At, B1); PG8_BAR;
            PG8_LDA(At, 0, 1); PG8_STAGE(PG8_SA(0, 0), a2, voffA);
            PG8_BAR; PG8_WAIT_L(0); PG8_MMA(1, 0, At, B0); PG8_BAR; PG8_SCHED;
            PG8_STAGE(PG8_SB(0, 1), b2 + hstep, voffB);
            PG8_WAIT_V(6); PG8_BAR; PG8_MMA(1, 1, At, B1); PG8_BAR;
            PG8_LDB(B0, 1, 0); PG8_SCHED; PG8_LDA(At, 1, 0); PG8_STAGE(PG8_SA(0, 1), a2 + hstep, voffA);
            PG8_WAIT_L(8); PG8_BAR; PG8_WAIT_L(0); PG8_MMA(0, 0, At, B0); PG8_BAR; PG8_SCHED;
            PG8_LDB(B1, 1, 1); PG8_STAGE(PG8_SB(1, 0), b3, voffB);
            PG8_BAR; PG8_WAIT_L(0); PG8_MMA(0, 1, At, B1); PG8_BAR;
            PG8_LDA(At, 1, 1); PG8_STAGE(PG8_SA(1, 0), a3, voffA);
            PG8_BAR; PG8_WAIT_L(0); PG8_MMA(1, 0, At, B0); PG8_BAR; PG8_SCHED;
            PG8_STAGE(PG8_SB(1, 1), b3 + hstep, voffB);
            PG8_WAIT_V(6); PG8_BAR; PG8_MMA(1, 1, At, B1); PG8_BAR;
            }
        }
        if constexpr (ALIGN_EPI) { if (wr == 0) PG8_BAR; }
        if constexpr (!Epi::AFTER_DRAIN) { E(acc, cur, wr, wc, fr, fq); S.done(cur); }
        if (!has_next) break;
#pragma unroll
        for (int a = 0; a < 2; ++a)
#pragma unroll
            for (int b = 0; b < 2; ++b)
#pragma unroll
                for (int m = 0; m < 4; ++m)
#pragma unroll
                    for (int n = 0; n < 2; ++n) acc[a][b][m][n] = (f32x4){0.f, 0.f, 0.f, 0.f};
        cur = nxt; cA = nA; cB = nB; ++ui;
        if constexpr (ALIGN_EPI) { if (wr == 1) PG8_BAR; }
    }
    PG8_WAIT_V(0);
    if constexpr (!ALIGN_EPI) { if (wr == 0) PG8_BAR; }
    PG8_BAR;
    if constexpr (Epi::AFTER_DRAIN) { E.fused(acc, cur, wr, wc, fr, fq, lds, wid, lane); S.done(cur); }
#undef PG8_SA
#undef PG8_SB
#undef PG8_STAGE
#undef PG8_LDA
#undef PG8_LDB
#undef PG8_MMA
#undef PG8_WAIT_V
#undef PG8_WAIT_L
#undef PG8_BAR
#undef PG8_SCHED
}
}
DI void ph_setup(const P& p, char* lds) {
  const int tid = otid(), nb = gridDim.x, bid = blockIdx.x;
  float* modL = (float*)(p.ws + WS_MOD);
  float* sc = (float*)lds;
  for (int it = bid; it < 192; it += nb) {
    const int layer = it / 96, cb = it % 96;
    const int lane = tid & 63, ks = tid >> 6;
    __syncthreads();
    for (int i = tid; i < 5 * 1024; i += NT) { const int v = i >> 10, k = i & 1023; const float cv = (v < 4) ? p.c[v * 1024 + k] : p.c_ctx[k]; sc[i] = silu_f(cv); }
    __syncthreads();
    const int n = cb * 64 + lane;
    const float* w = p.ada_w + ((size_t)layer * 1024 + ks * 128) * 6144 + n;
    float a0 = 0, a1 = 0, a2 = 0, a3 = 0, a4 = 0;
#pragma unroll 8
    for (int k = 0; k < 128; ++k) { const float wv = w[(size_t)k * 6144]; const int kk = ks * 128 + k; a0 += wv * sc[kk]; a1 += wv * sc[1024 + kk]; a2 += wv * sc[2048 + kk]; a3 += wv * sc[3072 + kk]; a4 += wv * sc[4096 + kk]; }
    float* red = sc + 5 * 1024;
    red[(ks * 5 + 0) * 64 + lane] = a0; red[(ks * 5 + 1) * 64 + lane] = a1; red[(ks * 5 + 2) * 64 + lane] = a2; red[(ks * 5 + 3) * 64 + lane] = a3; red[(ks * 5 + 4) * 64 + lane] = a4;
    __syncthreads();
    if (tid < 320) {
      const int v = tid >> 6, l = tid & 63;
      float sacc = p.ada_b[layer * 6144 + cb * 64 + l];
      for (int k8 = 0; k8 < 8; ++k8) sacc += red[(k8 * 5 + v) * 64 + l];
      modL[(layer * 5 + v) * 6144 + cb * 64 + l] = sacc;
    }
  }
  {
    float* rope = (float*)(p.ws + WS_ROPE);
    for (int i = bid * NT + tid; i < SEQ * 32; i += nb * NT) {
      const int l = i >> 5, d = i & 31;
      const float inv = exp2f(-(float)(2 * (d & 15)) * (13.287712379549449f / 32.f));
      const float pos = (d < 16) ? (float)(l >> 6) : (float)(l & 63);
      float s, c; sincosf(pos * inv, &s, &c);
      rope[2 * i] = c; rope[2 * i + 1] = s;
    }
  }
  {
    float* tl = (float*)lds;
    const int nt_in = (NIN / 64) * 16, nt_o = 16 * 16;
    for (int it = bid; it < nt_in + 2 * nt_o; it += nb) {
      const float* src; bf16_t* dst; int npitch, nb0, kb0, which;
      if (it < nt_in) { which = 0; nb0 = (it / 16) * 64; kb0 = (it % 16) * 64; src = p.w_in; dst = (bf16_t*)(p.ws + WS_WIN); npitch = 3616; }
      else if (it < nt_in + nt_o) { const int j = it - nt_in; which = 1; nb0 = (j / 16) * 64; kb0 = (j % 16) * 64; src = p.w_out_ab; dst = (bf16_t*)(p.ws + WS_WOUT); npitch = 1024; }
      else { const int j = it - nt_in - nt_o; which = 2; nb0 = (j / 16) * 64; kb0 = (j % 16) * 64; src = p.w_out_f; dst = (bf16_t*)(p.ws + WS_WF); npitch = 1024; }
      __syncthreads();
      for (int e = tid; e < 4096; e += NT) {
        const int kk = e >> 6, nn = e & 63; const int n = nb0 + nn;
        int sn = n;
        if (which == 0) {
          if (n < 2048) sn = n;
          else if (n < 3072) { const int pq = n & 63, blk = pq >> 3, e8 = pq & 7; sn = (n & ~63) + 32 + ((e8 < 4) ? 4 * blk + e8 : 32 + 4 * blk + (e8 - 4)); }
          else if (n < 3584) sn = n + 32;
          else if (n < 3616) sn = n - 1536;
          else sn = -1;
        }
        tl[kk * 65 + nn] = (sn >= 0) ? src[(size_t)(kb0 + kk) * npitch + sn] : 0.f;
      }
      __syncthreads();
      for (int e = tid; e < 4096; e += NT) { const int nn = e >> 6, kk = e & 63; dst[(size_t)(nb0 + nn) * 1024 + kb0 + kk] = (bf16_t)f2bf(tl[kk * 65 + nn]); }
    }
  }
  {
    float* kl = (float*)lds;
    float* wl = kl + 128 * 132;
    bf16_t* weff = (bf16_t*)(p.ws + WS_WEFF);
    for (int it = bid; it < 512; it += nb) {
      const int layer = it >> 8, hp = (it >> 4) & 15, kb = it & 15;
      __syncthreads();
      const float* ks = p.peer_keys + ((size_t)(layer * 16 + hp) * 128) * 128;
      for (int e = tid; e < 128 * 128; e += NT) kl[(e >> 7) * 132 + (e & 127)] = ks[e];
      const float* ws_ = p.peer_wq + ((size_t)layer * 1024 + kb * 64) * 2048 + hp * 128;
      for (int e = tid; e < 64 * 128; e += NT) wl[(e >> 7) * 132 + (e & 127)] = ws_[(size_t)(e >> 7) * 2048 + (e & 127)];
      __syncthreads();
      const int key = tid & 127, kq = tid >> 7;
      float a[16];
#pragma unroll
      for (int i = 0; i < 16; ++i) a[i] = 0.f;
      for (int d = 0; d < 128; d += 4) {
        const f32x4 kv = *(const f32x4*)(kl + key * 132 + d);
#pragma unroll
        for (int i = 0; i < 16; ++i) { const f32x4 wv = *(const f32x4*)(wl + (kq * 16 + i) * 132 + d); a[i] += kv[0] * wv[0] + kv[1] * wv[1] + kv[2] * wv[2] + kv[3] * wv[3]; }
      }
      bf16_t* o = weff + ((size_t)layer * 2048 + hp * 128 + key) * 1024 + kb * 64 + kq * 16;
      u32x4 o0, o1;
      o0[0] = pk2(a[0], a[1]); o0[1] = pk2(a[2], a[3]); o0[2] = pk2(a[4], a[5]); o0[3] = pk2(a[6], a[7]);
      o1[0] = pk2(a[8], a[9]); o1[1] = pk2(a[10], a[11]); o1[2] = pk2(a[12], a[13]); o1[3] = pk2(a[14], a[15]);
      *(u32x4*)o = o0; *(u32x4*)(o + 8) = o1;
    }
  }
  {
    bf16_t* d0 = (bf16_t*)(p.ws + WS_DFT0); bf16_t* d1 = (bf16_t*)(p.ws + WS_DFT1); bf16_t* d3 = (bf16_t*)(p.ws + WS_DFT3);
    for (int i = bid * NT + tid; i < 512 * 256; i += nb * NT) {
      const int n = i >> 8, c = i & 255, m = n & 255; const float fr = (float)((m * c) & 255) * (2.f / 256.f);
      d0[i] = (bf16_t)f2bf(n < 256 ? cospif(fr) : -sinpif(fr));
    }
    for (int i = bid * NT + tid; i < 128 * 128; i += nb * NT) {
      const int n = i >> 7, k = i & 127; const int k1 = 32 * (n >> 6) + (n & 31), ro = (n >> 5) & 1, ri = k >> 6, l1 = k & 63;
      const float fr = (float)((k1 * l1) & 63) * (2.f / 64.f); const float cs = cospif(fr), sn = sinpif(fr);
      d1[i] = (bf16_t)f2bf(ro == 0 ? (ri == 0 ? cs : sn) : (ri == 0 ? -sn : cs));
    }
    for (int i = bid * NT + tid; i < 128 * 256; i += nb * NT) {
      const int k2 = i >> 8, k = i & 255, ri = k >> 7, l2 = k & 127; const float fr = (float)((l2 * k2) & 127) * (2.f / 128.f);
      const float scl = 6.905339660024878e-4f;
      d3[i] = (bf16_t)f2bf((ri == 0 ? cospif(fr) : sinpif(fr)) * scl);
    }
  }
}

DI void norm_rows(const float* __restrict__ src, int row_begin, int nrows, const float* __restrict__ nw, const float* __restrict__ modbase  ,
                  int shift_j, int scale_j, bool ctx_tail  , bf16_t* __restrict__ dst, bool blk = false  ) {
  const int lane = otid() & 63, gw = (blk ? 0 : blockIdx.x * (NT / 64)) + (otid() >> 6), nw_ = (blk ? 1 : gridDim.x) * (NT / 64);
  for (int row = row_begin + gw; row < nrows; row += nw_) {
    const int v = (ctx_tail && row >= TL) ? 4 : (row >> 13);
    const float* xr = src + (size_t)row * DM;
    f32x4 xv[4]; float ss = 0.f;
#pragma unroll
    for (int i = 0; i < 4; ++i) { xv[i] = *(const f32x4*)(xr + lane * 4 + 256 * i); ss += xv[i][0] * xv[i][0] + xv[i][1] * xv[i][1] + xv[i][2] * xv[i][2] + xv[i][3] * xv[i][3]; }
    ss = wave_sum(ss);
    const float rs = rsqrtf(ss * (1.f / DM) + EPS);
    const float* sh = modbase + (size_t)v * 6144 + shift_j * 1024; const float* scp = modbase + (size_t)v * 6144 + scale_j * 1024;
#pragma unroll
    for (int i = 0; i < 4; ++i) {
      const int c = lane * 4 + 256 * i;
      const f32x4 w4 = *(const f32x4*)(nw + c), s4 = *(const f32x4*)(sh + c), c4 = *(const f32x4*)(scp + c);
      float y0 = xv[i][0] * rs * w4[0] * (1.f + c4[0]) + s4[0], y1 = xv[i][1] * rs * w4[1] * (1.f + c4[1]) + s4[1];
      float y2 = xv[i][2] * rs * w4[2] * (1.f + c4[2]) + s4[2], y3 = xv[i][3] * rs * w4[3] * (1.f + c4[3]) + s4[3];
      u32x2 o; o[0] = pk2(y0, y1); o[1] = pk2(y2, y3);
      *(u32x2*)(dst + (size_t)row * DM + c) = o;
    }
  }
}

struct EpiProjV {
  const P* p; int row0, col0;
  DI void operator()(f32x16 (&acc)[2][2], int wm, int wn, int lane) const {
    const int cb = col0 + wn * 64, h = lane >> 5, cl = lane & 31;
    const bool isctx = row0 >= TL;
    bf16_t* o = (bf16_t*)(p->ws + WS_VT);
    const int hv = (cb - 3072) >> 7, dvb = (cb - 3072) & 127;
#pragma unroll
    for (int mt = 0; mt < 2; ++mt)
#pragma unroll
      for (int nt = 0; nt < 2; ++nt)
#pragma unroll
        for (int g = 0; g < 4; ++g) {
          const int row = row0 + wm * 64 + mt * 32 + 8 * g + 4 * h;
          int b, pos; if (!isctx) { b = row >> 13; pos = row & (SEQ - 1); } else { const int rc = row - TL; b = rc >> 8; pos = SEQ + (rc & 255); }
          const int dv = dvb + nt * 32 + cl;
          u32x2 v; v[0] = pk2(acc[mt][nt][4 * g], acc[mt][nt][4 * g + 1]); v[1] = pk2(acc[mt][nt][4 * g + 2], acc[mt][nt][4 * g + 3]);
          *(u32x2*)(o + ((size_t)((b * 4 + hv) * 128 + dv)) * KVL + pos) = v;
        }
  }
};
struct EpiProjS {
  const P* p; int row0, col0;
  DI void operator()(f32x16 (&acc)[2][2], int wm, int wn, int lane) const {
    const int cb = col0 + wn * 64, h = lane >> 5, cl = lane & 31;
    const bool isctx = row0 >= TL;
    char* ws = p->ws;
    if (cb < 2048) {
      const bool isg = cb >= 1536;
      if (isg && isctx) return;
      bf16_t* o = (bf16_t*)(ws + (isg ? WS_GATE : WS_QKVRAW));
      const int pitch = isg ? 512 : 1536, cofs = isg ? cb - 1536 : cb;
#pragma unroll
      for (int mt = 0; mt < 2; ++mt) {
        const int row = row0 + wm * 64 + mt * 32 + cl;
#pragma unroll
        for (int nt = 0; nt < 2; ++nt)
#pragma unroll
          for (int g = 0; g < 4; ++g) {
            float v0 = acc[mt][nt][4 * g], v1 = acc[mt][nt][4 * g + 1], v2 = acc[mt][nt][4 * g + 2], v3 = acc[mt][nt][4 * g + 3];
            if (isg) { v0 = silu_f(v0); v1 = silu_f(v1); v2 = silu_f(v2); v3 = silu_f(v3); }
            u32x2 v; v[0] = pk2(v0, v1); v[1] = pk2(v2, v3);
            *(u32x2*)(o + (size_t)row * pitch + cofs + nt * 32 + 8 * g + 4 * h) = v;
          }
      }
    } else if (cb < 3072) {
      const bool isq = cb < 2560;
      if (isq && isctx) return;
      const float* rope = (const float*)(ws + WS_ROPE);
      bf16_t* o = (bf16_t*)(ws + (isq ? WS_Q : WS_K));
      const int cofs = cb - (isq ? 2048 : 2560);
      const float qs = isq ? 0.125f * 1.4426950408889634f : 1.f;
#pragma unroll
      for (int mt = 0; mt < 2; ++mt) {
        const int row = row0 + wm * 64 + mt * 32 + cl;
        size_t orow; int l = 0;
        if (!isctx) { l = row & (SEQ - 1); orow = isq ? (size_t)row : (size_t)(row >> 13) * KVL + l; }
        else { const int rc = row - TL; orow = (size_t)(rc >> 8) * KVL + SEQ + (rc & 255); }
#pragma unroll
        for (int g = 0; g < 4; ++g) {
          const int d0 = 8 * g + 4 * h;
          float o1[4], o2[4];
          if (!isctx) {
            const f32x4 ca = *(const f32x4*)(rope + ((size_t)l * 32 + d0) * 2), cb2 = *(const f32x4*)(rope + ((size_t)l * 32 + d0) * 2 + 4);
            const float cs[4] = {ca[0], ca[2], cb2[0], cb2[2]}, sn[4] = {ca[1], ca[3], cb2[1], cb2[3]};
#pragma unroll
            for (int r = 0; r < 4; ++r) { const float x1 = acc[mt][0][4 * g + r], x2 = acc[mt][1][4 * g + r]; o1[r] = (x1 * cs[r] - x2 * sn[r]) * qs; o2[r] = (x1 * sn[r] + x2 * cs[r]) * qs; }
          } else {
#pragma unroll
            for (int r = 0; r < 4; ++r) { o1[r] = acc[mt][0][4 * g + r]; o2[r] = acc[mt][1][4 * g + r]; }
          }
          u32x2 v; v[0] = pk2(o1[0], o1[1]); v[1] = pk2(o1[2], o1[3]); *(u32x2*)(o + orow * 512 + cofs + d0) = v;
          v[0] = pk2(o2[0], o2[1]); v[1] = pk2(o2[2], o2[3]); *(u32x2*)(o + orow * 512 + cofs + 32 + d0) = v;
        }
      }
    } else if (cb == 3584) {
      float* o = (float*)(ws + WS_BA);
#pragma unroll
      for (int mt = 0; mt < 2; ++mt) {
        const int row = row0 + wm * 64 + mt * 32 + cl;
#pragma unroll
        for (int g = 0; g < 4; ++g) {
          const int j0 = 8 * g + 4 * h;
          f32x4 y;
#pragma unroll
          for (int r = 0; r < 4; ++r) {
            const int j = j0 + r; const float v = acc[mt][0][4 * g + r];
            if (j0 < 16) y[r] = sigmoid_f(v);
            else { const float z = v + p->dt_bias[j - 16]; const float sp = (z > 20.f) ? z : log1pf(__expf(z)); y[r] = -__expf(p->a_log[j - 16]) * sp; }
          }
          *(f32x4*)(o + (size_t)row * 32 + j0) = y;
        }
      }
    }
  }
};

DI void ph_gemm_proj(const P& p, char* lds) {
  const bf16_t* A = (const bf16_t*)(p.ws + R0); const bf16_t* Bt = (const bf16_t*)(p.ws + WS_WIN);
  const int nM = TA / GBM, nN = NIN / GBN;
  for (int t = blockIdx.x; t < nM * nN; t += gridDim.x) {
    const int pm = t / nN, pn = t % nN;
    RowLin rf{A + (size_t)pm * GBM * DM, (size_t)DM};
    if (pn >= 24 && pn < 28) { EpiProjV ep{&p, pm * GBM, pn * GBN}; gemm_tile<false>(lds, rf, Bt + (size_t)pn * GBN * DM, DM, ep); }
    else { EpiProjS ep{&p, pm * GBM, pn * GBN}; gemm_tile<true>(lds, rf, Bt + (size_t)pn * GBN * DM, DM, ep); }
  }
}


struct PgResid {
  static constexpr bool PERM = true, AFTER_DRAIN = false;
  const float* xin; float* xout; const float* gmod;
  DI void operator()(const pg8::f32x4 (&acc)[2][2][4][2], const pg8::Unit& u, int wr, int wc, int fr, int fq) const {
#pragma unroll
    for (int ai = 0; ai < 2; ++ai)
#pragma unroll
      for (int m = 0; m < 4; ++m) {
        const int row = u.pm * 256 + ai * 128 + wr * 64 + m * 16 + fr;
        const float* gm = gmod + (size_t)(row >> 13) * 6144;
#pragma unroll
        for (int bj = 0; bj < 2; ++bj) {
          const int c0 = u.pn * 256 + bj * 128 + wc * 32 + 8 * fq;
#pragma unroll
          for (int n = 0; n < 2; ++n) {
            const f32x4 xv = *(const f32x4*)(xin + (size_t)row * DM + c0 + 4 * n), g4 = *(const f32x4*)(gm + c0 + 4 * n);
            *(f32x4*)(xout + (size_t)row * DM + c0 + 4 * n) = xv + g4 * acc[ai][bj][m][n];
          }
        }
      }
  }
};
struct PgBf16 {
  static constexpr bool PERM = true, AFTER_DRAIN = false;
  bf16_t* o; int pitch;
  DI void operator()(const pg8::f32x4 (&acc)[2][2][4][2], const pg8::Unit& u, int wr, int wc, int fr, int fq) const {
#pragma unroll
    for (int ai = 0; ai < 2; ++ai)
#pragma unroll
      for (int m = 0; m < 4; ++m) {
        const int row = u.pm * 256 + ai * 128 + wr * 64 + m * 16 + fr;
#pragma unroll
        for (int bj = 0; bj < 2; ++bj) {
          const int c0 = u.pn * 256 + bj * 128 + wc * 32 + 8 * fq;
          const f32x4 v0 = acc[ai][bj][m][0], v1 = acc[ai][bj][m][1];
          u32x4 w; w[0] = pk2(v0[0], v0[1]); w[1] = pk2(v0[2], v0[3]); w[2] = pk2(v1[0], v1[1]); w[3] = pk2(v1[2], v1[3]);
          *(u32x4*)(o + (size_t)row * pitch + c0) = w;
        }
      }
  }
};
struct PgProj {
  static constexpr bool PERM = true, AFTER_DRAIN = false;
  const P* p;
  DI void operator()(const pg8::f32x4 (&acc)[2][2][4][2], const pg8::Unit& u, int wr, int wc, int fr, int fq) const {
    char* ws = p->ws;
    const bool isctx = u.pm * 256 >= TL;
#pragma unroll
    for (int bj = 0; bj < 2; ++bj) {
      const int c0 = u.pn * 256 + bj * 128 + wc * 32 + 8 * fq;
      const int cs = u.pn * 256 + bj * 128 + wc * 32;
      if (cs < 2048) {
        const bool isg = cs >= 1536;
        if (isg && isctx) continue;
        bf16_t* o = (bf16_t*)(ws + (isg ? WS_GATE : WS_QKVRAW));
        const int pitch = isg ? 512 : 1536, cofs = isg ? c0 - 1536 : c0;
#pragma unroll
        for (int ai = 0; ai < 2; ++ai)
#pragma unroll
          for (int m = 0; m < 4; ++m) {
            const int row = u.pm * 256 + ai * 128 + wr * 64 + m * 16 + fr;
            f32x4 v0 = acc[ai][bj][m][0], v1 = acc[ai][bj][m][1];
            if (isg) {
#pragma unroll
              for (int r = 0; r < 4; ++r) { v0[r] = silu_f(v0[r]); v1[r] = silu_f(v1[r]); }
            }
            u32x4 w; w[0] = pk2(v0[0], v0[1]); w[1] = pk2(v0[2], v0[3]); w[2] = pk2(v1[0], v1[1]); w[3] = pk2(v1[2], v1[3]);
            *(u32x4*)(o + (size_t)row * pitch + cofs) = w;
          }
      } else if (cs < 3072) {
        const bool isq = cs < 2560;
        if (isq && isctx) continue;
        const float* rope = (const float*)(ws + WS_ROPE);
        bf16_t* o = (bf16_t*)(ws + (isq ? WS_Q : WS_K));
        const int gofs = (c0 & ~63) - (isq ? 2048 : 2560), d0 = ((c0 & 63) >> 3) * 4;
        const float qs = isq ? 0.125f * 1.4426950408889634f : 1.f;
#pragma unroll
        for (int ai = 0; ai < 2; ++ai)
#pragma unroll
          for (int m = 0; m < 4; ++m) {
            const int row = u.pm * 256 + ai * 128 + wr * 64 + m * 16 + fr;
            const f32x4 x1 = acc[ai][bj][m][0], x2 = acc[ai][bj][m][1];
            size_t orow; float o1[4], o2[4];
            if (!isctx) {
              const int l = row & (SEQ - 1);
              orow = isq ? (size_t)row : (size_t)(row >> 13) * KVL + l;
              const f32x4 ca = *(const f32x4*)(rope + ((size_t)l * 32 + d0) * 2), cb2 = *(const f32x4*)(rope + ((size_t)l * 32 + d0) * 2 + 4);
              const float cs4[4] = {ca[0], ca[2], cb2[0], cb2[2]}, sn4[4] = {ca[1], ca[3], cb2[1], cb2[3]};
#pragma unroll
              for (int r = 0; r < 4; ++r) { o1[r] = (x1[r] * cs4[r] - x2[r] * sn4[r]) * qs; o2[r] = (x1[r] * sn4[r] + x2[r] * cs4[r]) * qs; }
            } else {
              const int rc = row - TL; orow = (size_t)(rc >> 8) * KVL + SEQ + (rc & 255);
#pragma unroll
              for (int r = 0; r < 4; ++r) { o1[r] = x1[r]; o2[r] = x2[r]; }
            }
            u32x2 v; v[0] = pk2(o1[0], o1[1]); v[1] = pk2(o1[2], o1[3]); *(u32x2*)(o + orow * 512 + gofs + d0) = v;
            v[0] = pk2(o2[0], o2[1]); v[1] = pk2(o2[2], o2[3]); *(u32x2*)(o + orow * 512 + gofs + 32 + d0) = v;
          }
      } else if (cs < 3584) {
        bf16_t* o = (bf16_t*)(ws + WS_VT);
        const int hv = (c0 - 3072) >> 7, dv0 = (c0 - 3072) & 127;
#pragma unroll
        for (int ai = 0; ai < 2; ++ai)
#pragma unroll
          for (int m = 0; m < 4; ++m) {
            const int row = u.pm * 256 + ai * 128 + wr * 64 + m * 16 + fr;
            int b, pos; if (!isctx) { b = row >> 13; pos = row & (SEQ - 1); } else { const int rc = row - TL; b = rc >> 8; pos = SEQ + (rc & 255); }
            bf16_t* op = o + ((size_t)((b * 4 + hv) * 128 + dv0)) * KVL + pos;
#pragma unroll
            for (int n = 0; n < 2; ++n)
#pragma unroll
              for (int r = 0; r < 4; ++r) op[(size_t)(4 * n + r) * KVL] = (bf16_t)f2bf(acc[ai][bj][m][n][r]);
          }
      } else if (cs == 3584) {
        float* o = (float*)(ws + WS_BA);
        const int j0 = c0 - 3584;
#pragma unroll
        for (int ai = 0; ai < 2; ++ai)
#pragma unroll
          for (int m = 0; m < 4; ++m) {
            const int row = u.pm * 256 + ai * 128 + wr * 64 + m * 16 + fr;
#pragma unroll
            for (int n = 0; n < 2; ++n) {
              f32x4 y;
#pragma unroll
              for (int r = 0; r < 4; ++r) {
                const int j = j0 + 4 * n + r; const float v = acc[ai][bj][m][n][r];
                if (j0 < 16) y[r] = sigmoid_f(v);
                else { const float z = v + p->dt_bias[j - 16]; const float sp = (z > 20.f) ? z : log1pf(__expf(z)); y[r] = -__expf(p->a_log[j - 16]) * sp; }
              }
              *(f32x4*)(o + (size_t)row * 32 + j0 + 4 * n) = y;
            }
          }
      }
    }
  }
};
template <class Epi>
DI void pg8_run(char* lds, const bf16_t* A, const bf16_t* Bt, int M, int N, int K, const Epi& E) {
  pg8::Gemm g{A, Bt, M, N, K};
  pg8::StaticOrder S; S.init(M, N, (int)gridDim.x, (int)blockIdx.x);
  pg8::gemm_phase<Epi, pg8::StaticOrder, true, true>((PG8_LAS unsigned char*)lds, g, S, E);
}

DI void gdn_solve(const float* MT, const float* src  , const float* be, const float* gc  ,
                  int d, int part, int lane, bf16_t* uo) {
  float a[64];
#pragma unroll
  for (int i = 0; i < 64; ++i) {
    const int t = d ? 63 - i : i;
    float v = be[t] * src[t * 68 + lane];
    if (part) v *= __expf(gc[t]);
    a[i] = v;
  }
#pragma unroll
  for (int j = 0; j < 63; ++j) {
    const float xj = a[j];
#pragma unroll
    for (int i4 = ((j + 1) & ~3); i4 < 64; i4 += 4) {
      const f32x4 m = *(const f32x4*)(MT + j * 68 + i4);
#pragma unroll
      for (int q = 0; q < 4; ++q) if (i4 + q > j) a[i4 + q] -= m[q] * xj;
    }
  }
  if (part) {
#pragma unroll
    for (int i = 0; i < 64; ++i) uo[i * 64 + lane] = (bf16_t)f2bf(a[i]);
  } else {
#pragma unroll
    for (int c = 0; c < 8; ++c) {
      u32x4 o; o[0] = pk2(a[8 * c], a[8 * c + 1]); o[1] = pk2(a[8 * c + 2], a[8 * c + 3]); o[2] = pk2(a[8 * c + 4], a[8 * c + 5]); o[3] = pk2(a[8 * c + 6], a[8 * c + 7]);
      *(u32x4*)(uo + lane * 64 + 8 * c) = o;
    }
  }
}

template <int MODE = 0>
DI void ph_gdn_prep(const P& p, char* lds) {
  const int tid0 = otid();
  float* L = (float*)lds;
  constexpr int HSZ = 4 * 64 * 68 + 6 * 64;
  const bf16_t* raw = (const bf16_t*)(p.ws + WS_QKVRAW);
  const float* BA = (const float*)(p.ws + WS_BA);
  bf16_t* qn = (bf16_t*)(p.ws + WS_QN); bf16_t* kn = (bf16_t*)(p.ws + WS_KN);
  float* GC = (float*)(p.ws + WS_GC);
  bf16_t* UW = (bf16_t*)(p.ws + WS_UW);
  for (int it = blockIdx.x; it < NB * NCH * 4; it += gridDim.x) {
    int tid = tid0; asm volatile("" : "+v"(tid));
    const int lane = tid & 63, wave = __builtin_amdgcn_readfirstlane(tid >> 6);
    const int hpair = it & 3, cid = (it >> 2) % NCH, b = it / (4 * NCH);
    const int segbase = (cid < 4) ? TL + b * CTXL : b * SEQ, c0 = (cid < 4) ? cid * 64 : (cid - 4) * 64, seglen = (cid < 4) ? CTXL : SEQ;
    __syncthreads();
    {
      const int t = tid >> 3, c8 = tid & 7, sidx = c0 + t;
      const size_t grow = (size_t)(segbase + sidx);
      const bool hm = sidx - 1 >= 0, hp_ = sidx + 1 < seglen;
#pragma unroll
      for (int hh = 0; hh < 2; ++hh) {
        const int head = hpair * 2 + hh;
        float* kf = L + hh * HSZ; float* vf = kf + 64 * 68;
#pragma unroll
        for (int part = 0; part < 3; ++part) {
          const int ch = part * 512 + head * 64 + c8 * 8;
          const u32x4 z4 = {0u, 0u, 0u, 0u};
          const u32x4 rm = hm ? *(const u32x4*)(raw + (grow - 1) * 1536 + ch) : z4;
          const u32x4 r0v = *(const u32x4*)(raw + grow * 1536 + ch);
          const u32x4 rp = hp_ ? *(const u32x4*)(raw + (grow + 1) * 1536 + ch) : z4;
          float v[8]; float ss = 0.f;
#pragma unroll
          for (int w = 0; w < 4; ++w) {
            const f32x2_t w0 = *(const f32x2_t*)(p.conv_w + ch + 2 * w), w1 = *(const f32x2_t*)(p.conv_w + 1536 + ch + 2 * w), w2 = *(const f32x2_t*)(p.conv_w + 3072 + ch + 2 * w);
            v[2 * w] = silu_f(w0[0] * bflo(rm[w]) + w1[0] * bflo(r0v[w]) + w2[0] * bflo(rp[w]));
            v[2 * w + 1] = silu_f(w0[1] * bfhi(rm[w]) + w1[1] * bfhi(r0v[w]) + w2[1] * bfhi(rp[w]));
            ss += v[2 * w] * v[2 * w] + v[2 * w + 1] * v[2 * w + 1];
          }
          if (part < 2) {
            ss += __shfl_xor(ss, 1, 64); ss += __shfl_xor(ss, 2, 64); ss += __shfl_xor(ss, 4, 64);
            const float rn = rsqrtf(ss + EPS) * (part == 0 ? 0.125f : 1.f);
#pragma unroll
            for (int w = 0; w < 8; ++w) v[w] *= rn;
            u32x4 o; o[0] = pk2(v[0], v[1]); o[1] = pk2(v[2], v[3]); o[2] = pk2(v[4], v[5]); o[3] = pk2(v[6], v[7]);
            *(u32x4*)((part == 0 ? qn : kn) + grow * 512 + head * 64 + c8 * 8) = o;
          }
          if (part >= 1) {
            float* dst = (part == 1 ? kf : vf) + t * 68 + c8 * 8;
            *(f32x4*)dst = f32x4{v[0], v[1], v[2], v[3]}; *(f32x4*)(dst + 4) = f32x4{v[4], v[5], v[6], v[7]};
          }
        }
      }
    }
    if (MODE == 2) continue;
    if (wave < 4) {
      const int hh = wave >> 1, d = wave & 1, head = hpair * 2 + hh, t = lane;
      float* be = L + hh * HSZ + 4 * 64 * 68;
      const size_t row = (size_t)(segbase + c0 + t);
      be[d * 64 + t] = BA[row * 32 + d * 8 + head];
      const float g = BA[row * 32 + 16 + d * 8 + head];
      float a = g;
#pragma unroll
      for (int o = 1; o < 64; o <<= 1) {
        const float nb_ = d ? __shfl_down(a, o, 64) : __shfl_up(a, o, 64);
        const bool ok = d ? (lane + o < 64) : (lane >= o);
        a += ok ? nb_ : 0.f;
      }
      be[256 + d * 64 + t] = a;
      GC[((size_t)((b * 8 + head) * 2 + d) * NCH + cid) * 64 + (d ? 63 - t : t)] = a;
    }
    __syncthreads();
    {
      const int hh = wave >> 2, Ln = lane;
      float* kf = L + hh * HSZ; float* M0 = kf + 2 * 64 * 68; float* M1 = kf + 3 * 64 * 68; float* be = kf + 4 * 64 * 68; float* gc = be + 256;
      float a[16];
#pragma unroll
      for (int i = 0; i < 16; ++i) a[i] = 0.f;
#pragma unroll 1
      for (int c = 0; c < 64; c += 4) {
        const f32x4 kv = *(const f32x4*)(kf + Ln * 68 + c);
#pragma unroll
        for (int i = 0; i < 16; ++i) { const f32x4 kr = *(const f32x4*)(kf + ((wave & 3) * 16 + i) * 68 + c); a[i] += kv[0] * kr[0] + kv[1] * kr[1] + kv[2] * kr[2] + kv[3] * kr[3]; }
      }
      const float b0 = be[Ln], b1 = be[64 + Ln], g0 = gc[Ln], g1 = gc[64 + Ln];
#pragma unroll
      for (int i = 0; i < 16; ++i) {
        const int ti = (wave & 3) * 16 + i;
        if (Ln > ti) M0[ti * 68 + Ln] = b0 * a[i] * __expf(g0 - gc[ti]);
        else if (Ln < ti) M1[(63 - ti) * 68 + 63 - Ln] = b1 * a[i] * __expf(g1 - gc[64 + ti]);
      }
    }
    __syncthreads();
    if (MODE == 0) {
      const int hh = wave >> 2, d = (wave >> 1) & 1, part = wave & 1, head = hpair * 2 + hh;
      float* kf = L + hh * HSZ; float* vf = kf + 64 * 68; float* Md = kf + (2 + d) * 64 * 68; float* be = kf + 4 * 64 * 68; float* gc = be + 256;
      bf16_t* uo = UW + (((size_t)((b * 8 + head) * 2 + d) * NCH + cid) * 2 + part) * 4096;
      gdn_solve(Md, part ? kf : vf, be + d * 64, gc + d * 64, d, part, lane, uo);
    }
  }
}

#define MFMA16(a, b, c) __builtin_amdgcn_mfma_f32_16x16x32_bf16((a), (b), (c), 0, 0, 0)
constexpr int SC_LD = 72;
constexpr int SC_T = 64 * SC_LD * 2;
constexpr int SC_STAGE = 5 * SC_T + 1024;
constexpr int SC_KNL = 2 * SC_STAGE, SC_QNL = SC_KNL + SC_T;
DI bf16x8 pack8(const f32x4& a, const f32x4& b) { u32x4 r; r[0] = cvtpk(a[0], a[1]); r[1] = cvtpk(a[2], a[3]); r[2] = cvtpk(b[0], b[1]); r[3] = cvtpk(b[2], b[3]); return __builtin_bit_cast(bf16x8, r); }
DI bf16x8 afrag(const char* tile, int row, int kofs  ) {
  const char* pr = tile + (row * SC_LD + kofs) * 2;
  const u32x2 lo = *(const u32x2*)pr, hi = *(const u32x2*)(pr + 32);
  u32x4 r; r[0] = lo[0]; r[1] = lo[1]; r[2] = hi[0]; r[3] = hi[1];
  return __builtin_bit_cast(bf16x8, r);
}
template <int NOSTORE = 0>
DI void ph_gdn_scan(const P& p, char* lds) {
  const int tid = otid(), lane = tid & 63, wave = __builtin_amdgcn_readfirstlane(tid >> 6);
  const int c = lane & 15, q = lane >> 4;
  const bf16_t* qn = (const bf16_t*)(p.ws + WS_QN); const bf16_t* kn = (const bf16_t*)(p.ws + WS_KN);
  const float* GC = (const float*)(p.ws + WS_GC);
  const bf16_t* UW = (const bf16_t*)(p.ws + WS_UW);
  bf16_t* Ob = (bf16_t*)(p.ws + WS_OBUF);
  for (int it = blockIdx.x; it < 64; it += gridDim.x) {
    const int bhd = it, d = bhd & 1, head = (bhd >> 1) & 7, b = bhd >> 4;
    __syncthreads();
    if (wave >= 4) {
      const int pt = tid - 256;
      const int r0 = pt >> 3, cc = pt & 7;
      u32x4 rW0A, rW1A, rU0A, rU1A, rK0A, rK1A, rQ0A, rQ1A; f32x4 rGA;
      u32x4 rW0B, rW1B, rU0B, rU1B, rK0B, rK1B, rQ0B, rQ1B; f32x4 rGB;
#define SP_CID(n) (d ? ((n) < 4 ? 3 - (n) : 135 - (n)) : (n))
#define SP_LOAD(n, S) do { const int nn_ = (n) < NCH ? (n) : NCH - 1; const int cid_ = SP_CID(nn_); const bool lat_ = cid_ >= 4; const int sb_ = lat_ ? b * SEQ : TL + b * CTXL, c0_ = lat_ ? (cid_ - 4) * 64 : cid_ * 64; \
        const bf16_t* uw_ = UW + ((size_t)(bhd * NCH + cid_) * 2) * 4096; \
        rU0##S = *(const u32x4*)(uw_ + r0 * 64 + cc * 8); rU1##S = *(const u32x4*)(uw_ + (r0 + 32) * 64 + cc * 8); \
        rW0##S = *(const u32x4*)(uw_ + 4096 + r0 * 64 + cc * 8); rW1##S = *(const u32x4*)(uw_ + 4096 + (r0 + 32) * 64 + cc * 8); \
        const int t0_ = d ? 63 - r0 : r0, t1_ = d ? 31 - r0 : r0 + 32; \
        rK0##S = *(const u32x4*)(kn + (size_t)(sb_ + c0_ + t0_) * 512 + head * 64 + cc * 8); rK1##S = *(const u32x4*)(kn + (size_t)(sb_ + c0_ + t1_) * 512 + head * 64 + cc * 8); \
        const bf16_t* qk_ = lat_ ? qn : kn;     \
        rQ0##S = *(const u32x4*)(qk_ + (size_t)(sb_ + c0_ + t0_) * 512 + head * 64 + cc * 8); rQ1##S = *(const u32x4*)(qk_ + (size_t)(sb_ + c0_ + t1_) * 512 + head * 64 + cc * 8); \
        rG##S = *(const f32x4*)(GC + (size_t)(bhd * NCH + cid_) * 64 + (pt & 15) * 4); } while (0)
#define SP_A(n, S) do { char* st_ = lds + ((n) & 1) * SC_STAGE; const int o0_ = (r0 * SC_LD + cc * 8) * 2, o1_ = o0_ + 32 * SC_LD * 2; \
        *(u32x4*)(st_ + o0_) = rW0##S; *(u32x4*)(st_ + o1_) = rW1##S; *(u32x4*)(st_ + SC_T + o0_) = rU0##S; *(u32x4*)(st_ + SC_T + o1_) = rU1##S; \
        *(u32x4*)(lds + SC_KNL + o0_) = rK0##S; *(u32x4*)(lds + SC_KNL + o1_) = rK1##S; \
        *(u32x4*)(lds + SC_QNL + o0_) = rQ0##S; *(u32x4*)(lds + SC_QNL + o1_) = rQ1##S; \
        if (pt < 16) { float* gp_ = (float*)(st_ + 5 * SC_T); *(f32x4*)(gp_ + pt * 4) = rG##S; } } while (0)
#define SP_B(n) do { char* st_ = lds + ((n) & 1) * SC_STAGE; float* gp_ = (float*)(st_ + 5 * SC_T); const bool lat_ = SP_CID((n) < NCH ? (n) : NCH - 1) >= 4; \
        const float gl_ = gp_[63]; \
        if (pt < 64) { const float gi_ = gp_[pt]; gp_[64 + pt] = __expf(gi_); gp_[128 + pt] = __expf(gl_ - gi_); if (pt == 0) gp_[192] = __expf(gl_); } \
        {   \
          const int i_ = pt & 63; \
          _Pragma("unroll") for (int e_ = 0; e_ < 2; ++e_) { const int ch_ = (pt >> 6) * 2 + e_; const u32x4 kv_ = *(const u32x4*)(lds + SC_KNL + (i_ * SC_LD + ch_ * 8) * 2); \
            bf16_t* kt_ = (bf16_t*)(st_ + 2 * SC_T); \
            _Pragma("unroll") for (int w_ = 0; w_ < 4; ++w_) { kt_[(ch_ * 8 + 2 * w_) * SC_LD + i_] = (bf16_t)(kv_[w_] & 0xFFFFu); kt_[(ch_ * 8 + 2 * w_ + 1) * SC_LD + i_] = (bf16_t)(kv_[w_] >> 16); } } } \
        if (lat_) { \
          {   \
            _Pragma("unroll") for (int e_ = 0; e_ < 2; ++e_) { const int rr_ = r0 + 32 * e_; const float sc_ = __expf(gp_[rr_]); const u32x4 qv_ = *(const u32x4*)(lds + SC_QNL + (rr_ * SC_LD + cc * 8) * 2); u32x4 ov_; \
              _Pragma("unroll") for (int w_ = 0; w_ < 4; ++w_) ov_[w_] = cvtpk(bflo(qv_[w_]) * sc_, bfhi(qv_[w_]) * sc_); \
              *(u32x4*)(st_ + 3 * SC_T + (rr_ * SC_LD + cc * 8) * 2) = ov_; } } \
          {   \
            const int jt_ = wave - 4; \
            const bf16x8 ka0_ = *(const bf16x8*)(lds + SC_KNL + ((16 * jt_ + c) * SC_LD + 8 * q) * 2), ka1_ = *(const bf16x8*)(lds + SC_KNL + ((16 * jt_ + c) * SC_LD + 32 + 8 * q) * 2); \
            bf16x8 qb_[4][2]; \
            _Pragma("unroll") for (int it_ = 0; it_ < 4; ++it_) { qb_[it_][0] = *(const bf16x8*)(lds + SC_QNL + ((16 * it_ + c) * SC_LD + 8 * q) * 2); qb_[it_][1] = *(const bf16x8*)(lds + SC_QNL + ((16 * it_ + c) * SC_LD + 32 + 8 * q) * 2); } \
            const f32x4 gj_ = *(const f32x4*)(gp_ + 16 * jt_ + 4 * q); \
            float gi_[4]; _Pragma("unroll") for (int it_ = 0; it_ < 4; ++it_) gi_[it_] = gp_[16 * it_ + c]; \
            _Pragma("unroll") for (int it_ = 0; it_ < 4; ++it_) { \
              f32x4 ac_ = {0.f, 0.f, 0.f, 0.f}; \
              ac_ = MFMA16(ka0_, qb_[it_][0], ac_); ac_ = MFMA16(ka1_, qb_[it_][1], ac_); \
              const int i_ = 16 * it_ + c; \
              _Pragma("unroll") for (int r_ = 0; r_ < 4; ++r_) { const int j_ = 16 * jt_ + 4 * q + r_; const float e_ = __expf(fminf(gi_[it_] - gj_[r_], 0.f)); ac_[r_] = (i_ >= j_) ? ac_[r_] * e_ : 0.f; } \
              u32x2 ov_; ov_[0] = cvtpk(ac_[0], ac_[1]); ov_[1] = cvtpk(ac_[2], ac_[3]); \
              *(u32x2*)(st_ + 4 * SC_T + ((16 * it_ + c) * SC_LD + 16 * jt_ + 4 * q) * 2) = ov_; } } } } while (0)
      SP_LOAD(0, A); SP_LOAD(1, B);
      SP_A(0, A);
      __syncthreads();
      SP_B(0);
      SP_LOAD(2, A);
      __syncthreads();
#define SP_STEP(n, S) do { SP_A((n) + 1, S); SP_LOAD((n) + 3, S);        \
        __syncthreads();                 \
        SP_B((n) + 1); \
        __syncthreads();                 } while (0)
#pragma unroll 1
      for (int n = 0; n < NCH; n += 2) { SP_STEP(n, B); SP_STEP(n + 1, A); }
#undef SP_STEP
#undef SP_LOAD
#undef SP_A
#undef SP_B
    } else {
      f32x4 S[4];
#pragma unroll
      for (int i = 0; i < 4; ++i) S[i] = f32x4{0.f, 0.f, 0.f, 0.f};
      __syncthreads();
      __syncthreads();
#pragma unroll 1
      for (int n = 0; n < NCH; ++n) {
        const int cid = SP_CID(n); const bool lat = cid >= 4;
        const char* st = lds + (n & 1) * SC_STAGE; const float* gp = (const float*)(st + 5 * SC_T);
        bf16x8 Sb[2], Sn[2];
#pragma unroll
        for (int ks = 0; ks < 2; ++ks) {
          Sb[ks] = pack8(S[2 * ks], S[2 * ks + 1]);
          u32x4 t = __builtin_bit_cast(u32x4, Sb[ks]);
#pragma unroll
          for (int w = 0; w < 4; ++w) t[w] ^= 0x80008000u;
          Sn[ks] = __builtin_bit_cast(bf16x8, t);
        }
        u32x2 ur[4]; bf16x8 wf[4][2], kf2[4][2]; f32x4 sc4[4];
#pragma unroll
        for (int mt = 0; mt < 4; ++mt) {
          ur[mt] = *(const u32x2*)(st + SC_T + ((16 * wave + c) * SC_LD + 16 * mt + 4 * q) * 2);
          wf[mt][0] = afrag(st, 16 * mt + c, 4 * q); wf[mt][1] = afrag(st, 16 * mt + c, 32 + 4 * q);
          sc4[mt] = *(const f32x4*)(gp + 128 + 16 * mt + 4 * q);
        }
#pragma unroll
        for (int dt = 0; dt < 4; ++dt) { kf2[dt][0] = afrag(st + 2 * SC_T, 16 * dt + c, 4 * q); kf2[dt][1] = afrag(st + 2 * SC_T, 16 * dt + c, 32 + 4 * q); }
        const float gt = gp[192];
        f32x4 vn[4], vs[4];
#pragma unroll
        for (int mt = 0; mt < 4; ++mt) {
          f32x4 acc = {bflo(ur[mt][0]), bfhi(ur[mt][0]), bflo(ur[mt][1]), bfhi(ur[mt][1])};
          acc = MFMA16(wf[mt][0], Sn[0], acc);
          acc = MFMA16(wf[mt][1], Sn[1], acc);
          vn[mt] = acc;
          vs[mt] = acc * sc4[mt];
        }
        bf16x8 Vn[2], Vs[2];
#pragma unroll
        for (int ks = 0; ks < 2; ++ks) { Vn[ks] = pack8(vn[2 * ks], vn[2 * ks + 1]); Vs[ks] = pack8(vs[2 * ks], vs[2 * ks + 1]); }
        f32x4 Snew[4];
#pragma unroll
        for (int dt = 0; dt < 4; ++dt) {
          f32x4 acc = S[dt] * gt;
          acc = MFMA16(kf2[dt][0], Vs[0], acc);
          acc = MFMA16(kf2[dt][1], Vs[1], acc);
          Snew[dt] = acc;
        }
        __syncthreads();
        if (lat) {
          const int sb = b * SEQ, c0 = (cid - 4) * 64;
          bf16x8 qf[4][2], pf[4][2];
#pragma unroll
          for (int mt = 0; mt < 4; ++mt) {
            qf[mt][0] = afrag(st + 3 * SC_T, 16 * mt + c, 4 * q); qf[mt][1] = afrag(st + 3 * SC_T, 16 * mt + c, 32 + 4 * q);
            pf[mt][0] = afrag(st + 4 * SC_T, 16 * mt + c, 4 * q); pf[mt][1] = afrag(st + 4 * SC_T, 16 * mt + c, 32 + 4 * q);
          }
#pragma unroll
          for (int mt = 0; mt < 4; ++mt) {
            f32x4 o = {0.f, 0.f, 0.f, 0.f};
            o = MFMA16(Sb[0], qf[mt][0], o);
            o = MFMA16(Sb[1], qf[mt][1], o);
            o = MFMA16(Vn[0], pf[mt][0], o);
            o = MFMA16(Vn[1], pf[mt][1], o);
            const int i = 16 * mt + c, t = d ? 63 - i : i;
            u32x2 ov; ov[0] = cvtpk(o[0], o[1]); ov[1] = cvtpk(o[2], o[3]);
            if (!NOSTORE || ov[0] == 0x12345678u) *(u32x2*)(Ob + ((size_t)d * TL + sb + c0 + t) * 512 + head * 64 + 16 * wave + 4 * q) = ov;
          }
        }
#pragma unroll
        for (int dt = 0; dt < 4; ++dt) S[dt] = Snew[dt];
        __syncthreads();
      }
    }
#undef SP_CID
  }
}

constexpr int AT_KROW = 72, AT_VROW = 68;
constexpr int AT_KB = 2 * 64 * AT_KROW * 2, AT_VB = 128 * AT_VROW * 2, AT_STAGE = AT_KB + AT_VB;
DI void ph_attn(const P& p, char* lds) {
  const int tid = otid(), lane = tid & 63, wave = tid >> 6, wq = wave & 3, m = wave >> 2, h = lane >> 5, cl = lane & 31;
  const bf16_t* Qb = (const bf16_t*)(p.ws + WS_Q); const bf16_t* Kb = (const bf16_t*)(p.ws + WS_K); const bf16_t* VT = (const bf16_t*)(p.ws + WS_VT);
  bf16_t* mix = (bf16_t*)(p.ws + WS_MIX);
  for (int it = blockIdx.x; it < NB * 4 * 64; it += gridDim.x) {
    const int qb = it & 63, head = (it >> 6) & 3, b = it >> 8;
    const int qrow = b * SEQ + qb * 128 + wq * 32 + cl;
    bf16x8 qf[4];
#pragma unroll
    for (int kk = 0; kk < 4; ++kk) qf[kk] = *(const bf16x8*)(Qb + (size_t)qrow * 512 + (head * 2 + m) * 64 + kk * 16 + h * 8);
    f32x16 o[4];
#pragma unroll
    for (int i = 0; i < 4; ++i)
#pragma unroll
      for (int r = 0; r < 16; ++r) o[i][r] = 0.f;
    float mrun = -1e30f, lrun = 0.f;
    const bf16_t* kp0 = Kb + ((size_t)b * KVL + (tid >> 4)) * 512 + head * 128 + (tid & 15) * 8;
    const bf16_t* kp1 = kp0 + (size_t)32 * 512;
    const bf16_t* vp0 = VT + ((size_t)((b * 4 + head) * 128 + (tid >> 3))) * KVL + (tid & 7) * 8;
    const bf16_t* vp1 = vp0 + (size_t)64 * KVL;
    const int kw0 = ((((tid & 15) >> 3) * 64 + (tid >> 4)) * AT_KROW + ((tid & 15) & 7) * 8) * 2, kw1 = kw0 + 32 * AT_KROW * 2;
    const int vw0 = AT_KB + ((tid >> 3) * AT_VROW + (tid & 7) * 8) * 2, vw1 = vw0 + 64 * AT_VROW * 2;
    u32x4 rk0, rk1, rv0, rv1;
#define A_GLOAD(kv0) do { rk0 = *(const u32x4*)(kp0 + (size_t)(kv0) * 512); rk1 = *(const u32x4*)(kp1 + (size_t)(kv0) * 512); rv0 = *(const u32x4*)(vp0 + (kv0)); rv1 = *(const u32x4*)(vp1 + (kv0)); } while (0)
#define A_LWRITE(st) do { char* b_ = lds + (st) * AT_STAGE; *(u32x4*)(b_ + kw0) = rk0; *(u32x4*)(b_ + kw1) = rk1; \
      u32x2 t_; t_[0] = rv0[0]; t_[1] = rv0[1]; *(u32x2*)(b_ + vw0) = t_; t_[0] = rv0[2]; t_[1] = rv0[3]; *(u32x2*)(b_ + vw0 + 8) = t_; \
      t_[0] = rv1[0]; t_[1] = rv1[1]; *(u32x2*)(b_ + vw1) = t_; t_[0] = rv1[2]; t_[1] = rv1[3]; *(u32x2*)(b_ + vw1 + 8) = t_; } while (0)
    A_GLOAD(0);
    __syncthreads();
    A_LWRITE(0);
    __syncthreads();
    constexpr int NKT = KVL / 64;
    for (int kt = 0; kt < NKT; ++kt) {
      if (kt + 1 < NKT) A_GLOAD((kt + 1) * 64);
      const char* sb = lds + (kt & 1) * AT_STAGE;
      const char* ks = sb + (m * 64 * AT_KROW) * 2;
      f32x16 st[2];
#pragma unroll
      for (int k2 = 0; k2 < 2; ++k2) {
#pragma unroll
        for (int r = 0; r < 16; ++r) st[k2][r] = 0.f;
#pragma unroll
        for (int kk = 0; kk < 4; ++kk) {
          const bf16x8 a = *(const bf16x8*)(ks + ((k2 * 32 + cl) * AT_KROW + kk * 16 + h * 8) * 2);
          st[k2] = MFMA32(a, qf[kk], st[k2]);
        }
      }
      float mx = fmaxf(st[0][0], st[1][0]);
#pragma unroll
      for (int r = 1; r < 16; ++r) mx = fmaxf(mx, fmaxf(st[0][r], st[1][r]));
      mx = fmaxf(mx, __shfl_xor(mx, 32, 64));
      if (__any(mx > mrun + 8.f)) {
        const float mnew = fmaxf(mrun, mx);
        const float alpha = __builtin_amdgcn_exp2f(mrun - mnew);
        mrun = mnew; lrun *= alpha;
#pragma unroll
        for (int i = 0; i < 4; ++i)
#pragma unroll
          for (int r = 0; r < 16; ++r) o[i][r] *= alpha;
      }
      float rs = 0.f;
#pragma unroll
      for (int k2 = 0; k2 < 2; ++k2)
#pragma unroll
        for (int r = 0; r < 16; ++r) { const float pv = __builtin_amdgcn_exp2f(st[k2][r] - mrun); st[k2][r] = pv; rs += pv; }
      lrun += rs;
      const char* vsb = sb + AT_KB;
#pragma unroll
      for (int k2 = 0; k2 < 2; ++k2)
#pragma unroll
        for (int s = 0; s < 2; ++s) {
          u32x4 pb;
          pb[0] = cvtpk(st[k2][8 * s + 0], st[k2][8 * s + 1]); pb[1] = cvtpk(st[k2][8 * s + 2], st[k2][8 * s + 3]);
          pb[2] = cvtpk(st[k2][8 * s + 4], st[k2][8 * s + 5]); pb[3] = cvtpk(st[k2][8 * s + 6], st[k2][8 * s + 7]);
          const bf16x8 pfrag = __builtin_bit_cast(bf16x8, pb);
#pragma unroll
          for (int dt = 0; dt < 4; ++dt) {
            const char* vr = vsb + ((dt * 32 + cl) * AT_VROW + k2 * 32 + 16 * s + 4 * h) * 2;
            const u32x2 lo = *(const u32x2*)(vr), hi = *(const u32x2*)(vr + 16);
            u32x4 av; av[0] = lo[0]; av[1] = lo[1]; av[2] = hi[0]; av[3] = hi[1];
            o[dt] = MFMA32(__builtin_bit_cast(bf16x8, av), pfrag, o[dt]);
          }
        }
      if (kt + 1 < NKT) A_LWRITE((kt + 1) & 1);
      __syncthreads();
    }
#undef A_GLOAD
#undef A_LWRITE
    const float ltot = lrun + __shfl_xor(lrun, 32, 64);
    const float inv = 1.f / ltot;
    float* X = (float*)lds;
    if (m == 1) {
#pragma unroll
      for (int dt = 0; dt < 4; ++dt)
#pragma unroll
        for (int r = 0; r < 16; ++r) X[(wq * 32 + cl) * 129 + dt * 32 + crow(r, h)] = o[dt][r] * inv;
    }
    __syncthreads();
    if (m == 0) {
      float l1 = 0.f, l2 = 0.f;
      for (int i = 0; i < 64; ++i) { l1 += p.lam_q1[i] * p.lam_k1[i]; l2 += p.lam_q2[i] * p.lam_k2[i]; }
      const float lam = __expf(l1) - __expf(l2) + 0.2f;
      float ss = 0.f;
#pragma unroll
      for (int dt = 0; dt < 4; ++dt)
#pragma unroll
        for (int r = 0; r < 16; ++r) { const float dv = o[dt][r] * inv - lam * X[(wq * 32 + cl) * 129 + dt * 32 + crow(r, h)]; o[dt][r] = dv; ss += dv * dv; }
      ss += __shfl_xor(ss, 32, 64);
      const float rn = rsqrtf(ss * (1.f / 128.f) + EPS) * 0.8f;
#pragma unroll
      for (int dt = 0; dt < 4; ++dt)
#pragma unroll
        for (int g = 0; g < 4; ++g) {
          const int dv = dt * 32 + 8 * g + 4 * h;
          const f32x4 w4 = *(const f32x4*)(p.subln_w + dv);
          u32x2 v; v[0] = pk2(o[dt][4 * g] * rn * w4[0], o[dt][4 * g + 1] * rn * w4[1]); v[1] = pk2(o[dt][4 * g + 2] * rn * w4[2], o[dt][4 * g + 3] * rn * w4[3]);
          *(u32x2*)(mix + (size_t)qrow * DM + 512 + head * 128 + dv) = v;
        }
    }
    __syncthreads();
  }
}

DI void ph_mixout(const P& p) {
  const int lane = otid() & 63, gw = blockIdx.x * (NT / 64) + (otid() >> 6), nw_ = gridDim.x * (NT / 64);
  const bf16_t* Ob = (const bf16_t*)(p.ws + WS_OBUF); const bf16_t* gate = (const bf16_t*)(p.ws + WS_GATE);
  bf16_t* mix = (bf16_t*)(p.ws + WS_MIX);
  for (int row = gw; row < TL; row += nw_) {
    const u32x4 a = *(const u32x4*)(Ob + (size_t)row * 512 + lane * 8), bq = *(const u32x4*)(Ob + ((size_t)TL + row) * 512 + lane * 8);
    const u32x4 gv = *(const u32x4*)(gate + (size_t)row * 512 + lane * 8);
    float v[8]; float ss = 0.f;
#pragma unroll
    for (int i = 0; i < 4; ++i) { v[2 * i] = bflo(a[i]) + bflo(bq[i]); v[2 * i + 1] = bfhi(a[i]) + bfhi(bq[i]); ss += v[2 * i] * v[2 * i] + v[2 * i + 1] * v[2 * i + 1]; }
    ss += __shfl_xor(ss, 1, 64); ss += __shfl_xor(ss, 2, 64); ss += __shfl_xor(ss, 4, 64);
    const float rn = rsqrtf(ss * (1.f / 64.f) + EPS);
    const int c0 = (lane & 7) * 8;
    u32x4 ov;
#pragma unroll
    for (int i = 0; i < 4; ++i) ov[i] = pk2(v[2 * i] * rn * p.gdn_norm_w[c0 + 2 * i] * bflo(gv[i]), v[2 * i + 1] * rn * p.gdn_norm_w[c0 + 2 * i + 1] * bfhi(gv[i]));
    *(u32x4*)(mix + (size_t)row * DM + lane * 8) = ov;
  }
}

struct EpiResid {
  const float* xin; float* xout; const float* gmod  ; int row0, col0;
  DI void operator()(f32x16 (&acc)[2][2], int wm, int wn, int lane) const {
    const int h = lane >> 5, cl = lane & 31;
#pragma unroll
    for (int mt = 0; mt < 2; ++mt) {
      const int row = row0 + wm * 64 + mt * 32 + cl;
      const float* gm = gmod + (size_t)(row >> 13) * 6144;
#pragma unroll
      for (int nt = 0; nt < 2; ++nt)
#pragma unroll
        for (int g = 0; g < 4; ++g) {
          const int col = col0 + wn * 64 + nt * 32 + 8 * g + 4 * h;
          const f32x4 xv = *(const f32x4*)(xin + (size_t)row * DM + col), g4 = *(const f32x4*)(gm + col);
          f32x4 ov;
#pragma unroll
          for (int r = 0; r < 4; ++r) ov[r] = xv[r] + g4[r] * acc[mt][nt][4 * g + r];
          *(f32x4*)(xout + (size_t)row * DM + col) = ov;
        }
    }
  }
};
DI void ph_gemm_resid(const P& p, char* lds, const bf16_t* A, const bf16_t* Bt, const float* xin, const float* gmod) {
  const int nM = TL / GBM, nN = DM / GBN;
  for (int t = blockIdx.x; t < nM * nN; t += gridDim.x) {
    const int pm = t / nN, pn = t % nN;
    RowLin rf{A + (size_t)pm * GBM * DM, (size_t)DM};
    EpiResid ep{xin, p.out, gmod, pm * GBM, pn * GBN};
    gemm_tile<true>(lds, rf, Bt + (size_t)pn * GBN * DM, DM, ep);
  }
}

struct EpiBf16 {
  bf16_t* o; int pitch, row0, col0;
  DI void operator()(f32x16 (&acc)[2][2], int wm, int wn, int lane) const {
    const int h = lane >> 5, cl = lane & 31;
#pragma unroll
    for (int mt = 0; mt < 2; ++mt) {
      const int row = row0 + wm * 64 + mt * 32 + cl;
#pragma unroll
      for (int nt = 0; nt < 2; ++nt)
#pragma unroll
        for (int g = 0; g < 4; ++g) {
          u32x2 v; v[0] = pk2(acc[mt][nt][4 * g], acc[mt][nt][4 * g + 1]); v[1] = pk2(acc[mt][nt][4 * g + 2], acc[mt][nt][4 * g + 3]);
          *(u32x2*)(o + (size_t)row * pitch + col0 + wn * 64 + nt * 32 + 8 * g + 4 * h) = v;
        }
    }
  }
};
DI void ph_gemm_scores(const P& p, char* lds, int layer, size_t sc_off) {
  const bf16_t* A = (const bf16_t*)(p.ws + R0); const bf16_t* Bt = (const bf16_t*)(p.ws + WS_WEFF) + (size_t)layer * 2048 * 1024;
  const int nM = TL / GBM, nN = 2048 / GBN;
  for (int t = blockIdx.x; t < nM * nN; t += gridDim.x) {
    const int pm = t / nN, pn = t % nN;
    RowLin rf{A + (size_t)pm * GBM * DM, (size_t)DM};
    EpiBf16 ep{(bf16_t*)(p.ws + sc_off), 2048, pm * GBM, pn * GBN};
    gemm_tile<true>(lds, rf, Bt + (size_t)pn * GBN * DM, DM, ep);
  }
}

constexpr size_t WS_TSC = WS_BA;
DI void ph_tables(const P& p) {
  const int lane = otid() & 63, gw = blockIdx.x * (NT / 64) + (otid() >> 6), nw_ = gridDim.x * (NT / 64);
  float* tsc = (float*)(p.ws + WS_TSC);
  for (int rr = gw; rr < 4 * 16384; rr += nw_) {
    const int tb = rr >> 14, e = rr & 16383;
    const float* src = ((tb & 1) ? p.peer_v : p.peer_u) + ((size_t)(tb >> 1) * 16384 + e) * 1024 + lane * 16;
    f32x4 v[4]; float ss = 0.f;
#pragma unroll
    for (int i = 0; i < 4; ++i) { v[i] = *(const f32x4*)(src + 4 * i); ss += v[i][0] * v[i][0] + v[i][1] * v[i][1] + v[i][2] * v[i][2] + v[i][3] * v[i][3]; }
    ss = wave_sum(ss);
    const float sc = 0.5f * sqrtf(ss * (1.f / 1024.f)) + 1e-30f, inv = 1.f / sc;
    unsigned w0 = 0u, w1 = 0u;
    w0 = __builtin_amdgcn_cvt_scalef32_pk_fp4_f32(w0, v[0][0] * inv, v[0][1] * inv, 1.0f, 0);
    w0 = __builtin_amdgcn_cvt_scalef32_pk_fp4_f32(w0, v[0][2] * inv, v[0][3] * inv, 1.0f, 1);
    w0 = __builtin_amdgcn_cvt_scalef32_pk_fp4_f32(w0, v[1][0] * inv, v[1][1] * inv, 1.0f, 2);
    w0 = __builtin_amdgcn_cvt_scalef32_pk_fp4_f32(w0, v[1][2] * inv, v[1][3] * inv, 1.0f, 3);
    w1 = __builtin_amdgcn_cvt_scalef32_pk_fp4_f32(w1, v[2][0] * inv, v[2][1] * inv, 1.0f, 0);
    w1 = __builtin_amdgcn_cvt_scalef32_pk_fp4_f32(w1, v[2][2] * inv, v[2][3] * inv, 1.0f, 1);
    w1 = __builtin_amdgcn_cvt_scalef32_pk_fp4_f32(w1, v[3][0] * inv, v[3][1] * inv, 1.0f, 2);
    w1 = __builtin_amdgcn_cvt_scalef32_pk_fp4_f32(w1, v[3][2] * inv, v[3][3] * inv, 1.0f, 3);
    u32x2 o; o[0] = w0; o[1] = w1;
    unsigned char* dst = (unsigned char*)(p.ws + WS_TAB + (size_t)tb * 8 * MiB);
    *(u32x2*)(dst + ((((size_t)(lane >> 4)) * 16384 + e) << 7) + (lane & 15) * 8) = o;
    if (lane == 0) tsc[tb * 16384 + e] = sc;
  }
}

DI unsigned srt16(unsigned bf) { return (bf & 0x8000u) ? (~bf & 0xFFFFu) : (bf | 0x8000u); }
DI float unsrt16(unsigned s) { const unsigned bf = (s & 0x8000u) ? (s & 0x7FFFu) : (~s & 0xFFFFu); return __uint_as_float(bf << 16); }
DI unsigned ckey(float v, unsigned cid) { unsigned u = __float_as_uint(v); u = (u & 0x80000000u) ? ~u : (u | 0x80000000u); return (u & 0xFFFFFF00u) | (255u - cid); }
DI float unckey(unsigned k) { unsigned u = k & 0xFFFFFF00u; u = (u & 0x80000000u) ? (u & 0x7FFFFFFFu) : ~u; return __uint_as_float(u & 0xFFFFFF00u); }
DI void bsort16(unsigned (&k)[16]) {
#pragma unroll
  for (int sz = 2; sz <= 16; sz <<= 1)
#pragma unroll
    for (int j = sz >> 1; j > 0; j >>= 1)
#pragma unroll
      for (int i = 0; i < 16; ++i) {
        const int l = i ^ j;
        if (l > i) {
          const unsigned a = k[i], b = k[l], mx = a > b ? a : b, mn = a > b ? b : a;
          if ((i & sz) == 0) { k[i] = mx; k[l] = mn; } else { k[i] = mn; k[l] = mx; }
        }
      }
}
DI void bmerge16(unsigned (&k)[16]) {
#pragma unroll
  for (int j = 8; j > 0; j >>= 1)
#pragma unroll
    for (int i = 0; i < 16; ++i) {
      const int l = i ^ j;
      if (l > i) { const unsigned a = k[i], b = k[l]; k[i] = a > b ? a : b; k[l] = a > b ? b : a; }
    }
}
DI void topmerge16(unsigned (&run)[16], const unsigned (&g)[16]) {
#pragma unroll
  for (int i = 0; i < 16; ++i) run[i] = run[i] > g[15 - i] ? run[i] : g[15 - i];
  bmerge16(run);
}
DI void top16_of_128(const bf16_t* __restrict__ r, unsigned (&run)[16]) {
#pragma unroll 1
  for (int g = 0; g < 8; ++g) {
    const u32x4 v0 = *(const u32x4*)(r + g * 16), v1 = *(const u32x4*)(r + g * 16 + 8);
    unsigned k[16];
#pragma unroll
    for (int q = 0; q < 4; ++q) {
      k[2 * q] = (srt16(v0[q] & 0xFFFFu) << 16) | (127u - (g * 16 + 2 * q));
      k[2 * q + 1] = (srt16(v0[q] >> 16) << 16) | (127u - (g * 16 + 2 * q + 1));
      k[8 + 2 * q] = (srt16(v1[q] & 0xFFFFu) << 16) | (127u - (g * 16 + 8 + 2 * q));
      k[8 + 2 * q + 1] = (srt16(v1[q] >> 16) << 16) | (127u - (g * 16 + 8 + 2 * q + 1));
    }
    bsort16(k);
    if (g == 0) {
#pragma unroll
      for (int i = 0; i < 16; ++i) run[i] = k[i];
    } else topmerge16(run, k);
  }
}
DI void ph_topk(const P& p, char* lds, size_t sc_off, size_t ei_off, size_t eg_off) {
  const bf16_t* sc = (const bf16_t*)(p.ws + sc_off); int* EI = (int*)(p.ws + ei_off); float* EG = (float*)(p.ws + eg_off);
  unsigned char* sI = (unsigned char*)lds;
  const int tid = otid();
  const int tpb_ = TL / gridDim.x;
  for (int g = blockIdx.x * tpb_ * 8 + tid; g < (blockIdx.x + 1) * tpb_ * 8; g += NT) {
    const int t = g >> 3, head = g & 7;
    const bf16_t* r1 = sc + (size_t)t * 2048 + head * 256;
    unsigned k1[16], k2[16];
    top16_of_128(r1, k1);
    top16_of_128(r1 + 128, k2);
    float f1[16], f2[16];
#pragma unroll
    for (int i = 0; i < 16; ++i) { f1[i] = unsrt16(k1[i] >> 16); f2[i] = unsrt16(k2[i] >> 16); sI[i * NT + tid] = (unsigned char)(127u - (k1[i] & 127u)); sI[(16 + i) * NT + tid] = (unsigned char)(127u - (k2[i] & 127u)); }
    unsigned cg0[16], cg1[16], cg2[16], cg3[16];
#pragma unroll
    for (int i = 0; i < 16; ++i) { cg3[i] = 0u; }
    cg0[0] = ckey(f1[0] + f2[0], 0);
    cg0[1] = ckey(f1[0] + f2[1], 1);
    cg0[2] = ckey(f1[0] + f2[2], 2);
    cg0[3] = ckey(f1[0] + f2[3], 3);
    cg0[4] = ckey(f1[0] + f2[4], 4);
    cg0[5] = ckey(f1[0] + f2[5], 5);
    cg0[6] = ckey(f1[0] + f2[6], 6);
    cg0[7] = ckey(f1[0] + f2[7], 7);
    cg0[8] = ckey(f1[0] + f2[8], 8);
    cg0[9] = ckey(f1[0] + f2[9], 9);
    cg0[10] = ckey(f1[0] + f2[10], 10);
    cg0[11] = ckey(f1[0] + f2[11], 11);
    cg0[12] = ckey(f1[0] + f2[12], 12);
    cg0[13] = ckey(f1[0] + f2[13], 13);
    cg0[14] = ckey(f1[0] + f2[14], 14);
    cg0[15] = ckey(f1[0] + f2[15], 15);
    cg1[0] = ckey(f1[1] + f2[0], 16);
    cg1[1] = ckey(f1[1] + f2[1], 17);
    cg1[2] = ckey(f1[1] + f2[2], 18);
    cg1[3] = ckey(f1[1] + f2[3], 19);
    cg1[4] = ckey(f1[1] + f2[4], 20);
    cg1[5] = ckey(f1[1] + f2[5], 21);
    cg1[6] = ckey(f1[1] + f2[6], 22);
    cg1[7] = ckey(f1[1] + f2[7], 23);
    cg1[8] = ckey(f1[2] + f2[0], 32);
    cg1[9] = ckey(f1[2] + f2[1], 33);
    cg1[10] = ckey(f1[2] + f2[2], 34);
    cg1[11] = ckey(f1[2] + f2[3], 35);
    cg1[12] = ckey(f1[2] + f2[4], 36);
    cg1[13] = ckey(f1[3] + f2[0], 48);
    cg1[14] = ckey(f1[3] + f2[1], 49);
    cg1[15] = ckey(f1[3] + f2[2], 50);
    cg2[0] = ckey(f1[3] + f2[3], 51);
    cg2[1] = ckey(f1[4] + f2[0], 64);
    cg2[2] = ckey(f1[4] + f2[1], 65);
    cg2[3] = ckey(f1[4] + f2[2], 66);
    cg2[4] = ckey(f1[5] + f2[0], 80);
    cg2[5] = ckey(f1[5] + f2[1], 81);
    cg2[6] = ckey(f1[6] + f2[0], 96);
    cg2[7] = ckey(f1[6] + f2[1], 97);
    cg2[8] = ckey(f1[7] + f2[0], 112);
    cg2[9] = ckey(f1[7] + f2[1], 113);
    cg2[10] = ckey(f1[8] + f2[0], 128);
    cg2[11] = ckey(f1[9] + f2[0], 144);
    cg2[12] = ckey(f1[10] + f2[0], 160);
    cg2[13] = ckey(f1[11] + f2[0], 176);
    cg2[14] = ckey(f1[12] + f2[0], 192);
    cg2[15] = ckey(f1[13] + f2[0], 208);
    cg3[0] = ckey(f1[14] + f2[0], 224);
    cg3[1] = ckey(f1[15] + f2[0], 240);
    bsort16(cg0); bsort16(cg1); bsort16(cg2); bsort16(cg3);
    topmerge16(cg0, cg1); topmerge16(cg2, cg3); topmerge16(cg0, cg2);
    float e[16]; int id[16]; float sum = 0.f; const float s0 = unckey(cg0[0]);
#pragma unroll
    for (int k = 0; k < 16; ++k) {
      const unsigned cid = 255u - (cg0[k] & 255u);
      e[k] = __expf(unckey(cg0[k]) - s0); sum += e[k];
      id[k] = (int)sI[(cid >> 4) * NT + tid] * 128 + (int)sI[(16 + (cid & 15)) * NT + tid];
    }
    const float inv = 1.f / sum;
#pragma unroll
    for (int k = 0; k < 16; k += 4) {
      int4 iv = {id[k], id[k + 1], id[k + 2], id[k + 3]}; f32x4 gv = {e[k] * inv, e[k + 1] * inv, e[k + 2] * inv, e[k + 3] * inv};
      *(int4*)(EI + (size_t)g * 16 + k) = iv; *(f32x4*)(EG + (size_t)g * 16 + k) = gv;
    }
  }
}

DI void fp8x16_to_f32(const u32x4& w, float (&f)[16]) {
#pragma unroll
  for (int i = 0; i < 4; ++i) {
    const f32x2_t lo = __builtin_amdgcn_cvt_pk_f32_fp8((int)w[i], false), hi = __builtin_amdgcn_cvt_pk_f32_fp8((int)w[i], true);
    f[4 * i] = lo[0]; f[4 * i + 1] = lo[1]; f[4 * i + 2] = hi[0]; f[4 * i + 3] = hi[1];
  }
}
DI void block_handoff() {
  asm volatile("s_waitcnt vmcnt(0)" ::: "memory");
  __syncthreads();
  if (otid() == 0) { __builtin_amdgcn_fence(__ATOMIC_ACQUIRE, "agent"); asm volatile("s_waitcnt vmcnt(0)" ::: "memory"); }
  __syncthreads();
}
constexpr int PQ_NS = 4;
#define PQ_BEGIN() \
  const int tid = otid(), lane = tid & 63, wave = tid >> 6, g8 = lane >> 3, c16 = lane & 7; \
  const int tpb_ = TL / gridDim.x; \
  _Pragma("unroll 1") for (int x = 0; x < PQ_NS; ++x) { \
    const int tbeg = blockIdx.x * tpb_ + wave, tend = (blockIdx.x + 1) * tpb_;
#define PQ_END() }
#define FP4X8(wd, o0, o1, o2, o3) do { o0 = __builtin_amdgcn_cvt_scalef32_pk_f32_fp4((wd), 1.0f, 0); o1 = __builtin_amdgcn_cvt_scalef32_pk_f32_fp4((wd), 1.0f, 1); \
                                         o2 = __builtin_amdgcn_cvt_scalef32_pk_f32_fp4((wd), 1.0f, 2); o3 = __builtin_amdgcn_cvt_scalef32_pk_f32_fp4((wd), 1.0f, 3); } while (0)
DI void ph_peer_u(const P& p, char* lds, int layer, size_t ei_off, size_t part_off) {
  for (int rep = 0; rep <= p.lo; ++rep) {
  PQ_BEGIN()
  const bf16_t* hp = (const bf16_t*)(p.ws + R0) + x * 256 + c16 * 32;
  const unsigned char* us = (const unsigned char*)(p.ws + WS_TAB + (size_t)(layer * 2) * 8 * MiB) + ((size_t)x * 16384 << 7) + c16 * 16;
  const int* EI = (const int*)(p.ws + ei_off) + g8 * 16;
  unsigned* part = (unsigned*)(p.ws + part_off);
  int4 nid[4]; u32x4 nh[4];
#define PU_PREF(tt) do { const int t_ = (tt) < tend ? (tt) : tend - 1; \
    _Pragma("unroll") for (int i = 0; i < 4; ++i) { nid[i] = *(const int4*)(EI + (size_t)t_ * 128 + i * 4); nh[i] = *(const u32x4*)(hp + (size_t)t_ * DM + i * 8); } } while (0)
  PU_PREF(tbeg);
#pragma unroll 1
  for (int t = tbeg; t < tend; t += NT / 64) {
    f32x2_t hf[16]; int id[16];
#pragma unroll
    for (int i = 0; i < 4; ++i) {
#pragma unroll
      for (int w = 0; w < 4; ++w) hf[4 * i + w] = f32x2_t{bflo(nh[i][w]), bfhi(nh[i][w])};
      id[4 * i] = nid[i].x; id[4 * i + 1] = nid[i].y; id[4 * i + 2] = nid[i].z; id[4 * i + 3] = nid[i].w;
    }
    u32x4 ur[16];
#pragma unroll
    for (int i = 0; i < 16; ++i) ur[i] = *(const u32x4*)(us + ((size_t)id[i] << 7));
    float pd[16];
#pragma unroll
    for (int i = 0; i < 16; ++i) {
      f32x2_t a2 = {0.f, 0.f};
#pragma unroll
      for (int w = 0; w < 4; ++w) {
        f32x2_t f0, f1, f2, f3; FP4X8(ur[i][w], f0, f1, f2, f3);
        a2 = f0 * hf[4 * w] + a2; a2 = f1 * hf[4 * w + 1] + a2; a2 = f2 * hf[4 * w + 2] + a2; a2 = f3 * hf[4 * w + 3] + a2;
      }
      pd[i] = a2[0] + a2[1];
    }
    PU_PREF(t + NT / 64);
    float q8[8], q4[4], q2[2];
    { const bool up = (lane & 4) != 0;
#pragma unroll
      for (int m = 0; m < 8; ++m) { const float keep = up ? pd[8 + m] : pd[m], send = up ? pd[m] : pd[8 + m]; q8[m] = keep + __shfl_xor(send, 4, 64); } }
    { const bool up = (lane & 2) != 0;
#pragma unroll
      for (int m = 0; m < 4; ++m) { const float keep = up ? q8[4 + m] : q8[m], send = up ? q8[m] : q8[4 + m]; q4[m] = keep + __shfl_xor(send, 2, 64); } }
    { const bool up = (lane & 1) != 0;
#pragma unroll
      for (int m = 0; m < 2; ++m) { const float keep = up ? q4[2 + m] : q4[m], send = up ? q4[m] : q4[2 + m]; q2[m] = keep + __shfl_xor(send, 1, 64); } }
    part[((size_t)t * PQ_NS + x) * 64 + lane] = pk2(q2[0], q2[1]);
  }
  PQ_END()
  }
#undef PU_PREF
}
DI void ph_peer_comb(const P& p, int layer, size_t part_off, size_t ei_off, size_t eg_off, size_t w_off) {
  const unsigned* part = (const unsigned*)(p.ws + part_off); const float* EG = (const float*)(p.ws + eg_off); const int* EI = (const int*)(p.ws + ei_off); float* W = (float*)(p.ws + w_off);
  const float* su = (const float*)(p.ws + WS_TSC) + (size_t)(layer * 2) * 16384; const float* sv = su + 16384;
  const int tpbc_ = TL / gridDim.x;
  for (int g = blockIdx.x * tpbc_ * 64 + otid(); g < (blockIdx.x + 1) * tpbc_ * 64; g += NT) {
    const int t = g >> 6, j = g & 63;
    float d0 = 0.f, d1 = 0.f;
#pragma unroll
    for (int x = 0; x < PQ_NS; ++x) { const unsigned v = part[((size_t)t * PQ_NS + x) * 64 + j]; d0 += bflo(v); d1 += bfhi(v); }
    const f32x2_t gt = *(const f32x2_t*)(EG + (size_t)t * 128 + 2 * j);
    const int e0 = EI[(size_t)t * 128 + 2 * j], e1 = EI[(size_t)t * 128 + 2 * j + 1];
    f32x2_t o; o[0] = gelu_tanh(d0 * su[e0]) * gt[0] * sv[e0]; o[1] = gelu_tanh(d1 * su[e1]) * gt[1] * sv[e1];
    *(f32x2_t*)(W + (size_t)t * 128 + 2 * j) = o;
  }
}
DI void ph_peer_v(const P& p, char* lds, int layer, size_t ei_off, size_t w_off) {
  PQ_BEGIN()
  const unsigned char* vs = (const unsigned char*)(p.ws + WS_TAB + (size_t)(layer * 2 + 1) * 8 * MiB) + ((size_t)x * 16384 << 7) + c16 * 16;
  const int* EI = (const int*)(p.ws + ei_off) + g8 * 16; const float* W = (const float*)(p.ws + w_off) + g8 * 16;
  const float* modb = (const float*)(p.ws + WS_MOD) + (size_t)layer * 5 * 6144;
  const int col = x * 256 + 32 * (lane & 7) + 4 * (lane >> 3);
  int4 nid[4]; f32x4 nw[4];
#define PV_PREF(tt) do { const int t_ = (tt) < tend ? (tt) : tend - 1; \
    _Pragma("unroll") for (int i = 0; i < 4; ++i) { nid[i] = *(const int4*)(EI + (size_t)t_ * 128 + i * 4); nw[i] = *(const f32x4*)(W + (size_t)t_ * 128 + i * 4); } } while (0)
  PV_PREF(tbeg);
#pragma unroll 1
  for (int t = tbeg; t < tend; t += NT / 64) {
    int id[16]; float wv[16];
#pragma unroll
    for (int i = 0; i < 4; ++i) { id[4 * i] = nid[i].x; id[4 * i + 1] = nid[i].y; id[4 * i + 2] = nid[i].z; id[4 * i + 3] = nid[i].w; wv[4 * i] = nw[i][0]; wv[4 * i + 1] = nw[i][1]; wv[4 * i + 2] = nw[i][2]; wv[4 * i + 3] = nw[i][3]; }
    u32x4 vr[16];
#pragma unroll
    for (int i = 0; i < 16; ++i) vr[i] = *(const u32x4*)(vs + ((size_t)id[i] << 7));
    f32x2_t acc2[16];
#pragma unroll
    for (int j = 0; j < 16; ++j) acc2[j] = f32x2_t{0.f, 0.f};
#pragma unroll
    for (int i = 0; i < 16; ++i) {
      const f32x2_t w2 = {wv[i], wv[i]};
#pragma unroll
      for (int w = 0; w < 4; ++w) {
        f32x2_t f0, f1, f2, f3; FP4X8(vr[i][w], f0, f1, f2, f3);
        acc2[4 * w] = f0 * w2 + acc2[4 * w]; acc2[4 * w + 1] = f1 * w2 + acc2[4 * w + 1]; acc2[4 * w + 2] = f2 * w2 + acc2[4 * w + 2]; acc2[4 * w + 3] = f3 * w2 + acc2[4 * w + 3];
      }
    }
    PV_PREF(t + NT / 64);
    float acc[32];
#pragma unroll
    for (int j = 0; j < 16; ++j) { acc[2 * j] = acc2[j][0]; acc[2 * j + 1] = acc2[j][1]; }
    float q16[16], q8[8], q4[4];
    { const bool up = (lane & 32) != 0;
#pragma unroll
      for (int m = 0; m < 16; ++m) { const float keep = up ? acc[16 + m] : acc[m], send = up ? acc[m] : acc[16 + m]; q16[m] = keep + __shfl_xor(send, 32, 64); } }
    { const bool up = (lane & 16) != 0;
#pragma unroll
      for (int m = 0; m < 8; ++m) { const float keep = up ? q16[8 + m] : q16[m], send = up ? q16[m] : q16[8 + m]; q8[m] = keep + __shfl_xor(send, 16, 64); } }
    { const bool up = (lane & 8) != 0;
#pragma unroll
      for (int m = 0; m < 4; ++m) { const float keep = up ? q8[4 + m] : q8[m], send = up ? q8[m] : q8[4 + m]; q4[m] = keep + __shfl_xor(send, 8, 64); } }
    float* xr = p.out + (size_t)t * DM + col;
    const f32x4 xv = *(const f32x4*)xr, g2 = *(const f32x4*)(modb + (size_t)(t >> 13) * 6144 + 5 * 1024 + col);
    f32x4 ov;
#pragma unroll
    for (int m = 0; m < 4; ++m) ov[m] = xv[m] + g2[m] * q4[m];
    *(f32x4*)xr = ov;
  }
  PQ_END()
#undef PV_PREF
}
DI void ph_final_norm(const P& p, int r0, int r1) {
  const int lane = otid() & 63;
  for (int row = r0 + (otid() >> 6); row < r1; row += NT / 64) {
    float* xr = p.out + (size_t)row * DM;
    f32x4 xv[4]; float ss = 0.f;
#pragma unroll
    for (int i = 0; i < 4; ++i) { xv[i] = *(const f32x4*)(xr + lane * 4 + 256 * i); ss += xv[i][0] * xv[i][0] + xv[i][1] * xv[i][1] + xv[i][2] * xv[i][2] + xv[i][3] * xv[i][3]; }
    ss = wave_sum(ss);
    const float rs = rsqrtf(ss * (1.f / DM) + EPS);
#pragma unroll
    for (int i = 0; i < 4; ++i) { const f32x4 w4 = *(const f32x4*)(p.final_norm_w + lane * 4 + 256 * i); *(f32x4*)(xr + lane * 4 + 256 * i) = xv[i] * rs * w4; }
  }
}

struct RowFft0 { const bf16_t* base; DI const bf16_t* operator()(int r) const { return base + ((size_t)128 * (r & 63) + (r >> 6)) * DM; } };
struct EpiFft0 {
  bf16_t* zt; int bg, l20, col0;
  DI void operator()(f32x16 (&acc)[2][2], int wm, int wn, int lane) const {
    const int h = lane >> 5, cl = lane & 31;
#pragma unroll
    for (int mt = 0; mt < 2; ++mt)
#pragma unroll
      for (int nt = 0; nt < 2; ++nt) {
        const int n = col0 + wn * 64 + nt * 32 + cl, ri = n >> 8, mm = n & 255;
#pragma unroll
        for (int g = 0; g < 4; ++g) {
          const int r = wm * 64 + mt * 32 + 8 * g + 4 * h, l1 = r & 63, l2 = l20 + (r >> 6);
          u32x2 v; v[0] = pk2(acc[mt][nt][4 * g], acc[mt][nt][4 * g + 1]); v[1] = pk2(acc[mt][nt][4 * g + 2], acc[mt][nt][4 * g + 3]);
          *(u32x2*)(zt + (((size_t)(bg * 256 + mm) * 128 + l2) * 128 + ri * 64 + l1)) = v;
        }
      }
  }
};
DI void ph_fft0(const P& p, char* lds) {
  const bf16_t* h1 = (const bf16_t*)(p.ws + R0); const bf16_t* Bt = (const bf16_t*)(p.ws + WS_DFT0);
  for (int t = blockIdx.x; t < NB * 4 * 32 * 4; t += gridDim.x) {
    const int pn = t & 3, l2b = (t >> 2) & 31, g = (t >> 7) & 3, b = t >> 9;
    RowFft0 rf{h1 + ((size_t)b * SEQ + l2b * 4) * DM + g * 256};
    EpiFft0 ep{(bf16_t*)(p.ws + WS_ZT), b * 4 + g, l2b * 4, pn * GBN};
    gemm_tile<false>(lds, rf, Bt + (size_t)pn * GBN * 256, 256, ep);
  }
}
struct EpiFft1 {
  bf16_t* a2; int row0;
  DI void operator()(f32x16 (&acc)[2][2], int wm, int wn, int lane) const {
    const int h = lane >> 5, cl = lane & 31, k1 = 32 * wn + cl;
#pragma unroll
    for (int mt = 0; mt < 2; ++mt)
#pragma unroll
      for (int g = 0; g < 4; ++g) {
        const int R = row0 + wm * 64 + mt * 32 + 8 * g + 4 * h, l2 = R & 127, mm = (R >> 7) & 255, bg = R >> 15;
        float yr[4], yi[4];
#pragma unroll
        for (int q = 0; q < 4; ++q) {
          const float fr = (float)((l2 + q) * k1) * (1.f / 8192.f);
          const float cs = __builtin_amdgcn_cosf(fr), sn = __builtin_amdgcn_sinf(fr);
          const float ar = acc[mt][0][4 * g + q], ai = acc[mt][1][4 * g + q];
          yr[q] = ar * cs + ai * sn; yi[q] = ai * cs - ar * sn;
        }
        bf16_t* o = a2 + (((size_t)(bg * 64 + k1) * 256 + mm) * 256 + l2);
        u32x2 v; v[0] = pk2(yr[0], yr[1]); v[1] = pk2(yr[2], yr[3]); *(u32x2*)o = v;
        v[0] = pk2(yi[0], yi[1]); v[1] = pk2(yi[2], yi[3]); *(u32x2*)(o + 128) = v;
      }
  }
};
DI void ph_fft1(const P& p, char* lds) {
  const bf16_t* zt = (const bf16_t*)(p.ws + WS_ZT); const bf16_t* Bt = (const bf16_t*)(p.ws + WS_DFT1);
  const int nM = 16 * 256 * 128 / GBM;
  for (int t = blockIdx.x; t < nM; t += gridDim.x) {
    RowLin rf{zt + (size_t)t * GBM * 128, (size_t)128};
    EpiFft1 ep{(bf16_t*)(p.ws + WS_A2), t * GBM};
    gemm_tile<false>(lds, rf, Bt, 128, ep);
  }
}
struct EpiFft3 {
  bf16_t* fm; int row0;
  DI void operator()(f32x16 (&acc)[2][2], int wm, int wn, int lane) const {
    const int h = lane >> 5, cl = lane & 31;
#pragma unroll
    for (int mt = 0; mt < 2; ++mt)
#pragma unroll
      for (int nt = 0; nt < 2; ++nt) {
        const int k2 = wn * 64 + nt * 32 + cl;
#pragma unroll
        for (int g = 0; g < 4; ++g) {
          const int R = row0 + wm * 64 + mt * 32 + 8 * g + 4 * h, mm = R & 255, k1 = (R >> 8) & 63, bg = R >> 14;
          u32x2 v; v[0] = pk2(acc[mt][nt][4 * g], acc[mt][nt][4 * g + 1]); v[1] = pk2(acc[mt][nt][4 * g + 2], acc[mt][nt][4 * g + 3]);
          *(u32x2*)(fm + ((size_t)((bg >> 2) * SEQ + k1 + 64 * k2)) * DM + (bg & 3) * 256 + mm) = v;
        }
      }
  }
};
DI void ph_fft3(const P& p, char* lds) {
  const bf16_t* a2 = (const bf16_t*)(p.ws + WS_A2); const bf16_t* Bt = (const bf16_t*)(p.ws + WS_DFT3);
  const int nM = 16 * 64 * 256 / GBM;
  for (int t = blockIdx.x; t < nM; t += gridDim.x) {
    RowLin rf{a2 + (size_t)t * GBM * 256, (size_t)256};
    EpiFft3 ep{(bf16_t*)(p.ws + WS_FM), t * GBM};
    gemm_tile<false>(lds, rf, Bt, 256, ep);
  }
}

constexpr int NPHASE = 19;
template <int PH>
DI void run_phase(const P& p, char* lds) {
  const float* modL = (const float*)(p.ws + WS_MOD);
  const int tpb = TL / gridDim.x, t0 = blockIdx.x * tpb, t1 = t0 + tpb;
  if constexpr (PH == 0) ph_setup(p, lds);
  else if constexpr (PH == 1) { norm_rows(p.x, 0, TL, p.norm1_w, modL, 0, 1, false, (bf16_t*)(p.ws + R0));
                                norm_rows(p.ctx - (size_t)TL * DM, TL, TA, p.norm1_w, modL, 0, 1, true, (bf16_t*)(p.ws + R0)); }
  else if constexpr (PH == 2) { PgProj ep{&p}; pg8_run(lds, (const bf16_t*)(p.ws + R0), (const bf16_t*)(p.ws + WS_WIN), TA, NIN, DM, ep); }
  else if constexpr (PH == 3) ph_gdn_prep<0>(p, lds);
  else if constexpr (PH == 4) ph_gdn_scan<0>(p, lds);
  else if constexpr (PH == 5) { ph_attn(p, lds); ph_mixout(p); }
  else if constexpr (PH == 6) { PgResid ep{p.x, p.out, modL + 2 * 1024}; pg8_run(lds, (const bf16_t*)(p.ws + WS_MIX), (const bf16_t*)(p.ws + WS_WOUT), TL, DM, DM, ep); }
  else if constexpr (PH == 7) { norm_rows(p.out, 0, TL, p.norm2_w, modL, 3, 4, false, (bf16_t*)(p.ws + R0)); ph_tables(p); }
  else if constexpr (PH == 8) { PgBf16 ep{(bf16_t*)(p.ws + WS_SC0), 2048}; pg8_run(lds, (const bf16_t*)(p.ws + R0), (const bf16_t*)(p.ws + WS_WEFF), TL, 2048, DM, ep); }
  else if constexpr (PH == 9) { ph_topk(p, lds, WS_SC0, WS_EI0, WS_EG0); block_handoff(); ph_peer_u(p, lds, 0, WS_EI0, WS_PART0); }
  else if constexpr (PH == 10) { ph_peer_comb(p, 0, WS_PART0, WS_EI0, WS_EG0, WS_W0); block_handoff(); ph_peer_v(p, lds, 0, WS_EI0, WS_W0); block_handoff();
                                 norm_rows(p.out, t0, t1, p.norm1_w + DM, modL + 5 * 6144, 0, 1, false, (bf16_t*)(p.ws + R0), true); }
  else if constexpr (PH == 11) ph_fft0(p, lds);
  else if constexpr (PH == 12) ph_fft1(p, lds);
  else if constexpr (PH == 13) ph_fft3(p, lds);
  else if constexpr (PH == 14) { PgResid ep{p.out, p.out, modL + 5 * 6144 + 2 * 1024}; pg8_run(lds, (const bf16_t*)(p.ws + WS_FM), (const bf16_t*)(p.ws + WS_WF), TL, DM, DM, ep); }
  else if constexpr (PH == 15) norm_rows(p.out, 0, TL, p.norm2_w + DM, modL + 5 * 6144, 3, 4, false, (bf16_t*)(p.ws + R0));
  else if constexpr (PH == 16) { PgBf16 ep{(bf16_t*)(p.ws + WS_SC1), 2048}; pg8_run(lds, (const bf16_t*)(p.ws + R0), (const bf16_t*)(p.ws + WS_WEFF) + (size_t)2048 * 1024, TL, 2048, DM, ep); }
  else if constexpr (PH == 17) { ph_topk(p, lds, WS_SC1, WS_EI1, WS_EG1); block_handoff(); ph_peer_u(p, lds, 1, WS_EI1, WS_PART1); }
  else if constexpr (PH == 18) { ph_peer_comb(p, 1, WS_PART1, WS_EI1, WS_EG1, WS_W1); block_handoff(); ph_peer_v(p, lds, 1, WS_EI1, WS_W1); block_handoff(); ph_final_norm(p, t0, t1); }
}
#define XB_TMO      128
#define XB_XCNT(j)  (256  + 64 * (j))
#define XB_XSUB(j)  (1280 + 64 * (j))
#define XB_XGEN(j)  (2304 + 64 * (j))
#define XB_TOP      3328
#define XB_TOPGEN   3392
#define XCD_BAR_WORDS 3456
#define XB_SPIN_CAP (1u << 22)
#define LAS __attribute__((address_space(3)))
#define XB_SPIN(cond, bar) do { unsigned _sp = 0; while (cond) { __builtin_amdgcn_s_sleep(1); \
    if ((++_sp & 255u) == 0u) { if (xb_ld(&(bar)[XB_TMO])) break; if (_sp > XB_SPIN_CAP) { atomicAdd(&(bar)[XB_TMO], 1u); break; } } } } while (0)
struct XcdBarrier { unsigned* bar; unsigned x; volatile LAS unsigned* st; };
DI XcdBarrier xcd_barrier_post(unsigned* bar, volatile LAS unsigned* st) {
  XcdBarrier b; b.bar = bar; b.x = xb_xcc_id(); b.st = st;
  if (threadIdx.x == 0) (void)xb_add(&bar[XB_XCNT(b.x)], 1u);
  return b;
}
DI void xcd_barrier_complete(unsigned* bar, unsigned x, unsigned& nloc, unsigned& nx) {
  const unsigned G = gridDim.x * gridDim.y * gridDim.z;
  unsigned sum, cnt, mine, sp = 0u;
  for (;;) {
    sum = 0u; cnt = 0u; mine = 0u;
#pragma unroll
    for (unsigned j = 0; j < 16; ++j) { const unsigned c = xb_ld(&bar[XB_XCNT(j)]); sum += c; cnt += (c > 0u) ? 1u : 0u; mine = (j == x) ? c : mine; }
    if (sum == G) break;
    __builtin_amdgcn_s_sleep(1);
    if ((++sp & 255u) == 0u) { if (xb_ld(&bar[XB_TMO])) break; if (sp > XB_SPIN_CAP) { atomicAdd(&bar[XB_TMO], 1u); break; } }
  }
  nloc = mine > 0u ? mine : 1u; nx = cnt > 0u ? cnt : 1u;
}
DI void xcd_barrier(const XcdBarrier& b) {
  asm volatile("s_waitcnt vmcnt(0)" ::: "memory");
  __syncthreads();
  if (threadIdx.x == 0) {
    unsigned* bar = b.bar;
    __builtin_amdgcn_s_waitcnt(0);
    unsigned nloc = b.st[0], nx = b.st[1];
    if (nloc == 0u) { xcd_barrier_complete(bar, b.x, nloc, nx); b.st[0] = nloc; b.st[1] = nx; }
    const unsigned old = xb_add(&bar[XB_XSUB(b.x)], 1u);
    const unsigned gen = old / nloc;
    if (old + 1u == (gen + 1u) * nloc) {
      __builtin_amdgcn_fence(__ATOMIC_RELEASE, "agent");
      asm volatile("s_waitcnt vmcnt(0)" ::: "memory");
      const unsigned og = xb_add(&bar[XB_TOP], 1u);
      const unsigned tg = og / nx;
      if (og + 1u == (tg + 1u) * nx) xb_add(&bar[XB_TOPGEN], 1u);
      else XB_SPIN(xb_ld(&bar[XB_TOPGEN]) == tg, bar);
      __builtin_amdgcn_fence(__ATOMIC_ACQUIRE, "agent");
      xb_add(&bar[XB_XGEN(b.x)], 1u);
      asm volatile("s_waitcnt vmcnt(0)" ::: "memory");
    } else {
      XB_SPIN(xb_ld(&bar[XB_XGEN(b.x)]) == gen, bar);
      __builtin_amdgcn_fence(__ATOMIC_ACQUIRE, "agent");
      asm volatile("s_waitcnt vmcnt(0)" ::: "memory");
    }
  }
  __syncthreads();
}

constexpr int EXTRA_PHASE = -1;
constexpr int PROBE_MODE = 0;
template <int PH>
DI void run_all(const P& p, char* lds, const XcdBarrier& bar) {
  run_phase<PH>(p, lds);
  if constexpr (PH == EXTRA_PHASE) {
    xcd_barrier(bar);
    if constexpr (PH == 3) ph_gdn_prep<PROBE_MODE>(p, lds);
    else if constexpr (PH == 4) ph_gdn_scan<PROBE_MODE>(p, lds);
    else run_phase<PH>(p, lds);
  }
  if constexpr (PH + 1 < NPHASE) {
    if constexpr (PH == 0) { cg::this_grid().sync(); }
    else xcd_barrier(bar);
    run_all<PH + 1>(p, lds, bar);
  }
}
__global__ void __launch_bounds__(NT) mega(P p) {
  extern __shared__ __attribute__((aligned(16))) char lds[];
  volatile LAS unsigned* st = (volatile LAS unsigned*)(lds + LDS_BYTES - 16);
  if (threadIdx.x == 0) { st[0] = 0u; st[1] = 0u; }
  __syncthreads();
  XcdBarrier bar = xcd_barrier_post((unsigned*)(p.ws + WS_CTL), st);
  run_all<0>(p, lds, bar);
}

extern "C" void kernel_launch(void* const* d_in, const int* in_sizes, int n_in, void* d_out, int out_size, void* d_ws, size_t ws_size, hipStream_t stream) {
  static int grid = 0;
  if (grid == 0) {
    if (n_in != 25 || ws_size < WS_END) { fprintf(stderr, "kernel_launch: unexpected n_in %d or ws_size %zu\n", n_in, ws_size); grid = -1; return; }
    int dev = 0, cus = 0, per_cu = 0;
    (void)hipGetDevice(&dev); (void)hipDeviceGetAttribute(&cus, hipDeviceAttributeMultiprocessorCount, dev);
    (void)hipFuncSetAttribute((const void*)mega, hipFuncAttributeMaxDynamicSharedMemorySize, LDS_BYTES);
    if (hipOccupancyMaxActiveBlocksPerMultiprocessor(&per_cu, (const void*)mega, NT, LDS_BYTES) != hipSuccess || per_cu < 1) { fprintf(stderr, "kernel_launch: occupancy query failed (%d)\n", per_cu); per_cu = 1; }
    (void)hipGetLastError();
    if (per_cu > 1) per_cu = 1;
    grid = (cus > 0 ? cus : 256) * per_cu;
  }
  if (grid < 0) return;
  (void)hipMemsetAsync((char*)d_ws + WS_CTL, 0, CTL_ZERO_BYTES, stream);
  P p{};
  const float** pf = (const float**)&p;
  for (int i = 0; i < 25; ++i) pf[i] = (const float*)d_in[i];
  p.out = (float*)d_out; p.ws = (char*)d_ws; p.lo = 0; p.hi = NPHASE;
  void* args[] = {&p};
  hipError_t e = hipLaunchCooperativeKernel((const void*)mega, dim3(grid), dim3(NT), args, LDS_BYTES, stream);
  if (e != hipSuccess) fprintf(stderr, "cooperative launch failed: %s (grid %d)\n", hipGetErrorString(e), grid);
}
```

```cpp
#include <hip/hip_runtime.h>
#include <hip/hip_cooperative_groups.h>
#include <cstdio>
#include <cstdint>
namespace cg = cooperative_groups;

#define DI __device__ __forceinline__
typedef unsigned short bf16_t;
typedef short bf16x8 __attribute__((ext_vector_type(8)));
typedef short s16x4 __attribute__((ext_vector_type(4)));
typedef float f32x16 __attribute__((ext_vector_type(16)));
typedef float f32x4 __attribute__((ext_vector_type(4)));
typedef float f32x2_t __attribute__((ext_vector_type(2)));
typedef __bf16 bf16x2_t __attribute__((ext_vector_type(2)));
typedef unsigned u32x4 __attribute__((ext_vector_type(4)));
typedef unsigned u32x2 __attribute__((ext_vector_type(2)));

constexpr int NB = 4, SEQ = 8192, DM = 1024, CTXL = 256;
constexpr int TL = NB * SEQ;
constexpr int TC = NB * CTXL;
constexpr int TA = TL + TC;
constexpr int KVL = SEQ + CTXL;
constexpr int NIN = 3840;
constexpr int NCH = 132;
constexpr float EPS = 1e-6f;
constexpr int NT = 512;

constexpr size_t MiB = 1u << 20;
constexpr size_t WS_CTL = 0, WS_MOD = 64 * 1024, CTL_ZERO_BYTES = 512 * 1024;
constexpr size_t WS_ROPE = 1 * MiB, WS_WIN = 3 * MiB, WS_WOUT = 11 * MiB, WS_WF = 13 * MiB, WS_WEFF = 15 * MiB;
constexpr size_t WS_DFT0 = 23 * MiB, WS_DFT1 = 23 * MiB + 256 * 1024, WS_DFT3 = 23 * MiB + 512 * 1024;
constexpr size_t WS_BA = 24 * MiB, WS_GC = 29 * MiB;
constexpr size_t R0 = 32 * MiB, R1 = 98 * MiB, R2 = 197 * MiB, R3 = 329 * MiB, WS_END = 459 * MiB;
constexpr size_t WS_QN = R0, WS_KN = R0 + 33 * MiB;
constexpr size_t WS_QKVRAW = R1, WS_OBUF = R1;
constexpr size_t WS_UW = R2, WS_MIX = R2;
constexpr size_t WS_GATE = R3, WS_Q = R3 + 32 * MiB, WS_K = R3 + 64 * MiB, WS_VT = R3 + 97 * MiB;
constexpr size_t WS_TAB = R3 + 32 * MiB;
constexpr size_t WS_SC0 = R2, WS_EI0 = R1, WS_EG0 = R1 + 16 * MiB, WS_PART0 = 150 * MiB  , WS_W0 = R1 + 32 * MiB  ;
constexpr size_t WS_ZT = R1, WS_A2 = 226 * MiB, WS_FM = R1;
constexpr size_t WS_SC1 = 162 * MiB, WS_EI1 = 290 * MiB, WS_EG1 = 306 * MiB, WS_PART1 = 100 * MiB  , WS_W1 = 322 * MiB;

struct P {
  const float *x, *c, *ctx, *c_ctx, *ada_w, *ada_b, *norm1_w, *norm2_w, *w_in, *conv_w, *a_log, *dt_bias, *gdn_norm_w,
      *lam_q1, *lam_k1, *lam_q2, *lam_k2, *subln_w, *w_out_ab, *w_out_f, *peer_wq, *peer_keys, *peer_u, *peer_v, *final_norm_w;
  float* out; char* ws; int lo, hi;
};

DI unsigned f2bf(float f) { unsigned u = __float_as_uint(f); return (u + 0x7fffu + ((u >> 16) & 1u)) >> 16; }
DI unsigned pk2(float lo, float hi) { return f2bf(lo) | (f2bf(hi) << 16); }
DI unsigned cvtpk(float lo, float hi) { f32x2_t v = {lo, hi}; bf16x2_t b = __builtin_convertvector(v, bf16x2_t); return __builtin_bit_cast(unsigned, b); }
DI float bf2f(unsigned h) { return __uint_as_float(h << 16); }
DI float bflo(unsigned u) { return __uint_as_float(u << 16); }
DI float bfhi(unsigned u) { return __uint_as_float(u & 0xffff0000u); }
DI float wave_sum(float v) {
#pragma unroll
  for (int o = 32; o >= 1; o >>= 1) v += __shfl_xor(v, o, 64);
  return v;
}
DI int otid() { int t = threadIdx.x; asm volatile("" : "+v"(t)); return t; }
DI unsigned xb_ld(unsigned* p)              { return __hip_atomic_load(p, __ATOMIC_RELAXED, __HIP_MEMORY_SCOPE_AGENT); }
DI unsigned xb_add(unsigned* p, unsigned v) { return __hip_atomic_fetch_add(p, v, __ATOMIC_RELAXED, __HIP_MEMORY_SCOPE_AGENT); }
DI unsigned xb_xcc_id() { return (unsigned)__builtin_amdgcn_s_getreg((3 << 11) | 20) & 0xFu; }
DI float silu_f(float v) { return v / (1.f + __expf(-v)); }
DI float sigmoid_f(float v) { return 1.f / (1.f + __expf(-v)); }
DI float gelu_tanh(float v) {
  const float u = 0.7978845608028654f * (v + 0.044715f * v * v * v);
  const float e = __expf(2.f * u);
  const float t = 1.f - 2.f / (e + 1.f);
  return 0.5f * v * (1.f + t);
}
#define MFMA32(a, b, c) __builtin_amdgcn_mfma_f32_32x32x16_bf16((a), (b), (c), 0, 0, 0)

constexpr int GBM = 256, GBN = 128, GBK = 64, GLD = 72;
constexpr int G_A_BYTES = GBM * GLD * 2, G_B_BYTES = GBN * GLD * 2, G_STAGE = G_A_BYTES + G_B_BYTES;
constexpr int LDS_BYTES = 147456;

template <bool SWAP, class RowF, class Epi>
DI void gemm_tile(char* lds, const RowF& rowf, const bf16_t* __restrict__ Bt, const int K, const Epi& epi) {
  const int tid = otid(), lane = tid & 63, wave = tid >> 6, wm = wave >> 1, wn = wave & 1;
  const int lr = tid >> 3, lc = tid & 7;
  const bf16_t* ap0 = rowf(lr) + lc * 8;
  const bf16_t* ap1 = rowf(lr + 64) + lc * 8;
  const bf16_t* ap2 = rowf(lr + 128) + lc * 8;
  const bf16_t* ap3 = rowf(lr + 192) + lc * 8;
  const bf16_t* bp0 = Bt + (size_t)lr * K + lc * 8;
  const bf16_t* bp1 = Bt + (size_t)(lr + 64) * K + lc * 8;
  const int woff = (lr * GLD + lc * 8) * 2;
  u32x4 raX0, raX1, raX2, raX3, rbX0, rbX1, raY0, raY1, raY2, raY3, rbY0, rbY1;
  f32x16 acc[2][2];
#pragma unroll
  for (int i = 0; i < 2; ++i)
#pragma unroll
    for (int j = 0; j < 2; ++j)
#pragma unroll
      for (int r = 0; r < 16; ++r) acc[i][j][r] = 0.f;
  const int nk = K / GBK;
#define G_GLOAD(S, kt_) do { const int k0_ = ((kt_) < nk ? (kt_) : nk - 1) * GBK; \
    ra##S##0 = *(const u32x4*)(ap0 + k0_); ra##S##1 = *(const u32x4*)(ap1 + k0_); ra##S##2 = *(const u32x4*)(ap2 + k0_); ra##S##3 = *(const u32x4*)(ap3 + k0_); \
    rb##S##0 = *(const u32x4*)(bp0 + k0_); rb##S##1 = *(const u32x4*)(bp1 + k0_); } while (0)
#define G_LWRITE(S, st) do { char* b_ = lds + (st) * G_STAGE + woff; *(u32x4*)(b_) = ra##S##0; *(u32x4*)(b_ + 64 * GLD * 2) = ra##S##1; *(u32x4*)(b_ + 128 * GLD * 2) = ra##S##2; *(u32x4*)(b_ + 192 * GLD * 2) = ra##S##3; \
    *(u32x4*)(b_ + G_A_BYTES) = rb##S##0; *(u32x4*)(b_ + G_A_BYTES + 64 * GLD * 2) = rb##S##1; } while (0)
  const int aoff = ((wm * 64 + (lane & 31)) * GLD + (lane >> 5) * 8) * 2;
  const int boff = G_A_BYTES + ((wn * 64 + (lane & 31)) * GLD + (lane >> 5) * 8) * 2;
#define G_COMPUTE(st) do { const char* sb = lds + (st) * G_STAGE; \
    _Pragma("unroll") for (int kk = 0; kk < 4; ++kk) { \
      const bf16x8 a0 = *(const bf16x8*)(sb + aoff + kk * 32); \
      const bf16x8 a1 = *(const bf16x8*)(sb + aoff + 32 * GLD * 2 + kk * 32); \
      const bf16x8 b0 = *(const bf16x8*)(sb + boff + kk * 32); \
      const bf16x8 b1 = *(const bf16x8*)(sb + boff + 32 * GLD * 2 + kk * 32); \
      if (SWAP) { \
        acc[0][0] = MFMA32(b0, a0, acc[0][0]); acc[0][1] = MFMA32(b1, a0, acc[0][1]); \
        acc[1][0] = MFMA32(b0, a1, acc[1][0]); acc[1][1] = MFMA32(b1, a1, acc[1][1]); \
      } else { \
        acc[0][0] = MFMA32(a0, b0, acc[0][0]); acc[0][1] = MFMA32(a0, b1, acc[0][1]); \
        acc[1][0] = MFMA32(a1, b0, acc[1][0]); acc[1][1] = MFMA32(a1, b1, acc[1][1]); \
      } } } while (0)
  G_GLOAD(X, 0); G_GLOAD(Y, 1);
  __syncthreads();
  G_LWRITE(X, 0);
  __syncthreads();
#pragma unroll 1
  for (int kt = 0; kt < nk; kt += 2) {
    G_GLOAD(X, kt + 2);
    G_COMPUTE(0);
    G_LWRITE(Y, 1);
    __syncthreads();
    G_GLOAD(Y, kt + 3);
    G_COMPUTE(1);
    if (kt + 2 < nk) G_LWRITE(X, 0);
    __syncthreads();
  }
  epi(acc, wm, wn, lane);
#undef G_GLOAD
#undef G_LWRITE
#undef G_COMPUTE
}
DI int crow(int reg, int h) { return (reg & 3) + 8 * (reg >> 2) + 4 * h; }

struct RowLin { const bf16_t* base; size_t pitch; DI const bf16_t* operator()(int r) const { return base + (size_t)r * pitch; } };

namespace pg8 {
#define PG8_LAS __attribute__((address_space(3)))
typedef unsigned short bf16_t;
typedef short bf16x8 __attribute__((ext_vector_type(8)));
typedef float f32x4 __attribute__((ext_vector_type(4)));
typedef unsigned u32x4 __attribute__((ext_vector_type(4)));
constexpr int BM = 256, BK = 64, HALF = 128, HTB = HALF * BK * 2  , STAGE_BYTES = 8 * HTB, NXCD = 8, WGM = 8;

__host__ __device__ __forceinline__ int lds_byte(int r, int c) { const int st = (r >> 4) * 2 + (c >> 5), rr = r & 15, cc = c & 31, ob = rr * 64 + cc * 2; return st * 1024 + (ob ^ (((ob >> 9) & 1) << 5)); }
__host__ __device__ __forceinline__ void stage_rc(int b, int& R, int& C) { const int st = b / 1024, sb = b % 1024, swz = sb ^ (((sb >> 9) & 1) << 5); R = (st >> 1) * 16 + swz / 64; C = (st & 1) * 32 + (swz % 64) / 2; }
__host__ __device__ __forceinline__ int perm32(int rho) { const int n = rho >> 4, i = rho & 15; return 8 * (i >> 2) + 4 * n + (i & 3); }

struct Unit { int pm, pn; };
struct Gemm { const bf16_t* A; const bf16_t* Bt; int M, N, K; };

struct StaticOrder {
    int nM, nN, nwg, G, c;
    __host__ __device__ void init(int M, int N, int G_, int c_) { nM = M / BM; nN = N / BM; nwg = nM * nN; G = G_; c = c_; }
    __host__ __device__ bool next(int i, Unit& u) const {
        const long L = (long)i * G + c; if (L >= nwg) return false;
        int wgid = (int)L; { const int q = nwg / NXCD, r = nwg % NXCD, xcd = wgid % NXCD, off = wgid / NXCD; wgid = (xcd < r ? xcd * (q + 1) : r * (q + 1) + (xcd - r) * q) + off; }
        const int nig = WGM * nN, gid = wgid / nig, fm = gid * WGM, gsz = (nM - fm) < WGM ? (nM - fm) : WGM;
        u.pm = fm + ((wgid % nig) % gsz); u.pn = (wgid % nig) / gsz; return true;
    }
    __device__ __forceinline__ void a_ready(const Unit&) const {}
    __device__ __forceinline__ void done(const Unit&) const {}
};
template <class Epi, class Sched, bool ALIGN_EPI = false, bool SP2 = false>
__device__ __forceinline__ void gemm_phase(PG8_LAS unsigned char* lds, const Gemm g, const Sched& S, const Epi& E) {
    const int tid = otid(), wid = __builtin_amdgcn_readfirstlane(tid >> 6), lane = tid & 63, wr = wid >> 2, wc = wid & 3, fr = lane & 15, fq = lane >> 4;
    const int K = g.K, nt = K / BK;
    unsigned voffA[2], voffB[2];
#pragma unroll
    for (int i = 0; i < 2; ++i) { int R, C; stage_rc(tid * 16 + i * 8192, R, C); const int Rb = Epi::PERM ? ((R & ~31) + perm32(R & 31)) : R;
        voffA[i] = (unsigned)(R * K + C) * 2u; voffB[i] = (unsigned)(Rb * K + C) * 2u; }
    const size_t kstep = (size_t)(BK * 2);
    const size_t hstep = (size_t)HALF * K * 2;
    const size_t tstep = 2 * hstep;
    const unsigned ldsw = (unsigned)wid * 1024u;
    const int aoff = lds_byte(wr * 64 + fr, fq * 8), boff = lds_byte(wc * 32 + fr, fq * 8);
#define PG8_SA(b, h) (((b) * 2 + (h)) * HTB)
#define PG8_SB(b, h) ((4 + (b) * 2 + (h)) * HTB)
#define PG8_STAGE(bufoff, gbase, voff) do { _Pragma("unroll") for (int _i = 0; _i < 2; ++_i) \
        __builtin_amdgcn_global_load_lds((const unsigned*)((const char*)(gbase) + (voff)[_i]), (PG8_LAS unsigned*)(lds + (bufoff) + ldsw + _i * 8192), 16, 0, 0); } while (0)
#define PG8_LDA(dst, b, h) do { _Pragma("unroll") for (int m = 0; m < 4; ++m) _Pragma("unroll") for (int k = 0; k < 2; ++k) dst[m][k] = *(const PG8_LAS bf16x8*)(lds + PG8_SA(b, h) + aoff + m * 2048 + k * 1024); } while (0)
#define PG8_LDB(dst, b, h) do { _Pragma("unroll") for (int n = 0; n < 2; ++n) _Pragma("unroll") for (int k = 0; k < 2; ++k) dst[n][k] = *(const PG8_LAS bf16x8*)(lds + PG8_SB(b, h) + boff + n * 2048 + k * 1024); } while (0)
#define PG8_MMA(ai, bj, At, Bt) do { __builtin_amdgcn_s_setprio(1); _Pragma("unroll") for (int m = 0; m < 4; ++m) _Pragma("unroll") for (int n = 0; n < 2; ++n) _Pragma("unroll") for (int k = 0; k < 2; ++k) \
        acc[ai][bj][m][n] = __builtin_amdgcn_mfma_f32_16x16x32_bf16(Bt[n][k], At[m][k], acc[ai][bj][m][n], 0, 0, 0); __builtin_amdgcn_s_setprio(0); } while (0)
#define PG8_WAIT_V(n) asm volatile("s_waitcnt vmcnt(" #n ")" ::: "memory")
#define PG8_WAIT_L(n) asm volatile("s_waitcnt lgkmcnt(" #n ")" ::: "memory")
#define PG8_BAR __builtin_amdgcn_s_barrier()
#define PG8_SCHED __builtin_amdgcn_sched_barrier(0)
    Unit cur, nxt; int ui = 0;
    if (!S.next(0, cur)) return;
    f32x4 acc[2][2][4][2];
#pragma unroll
    for (int a = 0; a < 2; ++a)
#pragma unroll
        for (int b = 0; b < 2; ++b)
#pragma unroll
            for (int m = 0; m < 4; ++m)
#pragma unroll
                for (int n = 0; n < 2; ++n) acc[a][b][m][n] = (f32x4){0.f, 0.f, 0.f, 0.f};
    bf16x8 At[4][2], B0[2][2], B1[2][2];
    const char* cA = (const char*)g.A + (size_t)cur.pm * tstep; const char* cB = (const char*)g.Bt + (size_t)cur.pn * tstep;
    S.a_ready(cur);
    if constexpr (SP2) {
        PG8_STAGE(PG8_SB(0, 0), cB, voffB); PG8_STAGE(PG8_SB(0, 1), cB + hstep, voffB); PG8_STAGE(PG8_SA(0, 0), cA, voffA); PG8_STAGE(PG8_SA(0, 1), cA + hstep, voffA);
        if (wr == 1) PG8_BAR;
        PG8_WAIT_V(2); PG8_BAR;
        PG8_STAGE(PG8_SB(1, 0), cB + kstep, voffB); PG8_STAGE(PG8_SA(1, 0), cA + kstep, voffA); PG8_STAGE(PG8_SB(1, 1), cB + hstep + kstep, voffB);
        PG8_WAIT_V(6); PG8_BAR;
    } else {
        PG8_STAGE(PG8_SB(0, 0), cB, voffB); PG8_STAGE(PG8_SA(0, 0), cA, voffA); PG8_STAGE(PG8_SB(0, 1), cB + hstep, voffB); PG8_STAGE(PG8_SA(0, 1), cA + hstep, voffA);
        if (wr == 1) PG8_BAR;
        PG8_WAIT_V(4); PG8_BAR;
        PG8_STAGE(PG8_SB(1, 0), cB + kstep, voffB); PG8_STAGE(PG8_SA(1, 0), cA + kstep, voffA); PG8_STAGE(PG8_SB(1, 1), cB + hstep + kstep, voffB);
        PG8_WAIT_V(6); PG8_BAR;
    }
    for (;;) {
        const bool has_next = S.next(ui + 1, nxt);
        const char* nA = has_next ? (const char*)g.A + (size_t)nxt.pm * tstep : cA; const char* nB = has_next ? (const char*)g.Bt + (size_t)nxt.pn * tstep : cB;
        for (int t = 0; t < nt; t += 2) {
            const bool last = (t == nt - 2);
            const char* a1 = cA + (size_t)(t + 1) * kstep;
            const char* a2 = last ? nA : cA + (size_t)(t + 2) * kstep; const char* b2 = last ? nB : cB + (size_t)(t + 2) * kstep;
            const char* a3 = a2 + kstep; const char* b3 = b2 + kstep;
            if (last && has_next) S.a_ready(nxt);
            if constexpr (SP2) {
            PG8_LDB(B0, 0, 0); PG8_LDB(B1, 0, 1); PG8_SCHED; PG8_LDA(At, 0, 0); PG8_STAGE(PG8_SA(1, 1), a1 + hstep, voffA);
            PG8_WAIT_V(8); PG8_WAIT_L(0); PG8_BAR; PG8_MMA(0, 0, At, B0); PG8_MMA(0, 1, At, B1); PG8_BAR; PG8_SCHED;
            PG8_LDA(At, 0, 1); PG8_STAGE(PG8_SB(0, 0), b2, voffB); PG8_STAGE(PG8_SB(0, 1), b2 + hstep, voffB); PG8_STAGE(PG8_SA(0, 0), a2, voffA);
            PG8_WAIT_V(8); PG8_WAIT_L(0); PG8_BAR; PG8_MMA(1, 0, At, B0); PG8_MMA(1, 1, At, B1); PG8_BAR; PG8_SCHED;
            PG8_LDB(B0, 1, 0); PG8_LDB(B1, 1, 1); PG8_SCHED; PG8_LDA(At, 1, 0); PG8_STAGE(PG8_SA(0, 1), a2 + hstep, voffA);
            PG8_WAIT_V(8); PG8_WAIT_L(0); PG8_BAR; PG8_MMA(0, 0, At, B0); PG8_MMA(0, 1, At, B1); PG8_BAR; PG8_SCHED;
            PG8_LDA(At, 1, 1); PG8_STAGE(PG8_SB(1, 0), b3, voffB); PG8_STAGE(PG8_SB(1, 1), b3 + hstep, voffB); PG8_STAGE(PG8_SA(1, 0), a3, voffA);
            PG8_WAIT_V(8); PG8_WAIT_L(0); PG8_BAR; PG8_MMA(1, 0, At, B0); PG8_MMA(1, 1, At, B1); PG8_BAR; PG8_SCHED;
            } else {
            PG8_LDB(B0, 0, 0); PG8_SCHED; PG8_LDA(At, 0, 0); PG8_STAGE(PG8_SA(1, 1), a1 + hstep, voffA);
            PG8_WAIT_L(8); PG8_BAR; PG8_WAIT_L(0); PG8_MMA(0, 0, At, B0); PG8_BAR; PG8_SCHED;
            PG8_LDB(B1, 0, 1); PG8_STAGE(PG8_SB(0, 0), b2, voffB);
            PG8_BAR; PG8_WAIT_L(0); PG8_MMA(0, 1, At, B1); PG8_BAR;
            PG8_LDA(At, 0, 1); PG8_STAGE(PG8_SA(0, 0), a2, voffA);
            PG8_BAR; PG8_WAIT_L(0); PG8_MMA(1, 0, At, B0); PG8_BAR; PG8_SCHED;
            PG8_STAGE(PG8_SB(0, 1), b2 + hstep, voffB);
            PG8_WAIT_V(6); PG8_BAR; PG8_MMA(1, 1, At, B1); PG8_BAR;
            PG8_LDB(B0, 1, 0); PG8_SCHED; PG8_LDA(At, 1, 0); PG8_STAGE(PG8_SA(0, 1), a2 + hstep, voffA);
            PG8_WAIT_L(8); PG8_BAR; PG8_WAIT_L(0); PG8_MMA(0, 0, At, B0); PG8_BAR; PG8_SCHED;
            PG8_LDB(B1, 1, 1); PG8_STAGE(PG8_SB(1, 0), b3, voffB);
            PG8_BAR; PG8_WAIT_L(0); PG8_MMA(0, 1, At, B1); PG8_BAR;
            PG8_LDA(At, 1, 1); PG8_STAGE(PG8_SA(1, 0), a3, voffA);
            PG8_BAR; PG8_WAIT_L(0); PG8_MMA(1, 0, At, B0); PG8_BAR; PG8_SCHED;
            PG8_STAGE(PG8_SB(1, 1), b3 + hstep, voffB);
            PG8_WAIT_V(6); PG8_BAR; PG8_MMA(1, 1, At, B1); PG8_BAR;
            }
        }
        if constexpr (ALIGN_EPI) { if (wr == 0) PG8_BAR; }
        if constexpr (!Epi::AFTER_DRAIN) { E(acc, cur, wr, wc, fr, fq); S.done(cur); }
        if (!has_next) break;
#pragma unroll
        for (int a = 0; a < 2; ++a)
#pragma unroll
            for (int b = 0; b < 2; ++b)
#pragma unroll
                for (int m = 0; m < 4; ++m)
#pragma unroll
                    for (int n = 0; n < 2; ++n) acc[a][b][m][n] = (f32x4){0.f, 0.f, 0.f, 0.f};
        cur = nxt; cA = nA; cB = nB; ++ui;
        if constexpr (ALIGN_EPI) { if (wr == 1) PG8_BAR; }
    }
    PG8_WAIT_V(0);
    if constexpr (!ALIGN_EPI) { if (wr == 0) PG8_BAR; }
    PG8_BAR;
    if constexpr (Epi::AFTER_DRAIN) { E.fused(acc, cur, wr, wc, fr, fq, lds, wid, lane); S.done(cur); }
#undef PG8_SA
#undef PG8_SB
#undef PG8_STAGE
#undef PG8_LDA
#undef PG8_LDB
#undef PG8_MMA
#undef PG8_WAIT_V
#undef PG8_WAIT_L
#undef PG8_BAR
#undef PG8_SCHED
}
}
DI void ph_setup(const P& p, char* lds) {
  const int tid = otid(), nb = gridDim.x, bid = blockIdx.x;
  float* modL = (float*)(p.ws + WS_MOD);
  float* sc = (float*)lds;
  for (int it = bid; it < 192; it += nb) {
    const int layer = it / 96, cb = it % 96;
    const int lane = tid & 63, ks = tid >> 6;
    __syncthreads();
    for (int i = tid; i < 5 * 1024; i += NT) { const int v = i >> 10, k = i & 1023; const float cv = (v < 4) ? p.c[v * 1024 + k] : p.c_ctx[k]; sc[i] = silu_f(cv); }
    __syncthreads();
    const int n = cb * 64 + lane;
    const float* w = p.ada_w + ((size_t)layer * 1024 + ks * 128) * 6144 + n;
    float a0 = 0, a1 = 0, a2 = 0, a3 = 0, a4 = 0;
#pragma unroll 8
    for (int k = 0; k < 128; ++k) { const float wv = w[(size_t)k * 6144]; const int kk = ks * 128 + k; a0 += wv * sc[kk]; a1 += wv * sc[1024 + kk]; a2 += wv * sc[2048 + kk]; a3 += wv * sc[3072 + kk]; a4 += wv * sc[4096 + kk]; }
    float* red = sc + 5 * 1024;
    red[(ks * 5 + 0) * 64 + lane] = a0; red[(ks * 5 + 1) * 64 + lane] = a1; red[(ks * 5 + 2) * 64 + lane] = a2; red[(ks * 5 + 3) * 64 + lane] = a3; red[(ks * 5 + 4) * 64 + lane] = a4;
    __syncthreads();
    if (tid < 320) {
      const int v = tid >> 6, l = tid & 63;
      float sacc = p.ada_b[layer * 6144 + cb * 64 + l];
      for (int k8 = 0; k8 < 8; ++k8) sacc += red[(k8 * 5 + v) * 64 + l];
      modL[(layer * 5 + v) * 6144 + cb * 64 + l] = sacc;
    }
  }
  {
    float* rope = (float*)(p.ws + WS_ROPE);
    for (int i = bid * NT + tid; i < SEQ * 32; i += nb * NT) {
      const int l = i >> 5, d = i & 31;
      const float inv = exp2f(-(float)(2 * (d & 15)) * (13.287712379549449f / 32.f));
      const float pos = (d < 16) ? (float)(l >> 6) : (float)(l & 63);
      float s, c; sincosf(pos * inv, &s, &c);
      rope[2 * i] = c; rope[2 * i + 1] = s;
    }
  }
  {
    float* tl = (float*)lds;
    const int nt_in = (NIN / 64) * 16, nt_o = 16 * 16;
    for (int it = bid; it < nt_in + 2 * nt_o; it += nb) {
      const float* src; bf16_t* dst; int npitch, nb0, kb0, which;
      if (it < nt_in) { which = 0; nb0 = (it / 16) * 64; kb0 = (it % 16) * 64; src = p.w_in; dst = (bf16_t*)(p.ws + WS_WIN); npitch = 3616; }
      else if (it < nt_in + nt_o) { const int j = it - nt_in; which = 1; nb0 = (j / 16) * 64; kb0 = (j % 16) * 64; src = p.w_out_ab; dst = (bf16_t*)(p.ws + WS_WOUT); npitch = 1024; }
      else { const int j = it - nt_in - nt_o; which = 2; nb0 = (j / 16) * 64; kb0 = (j % 16) * 64; src = p.w_out_f; dst = (bf16_t*)(p.ws + WS_WF); npitch = 1024; }
      __syncthreads();
      for (int e = tid; e < 4096; e += NT) {
        const int kk = e >> 6, nn = e & 63; const int n = nb0 + nn;
        int sn = n;
        if (which == 0) {
          if (n < 2048) sn = n;
          else if (n < 3072) { const int pq = n & 63, blk = pq >> 3, e8 = pq & 7; sn = (n & ~63) + 32 + ((e8 < 4) ? 4 * blk + e8 : 32 + 4 * blk + (e8 - 4)); }
          else if (n < 3584) sn = n + 32;
          else if (n < 3616) sn = n - 1536;
          else sn = -1;
        }
        tl[kk * 65 + nn] = (sn >= 0) ? src[(size_t)(kb0 + kk) * npitch + sn] : 0.f;
      }
      __syncthreads();
      for (int e = tid; e < 4096; e += NT) { const int nn = e >> 6, kk = e & 63; dst[(size_t)(nb0 + nn) * 1024 + kb0 + kk] = (bf16_t)f2bf(tl[kk * 65 + nn]); }
    }
  }
  {
    float* kl = (float*)lds;
    float* wl = kl + 128 * 132;
    bf16_t* weff = (bf16_t*)(p.ws + WS_WEFF);
    for (int it = bid; it < 512; it += nb) {
      const int layer = it >> 8, hp = (it >> 4) & 15, kb = it & 15;
      __syncthreads();
      const float* ks = p.peer_keys + ((size_t)(layer * 16 + hp) * 128) * 128;
      for (int e = tid; e < 128 * 128; e += NT) kl[(e >> 7) * 132 + (e & 127)] = ks[e];
      const float* ws_ = p.peer_wq + ((size_t)layer * 1024 + kb * 64) * 2048 + hp * 128;
      for (int e = tid; e < 64 * 128; e += NT) wl[(e >> 7) * 132 + (e & 127)] = ws_[(size_t)(e >> 7) * 2048 + (e & 127)];
      __syncthreads();
      const int key = tid & 127, kq = tid >> 7;
      float a[16];
#pragma unroll
      for (int i = 0; i < 16; ++i) a[i] = 0.f;
      for (int d = 0; d < 128; d += 4) {
        const f32x4 kv = *(const f32x4*)(kl + key * 132 + d);
#pragma unroll
        for (int i = 0; i < 16; ++i) { const f32x4 wv = *(const f32x4*)(wl + (kq * 16 + i) * 132 + d); a[i] += kv[0] * wv[0] + kv[1] * wv[1] + kv[2] * wv[2] + kv[3] * wv[3]; }
      }
      bf16_t* o = weff + ((size_t)layer * 2048 + hp * 128 + key) * 1024 + kb * 64 + kq * 16;
      u32x4 o0, o1;
      o0[0] = pk2(a[0], a[1]); o0[1] = pk2(a[2], a[3]); o0[2] = pk2(a[4], a[5]); o0[3] = pk2(a[6], a[7]);
      o1[0] = pk2(a[8], a[9]); o1[1] = pk2(a[10], a[11]); o1[2] = pk2(a[12], a[13]); o1[3] = pk2(a[14], a[15]);
      *(u32x4*)o = o0; *(u32x4*)(o + 8) = o1;
    }
  }
  {
    bf16_t* d0 = (bf16_t*)(p.ws + WS_DFT0); bf16_t* d1 = (bf16_t*)(p.ws + WS_DFT1); bf16_t* d3 = (bf16_t*)(p.ws + WS_DFT3);
    for (int i = bid * NT + tid; i < 512 * 256; i += nb * NT) {
      const int n = i >> 8, c = i & 255, m = n & 255; const float fr = (float)((m * c) & 255) * (2.f / 256.f);
      d0[i] = (bf16_t)f2bf(n < 256 ? cospif(fr) : -sinpif(fr));
    }
    for (int i = bid * NT + tid; i < 128 * 128; i += nb * NT) {
      const int n = i >> 7, k = i & 127; const int k1 = 32 * (n >> 6) + (n & 31), ro = (n >> 5) & 1, ri = k >> 6, l1 = k & 63;
      const float fr = (float)((k1 * l1) & 63) * (2.f / 64.f); const float cs = cospif(fr), sn = sinpif(fr);
      d1[i] = (bf16_t)f2bf(ro == 0 ? (ri == 0 ? cs : sn) : (ri == 0 ? -sn : cs));
    }
    for (int i = bid * NT + tid; i < 128 * 256; i += nb * NT) {
      const int k2 = i >> 8, k = i & 255, ri = k >> 7, l2 = k & 127; const float fr = (float)((l2 * k2) & 127) * (2.f / 128.f);
      const float scl = 6.905339660024878e-4f;
      d3[i] = (bf16_t)f2bf((ri == 0 ? cospif(fr) : sinpif(fr)) * scl);
    }
  }
}

DI void norm_rows(const float* __restrict__ src, int row_begin, int nrows, const float* __restrict__ nw, const float* __restrict__ modbase  ,
                  int shift_j, int scale_j, bool ctx_tail  , bf16_t* __restrict__ dst, bool blk = false  ) {
  const int lane = otid() & 63, gw = (blk ? 0 : blockIdx.x * (NT / 64)) + (otid() >> 6), nw_ = (blk ? 1 : gridDim.x) * (NT / 64);
  for (int row = row_begin + gw; row < nrows; row += nw_) {
    const int v = (ctx_tail && row >= TL) ? 4 : (row >> 13);
    const float* xr = src + (size_t)row * DM;
    f32x4 xv[4]; float ss = 0.f;
#pragma unroll
    for (int i = 0; i < 4; ++i) { xv[i] = *(const f32x4*)(xr + lane * 4 + 256 * i); ss += xv[i][0] * xv[i][0] + xv[i][1] * xv[i][1] + xv[i][2] * xv[i][2] + xv[i][3] * xv[i][3]; }
    ss = wave_sum(ss);
    const float rs = rsqrtf(ss * (1.f / DM) + EPS);
    const float* sh = modbase + (size_t)v * 6144 + shift_j * 1024; const float* scp = modbase + (size_t)v * 6144 + scale_j * 1024;
#pragma unroll
    for (int i = 0; i < 4; ++i) {
      const int c = lane * 4 + 256 * i;
      const f32x4 w4 = *(const f32x4*)(nw + c), s4 = *(const f32x4*)(sh + c), c4 = *(const f32x4*)(scp + c);
      float y0 = xv[i][0] * rs * w4[0] * (1.f + c4[0]) + s4[0], y1 = xv[i][1] * rs * w4[1] * (1.f + c4[1]) + s4[1];
      float y2 = xv[i][2] * rs * w4[2] * (1.f + c4[2]) + s4[2], y3 = xv[i][3] * rs * w4[3] * (1.f + c4[3]) + s4[3];
      u32x2 o; o[0] = pk2(y0, y1); o[1] = pk2(y2, y3);
      *(u32x2*)(dst + (size_t)row * DM + c) = o;
    }
  }
}

constexpr size_t WS_HQ = (size_t)393 * MiB, WS_HS = (size_t)425 * MiB;
DI void norm_rows_hq(const P& p, const float* __restrict__ nw, const float* __restrict__ modbase) {
  const int lane = otid() & 63, gw = blockIdx.x * (NT / 64) + (otid() >> 6), nw_ = gridDim.x * (NT / 64);
  bf16_t* dst = (bf16_t*)(p.ws + R0); unsigned char* hq = (unsigned char*)(p.ws + WS_HQ); float* hs = (float*)(p.ws + WS_HS);
  for (int row = gw; row < TL; row += nw_) {
    const float* xr = p.out + (size_t)row * DM + lane * 16;
    f32x4 xv[4]; float ss = 0.f;
#pragma unroll
    for (int i = 0; i < 4; ++i) { xv[i] = *(const f32x4*)(xr + 4 * i); ss += xv[i][0] * xv[i][0] + xv[i][1] * xv[i][1] + xv[i][2] * xv[i][2] + xv[i][3] * xv[i][3]; }
    ss = wave_sum(ss);
    const float rs = rsqrtf(ss * (1.f / DM) + EPS);
    const float* sh = modbase + (size_t)(row >> 13) * 6144 + 3 * 1024 + lane * 16; const float* scp = sh + 1024;
    float y[16]; float am = 0.f;
#pragma unroll
    for (int i = 0; i < 4; ++i) {
      const f32x4 w4 = *(const f32x4*)(nw + lane * 16 + 4 * i), s4 = *(const f32x4*)(sh + 4 * i), c4 = *(const f32x4*)(scp + 4 * i);
#pragma unroll
      for (int j = 0; j < 4; ++j) { y[4 * i + j] = xv[i][j] * rs * w4[j] * (1.f + c4[j]) + s4[j]; am = fmaxf(am, fabsf(y[4 * i + j])); }
    }
#pragma unroll
    for (int o = 32; o >= 1; o >>= 1) am = fmaxf(am, __shfl_xor(am, o, 64));
    u32x4 o0, o1;
#pragma unroll
    for (int i = 0; i < 4; ++i) { o0[i] = pk2(y[2 * i], y[2 * i + 1]); o1[i] = pk2(y[8 + 2 * i], y[9 + 2 * i]); }
    *(u32x4*)(dst + (size_t)row * DM + lane * 16) = o0; *(u32x4*)(dst + (size_t)row * DM + lane * 16 + 8) = o1;
    const float st = am * (1.f / 119.f) + 1e-30f, ist = 1.f / st;
    unsigned h0 = 0u, h1 = 0u, l0 = 0u, l1 = 0u;
#pragma unroll
    for (int j = 0; j < 8; ++j) {
      const int va = (int)fminf(fmaxf(rintf(y[j] * ist), -120.f), 119.f), vb = (int)fminf(fmaxf(rintf(y[8 + j] * ist), -120.f), 119.f);
      const int ha = (va + 8) >> 4, hb = (vb + 8) >> 4, la = va - 16 * ha, lb = vb - 16 * hb;
      h0 |= ((unsigned)ha & 15u) << (4 * j); h1 |= ((unsigned)hb & 15u) << (4 * j); l0 |= ((unsigned)la & 15u) << (4 * j); l1 |= ((unsigned)lb & 15u) << (4 * j);
    }
    u32x2 vh; vh[0] = h0; vh[1] = h1; *(u32x2*)(hq + (size_t)row * 1024 + lane * 8) = vh;
    u32x2 vl; vl[0] = l0; vl[1] = l1; *(u32x2*)(hq + (size_t)row * 1024 + 512 + lane * 8) = vl;
    if (lane == 0) hs[row] = st;
  }
}

struct EpiProjV {
  const P* p; int row0, col0;
  DI void operator()(f32x16 (&acc)[2][2], int wm, int wn, int lane) const {
    const int cb = col0 + wn * 64, h = lane >> 5, cl = lane & 31;
    const bool isctx = row0 >= TL;
    bf16_t* o = (bf16_t*)(p->ws + WS_VT);
    const int hv = (cb - 3072) >> 7, dvb = (cb - 3072) & 127;
#pragma unroll
    for (int mt = 0; mt < 2; ++mt)
#pragma unroll
      for (int nt = 0; nt < 2; ++nt)
#pragma unroll
        for (int g = 0; g < 4; ++g) {
          const int row = row0 + wm * 64 + mt * 32 + 8 * g + 4 * h;
          int b, pos; if (!isctx) { b = row >> 13; pos = row & (SEQ - 1); } else { const int rc = row - TL; b = rc >> 8; pos = SEQ + (rc & 255); }
          const int dv = dvb + nt * 32 + cl;
          u32x2 v; v[0] = pk2(acc[mt][nt][4 * g], acc[mt][nt][4 * g + 1]); v[1] = pk2(acc[mt][nt][4 * g + 2], acc[mt][nt][4 * g + 3]);
          *(u32x2*)(o + ((size_t)((b * 4 + hv) * 128 + dv)) * KVL + pos) = v;
        }
  }
};
struct EpiProjS {
  const P* p; int row0, col0;
  DI void operator()(f32x16 (&acc)[2][2], int wm, int wn, int lane) const {
    const int cb = col0 + wn * 64, h = lane >> 5, cl = lane & 31;
    const bool isctx = row0 >= TL;
    char* ws = p->ws;
    if (cb < 2048) {
      const bool isg = cb >= 1536;
      if (isg && isctx) return;
      bf16_t* o = (bf16_t*)(ws + (isg ? WS_GATE : WS_QKVRAW));
      const int pitch = isg ? 512 : 1536, cofs = isg ? cb - 1536 : cb;
#pragma unroll
      for (int mt = 0; mt < 2; ++mt) {
        const int row = row0 + wm * 64 + mt * 32 + cl;
#pragma unroll
        for (int nt = 0; nt < 2; ++nt)
#pragma unroll
          for (int g = 0; g < 4; ++g) {
            float v0 = acc[mt][nt][4 * g], v1 = acc[mt][nt][4 * g + 1], v2 = acc[mt][nt][4 * g + 2], v3 = acc[mt][nt][4 * g + 3];
            if (isg) { v0 = silu_f(v0); v1 = silu_f(v1); v2 = silu_f(v2); v3 = silu_f(v3); }
            u32x2 v; v[0] = pk2(v0, v1); v[1] = pk2(v2, v3);
            *(u32x2*)(o + (size_t)row * pitch + cofs + nt * 32 + 8 * g + 4 * h) = v;
          }
      }
    } else if (cb < 3072) {
      const bool isq = cb < 2560;
      if (isq && isctx) return;
      const float* rope = (const float*)(ws + WS_ROPE);
      bf16_t* o = (bf16_t*)(ws + (isq ? WS_Q : WS_K));
      const int cofs = cb - (isq ? 2048 : 2560);
      const float qs = isq ? 0.125f * 1.4426950408889634f : 1.f;
#pragma unroll
      for (int mt = 0; mt < 2; ++mt) {
        const int row = row0 + wm * 64 + mt * 32 + cl;
        size_t orow; int l = 0;
        if (!isctx) { l = row & (SEQ - 1); orow = isq ? (size_t)row : (size_t)(row >> 13) * KVL + l; }
        else { const int rc = row - TL; orow = (size_t)(rc >> 8) * KVL + SEQ + (rc & 255); }
#pragma unroll
        for (int g = 0; g < 4; ++g) {
          const int d0 = 8 * g + 4 * h;
          float o1[4], o2[4];
          if (!isctx) {
            const f32x4 ca = *(const f32x4*)(rope + ((size_t)l * 32 + d0) * 2), cb2 = *(const f32x4*)(rope + ((size_t)l * 32 + d0) * 2 + 4);
            const float cs[4] = {ca[0], ca[2], cb2[0], cb2[2]}, sn[4] = {ca[1], ca[3], cb2[1], cb2[3]};
#pragma unroll
            for (int r = 0; r < 4; ++r) { const float x1 = acc[mt][0][4 * g + r], x2 = acc[mt][1][4 * g + r]; o1[r] = (x1 * cs[r] - x2 * sn[r]) * qs; o2[r] = (x1 * sn[r] + x2 * cs[r]) * qs; }
          } else {
#pragma unroll
            for (int r = 0; r < 4; ++r) { o1[r] = acc[mt][0][4 * g + r]; o2[r] = acc[mt][1][4 * g + r]; }
          }
          u32x2 v; v[0] = pk2(o1[0], o1[1]); v[1] = pk2(o1[2], o1[3]); *(u32x2*)(o + orow * 512 + cofs + d0) = v;
          v[0] = pk2(o2[0], o2[1]); v[1] = pk2(o2[2], o2[3]); *(u32x2*)(o + orow * 512 + cofs + 32 + d0) = v;
        }
      }
    } else if (cb == 3584) {
      float* o = (float*)(ws + WS_BA);
#pragma unroll
      for (int mt = 0; mt < 2; ++mt) {
        const int row = row0 + wm * 64 + mt * 32 + cl;
#pragma unroll
        for (int g = 0; g < 4; ++g) {
          const int j0 = 8 * g + 4 * h;
          f32x4 y;
#pragma unroll
          for (int r = 0; r < 4; ++r) {
            const int j = j0 + r; const float v = acc[mt][0][4 * g + r];
            if (j0 < 16) y[r] = sigmoid_f(v);
            else { const float z = v + p->dt_bias[j - 16]; const float sp = (z > 20.f) ? z : log1pf(__expf(z)); y[r] = -__expf(p->a_log[j - 16]) * sp; }
          }
          *(f32x4*)(o + (size_t)row * 32 + j0) = y;
        }
      }
    }
  }
};

DI void ph_gemm_proj(const P& p, char* lds) {
  const bf16_t* A = (const bf16_t*)(p.ws + R0); const bf16_t* Bt = (const bf16_t*)(p.ws + WS_WIN);
  const int nM = TA / GBM, nN = NIN / GBN;
  for (int t = blockIdx.x; t < nM * nN; t += gridDim.x) {
    const int pm = t / nN, pn = t % nN;
    RowLin rf{A + (size_t)pm * GBM * DM, (size_t)DM};
    if (pn >= 24 && pn < 28) { EpiProjV ep{&p, pm * GBM, pn * GBN}; gemm_tile<false>(lds, rf, Bt + (size_t)pn * GBN * DM, DM, ep); }
    else { EpiProjS ep{&p, pm * GBM, pn * GBN}; gemm_tile<true>(lds, rf, Bt + (size_t)pn * GBN * DM, DM, ep); }
  }
}


struct PgResid {
  static constexpr bool PERM = true, AFTER_DRAIN = false;
  const float* xin; float* xout; const float* gmod;
  DI void operator()(const pg8::f32x4 (&acc)[2][2][4][2], const pg8::Unit& u, int wr, int wc, int fr, int fq) const {
#pragma unroll
    for (int ai = 0; ai < 2; ++ai)
#pragma unroll
      for (int m = 0; m < 4; ++m) {
        const int row = u.pm * 256 + ai * 128 + wr * 64 + m * 16 + fr;
        const float* gm = gmod + (size_t)(row >> 13) * 6144;
#pragma unroll
        for (int bj = 0; bj < 2; ++bj) {
          const int c0 = u.pn * 256 + bj * 128 + wc * 32 + 8 * fq;
#pragma unroll
          for (int n = 0; n < 2; ++n) {
            const f32x4 xv = *(const f32x4*)(xin + (size_t)row * DM + c0 + 4 * n), g4 = *(const f32x4*)(gm + c0 + 4 * n);
            *(f32x4*)(xout + (size_t)row * DM + c0 + 4 * n) = xv + g4 * acc[ai][bj][m][n];
          }
        }
      }
  }
};
struct PgBf16 {
  static constexpr bool PERM = true, AFTER_DRAIN = false;
  bf16_t* o; int pitch;
  DI void operator()(const pg8::f32x4 (&acc)[2][2][4][2], const pg8::Unit& u, int wr, int wc, int fr, int fq) const {
#pragma unroll
    for (int ai = 0; ai < 2; ++ai)
#pragma unroll
      for (int m = 0; m < 4; ++m) {
        const int row = u.pm * 256 + ai * 128 + wr * 64 + m * 16 + fr;
#pragma unroll
        for (int bj = 0; bj < 2; ++bj) {
          const int c0 = u.pn * 256 + bj * 128 + wc * 32 + 8 * fq;
          const f32x4 v0 = acc[ai][bj][m][0], v1 = acc[ai][bj][m][1];
          u32x4 w; w[0] = pk2(v0[0], v0[1]); w[1] = pk2(v0[2], v0[3]); w[2] = pk2(v1[0], v1[1]); w[3] = pk2(v1[2], v1[3]);
          *(u32x4*)(o + (size_t)row * pitch + c0) = w;
        }
      }
  }
};
struct PgProj {
  static constexpr bool PERM = true, AFTER_DRAIN = false;
  const P* p;
  DI void operator()(const pg8::f32x4 (&acc)[2][2][4][2], const pg8::Unit& u, int wr, int wc, int fr, int fq) const {
    char* ws = p->ws;
    const bool isctx = u.pm * 256 >= TL;
#pragma unroll
    for (int bj = 0; bj < 2; ++bj) {
      const int c0 = u.pn * 256 + bj * 128 + wc * 32 + 8 * fq;
      const int cs = u.pn * 256 + bj * 128 + wc * 32;
      if (cs < 2048) {
        const bool isg = cs >= 1536;
        if (isg && isctx) continue;
        bf16_t* o = (bf16_t*)(ws + (isg ? WS_GATE : WS_QKVRAW));
        const int pitch = isg ? 512 : 1536, cofs = isg ? c0 - 1536 : c0;
#pragma unroll
        for (int ai = 0; ai < 2; ++ai)
#pragma unroll
          for (int m = 0; m < 4; ++m) {
            const int row = u.pm * 256 + ai * 128 + wr * 64 + m * 16 + fr;
            f32x4 v0 = acc[ai][bj][m][0], v1 = acc[ai][bj][m][1];
            if (isg) {
#pragma unroll
              for (int r = 0; r < 4; ++r) { v0[r] = silu_f(v0[r]); v1[r] = silu_f(v1[r]); }
            }
            u32x4 w; w[0] = pk2(v0[0], v0[1]); w[1] = pk2(v0[2], v0[3]); w[2] = pk2(v1[0], v1[1]); w[3] = pk2(v1[2], v1[3]);
            *(u32x4*)(o + (size_t)row * pitch + cofs) = w;
          }
      } else if (cs < 3072) {
        const bool isq = cs < 2560;
        if (isq && isctx) continue;
        const float* rope = (const float*)(ws + WS_ROPE);
        bf16_t* o = (bf16_t*)(ws + (isq ? WS_Q : WS_K));
        const int gofs = (c0 & ~63) - (isq ? 2048 : 2560), d0 = ((c0 & 63) >> 3) * 4;
        const float qs = isq ? 0.125f * 1.4426950408889634f : 1.f;
#pragma unroll
        for (int ai = 0; ai < 2; ++ai)
#pragma unroll
          for (int m = 0; m < 4; ++m) {
            const int row = u.pm * 256 + ai * 128 + wr * 64 + m * 16 + fr;
            const f32x4 x1 = acc[ai][bj][m][0], x2 = acc[ai][bj][m][1];
            size_t orow; float o1[4], o2[4];
            if (!isctx) {
              const int l = row & (SEQ - 1);
              orow = isq ? (size_t)row : (size_t)(row >> 13) * KVL + l;
              const f32x4 ca = *(const f32x4*)(rope + ((size_t)l * 32 + d0) * 2), cb2 = *(const f32x4*)(rope + ((size_t)l * 32 + d0) * 2 + 4);
              const float cs4[4] = {ca[0], ca[2], cb2[0], cb2[2]}, sn4[4] = {ca[1], ca[3], cb2[1], cb2[3]};
#pragma unroll
              for (int r = 0; r < 4; ++r) { o1[r] = (x1[r] * cs4[r] - x2[r] * sn4[r]) * qs; o2[r] = (x1[r] * sn4[r] + x2[r] * cs4[r]) * qs; }
            } else {
              const int rc = row - TL; orow = (size_t)(rc >> 8) * KVL + SEQ + (rc & 255);
#pragma unroll
              for (int r = 0; r < 4; ++r) { o1[r] = x1[r]; o2[r] = x2[r]; }
            }
            u32x2 v; v[0] = pk2(o1[0], o1[1]); v[1] = pk2(o1[2], o1[3]); *(u32x2*)(o + orow * 512 + gofs + d0) = v;
            v[0] = pk2(o2[0], o2[1]); v[1] = pk2(o2[2], o2[3]); *(u32x2*)(o + orow * 512 + gofs + 32 + d0) = v;
          }
      } else if (cs < 3584) {
        bf16_t* o = (bf16_t*)(ws + WS_VT);
        const int hv = (c0 - 3072) >> 7, dv0 = (c0 - 3072) & 127;
#pragma unroll
        for (int ai = 0; ai < 2; ++ai)
#pragma unroll
          for (int m = 0; m < 4; ++m) {
            const int row = u.pm * 256 + ai * 128 + wr * 64 + m * 16 + fr;
            int b, pos; if (!isctx) { b = row >> 13; pos = row & (SEQ - 1); } else { const int rc = row - TL; b = rc >> 8; pos = SEQ + (rc & 255); }
            bf16_t* op = o + ((size_t)((b * 4 + hv) * 128 + dv0)) * KVL + pos;
#pragma unroll
            for (int n = 0; n < 2; ++n)
#pragma unroll
              for (int r = 0; r < 4; ++r) op[(size_t)(4 * n + r) * KVL] = (bf16_t)f2bf(acc[ai][bj][m][n][r]);
          }
      } else if (cs == 3584) {
        float* o = (float*)(ws + WS_BA);
        const int j0 = c0 - 3584;
#pragma unroll
        for (int ai = 0; ai < 2; ++ai)
#pragma unroll
          for (int m = 0; m < 4; ++m) {
            const int row = u.pm * 256 + ai * 128 + wr * 64 + m * 16 + fr;
#pragma unroll
            for (int n = 0; n < 2; ++n) {
              f32x4 y;
#pragma unroll
              for (int r = 0; r < 4; ++r) {
                const int j = j0 + 4 * n + r; const float v = acc[ai][bj][m][n][r];
                if (j0 < 16) y[r] = sigmoid_f(v);
                else { const float z = v + p->dt_bias[j - 16]; const float sp = (z > 20.f) ? z : log1pf(__expf(z)); y[r] = -__expf(p->a_log[j - 16]) * sp; }
              }
              *(f32x4*)(o + (size_t)row * 32 + j0 + 4 * n) = y;
            }
          }
      }
    }
  }
};
template <class Epi>
DI void pg8_run(char* lds, const bf16_t* A, const bf16_t* Bt, int M, int N, int K, const Epi& E) {
  pg8::Gemm g{A, Bt, M, N, K};
  pg8::StaticOrder S; S.init(M, N, (int)gridDim.x, (int)blockIdx.x);
  pg8::gemm_phase<Epi, pg8::StaticOrder, true, true>((PG8_LAS unsigned char*)lds, g, S, E);
}

DI void gdn_solve(const float* MT, const float* src  , const float* be, const float* gc  ,
                  int d, int part, int lane, bf16_t* uo) {
  float a[64];
#pragma unroll
  for (int i = 0; i < 64; ++i) {
    const int t = d ? 63 - i : i;
    float v = be[t] * src[t * 68 + lane];
    if (part) v *= __expf(gc[t]);
    a[i] = v;
  }
#pragma unroll
  for (int j = 0; j < 63; ++j) {
    const float xj = a[j];
#pragma unroll
    for (int i4 = ((j + 1) & ~3); i4 < 64; i4 += 4) {
      const f32x4 m = *(const f32x4*)(MT + j * 68 + i4);
#pragma unroll
      for (int q = 0; q < 4; ++q) if (i4 + q > j) a[i4 + q] -= m[q] * xj;
    }
  }
  if (part) {
#pragma unroll
    for (int i = 0; i < 64; ++i) uo[i * 64 + lane] = (bf16_t)f2bf(a[i]);
  } else {
#pragma unroll
    for (int c = 0; c < 8; ++c) {
      u32x4 o; o[0] = pk2(a[8 * c], a[8 * c + 1]); o[1] = pk2(a[8 * c + 2], a[8 * c + 3]); o[2] = pk2(a[8 * c + 4], a[8 * c + 5]); o[3] = pk2(a[8 * c + 6], a[8 * c + 7]);
      *(u32x4*)(uo + lane * 64 + 8 * c) = o;
    }
  }
}

template <int MODE = 0>
DI void ph_gdn_prep(const P& p, char* lds) {
  const int tid0 = otid();
  float* L = (float*)lds;
  constexpr int HSZ = 4 * 64 * 68 + 6 * 64;
  const bf16_t* raw = (const bf16_t*)(p.ws + WS_QKVRAW);
  const float* BA = (const float*)(p.ws + WS_BA);
  bf16_t* qn = (bf16_t*)(p.ws + WS_QN); bf16_t* kn = (bf16_t*)(p.ws + WS_KN);
  float* GC = (float*)(p.ws + WS_GC);
  bf16_t* UW = (bf16_t*)(p.ws + WS_UW);
  for (int it = blockIdx.x; it < NB * NCH * 4; it += gridDim.x) {
    int tid = tid0; asm volatile("" : "+v"(tid));
    const int lane = tid & 63, wave = __builtin_amdgcn_readfirstlane(tid >> 6);
    const int hpair = it & 3, cid = (it >> 2) % NCH, b = it / (4 * NCH);
    const int segbase = (cid < 4) ? TL + b * CTXL : b * SEQ, c0 = (cid < 4) ? cid * 64 : (cid - 4) * 64, seglen = (cid < 4) ? CTXL : SEQ;
    __syncthreads();
    {
      const int t = tid >> 3, c8 = tid & 7, sidx = c0 + t;
      const size_t grow = (size_t)(segbase + sidx);
      const bool hm = sidx - 1 >= 0, hp_ = sidx + 1 < seglen;
#pragma unroll 1
      for (int hh = 0; hh < 2; ++hh) {
        const int head = hpair * 2 + hh;
        float* kf = L + hh * HSZ; float* vf = kf + 64 * 68;
#pragma unroll
        for (int part = 0; part < 3; ++part) {
          const int ch = part * 512 + head * 64 + c8 * 8;
          const u32x4 z4 = {0u, 0u, 0u, 0u};
          const u32x4 rm = hm ? *(const u32x4*)(raw + (grow - 1) * 1536 + ch) : z4;
          const u32x4 r0v = *(const u32x4*)(raw + grow * 1536 + ch);
          const u32x4 rp = hp_ ? *(const u32x4*)(raw + (grow + 1) * 1536 + ch) : z4;
          float v[8]; float ss = 0.f;
#pragma unroll
          for (int w = 0; w < 4; ++w) {
            const f32x2_t w0 = *(const f32x2_t*)(p.conv_w + ch + 2 * w), w1 = *(const f32x2_t*)(p.conv_w + 1536 + ch + 2 * w), w2 = *(const f32x2_t*)(p.conv_w + 3072 + ch + 2 * w);
            v[2 * w] = silu_f(w0[0] * bflo(rm[w]) + w1[0] * bflo(r0v[w]) + w2[0] * bflo(rp[w]));
            v[2 * w + 1] = silu_f(w0[1] * bfhi(rm[w]) + w1[1] * bfhi(r0v[w]) + w2[1] * bfhi(rp[w]));
            ss += v[2 * w] * v[2 * w] + v[2 * w + 1] * v[2 * w + 1];
          }
          if (part < 2) {
            ss += __shfl_xor(ss, 1, 64); ss += __shfl_xor(ss, 2, 64); ss += __shfl_xor(ss, 4, 64);
            const float rn = rsqrtf(ss + EPS) * (part == 0 ? 0.125f : 1.f);
#pragma unroll
            for (int w = 0; w < 8; ++w) v[w] *= rn;
            u32x4 o; o[0] = pk2(v[0], v[1]); o[1] = pk2(v[2], v[3]); o[2] = pk2(v[4], v[5]); o[3] = pk2(v[6], v[7]);
            *(u32x4*)((part == 0 ? qn : kn) + grow * 512 + head * 64 + c8 * 8) = o;
          }
          if (part >= 1) {
            float* dst = (part == 1 ? kf : vf) + t * 68 + c8 * 8;
            *(f32x4*)dst = f32x4{v[0], v[1], v[2], v[3]}; *(f32x4*)(dst + 4) = f32x4{v[4], v[5], v[6], v[7]};
          }
        }
      }
    }
    if (MODE == 2) continue;
    if (wave < 4) {
      const int hh = wave >> 1, d = wave & 1, head = hpair * 2 + hh, t = lane;
      float* be = L + hh * HSZ + 4 * 64 * 68;
      const size_t row = (size_t)(segbase + c0 + t);
      be[d * 64 + t] = BA[row * 32 + d * 8 + head];
      const float g = BA[row * 32 + 16 + d * 8 + head];
      float a = g;
#pragma unroll
      for (int o = 1; o < 64; o <<= 1) {
        const float nb_ = d ? __shfl_down(a, o, 64) : __shfl_up(a, o, 64);
        const bool ok = d ? (lane + o < 64) : (lane >= o);
        a += ok ? nb_ : 0.f;
      }
      be[256 + d * 64 + t] = a;
      GC[((size_t)((b * 8 + head) * 2 + d) * NCH + cid) * 64 + (d ? 63 - t : t)] = a;
    }
    __syncthreads();
    {
      const int hh = wave >> 2, Ln = lane;
      float* kf = L + hh * HSZ; float* M0 = kf + 2 * 64 * 68; float* M1 = kf + 3 * 64 * 68; float* be = kf + 4 * 64 * 68; float* gc = be + 256;
      float a[16];
#pragma unroll
      for (int i = 0; i < 16; ++i) a[i] = 0.f;
#pragma unroll 1
      for (int c = 0; c < 64; c += 4) {
        const f32x4 kv = *(const f32x4*)(kf + Ln * 68 + c);
#pragma unroll
        for (int i = 0; i < 16; ++i) { const f32x4 kr = *(const f32x4*)(kf + ((wave & 3) * 16 + i) * 68 + c); a[i] += kv[0] * kr[0] + kv[1] * kr[1] + kv[2] * kr[2] + kv[3] * kr[3]; }
      }
      const float b0 = be[Ln], b1 = be[64 + Ln], g0 = gc[Ln], g1 = gc[64 + Ln];
#pragma unroll
      for (int i = 0; i < 16; ++i) {
        const int ti = (wave & 3) * 16 + i;
        if (Ln > ti) M0[ti * 68 + Ln] = b0 * a[i] * __expf(g0 - gc[ti]);
        else if (Ln < ti) M1[(63 - ti) * 68 + 63 - Ln] = b1 * a[i] * __expf(g1 - gc[64 + ti]);
      }
    }
    __syncthreads();
    if (MODE == 0) {
      const int hh = wave >> 2, d = (wave >> 1) & 1, part = wave & 1, head = hpair * 2 + hh;
      float* kf = L + hh * HSZ; float* vf = kf + 64 * 68; float* Md = kf + (2 + d) * 64 * 68; float* be = kf + 4 * 64 * 68; float* gc = be + 256;
      bf16_t* uo = UW + (((size_t)((b * 8 + head) * 2 + d) * NCH + cid) * 2 + part) * 4096;
      gdn_solve(Md, part ? kf : vf, be + d * 64, gc + d * 64, d, part, lane, uo);
    }
  }
}

#define MFMA16(a, b, c) __builtin_amdgcn_mfma_f32_16x16x32_bf16((a), (b), (c), 0, 0, 0)
constexpr int SC_LD = 72;
constexpr int SC_T = 64 * SC_LD * 2;
constexpr int SC_STAGE = 5 * SC_T + 1024;
constexpr int SC_KNL = 2 * SC_STAGE, SC_QNL = SC_KNL + SC_T;
DI bf16x8 pack8(const f32x4& a, const f32x4& b) { u32x4 r; r[0] = cvtpk(a[0], a[1]); r[1] = cvtpk(a[2], a[3]); r[2] = cvtpk(b[0], b[1]); r[3] = cvtpk(b[2], b[3]); return __builtin_bit_cast(bf16x8, r); }
DI bf16x8 afrag(const char* tile, int row, int kofs  ) {
  const char* pr = tile + (row * SC_LD + kofs) * 2;
  const u32x2 lo = *(const u32x2*)pr, hi = *(const u32x2*)(pr + 32);
  u32x4 r; r[0] = lo[0]; r[1] = lo[1]; r[2] = hi[0]; r[3] = hi[1];
  return __builtin_bit_cast(bf16x8, r);
}
template <int NOSTORE = 0>
DI void ph_gdn_scan(const P& p, char* lds) {
  const int tid = otid(), lane = tid & 63, wave = __builtin_amdgcn_readfirstlane(tid >> 6);
  const int c = lane & 15, q = lane >> 4;
  const bf16_t* qn = (const bf16_t*)(p.ws + WS_QN); const bf16_t* kn = (const bf16_t*)(p.ws + WS_KN);
  const float* GC = (const float*)(p.ws + WS_GC);
  const bf16_t* UW = (const bf16_t*)(p.ws + WS_UW);
  bf16_t* Ob = (bf16_t*)(p.ws + WS_OBUF);
  for (int it = blockIdx.x; it < 64; it += gridDim.x) {
    const int bhd = it, d = bhd & 1, head = (bhd >> 1) & 7, b = bhd >> 4;
    __syncthreads();
    if (wave >= 4) {
      const int pt = tid - 256;
      const int r0 = pt >> 3, cc = pt & 7;
      u32x4 rW0A, rW1A, rU0A, rU1A, rK0A, rK1A, rQ0A, rQ1A; f32x4 rGA;
      u32x4 rW0B, rW1B, rU0B, rU1B, rK0B, rK1B, rQ0B, rQ1B; f32x4 rGB;
#define SP_CID(n) (d ? ((n) < 4 ? 3 - (n) : 135 - (n)) : (n))
#define SP_LOAD(n, S) do { const int nn_ = (n) < NCH ? (n) : NCH - 1; const int cid_ = SP_CID(nn_); const bool lat_ = cid_ >= 4; const int sb_ = lat_ ? b * SEQ : TL + b * CTXL, c0_ = lat_ ? (cid_ - 4) * 64 : cid_ * 64; \
        const bf16_t* uw_ = UW + ((size_t)(bhd * NCH + cid_) * 2) * 4096; \
        rU0##S = *(const u32x4*)(uw_ + r0 * 64 + cc * 8); rU1##S = *(const u32x4*)(uw_ + (r0 + 32) * 64 + cc * 8); \
        rW0##S = *(const u32x4*)(uw_ + 4096 + r0 * 64 + cc * 8); rW1##S = *(const u32x4*)(uw_ + 4096 + (r0 + 32) * 64 + cc * 8); \
        const int t0_ = d ? 63 - r0 : r0, t1_ = d ? 31 - r0 : r0 + 32; \
        rK0##S = *(const u32x4*)(kn + (size_t)(sb_ + c0_ + t0_) * 512 + head * 64 + cc * 8); rK1##S = *(const u32x4*)(kn + (size_t)(sb_ + c0_ + t1_) * 512 + head * 64 + cc * 8); \
        const bf16_t* qk_ = lat_ ? qn : kn;     \
        rQ0##S = *(const u32x4*)(qk_ + (size_t)(sb_ + c0_ + t0_) * 512 + head * 64 + cc * 8); rQ1##S = *(const u32x4*)(qk_ + (size_t)(sb_ + c0_ + t1_) * 512 + head * 64 + cc * 8); \
        rG##S = *(const f32x4*)(GC + (size_t)(bhd * NCH + cid_) * 64 + (pt & 15) * 4); } while (0)
#define SP_A(n, S) do { char* st_ = lds + ((n) & 1) * SC_STAGE; const int o0_ = (r0 * SC_LD + cc * 8) * 2, o1_ = o0_ + 32 * SC_LD * 2; \
        *(u32x4*)(st_ + o0_) = rW0##S; *(u32x4*)(st_ + o1_) = rW1##S; *(u32x4*)(st_ + SC_T + o0_) = rU0##S; *(u32x4*)(st_ + SC_T + o1_) = rU1##S; \
        *(u32x4*)(lds + SC_KNL + o0_) = rK0##S; *(u32x4*)(lds + SC_KNL + o1_) = rK1##S; \
        *(u32x4*)(lds + SC_QNL + o0_) = rQ0##S; *(u32x4*)(lds + SC_QNL + o1_) = rQ1##S; \
        if (pt < 16) { float* gp_ = (float*)(st_ + 5 * SC_T); *(f32x4*)(gp_ + pt * 4) = rG##S; } } while (0)
#define SP_B(n) do { char* st_ = lds + ((n) & 1) * SC_STAGE; float* gp_ = (float*)(st_ + 5 * SC_T); const bool lat_ = SP_CID((n) < NCH ? (n) : NCH - 1) >= 4; \
        const float gl_ = gp_[63]; \
        if (pt < 64) { const float gi_ = gp_[pt]; gp_[64 + pt] = __expf(gi_); gp_[128 + pt] = __expf(gl_ - gi_); if (pt == 0) gp_[192] = __expf(gl_); } \
        {   \
          const int i_ = pt & 63; \
          _Pragma("unroll") for (int e_ = 0; e_ < 2; ++e_) { const int ch_ = (pt >> 6) * 2 + e_; const u32x4 kv_ = *(const u32x4*)(lds + SC_KNL + (i_ * SC_LD + ch_ * 8) * 2); \
            bf16_t* kt_ = (bf16_t*)(st_ + 2 * SC_T); \
            _Pragma("unroll") for (int w_ = 0; w_ < 4; ++w_) { kt_[(ch_ * 8 + 2 * w_) * SC_LD + i_] = (bf16_t)(kv_[w_] & 0xFFFFu); kt_[(ch_ * 8 + 2 * w_ + 1) * SC_LD + i_] = (bf16_t)(kv_[w_] >> 16); } } } \
        if (lat_) { \
          {   \
            _Pragma("unroll") for (int e_ = 0; e_ < 2; ++e_) { const int rr_ = r0 + 32 * e_; const float sc_ = __expf(gp_[rr_]); const u32x4 qv_ = *(const u32x4*)(lds + SC_QNL + (rr_ * SC_LD + cc * 8) * 2); u32x4 ov_; \
              _Pragma("unroll") for (int w_ = 0; w_ < 4; ++w_) ov_[w_] = cvtpk(bflo(qv_[w_]) * sc_, bfhi(qv_[w_]) * sc_); \
              *(u32x4*)(st_ + 3 * SC_T + (rr_ * SC_LD + cc * 8) * 2) = ov_; } } \
          {   \
            const int jt_ = wave - 4; \
            const bf16x8 ka0_ = *(const bf16x8*)(lds + SC_KNL + ((16 * jt_ + c) * SC_LD + 8 * q) * 2), ka1_ = *(const bf16x8*)(lds + SC_KNL + ((16 * jt_ + c) * SC_LD + 32 + 8 * q) * 2); \
            bf16x8 qb_[4][2]; \
            _Pragma("unroll") for (int it_ = 0; it_ < 4; ++it_) { qb_[it_][0] = *(const bf16x8*)(lds + SC_QNL + ((16 * it_ + c) * SC_LD + 8 * q) * 2); qb_[it_][1] = *(const bf16x8*)(lds + SC_QNL + ((16 * it_ + c) * SC_LD + 32 + 8 * q) * 2); } \
            const f32x4 gj_ = *(const f32x4*)(gp_ + 16 * jt_ + 4 * q); \
            float gi_[4]; _Pragma("unroll") for (int it_ = 0; it_ < 4; ++it_) gi_[it_] = gp_[16 * it_ + c]; \
            _Pragma("unroll") for (int it_ = 0; it_ < 4; ++it_) { \
              f32x4 ac_ = {0.f, 0.f, 0.f, 0.f}; \
              ac_ = MFMA16(ka0_, qb_[it_][0], ac_); ac_ = MFMA16(ka1_, qb_[it_][1], ac_); \
              const int i_ = 16 * it_ + c; \
              _Pragma("unroll") for (int r_ = 0; r_ < 4; ++r_) { const int j_ = 16 * jt_ + 4 * q + r_; const float e_ = __expf(fminf(gi_[it_] - gj_[r_], 0.f)); ac_[r_] = (i_ >= j_) ? ac_[r_] * e_ : 0.f; } \
              u32x2 ov_; ov_[0] = cvtpk(ac_[0], ac_[1]); ov_[1] = cvtpk(ac_[2], ac_[3]); \
              *(u32x2*)(st_ + 4 * SC_T + ((16 * it_ + c) * SC_LD + 16 * jt_ + 4 * q) * 2) = ov_; } } } } while (0)
      SP_LOAD(0, A); SP_LOAD(1, B);
      SP_A(0, A);
      __syncthreads();
      SP_B(0);
      SP_LOAD(2, A);
      __syncthreads();
#define SP_STEP(n, S) do { SP_A((n) + 1, S); SP_LOAD((n) + 3, S);        \
        __syncthreads();                 \
        SP_B((n) + 1); \
        __syncthreads();                 } while (0)
#pragma unroll 1
      for (int n = 0; n < NCH; n += 2) { SP_STEP(n, B); SP_STEP(n + 1, A); }
#undef SP_STEP
#undef SP_LOAD
#undef SP_A
#undef SP_B
    } else {
      f32x4 S[4];
#pragma unroll
      for (int i = 0; i < 4; ++i) S[i] = f32x4{0.f, 0.f, 0.f, 0.f};
      __syncthreads();
      __syncthreads();
#pragma unroll 1
      for (int n = 0; n < NCH; ++n) {
        const int cid = SP_CID(n); const bool lat = cid >= 4;
        const char* st = lds + (n & 1) * SC_STAGE; const float* gp = (const float*)(st + 5 * SC_T);
        bf16x8 Sb[2], Sn[2];
#pragma unroll
        for (int ks = 0; ks < 2; ++ks) {
          Sb[ks] = pack8(S[2 * ks], S[2 * ks + 1]);
          u32x4 t = __builtin_bit_cast(u32x4, Sb[ks]);
#pragma unroll
          for (int w = 0; w < 4; ++w) t[w] ^= 0x80008000u;
          Sn[ks] = __builtin_bit_cast(bf16x8, t);
        }
        u32x2 ur[4]; bf16x8 wf[4][2], kf2[4][2]; f32x4 sc4[4];
#pragma unroll
        for (int mt = 0; mt < 4; ++mt) {
          ur[mt] = *(const u32x2*)(st + SC_T + ((16 * wave + c) * SC_LD + 16 * mt + 4 * q) * 2);
          wf[mt][0] = afrag(st, 16 * mt + c, 4 * q); wf[mt][1] = afrag(st, 16 * mt + c, 32 + 4 * q);
          sc4[mt] = *(const f32x4*)(gp + 128 + 16 * mt + 4 * q);
        }
#pragma unroll
        for (int dt = 0; dt < 4; ++dt) { kf2[dt][0] = afrag(st + 2 * SC_T, 16 * dt + c, 4 * q); kf2[dt][1] = afrag(st + 2 * SC_T, 16 * dt + c, 32 + 4 * q); }
        const float gt = gp[192];
        f32x4 vn[4], vs[4];
#pragma unroll
        for (int mt = 0; mt < 4; ++mt) {
          f32x4 acc = {bflo(ur[mt][0]), bfhi(ur[mt][0]), bflo(ur[mt][1]), bfhi(ur[mt][1])};
          acc = MFMA16(wf[mt][0], Sn[0], acc);
          acc = MFMA16(wf[mt][1], Sn[1], acc);
          vn[mt] = acc;
          vs[mt] = acc * sc4[mt];
        }
        bf16x8 Vn[2], Vs[2];
#pragma unroll
        for (int ks = 0; ks < 2; ++ks) { Vn[ks] = pack8(vn[2 * ks], vn[2 * ks + 1]); Vs[ks] = pack8(vs[2 * ks], vs[2 * ks + 1]); }
        f32x4 Snew[4];
#pragma unroll
        for (int dt = 0; dt < 4; ++dt) {
          f32x4 acc = S[dt] * gt;
          acc = MFMA16(kf2[dt][0], Vs[0], acc);
          acc = MFMA16(kf2[dt][1], Vs[1], acc);
          Snew[dt] = acc;
        }
        __syncthreads();
        if (lat) {
          const int sb = b * SEQ, c0 = (cid - 4) * 64;
          bf16x8 qf[4][2], pf[4][2];
#pragma unroll
          for (int mt = 0; mt < 4; ++mt) {
            qf[mt][0] = afrag(st + 3 * SC_T, 16 * mt + c, 4 * q); qf[mt][1] = afrag(st + 3 * SC_T, 16 * mt + c, 32 + 4 * q);
            pf[mt][0] = afrag(st + 4 * SC_T, 16 * mt + c, 4 * q); pf[mt][1] = afrag(st + 4 * SC_T, 16 * mt + c, 32 + 4 * q);
          }
#pragma unroll
          for (int mt = 0; mt < 4; ++mt) {
            f32x4 o = {0.f, 0.f, 0.f, 0.f};
            o = MFMA16(Sb[0], qf[mt][0], o);
            o = MFMA16(Sb[1], qf[mt][1], o);
            o = MFMA16(Vn[0], pf[mt][0], o);
            o = MFMA16(Vn[1], pf[mt][1], o);
            const int i = 16 * mt + c, t = d ? 63 - i : i;
            u32x2 ov; ov[0] = cvtpk(o[0], o[1]); ov[1] = cvtpk(o[2], o[3]);
            if (!NOSTORE || ov[0] == 0x12345678u) *(u32x2*)(Ob + ((size_t)d * TL + sb + c0 + t) * 512 + head * 64 + 16 * wave + 4 * q) = ov;
          }
        }
#pragma unroll
        for (int dt = 0; dt < 4; ++dt) S[dt] = Snew[dt];
        __syncthreads();
      }
    }
#undef SP_CID
  }
}

constexpr int AT_KROW = 72, AT_VROW = 68;
constexpr int AT_KB = 2 * 64 * AT_KROW * 2, AT_VB = 128 * AT_VROW * 2, AT_STAGE = AT_KB + AT_VB;
DI void ph_attn(const P& p, char* lds) {
  const int tid = otid(), lane = tid & 63, wave = tid >> 6, wq = wave & 3, m = wave >> 2, h = lane >> 5, cl = lane & 31;
  const bf16_t* Qb = (const bf16_t*)(p.ws + WS_Q); const bf16_t* Kb = (const bf16_t*)(p.ws + WS_K); const bf16_t* VT = (const bf16_t*)(p.ws + WS_VT);
  bf16_t* mix = (bf16_t*)(p.ws + WS_MIX);
  for (int it = blockIdx.x; it < NB * 4 * 64; it += gridDim.x) {
    const int qb = it & 63, head = (it >> 6) & 3, b = it >> 8;
    const int qrow = b * SEQ + qb * 128 + wq * 32 + cl;
    bf16x8 qf[4];
#pragma unroll
    for (int kk = 0; kk < 4; ++kk) qf[kk] = *(const bf16x8*)(Qb + (size_t)qrow * 512 + (head * 2 + m) * 64 + kk * 16 + h * 8);
    f32x16 o[4];
#pragma unroll
    for (int i = 0; i < 4; ++i)
#pragma unroll
      for (int r = 0; r < 16; ++r) o[i][r] = 0.f;
    float mrun = -1e30f, lrun = 0.f;
    const bf16_t* kp0 = Kb + ((size_t)b * KVL + (tid >> 4)) * 512 + head * 128 + (tid & 15) * 8;
    const bf16_t* kp1 = kp0 + (size_t)32 * 512;
    const bf16_t* vp0 = VT + ((size_t)((b * 4 + head) * 128 + (tid >> 3))) * KVL + (tid & 7) * 8;
    const bf16_t* vp1 = vp0 + (size_t)64 * KVL;
    const int kw0 = ((((tid & 15) >> 3) * 64 + (tid >> 4)) * AT_KROW + ((tid & 15) & 7) * 8) * 2, kw1 = kw0 + 32 * AT_KROW * 2;
    const int vw0 = AT_KB + ((tid >> 3) * AT_VROW + (tid & 7) * 8) * 2, vw1 = vw0 + 64 * AT_VROW * 2;
    u32x4 rk0, rk1, rv0, rv1;
#define A_GLOAD(kv0) do { rk0 = *(const u32x4*)(kp0 + (size_t)(kv0) * 512); rk1 = *(const u32x4*)(kp1 + (size_t)(kv0) * 512); rv0 = *(const u32x4*)(vp0 + (kv0)); rv1 = *(const u32x4*)(vp1 + (kv0)); } while (0)
#define A_LWRITE(st) do { char* b_ = lds + (st) * AT_STAGE; *(u32x4*)(b_ + kw0) = rk0; *(u32x4*)(b_ + kw1) = rk1; \
      u32x2 t_; t_[0] = rv0[0]; t_[1] = rv0[1]; *(u32x2*)(b_ + vw0) = t_; t_[0] = rv0[2]; t_[1] = rv0[3]; *(u32x2*)(b_ + vw0 + 8) = t_; \
      t_[0] = rv1[0]; t_[1] = rv1[1]; *(u32x2*)(b_ + vw1) = t_; t_[0] = rv1[2]; t_[1] = rv1[3]; *(u32x2*)(b_ + vw1 + 8) = t_; } while (0)
    A_GLOAD(0);
    __syncthreads();
    A_LWRITE(0);
    __syncthreads();
    constexpr int NKT = KVL / 64;
    for (int kt = 0; kt < NKT; ++kt) {
      if (kt + 1 < NKT) A_GLOAD((kt + 1) * 64);
      const char* sb = lds + (kt & 1) * AT_STAGE;
      const char* ks = sb + (m * 64 * AT_KROW) * 2;
      f32x16 st[2];
#pragma unroll
      for (int k2 = 0; k2 < 2; ++k2) {
#pragma unroll
        for (int r = 0; r < 16; ++r) st[k2][r] = 0.f;
#pragma unroll
        for (int kk = 0; kk < 4; ++kk) {
          const bf16x8 a = *(const bf16x8*)(ks + ((k2 * 32 + cl) * AT_KROW + kk * 16 + h * 8) * 2);
          st[k2] = MFMA32(a, qf[kk], st[k2]);
        }
      }
      float mx = fmaxf(st[0][0], st[1][0]);
#pragma unroll
      for (int r = 1; r < 16; ++r) mx = fmaxf(mx, fmaxf(st[0][r], st[1][r]));
      mx = fmaxf(mx, __shfl_xor(mx, 32, 64));
      if (__any(mx > mrun + 8.f)) {
        const float mnew = fmaxf(mrun, mx);
        const float alpha = __builtin_amdgcn_exp2f(mrun - mnew);
        mrun = mnew; lrun *= alpha;
#pragma unroll
        for (int i = 0; i < 4; ++i)
#pragma unroll
          for (int r = 0; r < 16; ++r) o[i][r] *= alpha;
      }
      float rs = 0.f;
#pragma unroll
      for (int k2 = 0; k2 < 2; ++k2)
#pragma unroll
        for (int r = 0; r < 16; ++r) { const float pv = __builtin_amdgcn_exp2f(st[k2][r] - mrun); st[k2][r] = pv; rs += pv; }
      lrun += rs;
      const char* vsb = sb + AT_KB;
#pragma unroll
      for (int k2 = 0; k2 < 2; ++k2)
#pragma unroll
        for (int s = 0; s < 2; ++s) {
          u32x4 pb;
          pb[0] = cvtpk(st[k2][8 * s + 0], st[k2][8 * s + 1]); pb[1] = cvtpk(st[k2][8 * s + 2], st[k2][8 * s + 3]);
          pb[2] = cvtpk(st[k2][8 * s + 4], st[k2][8 * s + 5]); pb[3] = cvtpk(st[k2][8 * s + 6], st[k2][8 * s + 7]);
          const bf16x8 pfrag = __builtin_bit_cast(bf16x8, pb);
#pragma unroll
          for (int dt = 0; dt < 4; ++dt) {
            const char* vr = vsb + ((dt * 32 + cl) * AT_VROW + k2 * 32 + 16 * s + 4 * h) * 2;
            const u32x2 lo = *(const u32x2*)(vr), hi = *(const u32x2*)(vr + 16);
            u32x4 av; av[0] = lo[0]; av[1] = lo[1]; av[2] = hi[0]; av[3] = hi[1];
            o[dt] = MFMA32(__builtin_bit_cast(bf16x8, av), pfrag, o[dt]);
          }
        }
      if (kt + 1 < NKT) A_LWRITE((kt + 1) & 1);
      __syncthreads();
    }
#undef A_GLOAD
#undef A_LWRITE
    const float ltot = lrun + __shfl_xor(lrun, 32, 64);
    const float inv = 1.f / ltot;
    float* X = (float*)lds;
    if (m == 1) {
#pragma unroll
      for (int dt = 0; dt < 4; ++dt)
#pragma unroll
        for (int r = 0; r < 16; ++r) X[(wq * 32 + cl) * 129 + dt * 32 + crow(r, h)] = o[dt][r] * inv;
    }
    __syncthreads();
    if (m == 0) {
      float l1 = 0.f, l2 = 0.f;
      for (int i = 0; i < 64; ++i) { l1 += p.lam_q1[i] * p.lam_k1[i]; l2 += p.lam_q2[i] * p.lam_k2[i]; }
      const float lam = __expf(l1) - __expf(l2) + 0.2f;
      float ss = 0.f;
#pragma unroll
      for (int dt = 0; dt < 4; ++dt)
#pragma unroll
        for (int r = 0; r < 16; ++r) { const float dv = o[dt][r] * inv - lam * X[(wq * 32 + cl) * 129 + dt * 32 + crow(r, h)]; o[dt][r] = dv; ss += dv * dv; }
      ss += __shfl_xor(ss, 32, 64);
      const float rn = rsqrtf(ss * (1.f / 128.f) + EPS) * 0.8f;
#pragma unroll
      for (int dt = 0; dt < 4; ++dt)
#pragma unroll
        for (int g = 0; g < 4; ++g) {
          const int dv = dt * 32 + 8 * g + 4 * h;
          const f32x4 w4 = *(const f32x4*)(p.subln_w + dv);
          u32x2 v; v[0] = pk2(o[dt][4 * g] * rn * w4[0], o[dt][4 * g + 1] * rn * w4[1]); v[1] = pk2(o[dt][4 * g + 2] * rn * w4[2], o[dt][4 * g + 3] * rn * w4[3]);
          *(u32x2*)(mix + (size_t)qrow * DM + 512 + head * 128 + dv) = v;
        }
    }
    __syncthreads();
  }
}

DI void ph_mixout(const P& p) {
  const int lane = otid() & 63, gw = blockIdx.x * (NT / 64) + (otid() >> 6), nw_ = gridDim.x * (NT / 64);
  const bf16_t* Ob = (const bf16_t*)(p.ws + WS_OBUF); const bf16_t* gate = (const bf16_t*)(p.ws + WS_GATE);
  bf16_t* mix = (bf16_t*)(p.ws + WS_MIX);
  for (int row = gw; row < TL; row += nw_) {
    const u32x4 a = *(const u32x4*)(Ob + (size_t)row * 512 + lane * 8), bq = *(const u32x4*)(Ob + ((size_t)TL + row) * 512 + lane * 8);
    const u32x4 gv = *(const u32x4*)(gate + (size_t)row * 512 + lane * 8);
    float v[8]; float ss = 0.f;
#pragma unroll
    for (int i = 0; i < 4; ++i) { v[2 * i] = bflo(a[i]) + bflo(bq[i]); v[2 * i + 1] = bfhi(a[i]) + bfhi(bq[i]); ss += v[2 * i] * v[2 * i] + v[2 * i + 1] * v[2 * i + 1]; }
    ss += __shfl_xor(ss, 1, 64); ss += __shfl_xor(ss, 2, 64); ss += __shfl_xor(ss, 4, 64);
    const float rn = rsqrtf(ss * (1.f / 64.f) + EPS);
    const int c0 = (lane & 7) * 8;
    u32x4 ov;
#pragma unroll
    for (int i = 0; i < 4; ++i) ov[i] = pk2(v[2 * i] * rn * p.gdn_norm_w[c0 + 2 * i] * bflo(gv[i]), v[2 * i + 1] * rn * p.gdn_norm_w[c0 + 2 * i + 1] * bfhi(gv[i]));
    *(u32x4*)(mix + (size_t)row * DM + lane * 8) = ov;
  }
}

struct EpiResid {
  const float* xin; float* xout; const float* gmod  ; int row0, col0;
  DI void operator()(f32x16 (&acc)[2][2], int wm, int wn, int lane) const {
    const int h = lane >> 5, cl = lane & 31;
#pragma unroll
    for (int mt = 0; mt < 2; ++mt) {
      const int row = row0 + wm * 64 + mt * 32 + cl;
      const float* gm = gmod + (size_t)(row >> 13) * 6144;
#pragma unroll
      for (int nt = 0; nt < 2; ++nt)
#pragma unroll
        for (int g = 0; g < 4; ++g) {
          const int col = col0 + wn * 64 + nt * 32 + 8 * g + 4 * h;
          const f32x4 xv = *(const f32x4*)(xin + (size_t)row * DM + col), g4 = *(const f32x4*)(gm + col);
          f32x4 ov;
#pragma unroll
          for (int r = 0; r < 4; ++r) ov[r] = xv[r] + g4[r] * acc[mt][nt][4 * g + r];
          *(f32x4*)(xout + (size_t)row * DM + col) = ov;
        }
    }
  }
};
DI void ph_gemm_resid(const P& p, char* lds, const bf16_t* A, const bf16_t* Bt, const float* xin, const float* gmod) {
  const int nM = TL / GBM, nN = DM / GBN;
  for (int t = blockIdx.x; t < nM * nN; t += gridDim.x) {
    const int pm = t / nN, pn = t % nN;
    RowLin rf{A + (size_t)pm * GBM * DM, (size_t)DM};
    EpiResid ep{xin, p.out, gmod, pm * GBM, pn * GBN};
    gemm_tile<true>(lds, rf, Bt + (size_t)pn * GBN * DM, DM, ep);
  }
}

struct EpiBf16 {
  bf16_t* o; int pitch, row0, col0;
  DI void operator()(f32x16 (&acc)[2][2], int wm, int wn, int lane) const {
    const int h = lane >> 5, cl = lane & 31;
#pragma unroll
    for (int mt = 0; mt < 2; ++mt) {
      const int row = row0 + wm * 64 + mt * 32 + cl;
#pragma unroll
      for (int nt = 0; nt < 2; ++nt)
#pragma unroll
        for (int g = 0; g < 4; ++g) {
          u32x2 v; v[0] = pk2(acc[mt][nt][4 * g], acc[mt][nt][4 * g + 1]); v[1] = pk2(acc[mt][nt][4 * g + 2], acc[mt][nt][4 * g + 3]);
          *(u32x2*)(o + (size_t)row * pitch + col0 + wn * 64 + nt * 32 + 8 * g + 4 * h) = v;
        }
    }
  }
};
DI void ph_gemm_scores(const P& p, char* lds, int layer, size_t sc_off) {
  const bf16_t* A = (const bf16_t*)(p.ws + R0); const bf16_t* Bt = (const bf16_t*)(p.ws + WS_WEFF) + (size_t)layer * 2048 * 1024;
  const int nM = TL / GBM, nN = 2048 / GBN;
  for (int t = blockIdx.x; t < nM * nN; t += gridDim.x) {
    const int pm = t / nN, pn = t % nN;
    RowLin rf{A + (size_t)pm * GBM * DM, (size_t)DM};
    EpiBf16 ep{(bf16_t*)(p.ws + sc_off), 2048, pm * GBM, pn * GBN};
    gemm_tile<true>(lds, rf, Bt + (size_t)pn * GBN * DM, DM, ep);
  }
}

constexpr size_t WS_TSC = WS_BA;
DI void ph_tables(const P& p) {
  const int lane = otid() & 63, gw = blockIdx.x * (NT / 64) + (otid() >> 6), nw_ = gridDim.x * (NT / 64);
  float* tsc = (float*)(p.ws + WS_TSC);
  for (int rr = gw; rr < 4 * 16384; rr += nw_) {
    const int tb = rr >> 14, e = rr & 16383;
    const float* src = ((tb & 1) ? p.peer_v : p.peer_u) + ((size_t)(tb >> 1) * 16384 + e) * 1024 + lane * 16;
    f32x4 v[4]; float ss = 0.f;
#pragma unroll
    for (int i = 0; i < 4; ++i) { v[i] = *(const f32x4*)(src + 4 * i); ss += v[i][0] * v[i][0] + v[i][1] * v[i][1] + v[i][2] * v[i][2] + v[i][3] * v[i][3]; }
    ss = wave_sum(ss);
    const bool isu = (tb & 1) == 0;
    const float sc = (isu ? 0.35f : 0.5f) * sqrtf(ss * (1.f / 1024.f)) + 1e-30f, inv = 1.f / sc;
    unsigned w0 = 0u, w1 = 0u;
    if (isu) {
#pragma unroll
      for (int i = 0; i < 2; ++i)
#pragma unroll
        for (int j = 0; j < 4; ++j) {
          const int qa = (int)fminf(fmaxf(rintf(v[i][j] * inv), -7.f), 7.f), qb = (int)fminf(fmaxf(rintf(v[2 + i][j] * inv), -7.f), 7.f);
          w0 |= ((unsigned)qa & 15u) << (4 * (4 * i + j)); w1 |= ((unsigned)qb & 15u) << (4 * (4 * i + j));
        }
    } else {
      w0 = __builtin_amdgcn_cvt_scalef32_pk_fp4_f32(w0, v[0][0] * inv, v[0][1] * inv, 1.0f, 0);
      w0 = __builtin_amdgcn_cvt_scalef32_pk_fp4_f32(w0, v[0][2] * inv, v[0][3] * inv, 1.0f, 1);
      w0 = __builtin_amdgcn_cvt_scalef32_pk_fp4_f32(w0, v[1][0] * inv, v[1][1] * inv, 1.0f, 2);
      w0 = __builtin_amdgcn_cvt_scalef32_pk_fp4_f32(w0, v[1][2] * inv, v[1][3] * inv, 1.0f, 3);
      w1 = __builtin_amdgcn_cvt_scalef32_pk_fp4_f32(w1, v[2][0] * inv, v[2][1] * inv, 1.0f, 0);
      w1 = __builtin_amdgcn_cvt_scalef32_pk_fp4_f32(w1, v[2][2] * inv, v[2][3] * inv, 1.0f, 1);
      w1 = __builtin_amdgcn_cvt_scalef32_pk_fp4_f32(w1, v[3][0] * inv, v[3][1] * inv, 1.0f, 2);
      w1 = __builtin_amdgcn_cvt_scalef32_pk_fp4_f32(w1, v[3][2] * inv, v[3][3] * inv, 1.0f, 3);
    }
    u32x2 o; o[0] = w0; o[1] = w1;
    unsigned char* dst = (unsigned char*)(p.ws + WS_TAB + (size_t)tb * 8 * MiB);
    *(u32x2*)(dst + ((((size_t)(lane >> 4)) * 16384 + e) << 7) + (lane & 15) * 8) = o;
    if (lane == 0) tsc[tb * 16384 + e] = sc;
  }
}

DI unsigned srt16(unsigned bf) { return (bf & 0x8000u) ? (~bf & 0xFFFFu) : (bf | 0x8000u); }
DI float unsrt16(unsigned s) { const unsigned bf = (s & 0x8000u) ? (s & 0x7FFFu) : (~s & 0xFFFFu); return __uint_as_float(bf << 16); }
DI unsigned ckey(float v, unsigned cid) { unsigned u = __float_as_uint(v); u = (u & 0x80000000u) ? ~u : (u | 0x80000000u); return (u & 0xFFFFFF00u) | (255u - cid); }
DI float unckey(unsigned k) { unsigned u = k & 0xFFFFFF00u; u = (u & 0x80000000u) ? (u & 0x7FFFFFFFu) : ~u; return __uint_as_float(u & 0xFFFFFF00u); }
DI void bsort16(unsigned (&k)[16]) {
#pragma unroll
  for (int sz = 2; sz <= 16; sz <<= 1)
#pragma unroll
    for (int j = sz >> 1; j > 0; j >>= 1)
#pragma unroll
      for (int i = 0; i < 16; ++i) {
        const int l = i ^ j;
        if (l > i) {
          const unsigned a = k[i], b = k[l], mx = a > b ? a : b, mn = a > b ? b : a;
          if ((i & sz) == 0) { k[i] = mx; k[l] = mn; } else { k[i] = mn; k[l] = mx; }
        }
      }
}
DI void bmerge16(unsigned (&k)[16]) {
#pragma unroll
  for (int j = 8; j > 0; j >>= 1)
#pragma unroll
    for (int i = 0; i < 16; ++i) {
      const int l = i ^ j;
      if (l > i) { const unsigned a = k[i], b = k[l]; k[i] = a > b ? a : b; k[l] = a > b ? b : a; }
    }
}
DI void topmerge16(unsigned (&run)[16], const unsigned (&g)[16]) {
#pragma unroll
  for (int i = 0; i < 16; ++i) run[i] = run[i] > g[15 - i] ? run[i] : g[15 - i];
  bmerge16(run);
}
DI void top16_of_128(const bf16_t* __restrict__ r, unsigned (&run)[16]) {
#pragma unroll 1
  for (int g = 0; g < 8; ++g) {
    const u32x4 v0 = *(const u32x4*)(r + g * 16), v1 = *(const u32x4*)(r + g * 16 + 8);
    unsigned k[16];
#pragma unroll
    for (int q = 0; q < 4; ++q) {
      k[2 * q] = (srt16(v0[q] & 0xFFFFu) << 16) | (127u - (g * 16 + 2 * q));
      k[2 * q + 1] = (srt16(v0[q] >> 16) << 16) | (127u - (g * 16 + 2 * q + 1));
      k[8 + 2 * q] = (srt16(v1[q] & 0xFFFFu) << 16) | (127u - (g * 16 + 8 + 2 * q));
      k[8 + 2 * q + 1] = (srt16(v1[q] >> 16) << 16) | (127u - (g * 16 + 8 + 2 * q + 1));
    }
    bsort16(k);
    if (g == 0) {
#pragma unroll
      for (int i = 0; i < 16; ++i) run[i] = k[i];
    } else topmerge16(run, k);
  }
}
DI void ph_topk(const P& p, char* lds, size_t sc_off, size_t ei_off, size_t eg_off) {
  const bf16_t* sc = (const bf16_t*)(p.ws + sc_off); int* EI = (int*)(p.ws + ei_off); float* EG = (float*)(p.ws + eg_off);
  unsigned char* sI = (unsigned char*)lds;
  const int tid = otid();
  const int tpb_ = TL / gridDim.x;
  for (int g = blockIdx.x * tpb_ * 8 + tid; g < (blockIdx.x + 1) * tpb_ * 8; g += NT) {
    const int t = g >> 3, head = g & 7;
    const bf16_t* r1 = sc + (size_t)t * 2048 + head * 256;
    unsigned k1[16], k2[16];
    top16_of_128(r1, k1);
    top16_of_128(r1 + 128, k2);
    float f1[16], f2[16];
#pragma unroll
    for (int i = 0; i < 16; ++i) { f1[i] = unsrt16(k1[i] >> 16); f2[i] = unsrt16(k2[i] >> 16); sI[i * NT + tid] = (unsigned char)(127u - (k1[i] & 127u)); sI[(16 + i) * NT + tid] = (unsigned char)(127u - (k2[i] & 127u)); }
    unsigned cg0[16], cg1[16], cg2[16], cg3[16];
#pragma unroll
    for (int i = 0; i < 16; ++i) { cg3[i] = 0u; }
    cg0[0] = ckey(f1[0] + f2[0], 0);
    cg0[1] = ckey(f1[0] + f2[1], 1);
    cg0[2] = ckey(f1[0] + f2[2], 2);
    cg0[3] = ckey(f1[0] + f2[3], 3);
    cg0[4] = ckey(f1[0] + f2[4], 4);
    cg0[5] = ckey(f1[0] + f2[5], 5);
    cg0[6] = ckey(f1[0] + f2[6], 6);
    cg0[7] = ckey(f1[0] + f2[7], 7);
    cg0[8] = ckey(f1[0] + f2[8], 8);
    cg0[9] = ckey(f1[0] + f2[9], 9);
    cg0[10] = ckey(f1[0] + f2[10], 10);
    cg0[11] = ckey(f1[0] + f2[11], 11);
    cg0[12] = ckey(f1[0] + f2[12], 12);
    cg0[13] = ckey(f1[0] + f2[13], 13);
    cg0[14] = ckey(f1[0] + f2[14], 14);
    cg0[15] = ckey(f1[0] + f2[15], 15);
    cg1[0] = ckey(f1[1] + f2[0], 16);
    cg1[1] = ckey(f1[1] + f2[1], 17);
    cg1[2] = ckey(f1[1] + f2[2], 18);
    cg1[3] = ckey(f1[1] + f2[3], 19);
    cg1[4] = ckey(f1[1] + f2[4], 20);
    cg1[5] = ckey(f1[1] + f2[5], 21);
    cg1[6] = ckey(f1[1] + f2[6], 22);
    cg1[7] = ckey(f1[1] + f2[7], 23);
    cg1[8] = ckey(f1[2] + f2[0], 32);
    cg1[9] = ckey(f1[2] + f2[1], 33);
    cg1[10] = ckey(f1[2] + f2[2], 34);
    cg1[11] = ckey(f1[2] + f2[3], 35);
    cg1[12] = ckey(f1[2] + f2[4], 36);
    cg1[13] = ckey(f1[3] + f2[0], 48);
    cg1[14] = ckey(f1[3] + f2[1], 49);
    cg1[15] = ckey(f1[3] + f2[2], 50);
    cg2[0] = ckey(f1[3] + f2[3], 51);
    cg2[1] = ckey(f1[4] + f2[0], 64);
    cg2[2] = ckey(f1[4] + f2[1], 65);
    cg2[3] = ckey(f1[4] + f2[2], 66);
    cg2[4] = ckey(f1[5] + f2[0], 80);
    cg2[5] = ckey(f1[5] + f2[1], 81);
    cg2[6] = ckey(f1[6] + f2[0], 96);
    cg2[7] = ckey(f1[6] + f2[1], 97);
    cg2[8] = ckey(f1[7] + f2[0], 112);
    cg2[9] = ckey(f1[7] + f2[1], 113);
    cg2[10] = ckey(f1[8] + f2[0], 128);
    cg2[11] = ckey(f1[9] + f2[0], 144);
    cg2[12] = ckey(f1[10] + f2[0], 160);
    cg2[13] = ckey(f1[11] + f2[0], 176);
    cg2[14] = ckey(f1[12] + f2[0], 192);
    cg2[15] = ckey(f1[13] + f2[0], 208);
    cg3[0] = ckey(f1[14] + f2[0], 224);
    cg3[1] = ckey(f1[15] + f2[0], 240);
    bsort16(cg0); bsort16(cg1); bsort16(cg2); bsort16(cg3);
    topmerge16(cg0, cg1); topmerge16(cg2, cg3); topmerge16(cg0, cg2);
    float e[16]; int id[16]; float sum = 0.f; const float s0 = unckey(cg0[0]);
#pragma unroll
    for (int k = 0; k < 16; ++k) {
      const unsigned cid = 255u - (cg0[k] & 255u);
      e[k] = __expf(unckey(cg0[k]) - s0); sum += e[k];
      id[k] = (int)sI[(cid >> 4) * NT + tid] * 128 + (int)sI[(16 + (cid & 15)) * NT + tid];
    }
    const float inv = 1.f / sum;
#pragma unroll
    for (int k = 0; k < 16; k += 4) {
      int4 iv = {id[k], id[k + 1], id[k + 2], id[k + 3]}; f32x4 gv = {e[k] * inv, e[k + 1] * inv, e[k + 2] * inv, e[k + 3] * inv};
      *(int4*)(EI + (size_t)g * 16 + k) = iv; *(f32x4*)(EG + (size_t)g * 16 + k) = gv;
    }
  }
}

DI void fp8x16_to_f32(const u32x4& w, float (&f)[16]) {
#pragma unroll
  for (int i = 0; i < 4; ++i) {
    const f32x2_t lo = __builtin_amdgcn_cvt_pk_f32_fp8((int)w[i], false), hi = __builtin_amdgcn_cvt_pk_f32_fp8((int)w[i], true);
    f[4 * i] = lo[0]; f[4 * i + 1] = lo[1]; f[4 * i + 2] = hi[0]; f[4 * i + 3] = hi[1];
  }
}
DI void block_handoff() {
  asm volatile("s_waitcnt vmcnt(0)" ::: "memory");
  __syncthreads();
  if (otid() == 0) { __builtin_amdgcn_fence(__ATOMIC_ACQUIRE, "agent"); asm volatile("s_waitcnt vmcnt(0)" ::: "memory"); }
  __syncthreads();
}
constexpr int PQ_NS = 4;
#define PQ_BEGIN() \
  const int tid = otid(), lane = tid & 63, wave = tid >> 6, g8 = lane >> 3, c16 = lane & 7; \
  const int tpb_ = TL / gridDim.x; \
  _Pragma("unroll 1") for (int x = 0; x < PQ_NS; ++x) { \
    const int tbeg = blockIdx.x * tpb_ + wave, tend = (blockIdx.x + 1) * tpb_;
#define PQ_END() }
#define FP4X8(wd, o0, o1, o2, o3) do { o0 = __builtin_amdgcn_cvt_scalef32_pk_f32_fp4((wd), 1.0f, 0); o1 = __builtin_amdgcn_cvt_scalef32_pk_f32_fp4((wd), 1.0f, 1); \
                                         o2 = __builtin_amdgcn_cvt_scalef32_pk_f32_fp4((wd), 1.0f, 2); o3 = __builtin_amdgcn_cvt_scalef32_pk_f32_fp4((wd), 1.0f, 3); } while (0)
DI void ph_peer_u(const P& p, char* lds, int layer, size_t ei_off, size_t part_off) {
  for (int rep = 0; rep <= p.lo; ++rep) {
  PQ_BEGIN()
  const unsigned char* hq = (const unsigned char*)(p.ws + WS_HQ) + x * 128 + c16 * 16;
  const float* hs = (const float*)(p.ws + WS_HS);
  const unsigned char* us = (const unsigned char*)(p.ws + WS_TAB + (size_t)(layer * 2) * 8 * MiB) + ((size_t)x * 16384 << 7) + c16 * 16;
  const int* EI = (const int*)(p.ws + ei_off) + g8 * 16;
  unsigned* part = (unsigned*)(p.ws + part_off);
  int4 nid[4]; u32x4 nhh, nhl; float nsc;
#define PU_PREF(tt) do { const int t_ = (tt) < tend ? (tt) : tend - 1; \
    _Pragma("unroll") for (int i = 0; i < 4; ++i) nid[i] = *(const int4*)(EI + (size_t)t_ * 128 + i * 4); \
    nhh = *(const u32x4*)(hq + (size_t)t_ * 1024); nhl = *(const u32x4*)(hq + (size_t)t_ * 1024 + 512); nsc = hs[t_]; } while (0)
  PU_PREF(tbeg);
#pragma unroll 1
  for (int t = tbeg; t < tend; t += NT / 64) {
    int id[16];
#pragma unroll
    for (int i = 0; i < 4; ++i) { id[4 * i] = nid[i].x; id[4 * i + 1] = nid[i].y; id[4 * i + 2] = nid[i].z; id[4 * i + 3] = nid[i].w; }
    const u32x4 hh = nhh, hl = nhl; const float sct = nsc;
    u32x4 ur[16];
#pragma unroll
    for (int i = 0; i < 16; ++i) ur[i] = *(const u32x4*)(us + ((size_t)id[i] << 7));
    float pd[16];
#pragma unroll
    for (int i = 0; i < 16; ++i) {
      int ah = 0, al = 0;
#pragma unroll
      for (int w = 0; w < 4; ++w) { ah = __builtin_amdgcn_sdot8((int)ur[i][w], (int)hh[w], ah, false); al = __builtin_amdgcn_sdot8((int)ur[i][w], (int)hl[w], al, false); }
      pd[i] = (float)(16 * ah + al);
    }
    PU_PREF(t + NT / 64);
    float q8[8], q4[4], q2[2];
    { const bool up = (lane & 4) != 0;
#pragma unroll
      for (int m = 0; m < 8; ++m) { const float keep = up ? pd[8 + m] : pd[m], send = up ? pd[m] : pd[8 + m]; q8[m] = keep + __shfl_xor(send, 4, 64); } }
    { const bool up = (lane & 2) != 0;
#pragma unroll
      for (int m = 0; m < 4; ++m) { const float keep = up ? q8[4 + m] : q8[m], send = up ? q8[m] : q8[4 + m]; q4[m] = keep + __shfl_xor(send, 2, 64); } }
    { const bool up = (lane & 1) != 0;
#pragma unroll
      for (int m = 0; m < 2; ++m) { const float keep = up ? q4[2 + m] : q4[m], send = up ? q4[m] : q4[2 + m]; q2[m] = keep + __shfl_xor(send, 1, 64); } }
    part[((size_t)t * PQ_NS + x) * 64 + lane] = pk2(q2[0] * sct, q2[1] * sct);
  }
  PQ_END()
  }
#undef PU_PREF
}
DI void ph_peer_comb(const P& p, int layer, size_t part_off, size_t ei_off, size_t eg_off, size_t w_off) {
  const unsigned* part = (const unsigned*)(p.ws + part_off); const float* EG = (const float*)(p.ws + eg_off); const int* EI = (const int*)(p.ws + ei_off); float* W = (float*)(p.ws + w_off);
  const float* su = (const float*)(p.ws + WS_TSC) + (size_t)(layer * 2) * 16384; const float* sv = su + 16384;
  const int tpbc_ = TL / gridDim.x;
  for (int g = blockIdx.x * tpbc_ * 64 + otid(); g < (blockIdx.x + 1) * tpbc_ * 64; g += NT) {
    const int t = g >> 6, j = g & 63;
    float d0 = 0.f, d1 = 0.f;
#pragma unroll
    for (int x = 0; x < PQ_NS; ++x) { const unsigned v = part[((size_t)t * PQ_NS + x) * 64 + j]; d0 += bflo(v); d1 += bfhi(v); }
    const f32x2_t gt = *(const f32x2_t*)(EG + (size_t)t * 128 + 2 * j);
    const int e0 = EI[(size_t)t * 128 + 2 * j], e1 = EI[(size_t)t * 128 + 2 * j + 1];
    f32x2_t o; o[0] = gelu_tanh(d0 * su[e0]) * gt[0] * sv[e0]; o[1] = gelu_tanh(d1 * su[e1]) * gt[1] * sv[e1];
    *(f32x2_t*)(W + (size_t)t * 128 + 2 * j) = o;
  }
}
DI void ph_peer_v(const P& p, char* lds, int layer, size_t ei_off, size_t w_off) {
  PQ_BEGIN()
  const unsigned char* vs = (const unsigned char*)(p.ws + WS_TAB + (size_t)(layer * 2 + 1) * 8 * MiB) + ((size_t)x * 16384 << 7) + c16 * 16;
  const int* EI = (const int*)(p.ws + ei_off) + g8 * 16; const float* W = (const float*)(p.ws + w_off) + g8 * 16;
  const float* modb = (const float*)(p.ws + WS_MOD) + (size_t)layer * 5 * 6144;
  const int col = x * 256 + 32 * (lane & 7) + 4 * (lane >> 3);
  int4 nid[4]; f32x4 nw[4];
#define PV_PREF(tt) do { const int t_ = (tt) < tend ? (tt) : tend - 1; \
    _Pragma("unroll") for (int i = 0; i < 4; ++i) { nid[i] = *(const int4*)(EI + (size_t)t_ * 128 + i * 4); nw[i] = *(const f32x4*)(W + (size_t)t_ * 128 + i * 4); } } while (0)
  PV_PREF(tbeg);
#pragma unroll 1
  for (int t = tbeg; t < tend; t += NT / 64) {
    int id[16]; float wv[16];
#pragma unroll
    for (int i = 0; i < 4; ++i) { id[4 * i] = nid[i].x; id[4 * i + 1] = nid[i].y; id[4 * i + 2] = nid[i].z; id[4 * i + 3] = nid[i].w; wv[4 * i] = nw[i][0]; wv[4 * i + 1] = nw[i][1]; wv[4 * i + 2] = nw[i][2]; wv[4 * i + 3] = nw[i][3]; }
    u32x4 vr[16];
#pragma unroll
    for (int i = 0; i < 16; ++i) vr[i] = *(const u32x4*)(vs + ((size_t)id[i] << 7));
    f32x2_t acc2[16];
#pragma unroll
    for (int j = 0; j < 16; ++j) acc2[j] = f32x2_t{0.f, 0.f};
#pragma unroll
    for (int i = 0; i < 16; ++i) {
      const f32x2_t w2 = {wv[i], wv[i]};
#pragma unroll
      for (int w = 0; w < 4; ++w) {
        f32x2_t f0, f1, f2, f3; FP4X8(vr[i][w], f0, f1, f2, f3);
        acc2[4 * w] = f0 * w2 + acc2[4 * w]; acc2[4 * w + 1] = f1 * w2 + acc2[4 * w + 1]; acc2[4 * w + 2] = f2 * w2 + acc2[4 * w + 2]; acc2[4 * w + 3] = f3 * w2 + acc2[4 * w + 3];
      }
    }
    PV_PREF(t + NT / 64);
    float acc[32];
#pragma unroll
    for (int j = 0; j < 16; ++j) { acc[2 * j] = acc2[j][0]; acc[2 * j + 1] = acc2[j][1]; }
    float q16[16], q8[8], q4[4];
    { const bool up = (lane & 32) != 0;
#pragma unroll
      for (int m = 0; m < 16; ++m) { const float keep = up ? acc[16 + m] : acc[m], send = up ? acc[m] : acc[16 + m]; q16[m] = keep + __shfl_xor(send, 32, 64); } }
    { const bool up = (lane & 16) != 0;
#pragma unroll
      for (int m = 0; m < 8; ++m) { const float keep = up ? q16[8 + m] : q16[m], send = up ? q16[m] : q16[8 + m]; q8[m] = keep + __shfl_xor(send, 16, 64); } }
    { const bool up = (lane & 8) != 0;
#pragma unroll
      for (int m = 0; m < 4; ++m) { const float keep = up ? q8[4 + m] : q8[m], send = up ? q8[m] : q8[4 + m]; q4[m] = keep + __shfl_xor(send, 8, 64); } }
    float* xr = p.out + (size_t)t * DM + col;
    const f32x4 xv = *(const f32x4*)xr, g2 = *(const f32x4*)(modb + (size_t)(t >> 13) * 6144 + 5 * 1024 + col);
    f32x4 ov;
#pragma unroll
    for (int m = 0; m < 4; ++m) ov[m] = xv[m] + g2[m] * q4[m];
    *(f32x4*)xr = ov;
  }
  PQ_END()
#undef PV_PREF
}
DI void ph_final_norm(const P& p, int r0, int r1) {
  const int lane = otid() & 63;
  for (int row = r0 + (otid() >> 6); row < r1; row += NT / 64) {
    float* xr = p.out + (size_t)row * DM;
    f32x4 xv[4]; float ss = 0.f;
#pragma unroll
    for (int i = 0; i < 4; ++i) { xv[i] = *(const f32x4*)(xr + lane * 4 + 256 * i); ss += xv[i][0] * xv[i][0] + xv[i][1] * xv[i][1] + xv[i][2] * xv[i][2] + xv[i][3] * xv[i][3]; }
    ss = wave_sum(ss);
    const float rs = rsqrtf(ss * (1.f / DM) + EPS);
#pragma unroll
    for (int i = 0; i < 4; ++i) { const f32x4 w4 = *(const f32x4*)(p.final_norm_w + lane * 4 + 256 * i); *(f32x4*)(xr + lane * 4 + 256 * i) = xv[i] * rs * w4; }
  }
}

struct RowFft0 { const bf16_t* base; DI const bf16_t* operator()(int r) const { return base + ((size_t)128 * (r & 63) + (r >> 6)) * DM; } };
struct EpiFft0 {
  bf16_t* zt; int bg, l20, col0;
  DI void operator()(f32x16 (&acc)[2][2], int wm, int wn, int lane) const {
    const int h = lane >> 5, cl = lane & 31;
#pragma unroll
    for (int mt = 0; mt < 2; ++mt)
#pragma unroll
      for (int nt = 0; nt < 2; ++nt) {
        const int n = col0 + wn * 64 + nt * 32 + cl, ri = n >> 8, mm = n & 255;
#pragma unroll
        for (int g = 0; g < 4; ++g) {
          const int r = wm * 64 + mt * 32 + 8 * g + 4 * h, l1 = r & 63, l2 = l20 + (r >> 6);
          u32x2 v; v[0] = pk2(acc[mt][nt][4 * g], acc[mt][nt][4 * g + 1]); v[1] = pk2(acc[mt][nt][4 * g + 2], acc[mt][nt][4 * g + 3]);
          *(u32x2*)(zt + (((size_t)(bg * 256 + mm) * 128 + l2) * 128 + ri * 64 + l1)) = v;
        }
      }
  }
};
DI void ph_fft0(const P& p, char* lds) {
  const bf16_t* h1 = (const bf16_t*)(p.ws + R0); const bf16_t* Bt = (const bf16_t*)(p.ws + WS_DFT0);
  for (int t = blockIdx.x; t < NB * 4 * 32 * 4; t += gridDim.x) {
    const int pn = t & 3, l2b = (t >> 2) & 31, g = (t >> 7) & 3, b = t >> 9;
    RowFft0 rf{h1 + ((size_t)b * SEQ + l2b * 4) * DM + g * 256};
    EpiFft0 ep{(bf16_t*)(p.ws + WS_ZT), b * 4 + g, l2b * 4, pn * GBN};
    gemm_tile<false>(lds, rf, Bt + (size_t)pn * GBN * 256, 256, ep);
  }
}
struct EpiFft1 {
  bf16_t* a2; int row0;
  DI void operator()(f32x16 (&acc)[2][2], int wm, int wn, int lane) const {
    const int h = lane >> 5, cl = lane & 31, k1 = 32 * wn + cl;
#pragma unroll
    for (int mt = 0; mt < 2; ++mt)
#pragma unroll
      for (int g = 0; g < 4; ++g) {
        const int R = row0 + wm * 64 + mt * 32 + 8 * g + 4 * h, l2 = R & 127, mm = (R >> 7) & 255, bg = R >> 15;
        float yr[4], yi[4];
#pragma unroll
        for (int q = 0; q < 4; ++q) {
          const float fr = (float)((l2 + q) * k1) * (1.f / 8192.f);
          const float cs = __builtin_amdgcn_cosf(fr), sn = __builtin_amdgcn_sinf(fr);
          const float ar = acc[mt][0][4 * g + q], ai = acc[mt][1][4 * g + q];
          yr[q] = ar * cs + ai * sn; yi[q] = ai * cs - ar * sn;
        }
        bf16_t* o = a2 + (((size_t)(bg * 64 + k1) * 256 + mm) * 256 + l2);
        u32x2 v; v[0] = pk2(yr[0], yr[1]); v[1] = pk2(yr[2], yr[3]); *(u32x2*)o = v;
        v[0] = pk2(yi[0], yi[1]); v[1] = pk2(yi[2], yi[3]); *(u32x2*)(o + 128) = v;
      }
  }
};
DI void ph_fft1(const P& p, char* lds) {
  const bf16_t* zt = (const bf16_t*)(p.ws + WS_ZT); const bf16_t* Bt = (const bf16_t*)(p.ws + WS_DFT1);
  const int nM = 16 * 256 * 128 / GBM;
  for (int t = blockIdx.x; t < nM; t += gridDim.x) {
    RowLin rf{zt + (size_t)t * GBM * 128, (size_t)128};
    EpiFft1 ep{(bf16_t*)(p.ws + WS_A2), t * GBM};
    gemm_tile<false>(lds, rf, Bt, 128, ep);
  }
}
struct EpiFft3 {
  bf16_t* fm; int row0;
  DI void operator()(f32x16 (&acc)[2][2], int wm, int wn, int lane) const {
    const int h = lane >> 5, cl = lane & 31;
#pragma unroll
    for (int mt = 0; mt < 2; ++mt)
#pragma unroll
      for (int nt = 0; nt < 2; ++nt) {
        const int k2 = wn * 64 + nt * 32 + cl;
#pragma unroll
        for (int g = 0; g < 4; ++g) {
          const int R = row0 + wm * 64 + mt * 32 + 8 * g + 4 * h, mm = R & 255, k1 = (R >> 8) & 63, bg = R >> 14;
          u32x2 v; v[0] = pk2(acc[mt][nt][4 * g], acc[mt][nt][4 * g + 1]); v[1] = pk2(acc[mt][nt][4 * g + 2], acc[mt][nt][4 * g + 3]);
          *(u32x2*)(fm + ((size_t)((bg >> 2) * SEQ + k1 + 64 * k2)) * DM + (bg & 3) * 256 + mm) = v;
        }
      }
  }
};
DI void ph_fft3(const P& p, char* lds) {
  const bf16_t* a2 = (const bf16_t*)(p.ws + WS_A2); const bf16_t* Bt = (const bf16_t*)(p.ws + WS_DFT3);
  const int nM = 16 * 64 * 256 / GBM;
  for (int t = blockIdx.x; t < nM; t += gridDim.x) {
    RowLin rf{a2 + (size_t)t * GBM * 256, (size_t)256};
    EpiFft3 ep{(bf16_t*)(p.ws + WS_FM), t * GBM};
    gemm_tile<false>(lds, rf, Bt, 256, ep);
  }
}

constexpr int NPHASE = 19;
template <int PH>
DI void run_phase(const P& p, char* lds) {
  const float* modL = (const float*)(p.ws + WS_MOD);
  const int tpb = TL / gridDim.x, t0 = blockIdx.x * tpb, t1 = t0 + tpb;
  if constexpr (PH == 0) ph_setup(p, lds);
  else if constexpr (PH == 1) { norm_rows(p.x, 0, TL, p.norm1_w, modL, 0, 1, false, (bf16_t*)(p.ws + R0));
                                norm_rows(p.ctx - (size_t)TL * DM, TL, TA, p.norm1_w, modL, 0, 1, true, (bf16_t*)(p.ws + R0)); }
  else if constexpr (PH == 2) { PgProj ep{&p}; pg8_run(lds, (const bf16_t*)(p.ws + R0), (const bf16_t*)(p.ws + WS_WIN), TA, NIN, DM, ep); }
  else if constexpr (PH == 3) ph_gdn_prep<0>(p, lds);
  else if constexpr (PH == 4) ph_gdn_scan<0>(p, lds);
  else if constexpr (PH == 5) { ph_attn(p, lds); ph_mixout(p); }
  else if constexpr (PH == 6) { PgResid ep{p.x, p.out, modL + 2 * 1024}; pg8_run(lds, (const bf16_t*)(p.ws + WS_MIX), (const bf16_t*)(p.ws + WS_WOUT), TL, DM, DM, ep); }
  else if constexpr (PH == 7) { norm_rows_hq(p, p.norm2_w, modL); ph_tables(p); }
  else if constexpr (PH == 8) { PgBf16 ep{(bf16_t*)(p.ws + WS_SC0), 2048}; pg8_run(lds, (const bf16_t*)(p.ws + R0), (const bf16_t*)(p.ws + WS_WEFF), TL, 2048, DM, ep); }
  else if constexpr (PH == 9) { ph_topk(p, lds, WS_SC0, WS_EI0, WS_EG0); block_handoff(); ph_peer_u(p, lds, 0, WS_EI0, WS_PART0); }
  else if constexpr (PH == 10) { ph_peer_comb(p, 0, WS_PART0, WS_EI0, WS_EG0, WS_W0); block_handoff(); ph_peer_v(p, lds, 0, WS_EI0, WS_W0); block_handoff();
                                 norm_rows(p.out, t0, t1, p.norm1_w + DM, modL + 5 * 6144, 0, 1, false, (bf16_t*)(p.ws + R0), true); }
  else if constexpr (PH == 11) ph_fft0(p, lds);
  else if constexpr (PH == 12) ph_fft1(p, lds);
  else if constexpr (PH == 13) ph_fft3(p, lds);
  else if constexpr (PH == 14) { PgResid ep{p.out, p.out, modL + 5 * 6144 + 2 * 1024}; pg8_run(lds, (const bf16_t*)(p.ws + WS_FM), (const bf16_t*)(p.ws + WS_WF), TL, DM, DM, ep); }
  else if constexpr (PH == 15) norm_rows_hq(p, p.norm2_w + DM, modL + 5 * 6144);
  else if constexpr (PH == 16) { PgBf16 ep{(bf16_t*)(p.ws + WS_SC1), 2048}; pg8_run(lds, (const bf16_t*)(p.ws + R0), (const bf16_t*)(p.ws + WS_WEFF) + (size_t)2048 * 1024, TL, 2048, DM, ep); }
  else if constexpr (PH == 17) { ph_topk(p, lds, WS_SC1, WS_EI1, WS_EG1); block_handoff(); ph_peer_u(p, lds, 1, WS_EI1, WS_PART1); }
  else if constexpr (PH == 18) { ph_peer_comb(p, 1, WS_PART1, WS_EI1, WS_EG1, WS_W1); block_handoff(); ph_peer_v(p, lds, 1, WS_EI1, WS_W1); block_handoff(); ph_final_norm(p, t0, t1); }
}
#define XB_TMO      128
#define XB_XCNT(j)  (256  + 64 * (j))
#define XB_XSUB(j)  (1280 + 64 * (j))
#define XB_XGEN(j)  (2304 + 64 * (j))
#define XB_TOP      3328
#define XB_TOPGEN   3392
#define XCD_BAR_WORDS 3456
#define XB_SPIN_CAP (1u << 22)
#define LAS __attribute__((address_space(3)))
#define XB_SPIN(cond, bar) do { unsigned _sp = 0; while (cond) { __builtin_amdgcn_s_sleep(1); \
    if ((++_sp & 255u) == 0u) { if (xb_ld(&(bar)[XB_TMO])) break; if (_sp > XB_SPIN_CAP) { atomicAdd(&(bar)[XB_TMO], 1u); break; } } } } while (0)
struct XcdBarrier { unsigned* bar; unsigned x; volatile LAS unsigned* st; };
DI XcdBarrier xcd_barrier_post(unsigned* bar, volatile LAS unsigned* st) {
  XcdBarrier b; b.bar = bar; b.x = xb_xcc_id(); b.st = st;
  if (threadIdx.x == 0) (void)xb_add(&bar[XB_XCNT(b.x)], 1u);
  return b;
}
DI void xcd_barrier_complete(unsigned* bar, unsigned x, unsigned& nloc, unsigned& nx) {
  const unsigned G = gridDim.x * gridDim.y * gridDim.z;
  unsigned sum, cnt, mine, sp = 0u;
  for (;;) {
    sum = 0u; cnt = 0u; mine = 0u;
#pragma unroll
    for (unsigned j = 0; j < 16; ++j) { const unsigned c = xb_ld(&bar[XB_XCNT(j)]); sum += c; cnt += (c > 0u) ? 1u : 0u; mine = (j == x) ? c : mine; }
    if (sum == G) break;
    __builtin_amdgcn_s_sleep(1);
    if ((++sp & 255u) == 0u) { if (xb_ld(&bar[XB_TMO])) break; if (sp > XB_SPIN_CAP) { atomicAdd(&bar[XB_TMO], 1u); break; } }
  }
  nloc = mine > 0u ? mine : 1u; nx = cnt > 0u ? cnt : 1u;
}
DI void xcd_barrier(const XcdBarrier& b) {
  asm volatile("s_waitcnt vmcnt(0)" ::: "memory");
  __syncthreads();
  if (threadIdx.x == 0) {
    unsigned* bar = b.bar;
    __builtin_amdgcn_s_waitcnt(0);
    unsigned nloc = b.st[0], nx = b.st[1];
    if (nloc == 0u) { xcd_barrier_complete(bar, b.x, nloc, nx); b.st[0] = nloc; b.st[1] = nx; }
    const unsigned old = xb_add(&bar[XB_XSUB(b.x)], 1u);
    const unsigned gen = old / nloc;
    if (old + 1u == (gen + 1u) * nloc) {
      __builtin_amdgcn_fence(__ATOMIC_RELEASE, "agent");
      asm volatile("s_waitcnt vmcnt(0)" ::: "memory");
      const unsigned og = xb_add(&bar[XB_TOP], 1u);
      const unsigned tg = og / nx;
      if (og + 1u == (tg + 1u) * nx) xb_add(&bar[XB_TOPGEN], 1u);
      else XB_SPIN(xb_ld(&bar[XB_TOPGEN]) == tg, bar);
      __builtin_amdgcn_fence(__ATOMIC_ACQUIRE, "agent");
      xb_add(&bar[XB_XGEN(b.x)], 1u);
      asm volatile("s_waitcnt vmcnt(0)" ::: "memory");
    } else {
      XB_SPIN(xb_ld(&bar[XB_XGEN(b.x)]) == gen, bar);
      __builtin_amdgcn_fence(__ATOMIC_ACQUIRE, "agent");
      asm volatile("s_waitcnt vmcnt(0)" ::: "memory");
    }
  }
  __syncthreads();
}

constexpr int EXTRA_PHASE = -1;
constexpr int PROBE_MODE = 0;
template <int PH>
DI void run_all(const P& p, char* lds, const XcdBarrier& bar) {
  run_phase<PH>(p, lds);
  if constexpr (PH == EXTRA_PHASE) {
    xcd_barrier(bar);
    if constexpr (PH == 3) ph_gdn_prep<PROBE_MODE>(p, lds);
    else if constexpr (PH == 4) ph_gdn_scan<PROBE_MODE>(p, lds);
    else run_phase<PH>(p, lds);
  }
  if constexpr (PH + 1 < NPHASE) {
    if constexpr (PH == 0) { cg::this_grid().sync(); }
    else xcd_barrier(bar);
    run_all<PH + 1>(p, lds, bar);
  }
}
__global__ void __launch_bounds__(NT) mega(P p) {
  extern __shared__ __attribute__((aligned(16))) char lds[];
  volatile LAS unsigned* st = (volatile LAS unsigned*)(lds + LDS_BYTES - 16);
  if (threadIdx.x == 0) { st[0] = 0u; st[1] = 0u; }
  __syncthreads();
  XcdBarrier bar = xcd_barrier_post((unsigned*)(p.ws + WS_CTL), st);
  run_all<0>(p, lds, bar);
}

extern "C" void kernel_launch(void* const* d_in, const int* in_sizes, int n_in, void* d_out, int out_size, void* d_ws, size_t ws_size, hipStream_t stream) {
  static int grid = 0;
  if (grid == 0) {
    if (n_in != 25 || ws_size < WS_END) { fprintf(stderr, "kernel_launch: unexpected n_in %d or ws_size %zu\n", n_in, ws_size); grid = -1; return; }
    int dev = 0, cus = 0, per_cu = 0;
    (void)hipGetDevice(&dev); (void)hipDeviceGetAttribute(&cus, hipDeviceAttributeMultiprocessorCount, dev);
    (void)hipFuncSetAttribute((const void*)mega, hipFuncAttributeMaxDynamicSharedMemorySize, LDS_BYTES);
    if (hipOccupancyMaxActiveBlocksPerMultiprocessor(&per_cu, (const void*)mega, NT, LDS_BYTES) != hipSuccess || per_cu < 1) { fprintf(stderr, "kernel_launch: occupancy query failed (%d)\n", per_cu); per_cu = 1; }
    (void)hipGetLastError();
    if (per_cu > 1) per_cu = 1;
    grid = (cus > 0 ? cus : 256) * per_cu;
  }
  if (grid < 0) return;
  (void)hipMemsetAsync((char*)d_ws + WS_CTL, 0, CTL_ZERO_BYTES, stream);
  P p{};
  const float** pf = (const float**)&p;
  for (int i = 0; i < 25; ++i) pf[i] = (const float*)d_in[i];
  p.out = (float*)d_out; p.ws = (char*)d_ws; p.lo = 0; p.hi = NPHASE;
  void* args[] = {&p};
  hipError_t e = hipLaunchCooperativeKernel((const void*)mega, dim3(grid), dim3(NT), args, LDS_BYTES, stream);
  if (e != hipSuccess) fprintf(stderr, "cooperative launch failed: %s (grid %d)\n", hipGetErrorString(e), grid);
}
```

```cpp
#include <hip/hip_runtime.h>
#include <hip/hip_cooperative_groups.h>
#include <cstdio>
#include <cstdint>
namespace cg = cooperative_groups;

#define DI __device__ __forceinline__
typedef unsigned short bf16_t;
typedef short bf16x8 __attribute__((ext_vector_type(8)));
typedef short s16x4 __attribute__((ext_vector_type(4)));
typedef float f32x16 __attribute__((ext_vector_type(16)));
typedef float f32x4 __attribute__((ext_vector_type(4)));
typedef float f32x2_t __attribute__((ext_vector_type(2)));
typedef __bf16 bf16x2_t __attribute__((ext_vector_type(2)));
typedef unsigned u32x4 __attribute__((ext_vector_type(4)));
typedef unsigned u32x2 __attribute__((ext_vector_type(2)));

constexpr int NB = 4, SEQ = 8192, DM = 1024, CTXL = 256;
constexpr int TL = NB * SEQ;
constexpr int TC = NB * CTXL;
constexpr int TA = TL + TC;
constexpr int KVL = SEQ + CTXL;
constexpr int NIN = 3840;
constexpr int NCH = 132;
constexpr float EPS = 1e-6f;
constexpr int NT = 512;

constexpr size_t MiB = 1u << 20;
constexpr size_t WS_CTL = 0, WS_MOD = 64 * 1024, CTL_ZERO_BYTES = 512 * 1024;
constexpr size_t WS_ROPE = 1 * MiB, WS_WIN = 3 * MiB, WS_WOUT = 11 * MiB, WS_WF = 13 * MiB, WS_WEFF = 15 * MiB;
constexpr size_t WS_DFT0 = 23 * MiB, WS_DFT1 = 23 * MiB + 256 * 1024, WS_DFT3 = 23 * MiB + 512 * 1024;
constexpr size_t WS_BA = 24 * MiB, WS_GC = 29 * MiB;
constexpr size_t R0 = 32 * MiB, R1 = 98 * MiB, R2 = 197 * MiB, R3 = 329 * MiB, WS_END = 459 * MiB;
constexpr size_t WS_QN = R0, WS_KN = R0 + 33 * MiB;
constexpr size_t WS_QKVRAW = R1, WS_OBUF = R1;
constexpr size_t WS_UW = R2, WS_MIX = R2;
constexpr size_t WS_GATE = R3, WS_Q = R3 + 32 * MiB, WS_K = R3 + 64 * MiB, WS_VT = R3 + 97 * MiB;
constexpr size_t WS_TAB = R3 + 32 * MiB;
constexpr size_t WS_SC0 = R2, WS_EI0 = R1, WS_EG0 = R1 + 16 * MiB, WS_PART0 = 150 * MiB  , WS_W0 = R1 + 32 * MiB  ;
constexpr size_t WS_ZT = R1, WS_A2 = 226 * MiB, WS_FM = R1;
constexpr size_t WS_SC1 = 162 * MiB, WS_EI1 = 290 * MiB, WS_EG1 = 306 * MiB, WS_PART1 = 100 * MiB  , WS_W1 = 322 * MiB;

struct P {
  const float *x, *c, *ctx, *c_ctx, *ada_w, *ada_b, *norm1_w, *norm2_w, *w_in, *conv_w, *a_log, *dt_bias, *gdn_norm_w,
      *lam_q1, *lam_k1, *lam_q2, *lam_k2, *subln_w, *w_out_ab, *w_out_f, *peer_wq, *peer_keys, *peer_u, *peer_v, *final_norm_w;
  float* out; char* ws; int lo, hi;
};

DI unsigned f2bf(float f) { unsigned u = __float_as_uint(f); return (u + 0x7fffu + ((u >> 16) & 1u)) >> 16; }
DI unsigned pk2(float lo, float hi) { return f2bf(lo) | (f2bf(hi) << 16); }
DI unsigned cvtpk(float lo, float hi) { f32x2_t v = {lo, hi}; bf16x2_t b = __builtin_convertvector(v, bf16x2_t); return __builtin_bit_cast(unsigned, b); }
DI float bf2f(unsigned h) { return __uint_as_float(h << 16); }
DI float bflo(unsigned u) { return __uint_as_float(u << 16); }
DI float bfhi(unsigned u) { return __uint_as_float(u & 0xffff0000u); }
DI float wave_sum(float v) {
#pragma unroll
  for (int o = 32; o >= 1; o >>= 1) v += __shfl_xor(v, o, 64);
  return v;
}
DI int otid() { int t = threadIdx.x; asm volatile("" : "+v"(t)); return t; }
DI unsigned xb_ld(unsigned* p)              { return __hip_atomic_load(p, __ATOMIC_RELAXED, __HIP_MEMORY_SCOPE_AGENT); }
DI unsigned xb_add(unsigned* p, unsigned v) { return __hip_atomic_fetch_add(p, v, __ATOMIC_RELAXED, __HIP_MEMORY_SCOPE_AGENT); }
DI unsigned xb_xcc_id() { return (unsigned)__builtin_amdgcn_s_getreg((3 << 11) | 20) & 0xFu; }
DI float silu_f(float v) { return v / (1.f + __expf(-v)); }
DI float sigmoid_f(float v) { return 1.f / (1.f + __expf(-v)); }
DI float gelu_tanh(float v) {
  const float u = 0.7978845608028654f * (v + 0.044715f * v * v * v);
  const float e = __expf(2.f * u);
  const float t = 1.f - 2.f / (e + 1.f);
  return 0.5f * v * (1.f + t);
}
#define MFMA32(a, b, c) __builtin_amdgcn_mfma_f32_32x32x16_bf16((a), (b), (c), 0, 0, 0)

constexpr int GBM = 256, GBN = 128, GBK = 64, GLD = 72;
constexpr int G_A_BYTES = GBM * GLD * 2, G_B_BYTES = GBN * GLD * 2, G_STAGE = G_A_BYTES + G_B_BYTES;
constexpr int LDS_BYTES = 147456;

template <bool SWAP, class RowF, class Epi>
DI void gemm_tile(char* lds, const RowF& rowf, const bf16_t* __restrict__ Bt, const int K, const Epi& epi) {
  const int tid = otid(), lane = tid & 63, wave = tid >> 6, wm = wave >> 1, wn = wave & 1;
  const int lr = tid >> 3, lc = tid & 7;
  const bf16_t* ap0 = rowf(lr) + lc * 8;
  const bf16_t* ap1 = rowf(lr + 64) + lc * 8;
  const bf16_t* ap2 = rowf(lr + 128) + lc * 8;
  const bf16_t* ap3 = rowf(lr + 192) + lc * 8;
  const bf16_t* bp0 = Bt + (size_t)lr * K + lc * 8;
  const bf16_t* bp1 = Bt + (size_t)(lr + 64) * K + lc * 8;
  const int woff = (lr * GLD + lc * 8) * 2;
  u32x4 raX0, raX1, raX2, raX3, rbX0, rbX1, raY0, raY1, raY2, raY3, rbY0, rbY1;
  f32x16 acc[2][2];
#pragma unroll
  for (int i = 0; i < 2; ++i)
#pragma unroll
    for (int j = 0; j < 2; ++j)
#pragma unroll
      for (int r = 0; r < 16; ++r) acc[i][j][r] = 0.f;
  const int nk = K / GBK;
#define G_GLOAD(S, kt_) do { const int k0_ = ((kt_) < nk ? (kt_) : nk - 1) * GBK; \
    ra##S##0 = *(const u32x4*)(ap0 + k0_); ra##S##1 = *(const u32x4*)(ap1 + k0_); ra##S##2 = *(const u32x4*)(ap2 + k0_); ra##S##3 = *(const u32x4*)(ap3 + k0_); \
    rb##S##0 = *(const u32x4*)(bp0 + k0_); rb##S##1 = *(const u32x4*)(bp1 + k0_); } while (0)
#define G_LWRITE(S, st) do { char* b_ = lds + (st) * G_STAGE + woff; *(u32x4*)(b_) = ra##S##0; *(u32x4*)(b_ + 64 * GLD * 2) = ra##S##1; *(u32x4*)(b_ + 128 * GLD * 2) = ra##S##2; *(u32x4*)(b_ + 192 * GLD * 2) = ra##S##3; \
    *(u32x4*)(b_ + G_A_BYTES) = rb##S##0; *(u32x4*)(b_ + G_A_BYTES + 64 * GLD * 2) = rb##S##1; } while (0)
  const int aoff = ((wm * 64 + (lane & 31)) * GLD + (lane >> 5) * 8) * 2;
  const int boff = G_A_BYTES + ((wn * 64 + (lane & 31)) * GLD + (lane >> 5) * 8) * 2;
#define G_COMPUTE(st) do { const char* sb = lds + (st) * G_STAGE; \
    _Pragma("unroll") for (int kk = 0; kk < 4; ++kk) { \
      const bf16x8 a0 = *(const bf16x8*)(sb + aoff + kk * 32); \
      const bf16x8 a1 = *(const bf16x8*)(sb + aoff + 32 * GLD * 2 + kk * 32); \
      const bf16x8 b0 = *(const bf16x8*)(sb + boff + kk * 32); \
      const bf16x8 b1 = *(const bf16x8*)(sb + boff + 32 * GLD * 2 + kk * 32); \
      if (SWAP) { \
        acc[0][0] = MFMA32(b0, a0, acc[0][0]); acc[0][1] = MFMA32(b1, a0, acc[0][1]); \
        acc[1][0] = MFMA32(b0, a1, acc[1][0]); acc[1][1] = MFMA32(b1, a1, acc[1][1]); \
      } else { \
        acc[0][0] = MFMA32(a0, b0, acc[0][0]); acc[0][1] = MFMA32(a0, b1, acc[0][1]); \
        acc[1][0] = MFMA32(a1, b0, acc[1][0]); acc[1][1] = MFMA32(a1, b1, acc[1][1]); \
      } } } while (0)
  G_GLOAD(X, 0); G_GLOAD(Y, 1);
  __syncthreads();
  G_LWRITE(X, 0);
  __syncthreads();
#pragma unroll 1
  for (int kt = 0; kt < nk; kt += 2) {
    G_GLOAD(X, kt + 2);
    G_COMPUTE(0);
    G_LWRITE(Y, 1);
    __syncthreads();
    G_GLOAD(Y, kt + 3);
    G_COMPUTE(1);
    if (kt + 2 < nk) G_LWRITE(X, 0);
    __syncthreads();
  }
  epi(acc, wm, wn, lane);
#undef G_GLOAD
#undef G_LWRITE
#undef G_COMPUTE
}
DI int crow(int reg, int h) { return (reg & 3) + 8 * (reg >> 2) + 4 * h; }

struct RowLin { const bf16_t* base; size_t pitch; DI const bf16_t* operator()(int r) const { return base + (size_t)r * pitch; } };

namespace pg8 {
#define PG8_LAS __attribute__((address_space(3)))
typedef int v4i_t __attribute__((ext_vector_type(4)));
typedef unsigned short bf16_t;
typedef short bf16x8 __attribute__((ext_vector_type(8)));
typedef float f32x4 __attribute__((ext_vector_type(4)));
typedef unsigned u32x4 __attribute__((ext_vector_type(4)));
constexpr int BM = 256, BK = 64, HALF = 128, HTB = HALF * BK * 2  , STAGE_BYTES = 8 * HTB, NXCD = 8, WGM = 8;

__host__ __device__ __forceinline__ int lds_byte(int r, int c) { const int st = (r >> 4) * 2 + (c >> 5), rr = r & 15, cc = c & 31, ob = rr * 64 + cc * 2; return st * 1024 + (ob ^ (((ob >> 9) & 1) << 5)); }
__host__ __device__ __forceinline__ void stage_rc(int b, int& R, int& C) { const int st = b / 1024, sb = b % 1024, swz = sb ^ (((sb >> 9) & 1) << 5); R = (st >> 1) * 16 + swz / 64; C = (st & 1) * 32 + (swz % 64) / 2; }
__host__ __device__ __forceinline__ int perm32(int rho) { const int n = rho >> 4, i = rho & 15; return 8 * (i >> 2) + 4 * n + (i & 3); }

struct Unit { int pm, pn; };
struct Gemm { const bf16_t* A; const bf16_t* Bt; int M, N, K; };

struct StaticOrder {
    int nM, nN, nwg, G, c;
    __host__ __device__ void init(int M, int N, int G_, int c_) { nM = M / BM; nN = N / BM; nwg = nM * nN; G = G_; c = c_; }
    __host__ __device__ bool next(int i, Unit& u) const {
        const long L = (long)i * G + c; if (L >= nwg) return false;
        int wgid = (int)L; { const int q = nwg / NXCD, r = nwg % NXCD, xcd = wgid % NXCD, off = wgid / NXCD; wgid = (xcd < r ? xcd * (q + 1) : r * (q + 1) + (xcd - r) * q) + off; }
        const int nig = WGM * nN, gid = wgid / nig, fm = gid * WGM, gsz = (nM - fm) < WGM ? (nM - fm) : WGM;
        u.pm = fm + ((wgid % nig) % gsz); u.pn = (wgid % nig) / gsz; return true;
    }
    __device__ __forceinline__ void a_ready(const Unit&) const {}
    __device__ __forceinline__ void done(const Unit&) const {}
};
template <class Epi, class Sched, bool ALIGN_EPI = false, bool SP2 = false, bool I8 = false>
__device__ __forceinline__ void gemm_phase(PG8_LAS unsigned char* lds, const Gemm g, const Sched& S, const Epi& E) {
    const int tid = otid(), wid = __builtin_amdgcn_readfirstlane(tid >> 6), lane = tid & 63, wr = wid >> 2, wc = wid & 3, fr = lane & 15, fq = lane >> 4;
    const int K = g.K, nt = K / BK;
    unsigned voffA[2], voffB[2];
#pragma unroll
    for (int i = 0; i < 2; ++i) { int R, C; stage_rc(tid * 16 + i * 8192, R, C); const int Rb = Epi::PERM ? ((R & ~31) + perm32(R & 31)) : R;
        voffA[i] = (unsigned)(R * K + C) * 2u; voffB[i] = (unsigned)(Rb * K + C) * 2u; }
    const size_t kstep = (size_t)(BK * 2);
    const size_t hstep = (size_t)HALF * K * 2;
    const size_t tstep = 2 * hstep;
    const unsigned ldsw = (unsigned)wid * 1024u;
    const int aoff = lds_byte(wr * 64 + fr, fq * 8), boff = lds_byte(wc * 32 + fr, fq * 8);
#define PG8_SA(b, h) (((b) * 2 + (h)) * HTB)
#define PG8_SB(b, h) ((4 + (b) * 2 + (h)) * HTB)
#define PG8_STAGE(bufoff, gbase, voff) do { _Pragma("unroll") for (int _i = 0; _i < 2; ++_i) \
        __builtin_amdgcn_global_load_lds((const unsigned*)((const char*)(gbase) + (voff)[_i]), (PG8_LAS unsigned*)(lds + (bufoff) + ldsw + _i * 8192), 16, 0, 0); } while (0)
#define PG8_LDA(dst, b, h) do { _Pragma("unroll") for (int m = 0; m < 4; ++m) _Pragma("unroll") for (int k = 0; k < 2; ++k) dst[m][k] = *(const PG8_LAS bf16x8*)(lds + PG8_SA(b, h) + aoff + m * 2048 + k * 1024); } while (0)
#define PG8_LDB(dst, b, h) do { _Pragma("unroll") for (int n = 0; n < 2; ++n) _Pragma("unroll") for (int k = 0; k < 2; ++k) dst[n][k] = *(const PG8_LAS bf16x8*)(lds + PG8_SB(b, h) + boff + n * 2048 + k * 1024); } while (0)
#define PG8_MMA(ai, bj, At, Bt) do { __builtin_amdgcn_s_setprio(1); _Pragma("unroll") for (int m = 0; m < 4; ++m) _Pragma("unroll") for (int n = 0; n < 2; ++n) _Pragma("unroll") for (int k = 0; k < 2; ++k) \
        { if constexpr (I8) acc[ai][bj][m][n] = __builtin_bit_cast(f32x4, __builtin_amdgcn_mfma_i32_16x16x64_i8(__builtin_bit_cast(v4i_t, Bt[n][k]), __builtin_bit_cast(v4i_t, At[m][k]), __builtin_bit_cast(v4i_t, acc[ai][bj][m][n]), 0, 0, 0)); \
          else acc[ai][bj][m][n] = __builtin_amdgcn_mfma_f32_16x16x32_bf16(Bt[n][k], At[m][k], acc[ai][bj][m][n], 0, 0, 0); } __builtin_amdgcn_s_setprio(0); } while (0)
#define PG8_WAIT_V(n) asm volatile("s_waitcnt vmcnt(" #n ")" ::: "memory")
#define PG8_WAIT_L(n) asm volatile("s_waitcnt lgkmcnt(" #n ")" ::: "memory")
#define PG8_BAR __builtin_amdgcn_s_barrier()
#define PG8_SCHED __builtin_amdgcn_sched_barrier(0)
    Unit cur, nxt; int ui = 0;
    if (!S.next(0, cur)) return;
    f32x4 acc[2][2][4][2];
#pragma unroll
    for (int a = 0; a < 2; ++a)
#pragma unroll
        for (int b = 0; b < 2; ++b)
#pragma unroll
            for (int m = 0; m < 4; ++m)
#pragma unroll
                for (int n = 0; n < 2; ++n) acc[a][b][m][n] = (f32x4){0.f, 0.f, 0.f, 0.f};
    bf16x8 At[4][2], B0[2][2], B1[2][2];
    const char* cA = (const char*)g.A + (size_t)cur.pm * tstep; const char* cB = (const char*)g.Bt + (size_t)cur.pn * tstep;
    S.a_ready(cur);
    if constexpr (SP2) {
        PG8_STAGE(PG8_SB(0, 0), cB, voffB); PG8_STAGE(PG8_SB(0, 1), cB + hstep, voffB); PG8_STAGE(PG8_SA(0, 0), cA, voffA); PG8_STAGE(PG8_SA(0, 1), cA + hstep, voffA);
        if (wr == 1) PG8_BAR;
        PG8_WAIT_V(2); PG8_BAR;
        PG8_STAGE(PG8_SB(1, 0), cB + kstep, voffB); PG8_STAGE(PG8_SA(1, 0), cA + kstep, voffA); PG8_STAGE(PG8_SB(1, 1), cB + hstep + kstep, voffB);
        PG8_WAIT_V(6); PG8_BAR;
    } else {
        PG8_STAGE(PG8_SB(0, 0), cB, voffB); PG8_STAGE(PG8_SA(0, 0), cA, voffA); PG8_STAGE(PG8_SB(0, 1), cB + hstep, voffB); PG8_STAGE(PG8_SA(0, 1), cA + hstep, voffA);
        if (wr == 1) PG8_BAR;
        PG8_WAIT_V(4); PG8_BAR;
        PG8_STAGE(PG8_SB(1, 0), cB + kstep, voffB); PG8_STAGE(PG8_SA(1, 0), cA + kstep, voffA); PG8_STAGE(PG8_SB(1, 1), cB + hstep + kstep, voffB);
        PG8_WAIT_V(6); PG8_BAR;
    }
    for (;;) {
        const bool has_next = S.next(ui + 1, nxt);
        const char* nA = has_next ? (const char*)g.A + (size_t)nxt.pm * tstep : cA; const char* nB = has_next ? (const char*)g.Bt + (size_t)nxt.pn * tstep : cB;
        for (int t = 0; t < nt; t += 2) {
            const bool last = (t == nt - 2);
            const char* a1 = cA + (size_t)(t + 1) * kstep;
            const char* a2 = last ? nA : cA + (size_t)(t + 2) * kstep; const char* b2 = last ? nB : cB + (size_t)(t + 2) * kstep;
            const char* a3 = a2 + kstep; const char* b3 = b2 + kstep;
            if (last && has_next) S.a_ready(nxt);
            if constexpr (SP2) {
            PG8_LDB(B0, 0, 0); PG8_LDB(B1, 0, 1); PG8_SCHED; PG8_LDA(At, 0, 0); PG8_STAGE(PG8_SA(1, 1), a1 + hstep, voffA);
            PG8_WAIT_V(8); PG8_WAIT_L(0); PG8_BAR; PG8_MMA(0, 0, At, B0); PG8_MMA(0, 1, At, B1); PG8_BAR; PG8_SCHED;
            PG8_LDA(At, 0, 1); PG8_STAGE(PG8_SB(0, 0), b2, voffB); PG8_STAGE(PG8_SB(0, 1), b2 + hstep, voffB); PG8_STAGE(PG8_SA(0, 0), a2, voffA);
            PG8_WAIT_V(8); PG8_WAIT_L(0); PG8_BAR; PG8_MMA(1, 0, At, B0); PG8_MMA(1, 1, At, B1); PG8_BAR; PG8_SCHED;
            PG8_LDB(B0, 1, 0); PG8_LDB(B1, 1, 1); PG8_SCHED; PG8_LDA(At, 1, 0); PG8_STAGE(PG8_SA(0, 1), a2 + hstep, voffA);
            PG8_WAIT_V(8); PG8_WAIT_L(0); PG8_BAR; PG8_MMA(0, 0, At, B0); PG8_MMA(0, 1, At, B1); PG8_BAR; PG8_SCHED;
            PG8_LDA(At, 1, 1); PG8_STAGE(PG8_SB(1, 0), b3, voffB); PG8_STAGE(PG8_SB(1, 1), b3 + hstep, voffB); PG8_STAGE(PG8_SA(1, 0), a3, voffA);
            PG8_WAIT_V(8); PG8_WAIT_L(0); PG8_BAR; PG8_MMA(1, 0, At, B0); PG8_MMA(1, 1, At, B1); PG8_BAR; PG8_SCHED;
            } else {
            PG8_LDB(B0, 0, 0); PG8_SCHED; PG8_LDA(At, 0, 0); PG8_STAGE(PG8_SA(1, 1), a1 + hstep, voffA);
            PG8_WAIT_L(8); PG8_BAR; PG8_WAIT_L(0); PG8_MMA(0, 0, At, B0); PG8_BAR; PG8_SCHED;
            PG8_LDB(B1, 0, 1); PG8_STAGE(PG8_SB(0, 0), b2, voffB);
            PG8_BAR; PG8_WAIT_L(0); PG8_MMA(0, 1, At, B1); PG8_BAR;
            PG8_LDA(At, 0, 1); PG8_STAGE(PG8_SA(0, 0), a2, voffA);
            PG8_BAR; PG8_WAIT_L(0); PG8_MMA(1, 0, At, B0); PG8_BAR; PG8_SCHED;
            PG8_STAGE(PG8_SB(0, 1), b2 + hstep, voffB);
            PG8_WAIT_V(6); PG8_BAR; PG8_MMA(1, 1, At, B1); PG8_BAR;
            PG8_LDB(B0, 1, 0); PG8_SCHED; PG8_LDA(At, 1, 0); PG8_STAGE(PG8_SA(0, 1), a2 + hstep, voffA);
            PG8_WAIT_L(8); PG8_BAR; PG8_WAIT_L(0); PG8_MMA(0, 0, At, B0); PG8_BAR; PG8_SCHED;
            PG8_LDB(B1, 1, 1); PG8_STAGE(PG8_SB(1, 0), b3, voffB);
            PG8_BAR; PG8_WAIT_L(0); PG8_MMA(0, 1, At, B1); PG8_BAR;
            PG8_LDA(At, 1, 1); PG8_STAGE(PG8_SA(1, 0), a3, voffA);
            PG8_BAR; PG8_WAIT_L(0); PG8_MMA(1, 0, At, B0); PG8_BAR; PG8_SCHED;
            PG8_STAGE(PG8_SB(1, 1), b3 + hstep, voffB);
            PG8_WAIT_V(6); PG8_BAR; PG8_MMA(1, 1, At, B1); PG8_BAR;
            }
        }
        if constexpr (ALIGN_EPI) { if (wr == 0) PG8_BAR; }
        if constexpr (!Epi::AFTER_DRAIN) { E(acc, cur, wr, wc, fr, fq); S.done(cur); }
        if (!has_next) break;
#pragma unroll
        for (int a = 0; a < 2; ++a)
#pragma unroll
            for (int b = 0; b < 2; ++b)
#pragma unroll
                for (int m = 0; m < 4; ++m)
#pragma unroll
                    for (int n = 0; n < 2; ++n) acc[a][b][m][n] = (f32x4){0.f, 0.f, 0.f, 0.f};
        cur = nxt; cA = nA; cB = nB; ++ui;
        if constexpr (ALIGN_EPI) { if (wr == 1) PG8_BAR; }
    }
    PG8_WAIT_V(0);
    if constexpr (!ALIGN_EPI) { if (wr == 0) PG8_BAR; }
    PG8_BAR;
    if constexpr (Epi::AFTER_DRAIN) { E.fused(acc, cur, wr, wc, fr, fq, lds, wid, lane); S.done(cur); }
#undef PG8_SA
#undef PG8_SB
#undef PG8_STAGE
#undef PG8_LDA
#undef PG8_LDB
#undef PG8_MMA
#undef PG8_WAIT_V
#undef PG8_WAIT_L
#undef PG8_BAR
#undef PG8_SCHED
}
}
DI void ph_setup(const P& p, char* lds) {
  const int tid = otid(), nb = gridDim.x, bid = blockIdx.x;
  float* modL = (float*)(p.ws + WS_MOD);
  float* sc = (float*)lds;
  for (int it = bid; it < 192; it += nb) {
    const int layer = it / 96, cb = it % 96;
    const int lane = tid & 63, ks = tid >> 6;
    __syncthreads();
    for (int i = tid; i < 5 * 1024; i += NT) { const int v = i >> 10, k = i & 1023; const float cv = (v < 4) ? p.c[v * 1024 + k] : p.c_ctx[k]; sc[i] = silu_f(cv); }
    __syncthreads();
    const int n = cb * 64 + lane;
    const float* w = p.ada_w + ((size_t)layer * 1024 + ks * 128) * 6144 + n;
    float a0 = 0, a1 = 0, a2 = 0, a3 = 0, a4 = 0;
#pragma unroll 8
    for (int k = 0; k < 128; ++k) { const float wv = w[(size_t)k * 6144]; const int kk = ks * 128 + k; a0 += wv * sc[kk]; a1 += wv * sc[1024 + kk]; a2 += wv * sc[2048 + kk]; a3 += wv * sc[3072 + kk]; a4 += wv * sc[4096 + kk]; }
    float* red = sc + 5 * 1024;
    red[(ks * 5 + 0) * 64 + lane] = a0; red[(ks * 5 + 1) * 64 + lane] = a1; red[(ks * 5 + 2) * 64 + lane] = a2; red[(ks * 5 + 3) * 64 + lane] = a3; red[(ks * 5 + 4) * 64 + lane] = a4;
    __syncthreads();
    if (tid < 320) {
      const int v = tid >> 6, l = tid & 63;
      float sacc = p.ada_b[layer * 6144 + cb * 64 + l];
      for (int k8 = 0; k8 < 8; ++k8) sacc += red[(k8 * 5 + v) * 64 + l];
      modL[(layer * 5 + v) * 6144 + cb * 64 + l] = sacc;
    }
  }
  {
    float* rope = (float*)(p.ws + WS_ROPE);
    for (int i = bid * NT + tid; i < SEQ * 32; i += nb * NT) {
      const int l = i >> 5, d = i & 31;
      const float inv = exp2f(-(float)(2 * (d & 15)) * (13.287712379549449f / 32.f));
      const float pos = (d < 16) ? (float)(l >> 6) : (float)(l & 63);
      float s, c; sincosf(pos * inv, &s, &c);
      rope[2 * i] = c; rope[2 * i + 1] = s;
    }
  }
  {
    float* tl = (float*)lds;
    const int nt_in = (NIN / 64) * 16, nt_o = 16 * 16;
    for (int it = bid; it < nt_in + 2 * nt_o; it += nb) {
      const float* src; bf16_t* dst; int npitch, nb0, kb0, which;
      if (it < nt_in) { which = 0; nb0 = (it / 16) * 64; kb0 = (it % 16) * 64; src = p.w_in; dst = (bf16_t*)(p.ws + WS_WIN); npitch = 3616; }
      else if (it < nt_in + nt_o) { const int j = it - nt_in; which = 1; nb0 = (j / 16) * 64; kb0 = (j % 16) * 64; src = p.w_out_ab; dst = (bf16_t*)(p.ws + WS_WOUT); npitch = 1024; }
      else { const int j = it - nt_in - nt_o; which = 2; nb0 = (j / 16) * 64; kb0 = (j % 16) * 64; src = p.w_out_f; dst = (bf16_t*)(p.ws + WS_WF); npitch = 1024; }
      __syncthreads();
      for (int e = tid; e < 4096; e += NT) {
        const int kk = e >> 6, nn = e & 63; const int n = nb0 + nn;
        int sn = n;
        if (which == 0) {
          if (n < 2048) sn = n;
          else if (n < 3072) { const int pq = n & 63, blk = pq >> 3, e8 = pq & 7; sn = (n & ~63) + 32 + ((e8 < 4) ? 4 * blk + e8 : 32 + 4 * blk + (e8 - 4)); }
          else if (n < 3584) sn = n + 32;
          else if (n < 3616) sn = n - 1536;
          else sn = -1;
        }
        tl[kk * 65 + nn] = (sn >= 0) ? src[(size_t)(kb0 + kk) * npitch + sn] : 0.f;
      }
      __syncthreads();
      for (int e = tid; e < 4096; e += NT) { const int nn = e >> 6, kk = e & 63; dst[(size_t)(nb0 + nn) * 1024 + kb0 + kk] = (bf16_t)f2bf(tl[kk * 65 + nn]); }
    }
  }
  {
    float* kl = (float*)lds;
    float* wl = kl + 128 * 132;
    bf16_t* weff = (bf16_t*)(p.ws + WS_WEFF);
    for (int it = bid; it < 512; it += nb) {
      const int layer = it >> 8, hp = (it >> 4) & 15, kb = it & 15;
      __syncthreads();
      const float* ks = p.peer_keys + ((size_t)(layer * 16 + hp) * 128) * 128;
      for (int e = tid; e < 128 * 128; e += NT) kl[(e >> 7) * 132 + (e & 127)] = ks[e];
      const float* ws_ = p.peer_wq + ((size_t)layer * 1024 + kb * 64) * 2048 + hp * 128;
      for (int e = tid; e < 64 * 128; e += NT) wl[(e >> 7) * 132 + (e & 127)] = ws_[(size_t)(e >> 7) * 2048 + (e & 127)];
      __syncthreads();
      const int key = tid & 127, kq = tid >> 7;
      float a[16];
#pragma unroll
      for (int i = 0; i < 16; ++i) a[i] = 0.f;
      for (int d = 0; d < 128; d += 4) {
        const f32x4 kv = *(const f32x4*)(kl + key * 132 + d);
#pragma unroll
        for (int i = 0; i < 16; ++i) { const f32x4 wv = *(const f32x4*)(wl + (kq * 16 + i) * 132 + d); a[i] += kv[0] * wv[0] + kv[1] * wv[1] + kv[2] * wv[2] + kv[3] * wv[3]; }
      }
      bf16_t* o = weff + ((size_t)layer * 2048 + hp * 128 + key) * 1024 + kb * 64 + kq * 16;
      u32x4 o0, o1;
      o0[0] = pk2(a[0], a[1]); o0[1] = pk2(a[2], a[3]); o0[2] = pk2(a[4], a[5]); o0[3] = pk2(a[6], a[7]);
      o1[0] = pk2(a[8], a[9]); o1[1] = pk2(a[10], a[11]); o1[2] = pk2(a[12], a[13]); o1[3] = pk2(a[14], a[15]);
      *(u32x4*)o = o0; *(u32x4*)(o + 8) = o1;
    }
  }
  {
    bf16_t* d0 = (bf16_t*)(p.ws + WS_DFT0); bf16_t* d1 = (bf16_t*)(p.ws + WS_DFT1); bf16_t* d3 = (bf16_t*)(p.ws + WS_DFT3);
    for (int i = bid * NT + tid; i < 512 * 256; i += nb * NT) {
      const int n = i >> 8, c = i & 255, m = n & 255; const float fr = (float)((m * c) & 255) * (2.f / 256.f);
      d0[i] = (bf16_t)f2bf(n < 256 ? cospif(fr) : -sinpif(fr));
    }
    for (int i = bid * NT + tid; i < 128 * 128; i += nb * NT) {
      const int n = i >> 7, k = i & 127; const int k1 = 32 * (n >> 6) + (n & 31), ro = (n >> 5) & 1, ri = k >> 6, l1 = k & 63;
      const float fr = (float)((k1 * l1) & 63) * (2.f / 64.f); const float cs = cospif(fr), sn = sinpif(fr);
      d1[i] = (bf16_t)f2bf(ro == 0 ? (ri == 0 ? cs : sn) : (ri == 0 ? -sn : cs));
    }
    for (int i = bid * NT + tid; i < 128 * 256; i += nb * NT) {
      const int k2 = i >> 8, k = i & 255, ri = k >> 7, l2 = k & 127; const float fr = (float)((l2 * k2) & 127) * (2.f / 128.f);
      const float scl = 6.905339660024878e-4f;
      d3[i] = (bf16_t)f2bf((ri == 0 ? cospif(fr) : sinpif(fr)) * scl);
    }
  }
}

DI void norm_rows(const float* __restrict__ src, int row_begin, int nrows, const float* __restrict__ nw, const float* __restrict__ modbase  ,
                  int shift_j, int scale_j, bool ctx_tail  , bf16_t* __restrict__ dst, bool blk = false  ) {
  const int lane = otid() & 63, gw = (blk ? 0 : blockIdx.x * (NT / 64)) + (otid() >> 6), nw_ = (blk ? 1 : gridDim.x) * (NT / 64);
  for (int row = row_begin + gw; row < nrows; row += nw_) {
    const int v = (ctx_tail && row >= TL) ? 4 : (row >> 13);
    const float* xr = src + (size_t)row * DM;
    f32x4 xv[4]; float ss = 0.f;
#pragma unroll
    for (int i = 0; i < 4; ++i) { xv[i] = *(const f32x4*)(xr + lane * 4 + 256 * i); ss += xv[i][0] * xv[i][0] + xv[i][1] * xv[i][1] + xv[i][2] * xv[i][2] + xv[i][3] * xv[i][3]; }
    ss = wave_sum(ss);
    const float rs = rsqrtf(ss * (1.f / DM) + EPS);
    const float* sh = modbase + (size_t)v * 6144 + shift_j * 1024; const float* scp = modbase + (size_t)v * 6144 + scale_j * 1024;
#pragma unroll
    for (int i = 0; i < 4; ++i) {
      const int c = lane * 4 + 256 * i;
      const f32x4 w4 = *(const f32x4*)(nw + c), s4 = *(const f32x4*)(sh + c), c4 = *(const f32x4*)(scp + c);
      float y0 = xv[i][0] * rs * w4[0] * (1.f + c4[0]) + s4[0], y1 = xv[i][1] * rs * w4[1] * (1.f + c4[1]) + s4[1];
      float y2 = xv[i][2] * rs * w4[2] * (1.f + c4[2]) + s4[2], y3 = xv[i][3] * rs * w4[3] * (1.f + c4[3]) + s4[3];
      u32x2 o; o[0] = pk2(y0, y1); o[1] = pk2(y2, y3);
      *(u32x2*)(dst + (size_t)row * DM + c) = o;
    }
  }
}

constexpr size_t WS_HQ = (size_t)393 * MiB, WS_HS = (size_t)425 * MiB;
DI void norm_rows_hq(const P& p, const float* __restrict__ nw, const float* __restrict__ modbase) {
  const int lane = otid() & 63, gw = blockIdx.x * (NT / 64) + (otid() >> 6), nw_ = gridDim.x * (NT / 64);
  bf16_t* dst = (bf16_t*)(p.ws + R0); unsigned char* hq = (unsigned char*)(p.ws + WS_HQ); float* hs = (float*)(p.ws + WS_HS);
  for (int row = gw; row < TL; row += nw_) {
    const float* xr = p.out + (size_t)row * DM + lane * 16;
    f32x4 xv[4]; float ss = 0.f;
#pragma unroll
    for (int i = 0; i < 4; ++i) { xv[i] = *(const f32x4*)(xr + 4 * i); ss += xv[i][0] * xv[i][0] + xv[i][1] * xv[i][1] + xv[i][2] * xv[i][2] + xv[i][3] * xv[i][3]; }
    ss = wave_sum(ss);
    const float rs = rsqrtf(ss * (1.f / DM) + EPS);
    const float* sh = modbase + (size_t)(row >> 13) * 6144 + 3 * 1024 + lane * 16; const float* scp = sh + 1024;
    float y[16]; float am = 0.f;
#pragma unroll
    for (int i = 0; i < 4; ++i) {
      const f32x4 w4 = *(const f32x4*)(nw + lane * 16 + 4 * i), s4 = *(const f32x4*)(sh + 4 * i), c4 = *(const f32x4*)(scp + 4 * i);
#pragma unroll
      for (int j = 0; j < 4; ++j) { y[4 * i + j] = xv[i][j] * rs * w4[j] * (1.f + c4[j]) + s4[j]; am = fmaxf(am, fabsf(y[4 * i + j])); }
    }
#pragma unroll
    for (int o = 32; o >= 1; o >>= 1) am = fmaxf(am, __shfl_xor(am, o, 64));
    const float st = am * (1.f / 119.f) + 1e-30f, ist = 1.f / st;
    unsigned h0 = 0u, h1 = 0u, l0 = 0u, l1 = 0u;
    u32x4 b8 = {0u, 0u, 0u, 0u};
#pragma unroll
    for (int j = 0; j < 8; ++j) {
      const int va = (int)fminf(fmaxf(rintf(y[j] * ist), -120.f), 119.f), vb = (int)fminf(fmaxf(rintf(y[8 + j] * ist), -120.f), 119.f);
      b8[j >> 2] |= ((unsigned)va & 255u) << (8 * (j & 3)); b8[2 + (j >> 2)] |= ((unsigned)vb & 255u) << (8 * (j & 3));
      const int ha = (va + 8) >> 4, hb = (vb + 8) >> 4, la = va - 16 * ha, lb = vb - 16 * hb;
      h0 |= ((unsigned)ha & 15u) << (4 * j); h1 |= ((unsigned)hb & 15u) << (4 * j); l0 |= ((unsigned)la & 15u) << (4 * j); l1 |= ((unsigned)lb & 15u) << (4 * j);
    }
    u32x2 vh; vh[0] = h0; vh[1] = h1; *(u32x2*)(hq + (size_t)row * 1024 + lane * 8) = vh;
    u32x2 vl; vl[0] = l0; vl[1] = l1; *(u32x2*)(hq + (size_t)row * 1024 + 512 + lane * 8) = vl;
    *(u32x4*)((unsigned char*)dst + (size_t)row * DM + lane * 16) = b8;
    if (lane == 0) hs[row] = st;
  }
}

constexpr size_t WS_WEFF8 = WS_WIN, WS_SW = WS_WIN + 5 * MiB;
DI void ph_quant_weff(const P& p) {
  const int lane = otid() & 63, gw = blockIdx.x * (NT / 64) + (otid() >> 6), nw_ = gridDim.x * (NT / 64);
  const bf16_t* w = (const bf16_t*)(p.ws + WS_WEFF); unsigned char* w8 = (unsigned char*)(p.ws + WS_WEFF8); float* sw = (float*)(p.ws + WS_SW);
  for (int row = gw; row < 4096; row += nw_) {
    const u32x4 a = *(const u32x4*)(w + (size_t)row * 1024 + lane * 16), b = *(const u32x4*)(w + (size_t)row * 1024 + lane * 16 + 8);
    float v[16]; float am = 0.f;
#pragma unroll
    for (int i = 0; i < 4; ++i) { v[2 * i] = bflo(a[i]); v[2 * i + 1] = bfhi(a[i]); v[8 + 2 * i] = bflo(b[i]); v[9 + 2 * i] = bfhi(b[i]); }
#pragma unroll
    for (int i = 0; i < 16; ++i) am = fmaxf(am, fabsf(v[i]));
#pragma unroll
    for (int o = 32; o >= 1; o >>= 1) am = fmaxf(am, __shfl_xor(am, o, 64));
    const float st = am * (1.f / 127.f) + 1e-30f, ist = 1.f / st;
    u32x4 o8 = {0u, 0u, 0u, 0u};
#pragma unroll
    for (int i = 0; i < 16; ++i) { const int qv = (int)fminf(fmaxf(rintf(v[i] * ist), -127.f), 127.f); o8[i >> 2] |= ((unsigned)qv & 255u) << (8 * (i & 3)); }
    *(u32x4*)(w8 + (size_t)row * 1024 + lane * 16) = o8;
    if (lane == 0) sw[row] = st;
  }
}

struct EpiProjV {
  const P* p; int row0, col0;
  DI void operator()(f32x16 (&acc)[2][2], int wm, int wn, int lane) const {
    const int cb = col0 + wn * 64, h = lane >> 5, cl = lane & 31;
    const bool isctx = row0 >= TL;
    bf16_t* o = (bf16_t*)(p->ws + WS_VT);
    const int hv = (cb - 3072) >> 7, dvb = (cb - 3072) & 127;
#pragma unroll
    for (int mt = 0; mt < 2; ++mt)
#pragma unroll
      for (int nt = 0; nt < 2; ++nt)
#pragma unroll
        for (int g = 0; g < 4; ++g) {
          const int row = row0 + wm * 64 + mt * 32 + 8 * g + 4 * h;
          int b, pos; if (!isctx) { b = row >> 13; pos = row & (SEQ - 1); } else { const int rc = row - TL; b = rc >> 8; pos = SEQ + (rc & 255); }
          const int dv = dvb + nt * 32 + cl;
          u32x2 v; v[0] = pk2(acc[mt][nt][4 * g], acc[mt][nt][4 * g + 1]); v[1] = pk2(acc[mt][nt][4 * g + 2], acc[mt][nt][4 * g + 3]);
          *(u32x2*)(o + ((size_t)((b * 4 + hv) * 128 + dv)) * KVL + pos) = v;
        }
  }
};
struct EpiProjS {
  const P* p; int row0, col0;
  DI void operator()(f32x16 (&acc)[2][2], int wm, int wn, int lane) const {
    const int cb = col0 + wn * 64, h = lane >> 5, cl = lane & 31;
    const bool isctx = row0 >= TL;
    char* ws = p->ws;
    if (cb < 2048) {
      const bool isg = cb >= 1536;
      if (isg && isctx) return;
      bf16_t* o = (bf16_t*)(ws + (isg ? WS_GATE : WS_QKVRAW));
      const int pitch = isg ? 512 : 1536, cofs = isg ? cb - 1536 : cb;
#pragma unroll
      for (int mt = 0; mt < 2; ++mt) {
        const int row = row0 + wm * 64 + mt * 32 + cl;
#pragma unroll
        for (int nt = 0; nt < 2; ++nt)
#pragma unroll
          for (int g = 0; g < 4; ++g) {
            float v0 = acc[mt][nt][4 * g], v1 = acc[mt][nt][4 * g + 1], v2 = acc[mt][nt][4 * g + 2], v3 = acc[mt][nt][4 * g + 3];
            if (isg) { v0 = silu_f(v0); v1 = silu_f(v1); v2 = silu_f(v2); v3 = silu_f(v3); }
            u32x2 v; v[0] = pk2(v0, v1); v[1] = pk2(v2, v3);
            *(u32x2*)(o + (size_t)row * pitch + cofs + nt * 32 + 8 * g + 4 * h) = v;
          }
      }
    } else if (cb < 3072) {
      const bool isq = cb < 2560;
      if (isq && isctx) return;
      const float* rope = (const float*)(ws + WS_ROPE);
      bf16_t* o = (bf16_t*)(ws + (isq ? WS_Q : WS_K));
      const int cofs = cb - (isq ? 2048 : 2560);
      const float qs = isq ? 0.125f * 1.4426950408889634f : 1.f;
#pragma unroll
      for (int mt = 0; mt < 2; ++mt) {
        const int row = row0 + wm * 64 + mt * 32 + cl;
        size_t orow; int l = 0;
        if (!isctx) { l = row & (SEQ - 1); orow = isq ? (size_t)row : (size_t)(row >> 13) * KVL + l; }
        else { const int rc = row - TL; orow = (size_t)(rc >> 8) * KVL + SEQ + (rc & 255); }
#pragma unroll
        for (int g = 0; g < 4; ++g) {
          const int d0 = 8 * g + 4 * h;
          float o1[4], o2[4];
          if (!isctx) {
            const f32x4 ca = *(const f32x4*)(rope + ((size_t)l * 32 + d0) * 2), cb2 = *(const f32x4*)(rope + ((size_t)l * 32 + d0) * 2 + 4);
            const float cs[4] = {ca[0], ca[2], cb2[0], cb2[2]}, sn[4] = {ca[1], ca[3], cb2[1], cb2[3]};
#pragma unroll
            for (int r = 0; r < 4; ++r) { const float x1 = acc[mt][0][4 * g + r], x2 = acc[mt][1][4 * g + r]; o1[r] = (x1 * cs[r] - x2 * sn[r]) * qs; o2[r] = (x1 * sn[r] + x2 * cs[r]) * qs; }
          } else {
#pragma unroll
            for (int r = 0; r < 4; ++r) { o1[r] = acc[mt][0][4 * g + r]; o2[r] = acc[mt][1][4 * g + r]; }
          }
          u32x2 v; v[0] = pk2(o1[0], o1[1]); v[1] = pk2(o1[2], o1[3]); *(u32x2*)(o + orow * 512 + cofs + d0) = v;
          v[0] = pk2(o2[0], o2[1]); v[1] = pk2(o2[2], o2[3]); *(u32x2*)(o + orow * 512 + cofs + 32 + d0) = v;
        }
      }
    } else if (cb == 3584) {
      float* o = (float*)(ws + WS_BA);
#pragma unroll
      for (int mt = 0; mt < 2; ++mt) {
        const int row = row0 + wm * 64 + mt * 32 + cl;
#pragma unroll
        for (int g = 0; g < 4; ++g) {
          const int j0 = 8 * g + 4 * h;
          f32x4 y;
#pragma unroll
          for (int r = 0; r < 4; ++r) {
            const int j = j0 + r; const float v = acc[mt][0][4 * g + r];
            if (j0 < 16) y[r] = sigmoid_f(v);
            else { const float z = v + p->dt_bias[j - 16]; const float sp = (z > 20.f) ? z : log1pf(__expf(z)); y[r] = -__expf(p->a_log[j - 16]) * sp; }
          }
          *(f32x4*)(o + (size_t)row * 32 + j0) = y;
        }
      }
    }
  }
};

DI void ph_gemm_proj(const P& p, char* lds) {
  const bf16_t* A = (const bf16_t*)(p.ws + R0); const bf16_t* Bt = (const bf16_t*)(p.ws + WS_WIN);
  const int nM = TA / GBM, nN = NIN / GBN;
  for (int t = blockIdx.x; t < nM * nN; t += gridDim.x) {
    const int pm = t / nN, pn = t % nN;
    RowLin rf{A + (size_t)pm * GBM * DM, (size_t)DM};
    if (pn >= 24 && pn < 28) { EpiProjV ep{&p, pm * GBM, pn * GBN}; gemm_tile<false>(lds, rf, Bt + (size_t)pn * GBN * DM, DM, ep); }
    else { EpiProjS ep{&p, pm * GBM, pn * GBN}; gemm_tile<true>(lds, rf, Bt + (size_t)pn * GBN * DM, DM, ep); }
  }
}


struct PgResid {
  static constexpr bool PERM = true, AFTER_DRAIN = false;
  const float* xin; float* xout; const float* gmod;
  DI void operator()(const pg8::f32x4 (&acc)[2][2][4][2], const pg8::Unit& u, int wr, int wc, int fr, int fq) const {
#pragma unroll
    for (int ai = 0; ai < 2; ++ai)
#pragma unroll
      for (int m = 0; m < 4; ++m) {
        const int row = u.pm * 256 + ai * 128 + wr * 64 + m * 16 + fr;
        const float* gm = gmod + (size_t)(row >> 13) * 6144;
#pragma unroll
        for (int bj = 0; bj < 2; ++bj) {
          const int c0 = u.pn * 256 + bj * 128 + wc * 32 + 8 * fq;
#pragma unroll
          for (int n = 0; n < 2; ++n) {
            const f32x4 xv = *(const f32x4*)(xin + (size_t)row * DM + c0 + 4 * n), g4 = *(const f32x4*)(gm + c0 + 4 * n);
            *(f32x4*)(xout + (size_t)row * DM + c0 + 4 * n) = xv + g4 * acc[ai][bj][m][n];
          }
        }
      }
  }
};
struct PgBf16 {
  static constexpr bool PERM = true, AFTER_DRAIN = false;
  bf16_t* o; int pitch;
  DI void operator()(const pg8::f32x4 (&acc)[2][2][4][2], const pg8::Unit& u, int wr, int wc, int fr, int fq) const {
#pragma unroll
    for (int ai = 0; ai < 2; ++ai)
#pragma unroll
      for (int m = 0; m < 4; ++m) {
        const int row = u.pm * 256 + ai * 128 + wr * 64 + m * 16 + fr;
#pragma unroll
        for (int bj = 0; bj < 2; ++bj) {
          const int c0 = u.pn * 256 + bj * 128 + wc * 32 + 8 * fq;
          const f32x4 v0 = acc[ai][bj][m][0], v1 = acc[ai][bj][m][1];
          u32x4 w; w[0] = pk2(v0[0], v0[1]); w[1] = pk2(v0[2], v0[3]); w[2] = pk2(v1[0], v1[1]); w[3] = pk2(v1[2], v1[3]);
          *(u32x4*)(o + (size_t)row * pitch + c0) = w;
        }
      }
  }
};
struct PgProj {
  static constexpr bool PERM = true, AFTER_DRAIN = false;
  const P* p;
  DI void operator()(const pg8::f32x4 (&acc)[2][2][4][2], const pg8::Unit& u, int wr, int wc, int fr, int fq) const {
    char* ws = p->ws;
    const bool isctx = u.pm * 256 >= TL;
#pragma unroll
    for (int bj = 0; bj < 2; ++bj) {
      const int c0 = u.pn * 256 + bj * 128 + wc * 32 + 8 * fq;
      const int cs = u.pn * 256 + bj * 128 + wc * 32;
      if (cs < 2048) {
        const bool isg = cs >= 1536;
        if (isg && isctx) continue;
        bf16_t* o = (bf16_t*)(ws + (isg ? WS_GATE : WS_QKVRAW));
        const int pitch = isg ? 512 : 1536, cofs = isg ? c0 - 1536 : c0;
#pragma unroll
        for (int ai = 0; ai < 2; ++ai)
#pragma unroll
          for (int m = 0; m < 4; ++m) {
            const int row = u.pm * 256 + ai * 128 + wr * 64 + m * 16 + fr;
            f32x4 v0 = acc[ai][bj][m][0], v1 = acc[ai][bj][m][1];
            if (isg) {
#pragma unroll
              for (int r = 0; r < 4; ++r) { v0[r] = silu_f(v0[r]); v1[r] = silu_f(v1[r]); }
            }
            u32x4 w; w[0] = pk2(v0[0], v0[1]); w[1] = pk2(v0[2], v0[3]); w[2] = pk2(v1[0], v1[1]); w[3] = pk2(v1[2], v1[3]);
            *(u32x4*)(o + (size_t)row * pitch + cofs) = w;
          }
      } else if (cs < 3072) {
        const bool isq = cs < 2560;
        if (isq && isctx) continue;
        const float* rope = (const float*)(ws + WS_ROPE);
        bf16_t* o = (bf16_t*)(ws + (isq ? WS_Q : WS_K));
        const int gofs = (c0 & ~63) - (isq ? 2048 : 2560), d0 = ((c0 & 63) >> 3) * 4;
        const float qs = isq ? 0.125f * 1.4426950408889634f : 1.f;
#pragma unroll
        for (int ai = 0; ai < 2; ++ai)
#pragma unroll
          for (int m = 0; m < 4; ++m) {
            const int row = u.pm * 256 + ai * 128 + wr * 64 + m * 16 + fr;
            const f32x4 x1 = acc[ai][bj][m][0], x2 = acc[ai][bj][m][1];
            size_t orow; float o1[4], o2[4];
            if (!isctx) {
              const int l = row & (SEQ - 1);
              orow = isq ? (size_t)row : (size_t)(row >> 13) * KVL + l;
              const f32x4 ca = *(const f32x4*)(rope + ((size_t)l * 32 + d0) * 2), cb2 = *(const f32x4*)(rope + ((size_t)l * 32 + d0) * 2 + 4);
              const float cs4[4] = {ca[0], ca[2], cb2[0], cb2[2]}, sn4[4] = {ca[1], ca[3], cb2[1], cb2[3]};
#pragma unroll
              for (int r = 0; r < 4; ++r) { o1[r] = (x1[r] * cs4[r] - x2[r] * sn4[r]) * qs; o2[r] = (x1[r] * sn4[r] + x2[r] * cs4[r]) * qs; }
            } else {
              const int rc = row - TL; orow = (size_t)(rc >> 8) * KVL + SEQ + (rc & 255);
#pragma unroll
              for (int r = 0; r < 4; ++r) { o1[r] = x1[r]; o2[r] = x2[r]; }
            }
            u32x2 v; v[0] = pk2(o1[0], o1[1]); v[1] = pk2(o1[2], o1[3]); *(u32x2*)(o + orow * 512 + gofs + d0) = v;
            v[0] = pk2(o2[0], o2[1]); v[1] = pk2(o2[2], o2[3]); *(u32x2*)(o + orow * 512 + gofs + 32 + d0) = v;
          }
      } else if (cs < 3584) {
        bf16_t* o = (bf16_t*)(ws + WS_VT);
        const int hv = (c0 - 3072) >> 7, dv0 = (c0 - 3072) & 127;
#pragma unroll
        for (int ai = 0; ai < 2; ++ai)
#pragma unroll
          for (int m = 0; m < 4; ++m) {
            const int row = u.pm * 256 + ai * 128 + wr * 64 + m * 16 + fr;
            int b, pos; if (!isctx) { b = row >> 13; pos = row & (SEQ - 1); } else { const int rc = row - TL; b = rc >> 8; pos = SEQ + (rc & 255); }
            bf16_t* op = o + ((size_t)((b * 4 + hv) * 128 + dv0)) * KVL + pos;
#pragma unroll
            for (int n = 0; n < 2; ++n)
#pragma unroll
              for (int r = 0; r < 4; ++r) op[(size_t)(4 * n + r) * KVL] = (bf16_t)f2bf(acc[ai][bj][m][n][r]);
          }
      } else if (cs == 3584) {
        float* o = (float*)(ws + WS_BA);
        const int j0 = c0 - 3584;
#pragma unroll
        for (int ai = 0; ai < 2; ++ai)
#pragma unroll
          for (int m = 0; m < 4; ++m) {
            const int row = u.pm * 256 + ai * 128 + wr * 64 + m * 16 + fr;
#pragma unroll
            for (int n = 0; n < 2; ++n) {
              f32x4 y;
#pragma unroll
              for (int r = 0; r < 4; ++r) {
                const int j = j0 + 4 * n + r; const float v = acc[ai][bj][m][n][r];
                if (j0 < 16) y[r] = sigmoid_f(v);
                else { const float z = v + p->dt_bias[j - 16]; const float sp = (z > 20.f) ? z : log1pf(__expf(z)); y[r] = -__expf(p->a_log[j - 16]) * sp; }
              }
              *(f32x4*)(o + (size_t)row * 32 + j0 + 4 * n) = y;
            }
          }
      }
    }
  }
};
struct PgScoreI8 {
  static constexpr bool PERM = true, AFTER_DRAIN = false;
  bf16_t* o; const float* srow; const float* scol;
  DI void operator()(const pg8::f32x4 (&acc)[2][2][4][2], const pg8::Unit& u, int wr, int wc, int fr, int fq) const {
#pragma unroll
    for (int bj = 0; bj < 2; ++bj) {
      const int c0 = u.pn * 256 + bj * 128 + wc * 32 + 8 * fq;
      const f32x4 s0 = *(const f32x4*)(scol + c0), s1 = *(const f32x4*)(scol + c0 + 4);
#pragma unroll
      for (int ai = 0; ai < 2; ++ai)
#pragma unroll
        for (int m = 0; m < 4; ++m) {
          const int row = u.pm * 256 + ai * 128 + wr * 64 + m * 16 + fr;
          const float sr = srow[row];
          const pg8::v4i_t i0 = __builtin_bit_cast(pg8::v4i_t, acc[ai][bj][m][0]), i1 = __builtin_bit_cast(pg8::v4i_t, acc[ai][bj][m][1]);
          u32x4 w;
          w[0] = pk2((float)i0[0] * sr * s0[0], (float)i0[1] * sr * s0[1]); w[1] = pk2((float)i0[2] * sr * s0[2], (float)i0[3] * sr * s0[3]);
          w[2] = pk2((float)i1[0] * sr * s1[0], (float)i1[1] * sr * s1[1]); w[3] = pk2((float)i1[2] * sr * s1[2], (float)i1[3] * sr * s1[3]);
          *(u32x4*)(o + (size_t)row * 2048 + c0) = w;
        }
    }
  }
};
template <class Epi>
DI void pg8_run_i8(char* lds, const void* A8, const void* Bt8, int M, int N, int Kbytes, const Epi& E) {
  pg8::Gemm g{(const pg8::bf16_t*)A8, (const pg8::bf16_t*)Bt8, M, N, Kbytes / 2};
  pg8::StaticOrder S; S.init(M, N, (int)gridDim.x, (int)blockIdx.x);
  pg8::gemm_phase<Epi, pg8::StaticOrder, true, true, true>((PG8_LAS unsigned char*)lds, g, S, E);
}
template <class Epi>
DI void pg8_run(char* lds, const bf16_t* A, const bf16_t* Bt, int M, int N, int K, const Epi& E) {
  pg8::Gemm g{A, Bt, M, N, K};
  pg8::StaticOrder S; S.init(M, N, (int)gridDim.x, (int)blockIdx.x);
  pg8::gemm_phase<Epi, pg8::StaticOrder, true, true>((PG8_LAS unsigned char*)lds, g, S, E);
}

DI void gdn_solve(const float* MT, const float* src  , const float* be, const float* gc  ,
                  int d, int part, int lane, bf16_t* uo) {
  float a[64];
#pragma unroll
  for (int i = 0; i < 64; ++i) {
    const int t = d ? 63 - i : i;
    float v = be[t] * src[t * 68 + lane];
    if (part) v *= __expf(gc[t]);
    a[i] = v;
  }
#pragma unroll
  for (int j = 0; j < 63; ++j) {
    const float xj = a[j];
#pragma unroll
    for (int i4 = ((j + 1) & ~3); i4 < 64; i4 += 4) {
      const f32x4 m = *(const f32x4*)(MT + j * 68 + i4);
#pragma unroll
      for (int q = 0; q < 4; ++q) if (i4 + q > j) a[i4 + q] -= m[q] * xj;
    }
  }
  if (part) {
#pragma unroll
    for (int i = 0; i < 64; ++i) uo[i * 64 + lane] = (bf16_t)f2bf(a[i]);
  } else {
#pragma unroll
    for (int c = 0; c < 8; ++c) {
      u32x4 o; o[0] = pk2(a[8 * c], a[8 * c + 1]); o[1] = pk2(a[8 * c + 2], a[8 * c + 3]); o[2] = pk2(a[8 * c + 4], a[8 * c + 5]); o[3] = pk2(a[8 * c + 6], a[8 * c + 7]);
      *(u32x4*)(uo + lane * 64 + 8 * c) = o;
    }
  }
}

template <int MODE = 0>
DI void ph_gdn_prep(const P& p, char* lds) {
  const int tid0 = otid();
  float* L = (float*)lds;
  constexpr int HSZ = 4 * 64 * 68 + 6 * 64;
  const bf16_t* raw = (const bf16_t*)(p.ws + WS_QKVRAW);
  const float* BA = (const float*)(p.ws + WS_BA);
  bf16_t* qn = (bf16_t*)(p.ws + WS_QN); bf16_t* kn = (bf16_t*)(p.ws + WS_KN);
  float* GC = (float*)(p.ws + WS_GC);
  bf16_t* UW = (bf16_t*)(p.ws + WS_UW);
  for (int it = blockIdx.x; it < NB * NCH * 4; it += gridDim.x) {
    int tid = tid0; asm volatile("" : "+v"(tid));
    const int lane = tid & 63, wave = __builtin_amdgcn_readfirstlane(tid >> 6);
    const int hpair = it & 3, cid = (it >> 2) % NCH, b = it / (4 * NCH);
    const int segbase = (cid < 4) ? TL + b * CTXL : b * SEQ, c0 = (cid < 4) ? cid * 64 : (cid - 4) * 64, seglen = (cid < 4) ? CTXL : SEQ;
    __syncthreads();
    {
      const int t = tid >> 3, c8 = tid & 7, sidx = c0 + t;
      const size_t grow = (size_t)(segbase + sidx);
      const bool hm = sidx - 1 >= 0, hp_ = sidx + 1 < seglen;
#pragma unroll 1
      for (int hh = 0; hh < 2; ++hh) {
        const int head = hpair * 2 + hh;
        float* kf = L + hh * HSZ; float* vf = kf + 64 * 68;
#pragma unroll
        for (int part = 0; part < 3; ++part) {
          const int ch = part * 512 + head * 64 + c8 * 8;
          const u32x4 z4 = {0u, 0u, 0u, 0u};
          const u32x4 rm = hm ? *(const u32x4*)(raw + (grow - 1) * 1536 + ch) : z4;
          const u32x4 r0v = *(const u32x4*)(raw + grow * 1536 + ch);
          const u32x4 rp = hp_ ? *(const u32x4*)(raw + (grow + 1) * 1536 + ch) : z4;
          float v[8]; float ss = 0.f;
#pragma unroll
          for (int w = 0; w < 4; ++w) {
            const f32x2_t w0 = *(const f32x2_t*)(p.conv_w + ch + 2 * w), w1 = *(const f32x2_t*)(p.conv_w + 1536 + ch + 2 * w), w2 = *(const f32x2_t*)(p.conv_w + 3072 + ch + 2 * w);
            v[2 * w] = silu_f(w0[0] * bflo(rm[w]) + w1[0] * bflo(r0v[w]) + w2[0] * bflo(rp[w]));
            v[2 * w + 1] = silu_f(w0[1] * bfhi(rm[w]) + w1[1] * bfhi(r0v[w]) + w2[1] * bfhi(rp[w]));
            ss += v[2 * w] * v[2 * w] + v[2 * w + 1] * v[2 * w + 1];
          }
          if (part < 2) {
            ss += __shfl_xor(ss, 1, 64); ss += __shfl_xor(ss, 2, 64); ss += __shfl_xor(ss, 4, 64);
            const float rn = rsqrtf(ss + EPS) * (part == 0 ? 0.125f : 1.f);
#pragma unroll
            for (int w = 0; w < 8; ++w) v[w] *= rn;
            u32x4 o; o[0] = pk2(v[0], v[1]); o[1] = pk2(v[2], v[3]); o[2] = pk2(v[4], v[5]); o[3] = pk2(v[6], v[7]);
            *(u32x4*)((part == 0 ? qn : kn) + grow * 512 + head * 64 + c8 * 8) = o;
          }
          if (part >= 1) {
            float* dst = (part == 1 ? kf : vf) + t * 68 + c8 * 8;
            *(f32x4*)dst = f32x4{v[0], v[1], v[2], v[3]}; *(f32x4*)(dst + 4) = f32x4{v[4], v[5], v[6], v[7]};
          }
        }
      }
    }
    if (MODE == 2) continue;
    if (wave < 4) {
      const int hh = wave >> 1, d = wave & 1, head = hpair * 2 + hh, t = lane;
      float* be = L + hh * HSZ + 4 * 64 * 68;
      const size_t row = (size_t)(segbase + c0 + t);
      be[d * 64 + t] = BA[row * 32 + d * 8 + head];
      const float g = BA[row * 32 + 16 + d * 8 + head];
      float a = g;
#pragma unroll
      for (int o = 1; o < 64; o <<= 1) {
        const float nb_ = d ? __shfl_down(a, o, 64) : __shfl_up(a, o, 64);
        const bool ok = d ? (lane + o < 64) : (lane >= o);
        a += ok ? nb_ : 0.f;
      }
      be[256 + d * 64 + t] = a;
      GC[((size_t)((b * 8 + head) * 2 + d) * NCH + cid) * 64 + (d ? 63 - t : t)] = a;
    }
    __syncthreads();
    {
      const int hh = wave >> 2, Ln = lane;
      float* kf = L + hh * HSZ; float* M0 = kf + 2 * 64 * 68; float* M1 = kf + 3 * 64 * 68; float* be = kf + 4 * 64 * 68; float* gc = be + 256;
      float a[16];
#pragma unroll
      for (int i = 0; i < 16; ++i) a[i] = 0.f;
#pragma unroll 1
      for (int c = 0; c < 64; c += 4) {
        const f32x4 kv = *(const f32x4*)(kf + Ln * 68 + c);
#pragma unroll
        for (int i = 0; i < 16; ++i) { const f32x4 kr = *(const f32x4*)(kf + ((wave & 3) * 16 + i) * 68 + c); a[i] += kv[0] * kr[0] + kv[1] * kr[1] + kv[2] * kr[2] + kv[3] * kr[3]; }
      }
      const float b0 = be[Ln], b1 = be[64 + Ln], g0 = gc[Ln], g1 = gc[64 + Ln];
#pragma unroll
      for (int i = 0; i < 16; ++i) {
        const int ti = (wave & 3) * 16 + i;
        if (Ln > ti) M0[ti * 68 + Ln] = b0 * a[i] * __expf(g0 - gc[ti]);
        else if (Ln < ti) M1[(63 - ti) * 68 + 63 - Ln] = b1 * a[i] * __expf(g1 - gc[64 + ti]);
      }
    }
    __syncthreads();
    if (MODE == 0) {
      const int hh = wave >> 2, d = (wave >> 1) & 1, part = wave & 1, head = hpair * 2 + hh;
      float* kf = L + hh * HSZ; float* vf = kf + 64 * 68; float* Md = kf + (2 + d) * 64 * 68; float* be = kf + 4 * 64 * 68; float* gc = be + 256;
      bf16_t* uo = UW + (((size_t)((b * 8 + head) * 2 + d) * NCH + cid) * 2 + part) * 4096;
      gdn_solve(Md, part ? kf : vf, be + d * 64, gc + d * 64, d, part, lane, uo);
    }
  }
}

#define MFMA16(a, b, c) __builtin_amdgcn_mfma_f32_16x16x32_bf16((a), (b), (c), 0, 0, 0)
constexpr int SC_LD = 72;
constexpr int SC_T = 64 * SC_LD * 2;
constexpr int SC_STAGE = 5 * SC_T + 1024;
constexpr int SC_KNL = 2 * SC_STAGE, SC_QNL = SC_KNL + SC_T;
DI bf16x8 pack8(const f32x4& a, const f32x4& b) { u32x4 r; r[0] = cvtpk(a[0], a[1]); r[1] = cvtpk(a[2], a[3]); r[2] = cvtpk(b[0], b[1]); r[3] = cvtpk(b[2], b[3]); return __builtin_bit_cast(bf16x8, r); }
DI bf16x8 afrag(const char* tile, int row, int kofs  ) {
  const char* pr = tile + (row * SC_LD + kofs) * 2;
  const u32x2 lo = *(const u32x2*)pr, hi = *(const u32x2*)(pr + 32);
  u32x4 r; r[0] = lo[0]; r[1] = lo[1]; r[2] = hi[0]; r[3] = hi[1];
  return __builtin_bit_cast(bf16x8, r);
}
template <int NOSTORE = 0>
DI void ph_gdn_scan(const P& p, char* lds) {
  const int tid = otid(), lane = tid & 63, wave = __builtin_amdgcn_readfirstlane(tid >> 6);
  const int c = lane & 15, q = lane >> 4;
  const bf16_t* qn = (const bf16_t*)(p.ws + WS_QN); const bf16_t* kn = (const bf16_t*)(p.ws + WS_KN);
  const float* GC = (const float*)(p.ws + WS_GC);
  const bf16_t* UW = (const bf16_t*)(p.ws + WS_UW);
  bf16_t* Ob = (bf16_t*)(p.ws + WS_OBUF);
  for (int it = blockIdx.x; it < 64; it += gridDim.x) {
    const int bhd = it, d = bhd & 1, head = (bhd >> 1) & 7, b = bhd >> 4;
    __syncthreads();
    if (wave >= 4) {
      const int pt = tid - 256;
      const int r0 = pt >> 3, cc = pt & 7;
      u32x4 rW0A, rW1A, rU0A, rU1A, rK0A, rK1A, rQ0A, rQ1A; f32x4 rGA;
      u32x4 rW0B, rW1B, rU0B, rU1B, rK0B, rK1B, rQ0B, rQ1B; f32x4 rGB;
#define SP_CID(n) (d ? ((n) < 4 ? 3 - (n) : 135 - (n)) : (n))
#define SP_LOAD(n, S) do { const int nn_ = (n) < NCH ? (n) : NCH - 1; const int cid_ = SP_CID(nn_); const bool lat_ = cid_ >= 4; const int sb_ = lat_ ? b * SEQ : TL + b * CTXL, c0_ = lat_ ? (cid_ - 4) * 64 : cid_ * 64; \
        const bf16_t* uw_ = UW + ((size_t)(bhd * NCH + cid_) * 2) * 4096; \
        rU0##S = *(const u32x4*)(uw_ + r0 * 64 + cc * 8); rU1##S = *(const u32x4*)(uw_ + (r0 + 32) * 64 + cc * 8); \
        rW0##S = *(const u32x4*)(uw_ + 4096 + r0 * 64 + cc * 8); rW1##S = *(const u32x4*)(uw_ + 4096 + (r0 + 32) * 64 + cc * 8); \
        const int t0_ = d ? 63 - r0 : r0, t1_ = d ? 31 - r0 : r0 + 32; \
        rK0##S = *(const u32x4*)(kn + (size_t)(sb_ + c0_ + t0_) * 512 + head * 64 + cc * 8); rK1##S = *(const u32x4*)(kn + (size_t)(sb_ + c0_ + t1_) * 512 + head * 64 + cc * 8); \
        const bf16_t* qk_ = lat_ ? qn : kn;     \
        rQ0##S = *(const u32x4*)(qk_ + (size_t)(sb_ + c0_ + t0_) * 512 + head * 64 + cc * 8); rQ1##S = *(const u32x4*)(qk_ + (size_t)(sb_ + c0_ + t1_) * 512 + head * 64 + cc * 8); \
        rG##S = *(const f32x4*)(GC + (size_t)(bhd * NCH + cid_) * 64 + (pt & 15) * 4); } while (0)
#define SP_A(n, S) do { char* st_ = lds + ((n) & 1) * SC_STAGE; const int o0_ = (r0 * SC_LD + cc * 8) * 2, o1_ = o0_ + 32 * SC_LD * 2; \
        *(u32x4*)(st_ + o0_) = rW0##S; *(u32x4*)(st_ + o1_) = rW1##S; *(u32x4*)(st_ + SC_T + o0_) = rU0##S; *(u32x4*)(st_ + SC_T + o1_) = rU1##S; \
        *(u32x4*)(lds + SC_KNL + o0_) = rK0##S; *(u32x4*)(lds + SC_KNL + o1_) = rK1##S; \
        *(u32x4*)(lds + SC_QNL + o0_) = rQ0##S; *(u32x4*)(lds + SC_QNL + o1_) = rQ1##S; \
        if (pt < 16) { float* gp_ = (float*)(st_ + 5 * SC_T); *(f32x4*)(gp_ + pt * 4) = rG##S; } } while (0)
#define SP_B(n) do { char* st_ = lds + ((n) & 1) * SC_STAGE; float* gp_ = (float*)(st_ + 5 * SC_T); const bool lat_ = SP_CID((n) < NCH ? (n) : NCH - 1) >= 4; \
        const float gl_ = gp_[63]; \
        if (pt < 64) { const float gi_ = gp_[pt]; gp_[64 + pt] = __expf(gi_); gp_[128 + pt] = __expf(gl_ - gi_); if (pt == 0) gp_[192] = __expf(gl_); } \
        {   \
          const int i_ = pt & 63; \
          _Pragma("unroll") for (int e_ = 0; e_ < 2; ++e_) { const int ch_ = (pt >> 6) * 2 + e_; const u32x4 kv_ = *(const u32x4*)(lds + SC_KNL + (i_ * SC_LD + ch_ * 8) * 2); \
            bf16_t* kt_ = (bf16_t*)(st_ + 2 * SC_T); \
            _Pragma("unroll") for (int w_ = 0; w_ < 4; ++w_) { kt_[(ch_ * 8 + 2 * w_) * SC_LD + i_] = (bf16_t)(kv_[w_] & 0xFFFFu); kt_[(ch_ * 8 + 2 * w_ + 1) * SC_LD + i_] = (bf16_t)(kv_[w_] >> 16); } } } \
        if (lat_) { \
          {   \
            _Pragma("unroll") for (int e_ = 0; e_ < 2; ++e_) { const int rr_ = r0 + 32 * e_; const float sc_ = __expf(gp_[rr_]); const u32x4 qv_ = *(const u32x4*)(lds + SC_QNL + (rr_ * SC_LD + cc * 8) * 2); u32x4 ov_; \
              _Pragma("unroll") for (int w_ = 0; w_ < 4; ++w_) ov_[w_] = cvtpk(bflo(qv_[w_]) * sc_, bfhi(qv_[w_]) * sc_); \
              *(u32x4*)(st_ + 3 * SC_T + (rr_ * SC_LD + cc * 8) * 2) = ov_; } } \
          {   \
            const int jt_ = wave - 4; \
            const bf16x8 ka0_ = *(const bf16x8*)(lds + SC_KNL + ((16 * jt_ + c) * SC_LD + 8 * q) * 2), ka1_ = *(const bf16x8*)(lds + SC_KNL + ((16 * jt_ + c) * SC_LD + 32 + 8 * q) * 2); \
            bf16x8 qb_[4][2]; \
            _Pragma("unroll") for (int it_ = 0; it_ < 4; ++it_) { qb_[it_][0] = *(const bf16x8*)(lds + SC_QNL + ((16 * it_ + c) * SC_LD + 8 * q) * 2); qb_[it_][1] = *(const bf16x8*)(lds + SC_QNL + ((16 * it_ + c) * SC_LD + 32 + 8 * q) * 2); } \
            const f32x4 gj_ = *(const f32x4*)(gp_ + 16 * jt_ + 4 * q); \
            float gi_[4]; _Pragma("unroll") for (int it_ = 0; it_ < 4; ++it_) gi_[it_] = gp_[16 * it_ + c]; \
            _Pragma("unroll") for (int it_ = 0; it_ < 4; ++it_) { \
              f32x4 ac_ = {0.f, 0.f, 0.f, 0.f}; \
              ac_ = MFMA16(ka0_, qb_[it_][0], ac_); ac_ = MFMA16(ka1_, qb_[it_][1], ac_); \
              const int i_ = 16 * it_ + c; \
              _Pragma("unroll") for (int r_ = 0; r_ < 4; ++r_) { const int j_ = 16 * jt_ + 4 * q + r_; const float e_ = __expf(fminf(gi_[it_] - gj_[r_], 0.f)); ac_[r_] = (i_ >= j_) ? ac_[r_] * e_ : 0.f; } \
              u32x2 ov_; ov_[0] = cvtpk(ac_[0], ac_[1]); ov_[1] = cvtpk(ac_[2], ac_[3]); \
              *(u32x2*)(st_ + 4 * SC_T + ((16 * it_ + c) * SC_LD + 16 * jt_ + 4 * q) * 2) = ov_; } } } } while (0)
      SP_LOAD(0, A); SP_LOAD(1, B);
      SP_A(0, A);
      __syncthreads();
      SP_B(0);
      SP_LOAD(2, A);
      __syncthreads();
#define SP_STEP(n, S) do { SP_A((n) + 1, S); SP_LOAD((n) + 3, S);        \
        __syncthreads();                 \
        SP_B((n) + 1); \
        __syncthreads();                 } while (0)
#pragma unroll 1
      for (int n = 0; n < NCH; n += 2) { SP_STEP(n, B); SP_STEP(n + 1, A); }
#undef SP_STEP
#undef SP_LOAD
#undef SP_A
#undef SP_B
    } else {
      f32x4 S[4];
#pragma unroll
      for (int i = 0; i < 4; ++i) S[i] = f32x4{0.f, 0.f, 0.f, 0.f};
      __syncthreads();
      __syncthreads();
#pragma unroll 1
      for (int n = 0; n < NCH; ++n) {
        const int cid = SP_CID(n); const bool lat = cid >= 4;
        const char* st = lds + (n & 1) * SC_STAGE; const float* gp = (const float*)(st + 5 * SC_T);
        bf16x8 Sb[2], Sn[2];
#pragma unroll
        for (int ks = 0; ks < 2; ++ks) {
          Sb[ks] = pack8(S[2 * ks], S[2 * ks + 1]);
          u32x4 t = __builtin_bit_cast(u32x4, Sb[ks]);
#pragma unroll
          for (int w = 0; w < 4; ++w) t[w] ^= 0x80008000u;
          Sn[ks] = __builtin_bit_cast(bf16x8, t);
        }
        u32x2 ur[4]; bf16x8 wf[4][2], kf2[4][2]; f32x4 sc4[4];
#pragma unroll
        for (int mt = 0; mt < 4; ++mt) {
          ur[mt] = *(const u32x2*)(st + SC_T + ((16 * wave + c) * SC_LD + 16 * mt + 4 * q) * 2);
          wf[mt][0] = afrag(st, 16 * mt + c, 4 * q); wf[mt][1] = afrag(st, 16 * mt + c, 32 + 4 * q);
          sc4[mt] = *(const f32x4*)(gp + 128 + 16 * mt + 4 * q);
        }
#pragma unroll
        for (int dt = 0; dt < 4; ++dt) { kf2[dt][0] = afrag(st + 2 * SC_T, 16 * dt + c, 4 * q); kf2[dt][1] = afrag(st + 2 * SC_T, 16 * dt + c, 32 + 4 * q); }
        const float gt = gp[192];
        f32x4 vn[4], vs[4];
#pragma unroll
        for (int mt = 0; mt < 4; ++mt) {
          f32x4 acc = {bflo(ur[mt][0]), bfhi(ur[mt][0]), bflo(ur[mt][1]), bfhi(ur[mt][1])};
          acc = MFMA16(wf[mt][0], Sn[0], acc);
          acc = MFMA16(wf[mt][1], Sn[1], acc);
          vn[mt] = acc;
          vs[mt] = acc * sc4[mt];
        }
        bf16x8 Vn[2], Vs[2];
#pragma unroll
        for (int ks = 0; ks < 2; ++ks) { Vn[ks] = pack8(vn[2 * ks], vn[2 * ks + 1]); Vs[ks] = pack8(vs[2 * ks], vs[2 * ks + 1]); }
        f32x4 Snew[4];
#pragma unroll
        for (int dt = 0; dt < 4; ++dt) {
          f32x4 acc = S[dt] * gt;
          acc = MFMA16(kf2[dt][0], Vs[0], acc);
          acc = MFMA16(kf2[dt][1], Vs[1], acc);
          Snew[dt] = acc;
        }
        __syncthreads();
        if (lat) {
          const int sb = b * SEQ, c0 = (cid - 4) * 64;
          bf16x8 qf[4][2], pf[4][2];
#pragma unroll
          for (int mt = 0; mt < 4; ++mt) {
            qf[mt][0] = afrag(st + 3 * SC_T, 16 * mt + c, 4 * q); qf[mt][1] = afrag(st + 3 * SC_T, 16 * mt + c, 32 + 4 * q);
            pf[mt][0] = afrag(st + 4 * SC_T, 16 * mt + c, 4 * q); pf[mt][1] = afrag(st + 4 * SC_T, 16 * mt + c, 32 + 4 * q);
          }
#pragma unroll
          for (int mt = 0; mt < 4; ++mt) {
            f32x4 o = {0.f, 0.f, 0.f, 0.f};
            o = MFMA16(Sb[0], qf[mt][0], o);
            o = MFMA16(Sb[1], qf[mt][1], o);
            o = MFMA16(Vn[0], pf[mt][0], o);
            o = MFMA16(Vn[1], pf[mt][1], o);
            const int i = 16 * mt + c, t = d ? 63 - i : i;
            u32x2 ov; ov[0] = cvtpk(o[0], o[1]); ov[1] = cvtpk(o[2], o[3]);
            if (!NOSTORE || ov[0] == 0x12345678u) *(u32x2*)(Ob + ((size_t)d * TL + sb + c0 + t) * 512 + head * 64 + 16 * wave + 4 * q) = ov;
          }
        }
#pragma unroll
        for (int dt = 0; dt < 4; ++dt) S[dt] = Snew[dt];
        __syncthreads();
      }
    }
#undef SP_CID
  }
}

constexpr int AT_KROW = 72, AT_VROW = 68;
constexpr int AT_KB = 2 * 64 * AT_KROW * 2, AT_VB = 128 * AT_VROW * 2, AT_STAGE = AT_KB + AT_VB;
DI void ph_attn(const P& p, char* lds) {
  const int tid = otid(), lane = tid & 63, wave = tid >> 6, wq = wave & 3, m = wave >> 2, h = lane >> 5, cl = lane & 31;
  const bf16_t* Qb = (const bf16_t*)(p.ws + WS_Q); const bf16_t* Kb = (const bf16_t*)(p.ws + WS_K); const bf16_t* VT = (const bf16_t*)(p.ws + WS_VT);
  bf16_t* mix = (bf16_t*)(p.ws + WS_MIX);
  for (int it = blockIdx.x; it < NB * 4 * 64; it += gridDim.x) {
    const int qb = it & 63, head = (it >> 6) & 3, b = it >> 8;
    const int qrow = b * SEQ + qb * 128 + wq * 32 + cl;
    bf16x8 qf[4];
#pragma unroll
    for (int kk = 0; kk < 4; ++kk) qf[kk] = *(const bf16x8*)(Qb + (size_t)qrow * 512 + (head * 2 + m) * 64 + kk * 16 + h * 8);
    f32x16 o[4];
#pragma unroll
    for (int i = 0; i < 4; ++i)
#pragma unroll
      for (int r = 0; r < 16; ++r) o[i][r] = 0.f;
    float mrun = -1e30f, lrun = 0.f;
    const bf16_t* kp0 = Kb + ((size_t)b * KVL + (tid >> 4)) * 512 + head * 128 + (tid & 15) * 8;
    const bf16_t* kp1 = kp0 + (size_t)32 * 512;
    const bf16_t* vp0 = VT + ((size_t)((b * 4 + head) * 128 + (tid >> 3))) * KVL + (tid & 7) * 8;
    const bf16_t* vp1 = vp0 + (size_t)64 * KVL;
    const int kw0 = ((((tid & 15) >> 3) * 64 + (tid >> 4)) * AT_KROW + ((tid & 15) & 7) * 8) * 2, kw1 = kw0 + 32 * AT_KROW * 2;
    const int vw0 = AT_KB + ((tid >> 3) * AT_VROW + (tid & 7) * 8) * 2, vw1 = vw0 + 64 * AT_VROW * 2;
    u32x4 rk0, rk1, rv0, rv1;
#define A_GLOAD(kv0) do { rk0 = *(const u32x4*)(kp0 + (size_t)(kv0) * 512); rk1 = *(const u32x4*)(kp1 + (size_t)(kv0) * 512); rv0 = *(const u32x4*)(vp0 + (kv0)); rv1 = *(const u32x4*)(vp1 + (kv0)); } while (0)
#define A_LWRITE(st) do { char* b_ = lds + (st) * AT_STAGE; *(u32x4*)(b_ + kw0) = rk0; *(u32x4*)(b_ + kw1) = rk1; \
      u32x2 t_; t_[0] = rv0[0]; t_[1] = rv0[1]; *(u32x2*)(b_ + vw0) = t_; t_[0] = rv0[2]; t_[1] = rv0[3]; *(u32x2*)(b_ + vw0 + 8) = t_; \
      t_[0] = rv1[0]; t_[1] = rv1[1]; *(u32x2*)(b_ + vw1) = t_; t_[0] = rv1[2]; t_[1] = rv1[3]; *(u32x2*)(b_ + vw1 + 8) = t_; } while (0)
    A_GLOAD(0);
    __syncthreads();
    A_LWRITE(0);
    __syncthreads();
    constexpr int NKT = KVL / 64;
    for (int kt = 0; kt < NKT; ++kt) {
      if (kt + 1 < NKT) A_GLOAD((kt + 1) * 64);
      const char* sb = lds + (kt & 1) * AT_STAGE;
      const char* ks = sb + (m * 64 * AT_KROW) * 2;
      f32x16 st[2];
#pragma unroll
      for (int k2 = 0; k2 < 2; ++k2) {
#pragma unroll
        for (int r = 0; r < 16; ++r) st[k2][r] = 0.f;
#pragma unroll
        for (int kk = 0; kk < 4; ++kk) {
          const bf16x8 a = *(const bf16x8*)(ks + ((k2 * 32 + cl) * AT_KROW + kk * 16 + h * 8) * 2);
          st[k2] = MFMA32(a, qf[kk], st[k2]);
        }
      }
      float mx = fmaxf(st[0][0], st[1][0]);
#pragma unroll
      for (int r = 1; r < 16; ++r) mx = fmaxf(mx, fmaxf(st[0][r], st[1][r]));
      mx = fmaxf(mx, __shfl_xor(mx, 32, 64));
      if (__any(mx > mrun + 8.f)) {
        const float mnew = fmaxf(mrun, mx);
        const float alpha = __builtin_amdgcn_exp2f(mrun - mnew);
        mrun = mnew; lrun *= alpha;
#pragma unroll
        for (int i = 0; i < 4; ++i)
#pragma unroll
          for (int r = 0; r < 16; ++r) o[i][r] *= alpha;
      }
      float rs = 0.f;
#pragma unroll
      for (int k2 = 0; k2 < 2; ++k2)
#pragma unroll
        for (int r = 0; r < 16; ++r) { const float pv = __builtin_amdgcn_exp2f(st[k2][r] - mrun); st[k2][r] = pv; rs += pv; }
      lrun += rs;
      const char* vsb = sb + AT_KB;
#pragma unroll
      for (int k2 = 0; k2 < 2; ++k2)
#pragma unroll
        for (int s = 0; s < 2; ++s) {
          u32x4 pb;
          pb[0] = cvtpk(st[k2][8 * s + 0], st[k2][8 * s + 1]); pb[1] = cvtpk(st[k2][8 * s + 2], st[k2][8 * s + 3]);
          pb[2] = cvtpk(st[k2][8 * s + 4], st[k2][8 * s + 5]); pb[3] = cvtpk(st[k2][8 * s + 6], st[k2][8 * s + 7]);
          const bf16x8 pfrag = __builtin_bit_cast(bf16x8, pb);
#pragma unroll
          for (int dt = 0; dt < 4; ++dt) {
            const char* vr = vsb + ((dt * 32 + cl) * AT_VROW + k2 * 32 + 16 * s + 4 * h) * 2;
            const u32x2 lo = *(const u32x2*)(vr), hi = *(const u32x2*)(vr + 16);
            u32x4 av; av[0] = lo[0]; av[1] = lo[1]; av[2] = hi[0]; av[3] = hi[1];
            o[dt] = MFMA32(__builtin_bit_cast(bf16x8, av), pfrag, o[dt]);
          }
        }
      if (kt + 1 < NKT) A_LWRITE((kt + 1) & 1);
      __syncthreads();
    }
#undef A_GLOAD
#undef A_LWRITE
    const float ltot = lrun + __shfl_xor(lrun, 32, 64);
    const float inv = 1.f / ltot;
    float* X = (float*)lds;
    if (m == 1) {
#pragma unroll
      for (int dt = 0; dt < 4; ++dt)
#pragma unroll
        for (int r = 0; r < 16; ++r) X[(wq * 32 + cl) * 129 + dt * 32 + crow(r, h)] = o[dt][r] * inv;
    }
    __syncthreads();
    if (m == 0) {
      float l1 = 0.f, l2 = 0.f;
      for (int i = 0; i < 64; ++i) { l1 += p.lam_q1[i] * p.lam_k1[i]; l2 += p.lam_q2[i] * p.lam_k2[i]; }
      const float lam = __expf(l1) - __expf(l2) + 0.2f;
      float ss = 0.f;
#pragma unroll
      for (int dt = 0; dt < 4; ++dt)
#pragma unroll
        for (int r = 0; r < 16; ++r) { const float dv = o[dt][r] * inv - lam * X[(wq * 32 + cl) * 129 + dt * 32 + crow(r, h)]; o[dt][r] = dv; ss += dv * dv; }
      ss += __shfl_xor(ss, 32, 64);
      const float rn = rsqrtf(ss * (1.f / 128.f) + EPS) * 0.8f;
#pragma unroll
      for (int dt = 0; dt < 4; ++dt)
#pragma unroll
        for (int g = 0; g < 4; ++g) {
          const int dv = dt * 32 + 8 * g + 4 * h;
          const f32x4 w4 = *(const f32x4*)(p.subln_w + dv);
          u32x2 v; v[0] = pk2(o[dt][4 * g] * rn * w4[0], o[dt][4 * g + 1] * rn * w4[1]); v[1] = pk2(o[dt][4 * g + 2] * rn * w4[2], o[dt][4 * g + 3] * rn * w4[3]);
          *(u32x2*)(mix + (size_t)qrow * DM + 512 + head * 128 + dv) = v;
        }
    }
    __syncthreads();
  }
}

DI void ph_mixout(const P& p) {
  const int lane = otid() & 63, gw = blockIdx.x * (NT / 64) + (otid() >> 6), nw_ = gridDim.x * (NT / 64);
  const bf16_t* Ob = (const bf16_t*)(p.ws + WS_OBUF); const bf16_t* gate = (const bf16_t*)(p.ws + WS_GATE);
  bf16_t* mix = (bf16_t*)(p.ws + WS_MIX);
  for (int row = gw; row < TL; row += nw_) {
    const u32x4 a = *(const u32x4*)(Ob + (size_t)row * 512 + lane * 8), bq = *(const u32x4*)(Ob + ((size_t)TL + row) * 512 + lane * 8);
    const u32x4 gv = *(const u32x4*)(gate + (size_t)row * 512 + lane * 8);
    float v[8]; float ss = 0.f;
#pragma unroll
    for (int i = 0; i < 4; ++i) { v[2 * i] = bflo(a[i]) + bflo(bq[i]); v[2 * i + 1] = bfhi(a[i]) + bfhi(bq[i]); ss += v[2 * i] * v[2 * i] + v[2 * i + 1] * v[2 * i + 1]; }
    ss += __shfl_xor(ss, 1, 64); ss += __shfl_xor(ss, 2, 64); ss += __shfl_xor(ss, 4, 64);
    const float rn = rsqrtf(ss * (1.f / 64.f) + EPS);
    const int c0 = (lane & 7) * 8;
    u32x4 ov;
#pragma unroll
    for (int i = 0; i < 4; ++i) ov[i] = pk2(v[2 * i] * rn * p.gdn_norm_w[c0 + 2 * i] * bflo(gv[i]), v[2 * i + 1] * rn * p.gdn_norm_w[c0 + 2 * i + 1] * bfhi(gv[i]));
    *(u32x4*)(mix + (size_t)row * DM + lane * 8) = ov;
  }
}

struct EpiResid {
  const float* xin; float* xout; const float* gmod  ; int row0, col0;
  DI void operator()(f32x16 (&acc)[2][2], int wm, int wn, int lane) const {
    const int h = lane >> 5, cl = lane & 31;
#pragma unroll
    for (int mt = 0; mt < 2; ++mt) {
      const int row = row0 + wm * 64 + mt * 32 + cl;
      const float* gm = gmod + (size_t)(row >> 13) * 6144;
#pragma unroll
      for (int nt = 0; nt < 2; ++nt)
#pragma unroll
        for (int g = 0; g < 4; ++g) {
          const int col = col0 + wn * 64 + nt * 32 + 8 * g + 4 * h;
          const f32x4 xv = *(const f32x4*)(xin + (size_t)row * DM + col), g4 = *(const f32x4*)(gm + col);
          f32x4 ov;
#pragma unroll
          for (int r = 0; r < 4; ++r) ov[r] = xv[r] + g4[r] * acc[mt][nt][4 * g + r];
          *(f32x4*)(xout + (size_t)row * DM + col) = ov;
        }
    }
  }
};
DI void ph_gemm_resid(const P& p, char* lds, const bf16_t* A, const bf16_t* Bt, const float* xin, const float* gmod) {
  const int nM = TL / GBM, nN = DM / GBN;
  for (int t = blockIdx.x; t < nM * nN; t += gridDim.x) {
    const int pm = t / nN, pn = t % nN;
    RowLin rf{A + (size_t)pm * GBM * DM, (size_t)DM};
    EpiResid ep{xin, p.out, gmod, pm * GBM, pn * GBN};
    gemm_tile<true>(lds, rf, Bt + (size_t)pn * GBN * DM, DM, ep);
  }
}

struct EpiBf16 {
  bf16_t* o; int pitch, row0, col0;
  DI void operator()(f32x16 (&acc)[2][2], int wm, int wn, int lane) const {
    const int h = lane >> 5, cl = lane & 31;
#pragma unroll
    for (int mt = 0; mt < 2; ++mt) {
      const int row = row0 + wm * 64 + mt * 32 + cl;
#pragma unroll
      for (int nt = 0; nt < 2; ++nt)
#pragma unroll
        for (int g = 0; g < 4; ++g) {
          u32x2 v; v[0] = pk2(acc[mt][nt][4 * g], acc[mt][nt][4 * g + 1]); v[1] = pk2(acc[mt][nt][4 * g + 2], acc[mt][nt][4 * g + 3]);
          *(u32x2*)(o + (size_t)row * pitch + col0 + wn * 64 + nt * 32 + 8 * g + 4 * h) = v;
        }
    }
  }
};
DI void ph_gemm_scores(const P& p, char* lds, int layer, size_t sc_off) {
  const bf16_t* A = (const bf16_t*)(p.ws + R0); const bf16_t* Bt = (const bf16_t*)(p.ws + WS_WEFF) + (size_t)layer * 2048 * 1024;
  const int nM = TL / GBM, nN = 2048 / GBN;
  for (int t = blockIdx.x; t < nM * nN; t += gridDim.x) {
    const int pm = t / nN, pn = t % nN;
    RowLin rf{A + (size_t)pm * GBM * DM, (size_t)DM};
    EpiBf16 ep{(bf16_t*)(p.ws + sc_off), 2048, pm * GBM, pn * GBN};
    gemm_tile<true>(lds, rf, Bt + (size_t)pn * GBN * DM, DM, ep);
  }
}

constexpr size_t WS_TSC = WS_BA;
DI void ph_tables(const P& p) {
  const int lane = otid() & 63, gw = blockIdx.x * (NT / 64) + (otid() >> 6), nw_ = gridDim.x * (NT / 64);
  float* tsc = (float*)(p.ws + WS_TSC);
  for (int rr = gw; rr < 4 * 16384; rr += nw_) {
    const int tb = rr >> 14, e = rr & 16383;
    const float* src = ((tb & 1) ? p.peer_v : p.peer_u) + ((size_t)(tb >> 1) * 16384 + e) * 1024 + lane * 16;
    f32x4 v[4]; float ss = 0.f;
#pragma unroll
    for (int i = 0; i < 4; ++i) { v[i] = *(const f32x4*)(src + 4 * i); ss += v[i][0] * v[i][0] + v[i][1] * v[i][1] + v[i][2] * v[i][2] + v[i][3] * v[i][3]; }
    ss = wave_sum(ss);
    const bool isu = (tb & 1) == 0;
    const float sc = (isu ? 0.35f : 0.5f) * sqrtf(ss * (1.f / 1024.f)) + 1e-30f, inv = 1.f / sc;
    unsigned w0 = 0u, w1 = 0u;
    if (isu) {
#pragma unroll
      for (int i = 0; i < 2; ++i)
#pragma unroll
        for (int j = 0; j < 4; ++j) {
          const int qa = (int)fminf(fmaxf(rintf(v[i][j] * inv), -7.f), 7.f), qb = (int)fminf(fmaxf(rintf(v[2 + i][j] * inv), -7.f), 7.f);
          w0 |= ((unsigned)qa & 15u) << (4 * (4 * i + j)); w1 |= ((unsigned)qb & 15u) << (4 * (4 * i + j));
        }
    } else {
      w0 = __builtin_amdgcn_cvt_scalef32_pk_fp4_f32(w0, v[0][0] * inv, v[0][1] * inv, 1.0f, 0);
      w0 = __builtin_amdgcn_cvt_scalef32_pk_fp4_f32(w0, v[0][2] * inv, v[0][3] * inv, 1.0f, 1);
      w0 = __builtin_amdgcn_cvt_scalef32_pk_fp4_f32(w0, v[1][0] * inv, v[1][1] * inv, 1.0f, 2);
      w0 = __builtin_amdgcn_cvt_scalef32_pk_fp4_f32(w0, v[1][2] * inv, v[1][3] * inv, 1.0f, 3);
      w1 = __builtin_amdgcn_cvt_scalef32_pk_fp4_f32(w1, v[2][0] * inv, v[2][1] * inv, 1.0f, 0);
      w1 = __builtin_amdgcn_cvt_scalef32_pk_fp4_f32(w1, v[2][2] * inv, v[2][3] * inv, 1.0f, 1);
      w1 = __builtin_amdgcn_cvt_scalef32_pk_fp4_f32(w1, v[3][0] * inv, v[3][1] * inv, 1.0f, 2);
      w1 = __builtin_amdgcn_cvt_scalef32_pk_fp4_f32(w1, v[3][2] * inv, v[3][3] * inv, 1.0f, 3);
    }
    u32x2 o; o[0] = w0; o[1] = w1;
    unsigned char* dst = (unsigned char*)(p.ws + WS_TAB + (size_t)tb * 8 * MiB);
    *(u32x2*)(dst + ((((size_t)(lane >> 4)) * 16384 + e) << 7) + (lane & 15) * 8) = o;
    if (lane == 0) tsc[tb * 16384 + e] = sc;
  }
}

DI unsigned srt16(unsigned bf) { return (bf & 0x8000u) ? (~bf & 0xFFFFu) : (bf | 0x8000u); }
DI float unsrt16(unsigned s) { const unsigned bf = (s & 0x8000u) ? (s & 0x7FFFu) : (~s & 0xFFFFu); return __uint_as_float(bf << 16); }
DI unsigned ckey(float v, unsigned cid) { unsigned u = __float_as_uint(v); u = (u & 0x80000000u) ? ~u : (u | 0x80000000u); return (u & 0xFFFFFF00u) | (255u - cid); }
DI float unckey(unsigned k) { unsigned u = k & 0xFFFFFF00u; u = (u & 0x80000000u) ? (u & 0x7FFFFFFFu) : ~u; return __uint_as_float(u & 0xFFFFFF00u); }
DI void bsort16(unsigned (&k)[16]) {
#pragma unroll
  for (int sz = 2; sz <= 16; sz <<= 1)
#pragma unroll
    for (int j = sz >> 1; j > 0; j >>= 1)
#pragma unroll
      for (int i = 0; i < 16; ++i) {
        const int l = i ^ j;
        if (l > i) {
          const unsigned a = k[i], b = k[l], mx = a > b ? a : b, mn = a > b ? b : a;
          if ((i & sz) == 0) { k[i] = mx; k[l] = mn; } else { k[i] = mn; k[l] = mx; }
        }
      }
}
DI void bmerge16(unsigned (&k)[16]) {
#pragma unroll
  for (int j = 8; j > 0; j >>= 1)
#pragma unroll
    for (int i = 0; i < 16; ++i) {
      const int l = i ^ j;
      if (l > i) { const unsigned a = k[i], b = k[l]; k[i] = a > b ? a : b; k[l] = a > b ? b : a; }
    }
}
DI void topmerge16(unsigned (&run)[16], const unsigned (&g)[16]) {
#pragma unroll
  for (int i = 0; i < 16; ++i) run[i] = run[i] > g[15 - i] ? run[i] : g[15 - i];
  bmerge16(run);
}
DI void top16_of_128(const bf16_t* __restrict__ r, unsigned (&run)[16]) {
#pragma unroll 1
  for (int g = 0; g < 8; ++g) {
    const u32x4 v0 = *(const u32x4*)(r + g * 16), v1 = *(const u32x4*)(r + g * 16 + 8);
    unsigned k[16];
#pragma unroll
    for (int q = 0; q < 4; ++q) {
      k[2 * q] = (srt16(v0[q] & 0xFFFFu) << 16) | (127u - (g * 16 + 2 * q));
      k[2 * q + 1] = (srt16(v0[q] >> 16) << 16) | (127u - (g * 16 + 2 * q + 1));
      k[8 + 2 * q] = (srt16(v1[q] & 0xFFFFu) << 16) | (127u - (g * 16 + 8 + 2 * q));
      k[8 + 2 * q + 1] = (srt16(v1[q] >> 16) << 16) | (127u - (g * 16 + 8 + 2 * q + 1));
    }
    bsort16(k);
    if (g == 0) {
#pragma unroll
      for (int i = 0; i < 16; ++i) run[i] = k[i];
    } else topmerge16(run, k);
  }
}
DI void ph_topk(const P& p, char* lds, size_t sc_off, size_t ei_off, size_t eg_off) {
  const bf16_t* sc = (const bf16_t*)(p.ws + sc_off); int* EI = (int*)(p.ws + ei_off); float* EG = (float*)(p.ws + eg_off);
  unsigned char* sI = (unsigned char*)lds;
  const int tid = otid();
  const int tpb_ = TL / gridDim.x;
  for (int g = blockIdx.x * tpb_ * 8 + tid; g < (blockIdx.x + 1) * tpb_ * 8; g += NT) {
    const int t = g >> 3, head = g & 7;
    const bf16_t* r1 = sc + (size_t)t * 2048 + head * 256;
    unsigned k1[16], k2[16];
    top16_of_128(r1, k1);
    top16_of_128(r1 + 128, k2);
    float f1[16], f2[16];
#pragma unroll
    for (int i = 0; i < 16; ++i) { f1[i] = unsrt16(k1[i] >> 16); f2[i] = unsrt16(k2[i] >> 16); sI[i * NT + tid] = (unsigned char)(127u - (k1[i] & 127u)); sI[(16 + i) * NT + tid] = (unsigned char)(127u - (k2[i] & 127u)); }
    unsigned cg0[16], cg1[16], cg2[16], cg3[16];
#pragma unroll
    for (int i = 0; i < 16; ++i) { cg3[i] = 0u; }
    cg0[0] = ckey(f1[0] + f2[0], 0);
    cg0[1] = ckey(f1[0] + f2[1], 1);
    cg0[2] = ckey(f1[0] + f2[2], 2);
    cg0[3] = ckey(f1[0] + f2[3], 3);
    cg0[4] = ckey(f1[0] + f2[4], 4);
    cg0[5] = ckey(f1[0] + f2[5], 5);
    cg0[6] = ckey(f1[0] + f2[6], 6);
    cg0[7] = ckey(f1[0] + f2[7], 7);
    cg0[8] = ckey(f1[0] + f2[8], 8);
    cg0[9] = ckey(f1[0] + f2[9], 9);
    cg0[10] = ckey(f1[0] + f2[10], 10);
    cg0[11] = ckey(f1[0] + f2[11], 11);
    cg0[12] = ckey(f1[0] + f2[12], 12);
    cg0[13] = ckey(f1[0] + f2[13], 13);
    cg0[14] = ckey(f1[0] + f2[14], 14);
    cg0[15] = ckey(f1[0] + f2[15], 15);
    cg1[0] = ckey(f1[1] + f2[0], 16);
    cg1[1] = ckey(f1[1] + f2[1], 17);
    cg1[2] = ckey(f1[1] + f2[2], 18);
    cg1[3] = ckey(f1[1] + f2[3], 19);
    cg1[4] = ckey(f1[1] + f2[4], 20);
    cg1[5] = ckey(f1[1] + f2[5], 21);
    cg1[6] = ckey(f1[1] + f2[6], 22);
    cg1[7] = ckey(f1[1] + f2[7], 23);
    cg1[8] = ckey(f1[2] + f2[0], 32);
    cg1[9] = ckey(f1[2] + f2[1], 33);
    cg1[10] = ckey(f1[2] + f2[2], 34);
    cg1[11] = ckey(f1[2] + f2[3], 35);
    cg1[12] = ckey(f1[2] + f2[4], 36);
    cg1[13] = ckey(f1[3] + f2[0], 48);
    cg1[14] = ckey(f1[3] + f2[1], 49);
    cg1[15] = ckey(f1[3] + f2[2], 50);
    cg2[0] = ckey(f1[3] + f2[3], 51);
    cg2[1] = ckey(f1[4] + f2[0], 64);
    cg2[2] = ckey(f1[4] + f2[1], 65);
    cg2[3] = ckey(f1[4] + f2[2], 66);
    cg2[4] = ckey(f1[5] + f2[0], 80);
    cg2[5] = ckey(f1[5] + f2[1], 81);
    cg2[6] = ckey(f1[6] + f2[0], 96);
    cg2[7] = ckey(f1[6] + f2[1], 97);
    cg2[8] = ckey(f1[7] + f2[0], 112);
    cg2[9] = ckey(f1[7] + f2[1], 113);
    cg2[10] = ckey(f1[8] + f2[0], 128);
    cg2[11] = ckey(f1[9] + f2[0], 144);
    cg2[12] = ckey(f1[10] + f2[0], 160);
    cg2[13] = ckey(f1[11] + f2[0], 176);
    cg2[14] = ckey(f1[12] + f2[0], 192);
    cg2[15] = ckey(f1[13] + f2[0], 208);
    cg3[0] = ckey(f1[14] + f2[0], 224);
    cg3[1] = ckey(f1[15] + f2[0], 240);
    bsort16(cg0); bsort16(cg1); bsort16(cg2); bsort16(cg3);
    topmerge16(cg0, cg1); topmerge16(cg2, cg3); topmerge16(cg0, cg2);
    float e[16]; int id[16]; float sum = 0.f; const float s0 = unckey(cg0[0]);
#pragma unroll
    for (int k = 0; k < 16; ++k) {
      const unsigned cid = 255u - (cg0[k] & 255u);
      e[k] = __expf(unckey(cg0[k]) - s0); sum += e[k];
      id[k] = (int)sI[(cid >> 4) * NT + tid] * 128 + (int)sI[(16 + (cid & 15)) * NT + tid];
    }
    const float inv = 1.f / sum;
#pragma unroll
    for (int k = 0; k < 16; k += 4) {
      int4 iv = {id[k], id[k + 1], id[k + 2], id[k + 3]}; f32x4 gv = {e[k] * inv, e[k + 1] * inv, e[k + 2] * inv, e[k + 3] * inv};
      *(int4*)(EI + (size_t)g * 16 + k) = iv; *(f32x4*)(EG + (size_t)g * 16 + k) = gv;
    }
  }
}

DI void fp8x16_to_f32(const u32x4& w, float (&f)[16]) {
#pragma unroll
  for (int i = 0; i < 4; ++i) {
    const f32x2_t lo = __builtin_amdgcn_cvt_pk_f32_fp8((int)w[i], false), hi = __builtin_amdgcn_cvt_pk_f32_fp8((int)w[i], true);
    f[4 * i] = lo[0]; f[4 * i + 1] = lo[1]; f[4 * i + 2] = hi[0]; f[4 * i + 3] = hi[1];
  }
}
DI void block_handoff() {
  asm volatile("s_waitcnt vmcnt(0)" ::: "memory");
  __syncthreads();
  if (otid() == 0) { __builtin_amdgcn_fence(__ATOMIC_ACQUIRE, "agent"); asm volatile("s_waitcnt vmcnt(0)" ::: "memory"); }
  __syncthreads();
}
constexpr int PQ_NS = 4;
#define PQ_BEGIN() \
  const int tid = otid(), lane = tid & 63, wave = tid >> 6, g8 = lane >> 3, c16 = lane & 7; \
  const int tpb_ = TL / gridDim.x; \
  _Pragma("unroll 1") for (int x = 0; x < PQ_NS; ++x) { \
    const int tbeg = blockIdx.x * tpb_ + wave, tend = (blockIdx.x + 1) * tpb_;
#define PQ_END() }
#define FP4X8(wd, o0, o1, o2, o3) do { o0 = __builtin_amdgcn_cvt_scalef32_pk_f32_fp4((wd), 1.0f, 0); o1 = __builtin_amdgcn_cvt_scalef32_pk_f32_fp4((wd), 1.0f, 1); \
                                         o2 = __builtin_amdgcn_cvt_scalef32_pk_f32_fp4((wd), 1.0f, 2); o3 = __builtin_amdgcn_cvt_scalef32_pk_f32_fp4((wd), 1.0f, 3); } while (0)
DI void ph_peer_u(const P& p, char* lds, int layer, size_t ei_off, size_t part_off) {
  for (int rep = 0; rep <= p.lo; ++rep) {
  PQ_BEGIN()
  const unsigned char* hq = (const unsigned char*)(p.ws + WS_HQ) + x * 128 + c16 * 16;
  const float* hs = (const float*)(p.ws + WS_HS);
  const unsigned char* us = (const unsigned char*)(p.ws + WS_TAB + (size_t)(layer * 2) * 8 * MiB) + ((size_t)x * 16384 << 7) + c16 * 16;
  const int* EI = (const int*)(p.ws + ei_off) + g8 * 16;
  unsigned* part = (unsigned*)(p.ws + part_off);
  int4 nid[4]; u32x4 nhh, nhl; float nsc;
#define PU_PREF(tt) do { const int t_ = (tt) < tend ? (tt) : tend - 1; \
    _Pragma("unroll") for (int i = 0; i < 4; ++i) nid[i] = *(const int4*)(EI + (size_t)t_ * 128 + i * 4); \
    nhh = *(const u32x4*)(hq + (size_t)t_ * 1024); nhl = *(const u32x4*)(hq + (size_t)t_ * 1024 + 512); nsc = hs[t_]; } while (0)
  PU_PREF(tbeg);
#pragma unroll 1
  for (int t = tbeg; t < tend; t += NT / 64) {
    int id[16];
#pragma unroll
    for (int i = 0; i < 4; ++i) { id[4 * i] = nid[i].x; id[4 * i + 1] = nid[i].y; id[4 * i + 2] = nid[i].z; id[4 * i + 3] = nid[i].w; }
    const u32x4 hh = nhh, hl = nhl; const float sct = nsc;
    u32x4 ur[16];
#pragma unroll
    for (int i = 0; i < 16; ++i) ur[i] = *(const u32x4*)(us + ((size_t)id[i] << 7));
    float pd[16];
#pragma unroll
    for (int i = 0; i < 16; ++i) {
      int ah = 0, al = 0;
#pragma unroll
      for (int w = 0; w < 4; ++w) { ah = __builtin_amdgcn_sdot8((int)ur[i][w], (int)hh[w], ah, false); al = __builtin_amdgcn_sdot8((int)ur[i][w], (int)hl[w], al, false); }
      pd[i] = (float)(16 * ah + al);
    }
    PU_PREF(t + NT / 64);
    float q8[8], q4[4], q2[2];
    { const bool up = (lane & 4) != 0;
#pragma unroll
      for (int m = 0; m < 8; ++m) { const float keep = up ? pd[8 + m] : pd[m], send = up ? pd[m] : pd[8 + m]; q8[m] = keep + __shfl_xor(send, 4, 64); } }
    { const bool up = (lane & 2) != 0;
#pragma unroll
      for (int m = 0; m < 4; ++m) { const float keep = up ? q8[4 + m] : q8[m], send = up ? q8[m] : q8[4 + m]; q4[m] = keep + __shfl_xor(send, 2, 64); } }
    { const bool up = (lane & 1) != 0;
#pragma unroll
      for (int m = 0; m < 2; ++m) { const float keep = up ? q4[2 + m] : q4[m], send = up ? q4[m] : q4[2 + m]; q2[m] = keep + __shfl_xor(send, 1, 64); } }
    part[((size_t)t * PQ_NS + x) * 64 + lane] = pk2(q2[0] * sct, q2[1] * sct);
  }
  PQ_END()
  }
#undef PU_PREF
}
DI void ph_peer_comb(const P& p, int layer, size_t part_off, size_t ei_off, size_t eg_off, size_t w_off) {
  const unsigned* part = (const unsigned*)(p.ws + part_off); const float* EG = (const float*)(p.ws + eg_off); const int* EI = (const int*)(p.ws + ei_off); float* W = (float*)(p.ws + w_off);
  const float* su = (const float*)(p.ws + WS_TSC) + (size_t)(layer * 2) * 16384; const float* sv = su + 16384;
  const int tpbc_ = TL / gridDim.x;
  for (int g = blockIdx.x * tpbc_ * 64 + otid(); g < (blockIdx.x + 1) * tpbc_ * 64; g += NT) {
    const int t = g >> 6, j = g & 63;
    float d0 = 0.f, d1 = 0.f;
#pragma unroll
    for (int x = 0; x < PQ_NS; ++x) { const unsigned v = part[((size_t)t * PQ_NS + x) * 64 + j]; d0 += bflo(v); d1 += bfhi(v); }
    const f32x2_t gt = *(const f32x2_t*)(EG + (size_t)t * 128 + 2 * j);
    const int e0 = EI[(size_t)t * 128 + 2 * j], e1 = EI[(size_t)t * 128 + 2 * j + 1];
    f32x2_t o; o[0] = gelu_tanh(d0 * su[e0]) * gt[0] * sv[e0]; o[1] = gelu_tanh(d1 * su[e1]) * gt[1] * sv[e1];
    *(f32x2_t*)(W + (size_t)t * 128 + 2 * j) = o;
  }
}
DI void ph_peer_v(const P& p, char* lds, int layer, size_t ei_off, size_t w_off) {
  PQ_BEGIN()
  const unsigned char* vs = (const unsigned char*)(p.ws + WS_TAB + (size_t)(layer * 2 + 1) * 8 * MiB) + ((size_t)x * 16384 << 7) + c16 * 16;
  const int* EI = (const int*)(p.ws + ei_off) + g8 * 16; const float* W = (const float*)(p.ws + w_off) + g8 * 16;
  const float* modb = (const float*)(p.ws + WS_MOD) + (size_t)layer * 5 * 6144;
  const int col = x * 256 + 32 * (lane & 7) + 4 * (lane >> 3);
  int4 nid[4]; f32x4 nw[4];
#define PV_PREF(tt) do { const int t_ = (tt) < tend ? (tt) : tend - 1; \
    _Pragma("unroll") for (int i = 0; i < 4; ++i) { nid[i] = *(const int4*)(EI + (size_t)t_ * 128 + i * 4); nw[i] = *(const f32x4*)(W + (size_t)t_ * 128 + i * 4); } } while (0)
  PV_PREF(tbeg);
#pragma unroll 1
  for (int t = tbeg; t < tend; t += NT / 64) {
    int id[16]; float wv[16];
#pragma unroll
    for (int i = 0; i < 4; ++i) { id[4 * i] = nid[i].x; id[4 * i + 1] = nid[i].y; id[4 * i + 2] = nid[i].z; id[4 * i + 3] = nid[i].w; wv[4 * i] = nw[i][0]; wv[4 * i + 1] = nw[i][1]; wv[4 * i + 2] = nw[i][2]; wv[4 * i + 3] = nw[i][3]; }
    u32x4 vr[16];
#pragma unroll
    for (int i = 0; i < 16; ++i) vr[i] = *(const u32x4*)(vs + ((size_t)id[i] << 7));
    f32x2_t acc2[16];
#pragma unroll
    for (int j = 0; j < 16; ++j) acc2[j] = f32x2_t{0.f, 0.f};
#pragma unroll
    for (int i = 0; i < 16; ++i) {
      const f32x2_t w2 = {wv[i], wv[i]};
#pragma unroll
      for (int w = 0; w < 4; ++w) {
        f32x2_t f0, f1, f2, f3; FP4X8(vr[i][w], f0, f1, f2, f3);
        acc2[4 * w] = f0 * w2 + acc2[4 * w]; acc2[4 * w + 1] = f1 * w2 + acc2[4 * w + 1]; acc2[4 * w + 2] = f2 * w2 + acc2[4 * w + 2]; acc2[4 * w + 3] = f3 * w2 + acc2[4 * w + 3];
      }
    }
    PV_PREF(t + NT / 64);
    float acc[32];
#pragma unroll
    for (int j = 0; j < 16; ++j) { acc[2 * j] = acc2[j][0]; acc[2 * j + 1] = acc2[j][1]; }
    float q16[16], q8[8], q4[4];
    { const bool up = (lane & 32) != 0;
#pragma unroll
      for (int m = 0; m < 16; ++m) { const float keep = up ? acc[16 + m] : acc[m], send = up ? acc[m] : acc[16 + m]; q16[m] = keep + __shfl_xor(send, 32, 64); } }
    { const bool up = (lane & 16) != 0;
#pragma unroll
      for (int m = 0; m < 8; ++m) { const float keep = up ? q16[8 + m] : q16[m], send = up ? q16[m] : q16[8 + m]; q8[m] = keep + __shfl_xor(send, 16, 64); } }
    { const bool up = (lane & 8) != 0;
#pragma unroll
      for (int m = 0; m < 4; ++m) { const float keep = up ? q8[4 + m] : q8[m], send = up ? q8[m] : q8[4 + m]; q4[m] = keep + __shfl_xor(send, 8, 64); } }
    float* xr = p.out + (size_t)t * DM + col;
    const f32x4 xv = *(const f32x4*)xr, g2 = *(const f32x4*)(modb + (size_t)(t >> 13) * 6144 + 5 * 1024 + col);
    f32x4 ov;
#pragma unroll
    for (int m = 0; m < 4; ++m) ov[m] = xv[m] + g2[m] * q4[m];
    *(f32x4*)xr = ov;
  }
  PQ_END()
#undef PV_PREF
}
DI void ph_final_norm(const P& p, int r0, int r1) {
  const int lane = otid() & 63;
  for (int row = r0 + (otid() >> 6); row < r1; row += NT / 64) {
    float* xr = p.out + (size_t)row * DM;
    f32x4 xv[4]; float ss = 0.f;
#pragma unroll
    for (int i = 0; i < 4; ++i) { xv[i] = *(const f32x4*)(xr + lane * 4 + 256 * i); ss += xv[i][0] * xv[i][0] + xv[i][1] * xv[i][1] + xv[i][2] * xv[i][2] + xv[i][3] * xv[i][3]; }
    ss = wave_sum(ss);
    const float rs = rsqrtf(ss * (1.f / DM) + EPS);
#pragma unroll
    for (int i = 0; i < 4; ++i) { const f32x4 w4 = *(const f32x4*)(p.final_norm_w + lane * 4 + 256 * i); *(f32x4*)(xr + lane * 4 + 256 * i) = xv[i] * rs * w4; }
  }
}

struct RowFft0 { const bf16_t* base; DI const bf16_t* operator()(int r) const { return base + ((size_t)128 * (r & 63) + (r >> 6)) * DM; } };
struct EpiFft0 {
  bf16_t* zt; int bg, l20, col0;
  DI void operator()(f32x16 (&acc)[2][2], int wm, int wn, int lane) const {
    const int h = lane >> 5, cl = lane & 31;
#pragma unroll
    for (int mt = 0; mt < 2; ++mt)
#pragma unroll
      for (int nt = 0; nt < 2; ++nt) {
        const int n = col0 + wn * 64 + nt * 32 + cl, ri = n >> 8, mm = n & 255;
#pragma unroll
        for (int g = 0; g < 4; ++g) {
          const int r = wm * 64 + mt * 32 + 8 * g + 4 * h, l1 = r & 63, l2 = l20 + (r >> 6);
          u32x2 v; v[0] = pk2(acc[mt][nt][4 * g], acc[mt][nt][4 * g + 1]); v[1] = pk2(acc[mt][nt][4 * g + 2], acc[mt][nt][4 * g + 3]);
          *(u32x2*)(zt + (((size_t)(bg * 256 + mm) * 128 + l2) * 128 + ri * 64 + l1)) = v;
        }
      }
  }
};
DI void ph_fft0(const P& p, char* lds) {
  const bf16_t* h1 = (const bf16_t*)(p.ws + R0); const bf16_t* Bt = (const bf16_t*)(p.ws + WS_DFT0);
  for (int t = blockIdx.x; t < NB * 4 * 32 * 4; t += gridDim.x) {
    const int pn = t & 3, l2b = (t >> 2) & 31, g = (t >> 7) & 3, b = t >> 9;
    RowFft0 rf{h1 + ((size_t)b * SEQ + l2b * 4) * DM + g * 256};
    EpiFft0 ep{(bf16_t*)(p.ws + WS_ZT), b * 4 + g, l2b * 4, pn * GBN};
    gemm_tile<false>(lds, rf, Bt + (size_t)pn * GBN * 256, 256, ep);
  }
}
struct EpiFft1 {
  bf16_t* a2; int row0;
  DI void operator()(f32x16 (&acc)[2][2], int wm, int wn, int lane) const {
    const int h = lane >> 5, cl = lane & 31, k1 = 32 * wn + cl;
#pragma unroll
    for (int mt = 0; mt < 2; ++mt)
#pragma unroll
      for (int g = 0; g < 4; ++g) {
        const int R = row0 + wm * 64 + mt * 32 + 8 * g + 4 * h, l2 = R & 127, mm = (R >> 7) & 255, bg = R >> 15;
        float yr[4], yi[4];
#pragma unroll
        for (int q = 0; q < 4; ++q) {
          const float fr = (float)((l2 + q) * k1) * (1.f / 8192.f);
          const float cs = __builtin_amdgcn_cosf(fr), sn = __builtin_amdgcn_sinf(fr);
          const float ar = acc[mt][0][4 * g + q], ai = acc[mt][1][4 * g + q];
          yr[q] = ar * cs + ai * sn; yi[q] = ai * cs - ar * sn;
        }
        bf16_t* o = a2 + (((size_t)(bg * 64 + k1) * 256 + mm) * 256 + l2);
        u32x2 v; v[0] = pk2(yr[0], yr[1]); v[1] = pk2(yr[2], yr[3]); *(u32x2*)o = v;
        v[0] = pk2(yi[0], yi[1]); v[1] = pk2(yi[2], yi[3]); *(u32x2*)(o + 128) = v;
      }
  }
};
DI void ph_fft1(const P& p, char* lds) {
  const bf16_t* zt = (const bf16_t*)(p.ws + WS_ZT); const bf16_t* Bt = (const bf16_t*)(p.ws + WS_DFT1);
  const int nM = 16 * 256 * 128 / GBM;
  for (int t = blockIdx.x; t < nM; t += gridDim.x) {
    RowLin rf{zt + (size_t)t * GBM * 128, (size_t)128};
    EpiFft1 ep{(bf16_t*)(p.ws + WS_A2), t * GBM};
    gemm_tile<false>(lds, rf, Bt, 128, ep);
  }
}
struct EpiFft3 {
  bf16_t* fm; int row0;
  DI void operator()(f32x16 (&acc)[2][2], int wm, int wn, int lane) const {
    const int h = lane >> 5, cl = lane & 31;
#pragma unroll
    for (int mt = 0; mt < 2; ++mt)
#pragma unroll
      for (int nt = 0; nt < 2; ++nt) {
        const int k2 = wn * 64 + nt * 32 + cl;
#pragma unroll
        for (int g = 0; g < 4; ++g) {
          const int R = row0 + wm * 64 + mt * 32 + 8 * g + 4 * h, mm = R & 255, k1 = (R >> 8) & 63, bg = R >> 14;
          u32x2 v; v[0] = pk2(acc[mt][nt][4 * g], acc[mt][nt][4 * g + 1]); v[1] = pk2(acc[mt][nt][4 * g + 2], acc[mt][nt][4 * g + 3]);
          *(u32x2*)(fm + ((size_t)((bg >> 2) * SEQ + k1 + 64 * k2)) * DM + (bg & 3) * 256 + mm) = v;
        }
      }
  }
};
DI void ph_fft3(const P& p, char* lds) {
  const bf16_t* a2 = (const bf16_t*)(p.ws + WS_A2); const bf16_t* Bt = (const bf16_t*)(p.ws + WS_DFT3);
  const int nM = 16 * 64 * 256 / GBM;
  for (int t = blockIdx.x; t < nM; t += gridDim.x) {
    RowLin rf{a2 + (size_t)t * GBM * 256, (size_t)256};
    EpiFft3 ep{(bf16_t*)(p.ws + WS_FM), t * GBM};
    gemm_tile<false>(lds, rf, Bt, 256, ep);
  }
}

constexpr int NPHASE = 19;
template <int PH>
DI void run_phase(const P& p, char* lds) {
  const float* modL = (const float*)(p.ws + WS_MOD);
  const int tpb = TL / gridDim.x, t0 = blockIdx.x * tpb, t1 = t0 + tpb;
  if constexpr (PH == 0) ph_setup(p, lds);
  else if constexpr (PH == 1) { norm_rows(p.x, 0, TL, p.norm1_w, modL, 0, 1, false, (bf16_t*)(p.ws + R0));
                                norm_rows(p.ctx - (size_t)TL * DM, TL, TA, p.norm1_w, modL, 0, 1, true, (bf16_t*)(p.ws + R0)); }
  else if constexpr (PH == 2) { PgProj ep{&p}; pg8_run(lds, (const bf16_t*)(p.ws + R0), (const bf16_t*)(p.ws + WS_WIN), TA, NIN, DM, ep); }
  else if constexpr (PH == 3) ph_gdn_prep<0>(p, lds);
  else if constexpr (PH == 4) ph_gdn_scan<0>(p, lds);
  else if constexpr (PH == 5) { ph_attn(p, lds); ph_mixout(p); }
  else if constexpr (PH == 6) { PgResid ep{p.x, p.out, modL + 2 * 1024}; pg8_run(lds, (const bf16_t*)(p.ws + WS_MIX), (const bf16_t*)(p.ws + WS_WOUT), TL, DM, DM, ep); }
  else if constexpr (PH == 7) { norm_rows_hq(p, p.norm2_w, modL); ph_quant_weff(p); ph_tables(p); }
  else if constexpr (PH == 8) { PgScoreI8 ep{(bf16_t*)(p.ws + WS_SC0), (const float*)(p.ws + WS_HS), (const float*)(p.ws + WS_SW)}; pg8_run_i8(lds, p.ws + R0, p.ws + WS_WEFF8, TL, 2048, 1024, ep); }
  else if constexpr (PH == 9) { ph_topk(p, lds, WS_SC0, WS_EI0, WS_EG0); block_handoff(); ph_peer_u(p, lds, 0, WS_EI0, WS_PART0); }
  else if constexpr (PH == 10) { ph_peer_comb(p, 0, WS_PART0, WS_EI0, WS_EG0, WS_W0); block_handoff(); ph_peer_v(p, lds, 0, WS_EI0, WS_W0); block_handoff();
                                 norm_rows(p.out, t0, t1, p.norm1_w + DM, modL + 5 * 6144, 0, 1, false, (bf16_t*)(p.ws + R0), true); }
  else if constexpr (PH == 11) ph_fft0(p, lds);
  else if constexpr (PH == 12) ph_fft1(p, lds);
  else if constexpr (PH == 13) ph_fft3(p, lds);
  else if constexpr (PH == 14) { PgResid ep{p.out, p.out, modL + 5 * 6144 + 2 * 1024}; pg8_run(lds, (const bf16_t*)(p.ws + WS_FM), (const bf16_t*)(p.ws + WS_WF), TL, DM, DM, ep); }
  else if constexpr (PH == 15) norm_rows_hq(p, p.norm2_w + DM, modL + 5 * 6144);
  else if constexpr (PH == 16) { PgScoreI8 ep{(bf16_t*)(p.ws + WS_SC1), (const float*)(p.ws + WS_HS), (const float*)(p.ws + WS_SW) + 2048}; pg8_run_i8(lds, p.ws + R0, p.ws + WS_WEFF8 + (size_t)2048 * 1024, TL, 2048, 1024, ep); }
  else if constexpr (PH == 17) { ph_topk(p, lds, WS_SC1, WS_EI1, WS_EG1); block_handoff(); ph_peer_u(p, lds, 1, WS_EI1, WS_PART1); }
  else if constexpr (PH == 18) { ph_peer_comb(p, 1, WS_PART1, WS_EI1, WS_EG1, WS_W1); block_handoff(); ph_peer_v(p, lds, 1, WS_EI1, WS_W1); block_handoff(); ph_final_norm(p, t0, t1); }
}
#define XB_TMO      128
#define XB_XCNT(j)  (256  + 64 * (j))
#define XB_XSUB(j)  (1280 + 64 * (j))
#define XB_XGEN(j)  (2304 + 64 * (j))
#define XB_TOP      3328
#define XB_TOPGEN   3392
#define XCD_BAR_WORDS 3456
#define XB_SPIN_CAP (1u << 22)
#define LAS __attribute__((address_space(3)))
#define XB_SPIN(cond, bar) do { unsigned _sp = 0; while (cond) { __builtin_amdgcn_s_sleep(1); \
    if ((++_sp & 255u) == 0u) { if (xb_ld(&(bar)[XB_TMO])) break; if (_sp > XB_SPIN_CAP) { atomicAdd(&(bar)[XB_TMO], 1u); break; } } } } while (0)
struct XcdBarrier { unsigned* bar; unsigned x; volatile LAS unsigned* st; };
DI XcdBarrier xcd_barrier_post(unsigned* bar, volatile LAS unsigned* st) {
  XcdBarrier b; b.bar = bar; b.x = xb_xcc_id(); b.st = st;
  if (threadIdx.x == 0) (void)xb_add(&bar[XB_XCNT(b.x)], 1u);
  return b;
}
DI void xcd_barrier_complete(unsigned* bar, unsigned x, unsigned& nloc, unsigned& nx) {
  const unsigned G = gridDim.x * gridDim.y * gridDim.z;
  unsigned sum, cnt, mine, sp = 0u;
  for (;;) {
    sum = 0u; cnt = 0u; mine = 0u;
#pragma unroll
    for (unsigned j = 0; j < 16; ++j) { const unsigned c = xb_ld(&bar[XB_XCNT(j)]); sum += c; cnt += (c > 0u) ? 1u : 0u; mine = (j == x) ? c : mine; }
    if (sum == G) break;
    __builtin_amdgcn_s_sleep(1);
    if ((++sp & 255u) == 0u) { if (xb_ld(&bar[XB_TMO])) break; if (sp > XB_SPIN_CAP) { atomicAdd(&bar[XB_TMO], 1u); break; } }
  }
  nloc = mine > 0u ? mine : 1u; nx = cnt > 0u ? cnt : 1u;
}
DI void xcd_barrier(const XcdBarrier& b) {
  asm volatile("s_waitcnt vmcnt(0)" ::: "memory");
  __syncthreads();
  if (threadIdx.x == 0) {
    unsigned* bar = b.bar;
    __builtin_amdgcn_s_waitcnt(0);
    unsigned nloc = b.st[0], nx = b.st[1];
    if (nloc == 0u) { xcd_barrier_complete(bar, b.x, nloc, nx); b.st[0] = nloc; b.st[1] = nx; }
    const unsigned old = xb_add(&bar[XB_XSUB(b.x)], 1u);
    const unsigned gen = old / nloc;
    if (old + 1u == (gen + 1u) * nloc) {
      __builtin_amdgcn_fence(__ATOMIC_RELEASE, "agent");
      asm volatile("s_waitcnt vmcnt(0)" ::: "memory");
      const unsigned og = xb_add(&bar[XB_TOP], 1u);
      const unsigned tg = og / nx;
      if (og + 1u == (tg + 1u) * nx) xb_add(&bar[XB_TOPGEN], 1u);
      else XB_SPIN(xb_ld(&bar[XB_TOPGEN]) == tg, bar);
      __builtin_amdgcn_fence(__ATOMIC_ACQUIRE, "agent");
      xb_add(&bar[XB_XGEN(b.x)], 1u);
      asm volatile("s_waitcnt vmcnt(0)" ::: "memory");
    } else {
      XB_SPIN(xb_ld(&bar[XB_XGEN(b.x)]) == gen, bar);
      __builtin_amdgcn_fence(__ATOMIC_ACQUIRE, "agent");
      asm volatile("s_waitcnt vmcnt(0)" ::: "memory");
    }
  }
  __syncthreads();
}

constexpr int EXTRA_PHASE = -1;
constexpr int PROBE_MODE = 0;
template <int PH>
DI void run_all(const P& p, char* lds, const XcdBarrier& bar) {
  run_phase<PH>(p, lds);
  if constexpr (PH == EXTRA_PHASE) {
    xcd_barrier(bar);
    if constexpr (PH == 3) ph_gdn_prep<PROBE_MODE>(p, lds);
    else if constexpr (PH == 4) ph_gdn_scan<PROBE_MODE>(p, lds);
    else run_phase<PH>(p, lds);
  }
  if constexpr (PH + 1 < NPHASE) {
    if constexpr (PH == 0) { cg::this_grid().sync(); }
    else xcd_barrier(bar);
    run_all<PH + 1>(p, lds, bar);
  }
}
__global__ void __launch_bounds__(NT) mega(P p) {
  extern __shared__ __attribute__((aligned(16))) char lds[];
  volatile LAS unsigned* st = (volatile LAS unsigned*)(lds + LDS_BYTES - 16);
  if (threadIdx.x == 0) { st[0] = 0u; st[1] = 0u; }
  __syncthreads();
  XcdBarrier bar = xcd_barrier_post((unsigned*)(p.ws + WS_CTL), st);
  run_all<0>(p, lds, bar);
}

extern "C" void kernel_launch(void* const* d_in, const int* in_sizes, int n_in, void* d_out, int out_size, void* d_ws, size_t ws_size, hipStream_t stream) {
  static int grid = 0;
  if (grid == 0) {
    if (n_in != 25 || ws_size < WS_END) { fprintf(stderr, "kernel_launch: unexpected n_in %d or ws_size %zu\n", n_in, ws_size); grid = -1; return; }
    int dev = 0, cus = 0, per_cu = 0;
    (void)hipGetDevice(&dev); (void)hipDeviceGetAttribute(&cus, hipDeviceAttributeMultiprocessorCount, dev);
    (void)hipFuncSetAttribute((const void*)mega, hipFuncAttributeMaxDynamicSharedMemorySize, LDS_BYTES);
    if (hipOccupancyMaxActiveBlocksPerMultiprocessor(&per_cu, (const void*)mega, NT, LDS_BYTES) != hipSuccess || per_cu < 1) { fprintf(stderr, "kernel_launch: occupancy query failed (%d)\n", per_cu); per_cu = 1; }
    (void)hipGetLastError();
    if (per_cu > 1) per_cu = 1;
    grid = (cus > 0 ? cus : 256) * per_cu;
  }
  if (grid < 0) return;
  (void)hipMemsetAsync((char*)d_ws + WS_CTL, 0, CTL_ZERO_BYTES, stream);
  P p{};
  const float** pf = (const float**)&p;
  for (int i = 0; i < 25; ++i) pf[i] = (const float*)d_in[i];
  p.out = (float*)d_out; p.ws = (char*)d_ws; p.lo = 0; p.hi = NPHASE;
  void* args[] = {&p};
  hipError_t e = hipLaunchCooperativeKernel((const void*)mega, dim3(grid), dim3(NT), args, LDS_BYTES, stream);
  if (e != hipSuccess) fprintf(stderr, "cooperative launch failed: %s (grid %d)\n", hipGetErrorString(e), grid);
}
```

```cpp
#include <hip/hip_runtime.h>
#include <hip/hip_cooperative_groups.h>
#include <cstdio>
#include <cstdint>
namespace cg = cooperative_groups;

#define DI __device__ __forceinline__
typedef unsigned short bf16_t;
typedef short bf16x8 __attribute__((ext_vector_type(8)));
typedef short s16x4 __attribute__((ext_vector_type(4)));
typedef float f32x16 __attribute__((ext_vector_type(16)));
typedef float f32x4 __attribute__((ext_vector_type(4)));
typedef float f32x2_t __attribute__((ext_vector_type(2)));
typedef __bf16 bf16x2_t __attribute__((ext_vector_type(2)));
typedef unsigned u32x4 __attribute__((ext_vector_type(4)));
typedef unsigned u32x2 __attribute__((ext_vector_type(2)));

constexpr int NB = 4, SEQ = 8192, DM = 1024, CTXL = 256;
constexpr int TL = NB * SEQ;
constexpr int TC = NB * CTXL;
constexpr int TA = TL + TC;
constexpr int KVL = SEQ + CTXL;
constexpr int NIN = 3840;
constexpr int NCH = 132;
constexpr float EPS = 1e-6f;
constexpr int NT = 512;

constexpr size_t MiB = 1u << 20;
constexpr size_t WS_CTL = 0, WS_MOD = 64 * 1024, CTL_ZERO_BYTES = 512 * 1024;
constexpr size_t WS_ROPE = 1 * MiB, WS_WIN = 3 * MiB, WS_WOUT = 11 * MiB, WS_WF = 13 * MiB, WS_WEFF = 15 * MiB;
constexpr size_t WS_DFT0 = 23 * MiB, WS_DFT1 = 23 * MiB + 256 * 1024, WS_DFT3 = 23 * MiB + 512 * 1024;
constexpr size_t WS_BA = 24 * MiB, WS_GC = 29 * MiB;
constexpr size_t R0 = 32 * MiB, R1 = 98 * MiB, R2 = 197 * MiB, R3 = 329 * MiB, WS_END = 459 * MiB;
constexpr size_t WS_QN = R0, WS_KN = R0 + 33 * MiB;
constexpr size_t WS_QKVRAW = R1, WS_OBUF = R1;
constexpr size_t WS_UW = R2, WS_MIX = R2;
constexpr size_t WS_GATE = R3, WS_Q = R3 + 32 * MiB, WS_K = R3 + 64 * MiB, WS_VT = R3 + 97 * MiB;
constexpr size_t WS_TAB = R3 + 32 * MiB;
constexpr size_t WS_SC0 = R2, WS_EI0 = R1, WS_EG0 = R1 + 16 * MiB, WS_PART0 = 150 * MiB  , WS_W0 = R1 + 32 * MiB  ;
constexpr size_t WS_ZT = R1, WS_A2 = 226 * MiB, WS_FM = R1;
constexpr size_t WS_SC1 = 162 * MiB, WS_EI1 = 290 * MiB, WS_EG1 = 306 * MiB, WS_PART1 = 100 * MiB  , WS_W1 = 322 * MiB;

struct P {
  const float *x, *c, *ctx, *c_ctx, *ada_w, *ada_b, *norm1_w, *norm2_w, *w_in, *conv_w, *a_log, *dt_bias, *gdn_norm_w,
      *lam_q1, *lam_k1, *lam_q2, *lam_k2, *subln_w, *w_out_ab, *w_out_f, *peer_wq, *peer_keys, *peer_u, *peer_v, *final_norm_w;
  float* out; char* ws; int lo, hi;
};

DI unsigned f2bf(float f) { unsigned u = __float_as_uint(f); return (u + 0x7fffu + ((u >> 16) & 1u)) >> 16; }
DI unsigned pk2(float lo, float hi) { return f2bf(lo) | (f2bf(hi) << 16); }
DI unsigned cvtpk(float lo, float hi) { f32x2_t v = {lo, hi}; bf16x2_t b = __builtin_convertvector(v, bf16x2_t); return __builtin_bit_cast(unsigned, b); }
DI float bf2f(unsigned h) { return __uint_as_float(h << 16); }
DI float bflo(unsigned u) { return __uint_as_float(u << 16); }
DI float bfhi(unsigned u) { return __uint_as_float(u & 0xffff0000u); }
DI float wave_sum(float v) {
#pragma unroll
  for (int o = 32; o >= 1; o >>= 1) v += __shfl_xor(v, o, 64);
  return v;
}
DI int otid() { int t = threadIdx.x; asm volatile("" : "+v"(t)); return t; }
DI unsigned xb_ld(unsigned* p)              { return __hip_atomic_load(p, __ATOMIC_RELAXED, __HIP_MEMORY_SCOPE_AGENT); }
DI unsigned xb_add(unsigned* p, unsigned v) { return __hip_atomic_fetch_add(p, v, __ATOMIC_RELAXED, __HIP_MEMORY_SCOPE_AGENT); }
DI unsigned xb_xcc_id() { return (unsigned)__builtin_amdgcn_s_getreg((3 << 11) | 20) & 0xFu; }
DI float silu_f(float v) { return v / (1.f + __expf(-v)); }
DI float sigmoid_f(float v) { return 1.f / (1.f + __expf(-v)); }
DI float gelu_tanh(float v) {
  const float u = 0.7978845608028654f * (v + 0.044715f * v * v * v);
  const float e = __expf(2.f * u);
  const float t = 1.f - 2.f / (e + 1.f);
  return 0.5f * v * (1.f + t);
}
#define MFMA32(a, b, c) __builtin_amdgcn_mfma_f32_32x32x16_bf16((a), (b), (c), 0, 0, 0)

constexpr int GBM = 256, GBN = 128, GBK = 64, GLD = 72;
constexpr int G_A_BYTES = GBM * GLD * 2, G_B_BYTES = GBN * GLD * 2, G_STAGE = G_A_BYTES + G_B_BYTES;
constexpr int LDS_BYTES = 147456;

template <bool SWAP, class RowF, class Epi>
DI void gemm_tile(char* lds, const RowF& rowf, const bf16_t* __restrict__ Bt, const int K, const Epi& epi) {
  const int tid = otid(), lane = tid & 63, wave = tid >> 6, wm = wave >> 1, wn = wave & 1;
  const int lr = tid >> 3, lc = tid & 7;
  const bf16_t* ap0 = rowf(lr) + lc * 8;
  const bf16_t* ap1 = rowf(lr + 64) + lc * 8;
  const bf16_t* ap2 = rowf(lr + 128) + lc * 8;
  const bf16_t* ap3 = rowf(lr + 192) + lc * 8;
  const bf16_t* bp0 = Bt + (size_t)lr * K + lc * 8;
  const bf16_t* bp1 = Bt + (size_t)(lr + 64) * K + lc * 8;
  const int woff = (lr * GLD + lc * 8) * 2;
  u32x4 raX0, raX1, raX2, raX3, rbX0, rbX1, raY0, raY1, raY2, raY3, rbY0, rbY1;
  f32x16 acc[2][2];
#pragma unroll
  for (int i = 0; i < 2; ++i)
#pragma unroll
    for (int j = 0; j < 2; ++j)
#pragma unroll
      for (int r = 0; r < 16; ++r) acc[i][j][r] = 0.f;
  const int nk = K / GBK;
#define G_GLOAD(S, kt_) do { const int k0_ = ((kt_) < nk ? (kt_) : nk - 1) * GBK; \
    ra##S##0 = *(const u32x4*)(ap0 + k0_); ra##S##1 = *(const u32x4*)(ap1 + k0_); ra##S##2 = *(const u32x4*)(ap2 + k0_); ra##S##3 = *(const u32x4*)(ap3 + k0_); \
    rb##S##0 = *(const u32x4*)(bp0 + k0_); rb##S##1 = *(const u32x4*)(bp1 + k0_); } while (0)
#define G_LWRITE(S, st) do { char* b_ = lds + (st) * G_STAGE + woff; *(u32x4*)(b_) = ra##S##0; *(u32x4*)(b_ + 64 * GLD * 2) = ra##S##1; *(u32x4*)(b_ + 128 * GLD * 2) = ra##S##2; *(u32x4*)(b_ + 192 * GLD * 2) = ra##S##3; \
    *(u32x4*)(b_ + G_A_BYTES) = rb##S##0; *(u32x4*)(b_ + G_A_BYTES + 64 * GLD * 2) = rb##S##1; } while (0)
  const int aoff = ((wm * 64 + (lane & 31)) * GLD + (lane >> 5) * 8) * 2;
  const int boff = G_A_BYTES + ((wn * 64 + (lane & 31)) * GLD + (lane >> 5) * 8) * 2;
#define G_COMPUTE(st) do { const char* sb = lds + (st) * G_STAGE; \
    _Pragma("unroll") for (int kk = 0; kk < 4; ++kk) { \
      const bf16x8 a0 = *(const bf16x8*)(sb + aoff + kk * 32); \
      const bf16x8 a1 = *(const bf16x8*)(sb + aoff + 32 * GLD * 2 + kk * 32); \
      const bf16x8 b0 = *(const bf16x8*)(sb + boff + kk * 32); \
      const bf16x8 b1 = *(const bf16x8*)(sb + boff + 32 * GLD * 2 + kk * 32); \
      if (SWAP) { \
        acc[0][0] = MFMA32(b0, a0, acc[0][0]); acc[0][1] = MFMA32(b1, a0, acc[0][1]); \
        acc[1][0] = MFMA32(b0, a1, acc[1][0]); acc[1][1] = MFMA32(b1, a1, acc[1][1]); \
      } else { \
        acc[0][0] = MFMA32(a0, b0, acc[0][0]); acc[0][1] = MFMA32(a0, b1, acc[0][1]); \
        acc[1][0] = MFMA32(a1, b0, acc[1][0]); acc[1][1] = MFMA32(a1, b1, acc[1][1]); \
      } } } while (0)
  G_GLOAD(X, 0); G_GLOAD(Y, 1);
  __syncthreads();
  G_LWRITE(X, 0);
  __syncthreads();
#pragma unroll 1
  for (int kt = 0; kt < nk; kt += 2) {
    G_GLOAD(X, kt + 2);
    G_COMPUTE(0);
    G_LWRITE(Y, 1);
    __syncthreads();
    G_GLOAD(Y, kt + 3);
    G_COMPUTE(1);
    if (kt + 2 < nk) G_LWRITE(X, 0);
    __syncthreads();
  }
  epi(acc, wm, wn, lane);
#undef G_GLOAD
#undef G_LWRITE
#undef G_COMPUTE
}
DI int crow(int reg, int h) { return (reg & 3) + 8 * (reg >> 2) + 4 * h; }

struct RowLin { const bf16_t* base; size_t pitch; DI const bf16_t* operator()(int r) const { return base + (size_t)r * pitch; } };

namespace pg8 {
#define PG8_LAS __attribute__((address_space(3)))
typedef int v4i_t __attribute__((ext_vector_type(4)));
typedef unsigned short bf16_t;
typedef short bf16x8 __attribute__((ext_vector_type(8)));
typedef float f32x4 __attribute__((ext_vector_type(4)));
typedef unsigned u32x4 __attribute__((ext_vector_type(4)));
constexpr int BM = 256, BK = 64, HALF = 128, HTB = HALF * BK * 2  , STAGE_BYTES = 8 * HTB, NXCD = 8, WGM = 8;

__host__ __device__ __forceinline__ int lds_byte(int r, int c) { const int st = (r >> 4) * 2 + (c >> 5), rr = r & 15, cc = c & 31, ob = rr * 64 + cc * 2; return st * 1024 + (ob ^ (((ob >> 9) & 1) << 5)); }
__host__ __device__ __forceinline__ void stage_rc(int b, int& R, int& C) { const int st = b / 1024, sb = b % 1024, swz = sb ^ (((sb >> 9) & 1) << 5); R = (st >> 1) * 16 + swz / 64; C = (st & 1) * 32 + (swz % 64) / 2; }
__host__ __device__ __forceinline__ int perm32(int rho) { const int n = rho >> 4, i = rho & 15; return 8 * (i >> 2) + 4 * n + (i & 3); }

struct Unit { int pm, pn; };
struct Gemm { const bf16_t* A; const bf16_t* Bt; int M, N, K; };

struct StaticOrder {
    int nM, nN, nwg, G, c;
    __host__ __device__ void init(int M, int N, int G_, int c_) { nM = M / BM; nN = N / BM; nwg = nM * nN; G = G_; c = c_; }
    __host__ __device__ bool next(int i, Unit& u) const {
        const long L = (long)i * G + c; if (L >= nwg) return false;
        int wgid = (int)L; { const int q = nwg / NXCD, r = nwg % NXCD, xcd = wgid % NXCD, off = wgid / NXCD; wgid = (xcd < r ? xcd * (q + 1) : r * (q + 1) + (xcd - r) * q) + off; }
        const int nig = WGM * nN, gid = wgid / nig, fm = gid * WGM, gsz = (nM - fm) < WGM ? (nM - fm) : WGM;
        u.pm = fm + ((wgid % nig) % gsz); u.pn = (wgid % nig) / gsz; return true;
    }
    __device__ __forceinline__ void a_ready(const Unit&) const {}
    __device__ __forceinline__ void done(const Unit&) const {}
};
template <class Epi, class Sched, bool ALIGN_EPI = false, bool SP2 = false, bool I8 = false>
__device__ __forceinline__ void gemm_phase(PG8_LAS unsigned char* lds, const Gemm g, const Sched& S, const Epi& E) {
    const int tid = otid(), wid = __builtin_amdgcn_readfirstlane(tid >> 6), lane = tid & 63, wr = wid >> 2, wc = wid & 3, fr = lane & 15, fq = lane >> 4;
    const int K = g.K, nt = K / BK;
    unsigned voffA[2], voffB[2];
#pragma unroll
    for (int i = 0; i < 2; ++i) { int R, C; stage_rc(tid * 16 + i * 8192, R, C); const int Rb = Epi::PERM ? ((R & ~31) + perm32(R & 31)) : R;
        voffA[i] = (unsigned)(R * K + C) * 2u; voffB[i] = (unsigned)(Rb * K + C) * 2u; }
    const size_t kstep = (size_t)(BK * 2);
    const size_t hstep = (size_t)HALF * K * 2;
    const size_t tstep = 2 * hstep;
    const unsigned ldsw = (unsigned)wid * 1024u;
    const int aoff = lds_byte(wr * 64 + fr, fq * 8), boff = lds_byte(wc * 32 + fr, fq * 8);
#define PG8_SA(b, h) (((b) * 2 + (h)) * HTB)
#define PG8_SB(b, h) ((4 + (b) * 2 + (h)) * HTB)
#define PG8_STAGE(bufoff, gbase, voff) do { _Pragma("unroll") for (int _i = 0; _i < 2; ++_i) \
        __builtin_amdgcn_global_load_lds((const unsigned*)((const char*)(gbase) + (voff)[_i]), (PG8_LAS unsigned*)(lds + (bufoff) + ldsw + _i * 8192), 16, 0, 0); } while (0)
#define PG8_LDA(dst, b, h) do { _Pragma("unroll") for (int m = 0; m < 4; ++m) _Pragma("unroll") for (int k = 0; k < 2; ++k) dst[m][k] = *(const PG8_LAS bf16x8*)(lds + PG8_SA(b, h) + aoff + m * 2048 + k * 1024); } while (0)
#define PG8_LDB(dst, b, h) do { _Pragma("unroll") for (int n = 0; n < 2; ++n) _Pragma("unroll") for (int k = 0; k < 2; ++k) dst[n][k] = *(const PG8_LAS bf16x8*)(lds + PG8_SB(b, h) + boff + n * 2048 + k * 1024); } while (0)
#define PG8_MMA(ai, bj, At, Bt) do { __builtin_amdgcn_s_setprio(1); _Pragma("unroll") for (int m = 0; m < 4; ++m) _Pragma("unroll") for (int n = 0; n < 2; ++n) _Pragma("unroll") for (int k = 0; k < 2; ++k) \
        { if constexpr (I8) acc[ai][bj][m][n] = __builtin_bit_cast(f32x4, __builtin_amdgcn_mfma_i32_16x16x64_i8(__builtin_bit_cast(v4i_t, Bt[n][k]), __builtin_bit_cast(v4i_t, At[m][k]), __builtin_bit_cast(v4i_t, acc[ai][bj][m][n]), 0, 0, 0)); \
          else acc[ai][bj][m][n] = __builtin_amdgcn_mfma_f32_16x16x32_bf16(Bt[n][k], At[m][k], acc[ai][bj][m][n], 0, 0, 0); } __builtin_amdgcn_s_setprio(0); } while (0)
#define PG8_WAIT_V(n) asm volatile("s_waitcnt vmcnt(" #n ")" ::: "memory")
#define PG8_WAIT_L(n) asm volatile("s_waitcnt lgkmcnt(" #n ")" ::: "memory")
#define PG8_BAR __builtin_amdgcn_s_barrier()
#define PG8_SCHED __builtin_amdgcn_sched_barrier(0)
    Unit cur, nxt; int ui = 0;
    if (!S.next(0, cur)) return;
    f32x4 acc[2][2][4][2];
#pragma unroll
    for (int a = 0; a < 2; ++a)
#pragma unroll
        for (int b = 0; b < 2; ++b)
#pragma unroll
            for (int m = 0; m < 4; ++m)
#pragma unroll
                for (int n = 0; n < 2; ++n) acc[a][b][m][n] = (f32x4){0.f, 0.f, 0.f, 0.f};
    bf16x8 At[4][2], B0[2][2], B1[2][2];
    const char* cA = (const char*)g.A + (size_t)cur.pm * tstep; const char* cB = (const char*)g.Bt + (size_t)cur.pn * tstep;
    S.a_ready(cur);
    if constexpr (SP2) {
        PG8_STAGE(PG8_SB(0, 0), cB, voffB); PG8_STAGE(PG8_SB(0, 1), cB + hstep, voffB); PG8_STAGE(PG8_SA(0, 0), cA, voffA); PG8_STAGE(PG8_SA(0, 1), cA + hstep, voffA);
        if (wr == 1) PG8_BAR;
        PG8_WAIT_V(2); PG8_BAR;
        PG8_STAGE(PG8_SB(1, 0), cB + kstep, voffB); PG8_STAGE(PG8_SA(1, 0), cA + kstep, voffA); PG8_STAGE(PG8_SB(1, 1), cB + hstep + kstep, voffB);
        PG8_WAIT_V(6); PG8_BAR;
    } else {
        PG8_STAGE(PG8_SB(0, 0), cB, voffB); PG8_STAGE(PG8_SA(0, 0), cA, voffA); PG8_STAGE(PG8_SB(0, 1), cB + hstep, voffB); PG8_STAGE(PG8_SA(0, 1), cA + hstep, voffA);
        if (wr == 1) PG8_BAR;
        PG8_WAIT_V(4); PG8_BAR;
        PG8_STAGE(PG8_SB(1, 0), cB + kstep, voffB); PG8_STAGE(PG8_SA(1, 0), cA + kstep, voffA); PG8_STAGE(PG8_SB(1, 1), cB + hstep + kstep, voffB);
        PG8_WAIT_V(6); PG8_BAR;
    }
    for (;;) {
        const bool has_next = S.next(ui + 1, nxt);
        const char* nA = has_next ? (const char*)g.A + (size_t)nxt.pm * tstep : cA; const char* nB = has_next ? (const char*)g.Bt + (size_t)nxt.pn * tstep : cB;
        for (int t = 0; t < nt; t += 2) {
            const bool last = (t == nt - 2);
            const char* a1 = cA + (size_t)(t + 1) * kstep;
            const char* a2 = last ? nA : cA + (size_t)(t + 2) * kstep; const char* b2 = last ? nB : cB + (size_t)(t + 2) * kstep;
            const char* a3 = a2 + kstep; const char* b3 = b2 + kstep;
            if (last && has_next) S.a_ready(nxt);
            if constexpr (SP2) {
            PG8_LDB(B0, 0, 0); PG8_LDB(B1, 0, 1); PG8_SCHED; PG8_LDA(At, 0, 0); PG8_STAGE(PG8_SA(1, 1), a1 + hstep, voffA);
            PG8_WAIT_V(8); PG8_WAIT_L(0); PG8_BAR; PG8_MMA(0, 0, At, B0); PG8_MMA(0, 1, At, B1); PG8_BAR; PG8_SCHED;
            PG8_LDA(At, 0, 1); PG8_STAGE(PG8_SB(0, 0), b2, voffB); PG8_STAGE(PG8_SB(0, 1), b2 + hstep, voffB); PG8_STAGE(PG8_SA(0, 0), a2, voffA);
            PG8_WAIT_V(8); PG8_WAIT_L(0); PG8_BAR; PG8_MMA(1, 0, At, B0); PG8_MMA(1, 1, At, B1); PG8_BAR; PG8_SCHED;
            PG8_LDB(B0, 1, 0); PG8_LDB(B1, 1, 1); PG8_SCHED; PG8_LDA(At, 1, 0); PG8_STAGE(PG8_SA(0, 1), a2 + hstep, voffA);
            PG8_WAIT_V(8); PG8_WAIT_L(0); PG8_BAR; PG8_MMA(0, 0, At, B0); PG8_MMA(0, 1, At, B1); PG8_BAR; PG8_SCHED;
            PG8_LDA(At, 1, 1); PG8_STAGE(PG8_SB(1, 0), b3, voffB); PG8_STAGE(PG8_SB(1, 1), b3 + hstep, voffB); PG8_STAGE(PG8_SA(1, 0), a3, voffA);
            PG8_WAIT_V(8); PG8_WAIT_L(0); PG8_BAR; PG8_MMA(1, 0, At, B0); PG8_MMA(1, 1, At, B1); PG8_BAR; PG8_SCHED;
            } else {
            PG8_LDB(B0, 0, 0); PG8_SCHED; PG8_LDA(At, 0, 0); PG8_STAGE(PG8_SA(1, 1), a1 + hstep, voffA);
            PG8_WAIT_L(8); PG8_BAR; PG8_WAIT_L(0); PG8_MMA(0, 0, At, B0); PG8_BAR; PG8_SCHED;
            PG8_LDB(B1, 0, 1); PG8_STAGE(PG8_SB(0, 0), b2, voffB);
            PG8_BAR; PG8_WAIT_L(0); PG8_MMA(0, 1, At, B1); PG8_BAR;
            PG8_LDA(At, 0, 1); PG8_STAGE(PG8_SA(0, 0), a2, voffA);
            PG8_BAR; PG8_WAIT_L(0); PG8_MMA(1, 0, At, B0); PG8_BAR; PG8_SCHED;
            PG8_STAGE(PG8_SB(0, 1), b2 + hstep, voffB);
            PG8_WAIT_V(6); PG8_BAR; PG8_MMA(1, 1, At, B1); PG8_BAR;
            PG8_LDB(B0, 1, 0); PG8_SCHED; PG8_LDA(At, 1, 0); PG8_STAGE(PG8_SA(0, 1), a2 + hstep, voffA);
            PG8_WAIT_L(8); PG8_BAR; PG8_WAIT_L(0); PG8_MMA(0, 0, At, B0); PG8_BAR; PG8_SCHED;
            PG8_LDB(B1, 1, 1); PG8_STAGE(PG8_SB(1, 0), b3, voffB);
            PG8_BAR; PG8_WAIT_L(0); PG8_MMA(0, 1, At, B1); PG8_BAR;
            PG8_LDA(At, 1, 1); PG8_STAGE(PG8_SA(1, 0), a3, voffA);
            PG8_BAR; PG8_WAIT_L(0); PG8_MMA(1, 0, At, B0); PG8_BAR; PG8_SCHED;
            PG8_STAGE(PG8_SB(1, 1), b3 + hstep, voffB);
            PG8_WAIT_V(6); PG8_BAR; PG8_MMA(1, 1, At, B1); PG8_BAR;
            }
        }
        if constexpr (ALIGN_EPI) { if (wr == 0) PG8_BAR; }
        if constexpr (I8) { if constexpr (Epi::DEQ) { E.deq(acc, cur, wr, wc, fr, fq); __builtin_amdgcn_sched_barrier(0); } }
        if constexpr (!Epi::AFTER_DRAIN) { E(acc, cur, wr, wc, fr, fq); S.done(cur); }
        if (!has_next) break;
#pragma unroll
        for (int a = 0; a < 2; ++a)
#pragma unroll
            for (int b = 0; b < 2; ++b)
#pragma unroll
                for (int m = 0; m < 4; ++m)
#pragma unroll
                    for (int n = 0; n < 2; ++n) acc[a][b][m][n] = (f32x4){0.f, 0.f, 0.f, 0.f};
        cur = nxt; cA = nA; cB = nB; ++ui;
        if constexpr (ALIGN_EPI) { if (wr == 1) PG8_BAR; }
    }
    PG8_WAIT_V(0);
    if constexpr (!ALIGN_EPI) { if (wr == 0) PG8_BAR; }
    PG8_BAR;
    if constexpr (Epi::AFTER_DRAIN) { E.fused(acc, cur, wr, wc, fr, fq, lds, wid, lane); S.done(cur); }
#undef PG8_SA
#undef PG8_SB
#undef PG8_STAGE
#undef PG8_LDA
#undef PG8_LDB
#undef PG8_MMA
#undef PG8_WAIT_V
#undef PG8_WAIT_L
#undef PG8_BAR
#undef PG8_SCHED
}
}
DI void ph_setup(const P& p, char* lds) {
  const int tid = otid(), nb = gridDim.x, bid = blockIdx.x;
  float* modL = (float*)(p.ws + WS_MOD);
  float* sc = (float*)lds;
  for (int it = bid; it < 192; it += nb) {
    const int layer = it / 96, cb = it % 96;
    const int lane = tid & 63, ks = tid >> 6;
    __syncthreads();
    for (int i = tid; i < 5 * 1024; i += NT) { const int v = i >> 10, k = i & 1023; const float cv = (v < 4) ? p.c[v * 1024 + k] : p.c_ctx[k]; sc[i] = silu_f(cv); }
    __syncthreads();
    const int n = cb * 64 + lane;
    const float* w = p.ada_w + ((size_t)layer * 1024 + ks * 128) * 6144 + n;
    float a0 = 0, a1 = 0, a2 = 0, a3 = 0, a4 = 0;
#pragma unroll 8
    for (int k = 0; k < 128; ++k) { const float wv = w[(size_t)k * 6144]; const int kk = ks * 128 + k; a0 += wv * sc[kk]; a1 += wv * sc[1024 + kk]; a2 += wv * sc[2048 + kk]; a3 += wv * sc[3072 + kk]; a4 += wv * sc[4096 + kk]; }
    float* red = sc + 5 * 1024;
    red[(ks * 5 + 0) * 64 + lane] = a0; red[(ks * 5 + 1) * 64 + lane] = a1; red[(ks * 5 + 2) * 64 + lane] = a2; red[(ks * 5 + 3) * 64 + lane] = a3; red[(ks * 5 + 4) * 64 + lane] = a4;
    __syncthreads();
    if (tid < 320) {
      const int v = tid >> 6, l = tid & 63;
      float sacc = p.ada_b[layer * 6144 + cb * 64 + l];
      for (int k8 = 0; k8 < 8; ++k8) sacc += red[(k8 * 5 + v) * 64 + l];
      modL[(layer * 5 + v) * 6144 + cb * 64 + l] = sacc;
    }
  }
  {
    float* rope = (float*)(p.ws + WS_ROPE);
    for (int i = bid * NT + tid; i < SEQ * 32; i += nb * NT) {
      const int l = i >> 5, d = i & 31;
      const float inv = exp2f(-(float)(2 * (d & 15)) * (13.287712379549449f / 32.f));
      const float pos = (d < 16) ? (float)(l >> 6) : (float)(l & 63);
      float s, c; sincosf(pos * inv, &s, &c);
      rope[2 * i] = c; rope[2 * i + 1] = s;
    }
  }
  {
    float* tl = (float*)lds;
    const int nt_in = (NIN / 64) * 16, nt_o = 16 * 16;
    for (int it = bid; it < nt_in + 2 * nt_o; it += nb) {
      const float* src; bf16_t* dst; int npitch, nb0, kb0, which;
      if (it < nt_in) { which = 0; nb0 = (it / 16) * 64; kb0 = (it % 16) * 64; src = p.w_in; dst = (bf16_t*)(p.ws + WS_WIN); npitch = 3616; }
      else if (it < nt_in + nt_o) { const int j = it - nt_in; which = 1; nb0 = (j / 16) * 64; kb0 = (j % 16) * 64; src = p.w_out_ab; dst = (bf16_t*)(p.ws + WS_WOUT); npitch = 1024; }
      else { const int j = it - nt_in - nt_o; which = 2; nb0 = (j / 16) * 64; kb0 = (j % 16) * 64; src = p.w_out_f; dst = (bf16_t*)(p.ws + WS_WF); npitch = 1024; }
      __syncthreads();
      for (int e = tid; e < 4096; e += NT) {
        const int kk = e >> 6, nn = e & 63; const int n = nb0 + nn;
        int sn = n;
        if (which == 0) {
          if (n < 2048) sn = n;
          else if (n < 3072) { const int pq = n & 63, blk = pq >> 3, e8 = pq & 7; sn = (n & ~63) + 32 + ((e8 < 4) ? 4 * blk + e8 : 32 + 4 * blk + (e8 - 4)); }
          else if (n < 3584) sn = n + 32;
          else if (n < 3616) sn = n - 1536;
          else sn = -1;
        }
        tl[kk * 65 + nn] = (sn >= 0) ? src[(size_t)(kb0 + kk) * npitch + sn] : 0.f;
      }
      __syncthreads();
      for (int e = tid; e < 4096; e += NT) { const int nn = e >> 6, kk = e & 63; dst[(size_t)(nb0 + nn) * 1024 + kb0 + kk] = (bf16_t)f2bf(tl[kk * 65 + nn]); }
    }
  }
  {
    float* kl = (float*)lds;
    float* wl = kl + 128 * 132;
    bf16_t* weff = (bf16_t*)(p.ws + WS_WEFF);
    for (int it = bid; it < 512; it += nb) {
      const int layer = it >> 8, hp = (it >> 4) & 15, kb = it & 15;
      __syncthreads();
      const float* ks = p.peer_keys + ((size_t)(layer * 16 + hp) * 128) * 128;
      for (int e = tid; e < 128 * 128; e += NT) kl[(e >> 7) * 132 + (e & 127)] = ks[e];
      const float* ws_ = p.peer_wq + ((size_t)layer * 1024 + kb * 64) * 2048 + hp * 128;
      for (int e = tid; e < 64 * 128; e += NT) wl[(e >> 7) * 132 + (e & 127)] = ws_[(size_t)(e >> 7) * 2048 + (e & 127)];
      __syncthreads();
      const int key = tid & 127, kq = tid >> 7;
      float a[16];
#pragma unroll
      for (int i = 0; i < 16; ++i) a[i] = 0.f;
      for (int d = 0; d < 128; d += 4) {
        const f32x4 kv = *(const f32x4*)(kl + key * 132 + d);
#pragma unroll
        for (int i = 0; i < 16; ++i) { const f32x4 wv = *(const f32x4*)(wl + (kq * 16 + i) * 132 + d); a[i] += kv[0] * wv[0] + kv[1] * wv[1] + kv[2] * wv[2] + kv[3] * wv[3]; }
      }
      bf16_t* o = weff + ((size_t)layer * 2048 + hp * 128 + key) * 1024 + kb * 64 + kq * 16;
      u32x4 o0, o1;
      o0[0] = pk2(a[0], a[1]); o0[1] = pk2(a[2], a[3]); o0[2] = pk2(a[4], a[5]); o0[3] = pk2(a[6], a[7]);
      o1[0] = pk2(a[8], a[9]); o1[1] = pk2(a[10], a[11]); o1[2] = pk2(a[12], a[13]); o1[3] = pk2(a[14], a[15]);
      *(u32x4*)o = o0; *(u32x4*)(o + 8) = o1;
    }
  }
  {
    bf16_t* d0 = (bf16_t*)(p.ws + WS_DFT0); bf16_t* d1 = (bf16_t*)(p.ws + WS_DFT1); bf16_t* d3 = (bf16_t*)(p.ws + WS_DFT3);
    for (int i = bid * NT + tid; i < 512 * 256; i += nb * NT) {
      const int n = i >> 8, c = i & 255, m = n & 255; const float fr = (float)((m * c) & 255) * (2.f / 256.f);
      d0[i] = (bf16_t)f2bf(n < 256 ? cospif(fr) : -sinpif(fr));
    }
    for (int i = bid * NT + tid; i < 128 * 128; i += nb * NT) {
      const int n = i >> 7, k = i & 127; const int k1 = 32 * (n >> 6) + (n & 31), ro = (n >> 5) & 1, ri = k >> 6, l1 = k & 63;
      const float fr = (float)((k1 * l1) & 63) * (2.f / 64.f); const float cs = cospif(fr), sn = sinpif(fr);
      d1[i] = (bf16_t)f2bf(ro == 0 ? (ri == 0 ? cs : sn) : (ri == 0 ? -sn : cs));
    }
    for (int i = bid * NT + tid; i < 128 * 256; i += nb * NT) {
      const int k2 = i >> 8, k = i & 255, ri = k >> 7, l2 = k & 127; const float fr = (float)((l2 * k2) & 127) * (2.f / 128.f);
      const float scl = 6.905339660024878e-4f;
      d3[i] = (bf16_t)f2bf((ri == 0 ? cospif(fr) : sinpif(fr)) * scl);
    }
  }
}

DI void norm_rows(const float* __restrict__ src, int row_begin, int nrows, const float* __restrict__ nw, const float* __restrict__ modbase  ,
                  int shift_j, int scale_j, bool ctx_tail  , bf16_t* __restrict__ dst, bool blk = false  ) {
  const int lane = otid() & 63, gw = (blk ? 0 : blockIdx.x * (NT / 64)) + (otid() >> 6), nw_ = (blk ? 1 : gridDim.x) * (NT / 64);
  for (int row = row_begin + gw; row < nrows; row += nw_) {
    const int v = (ctx_tail && row >= TL) ? 4 : (row >> 13);
    const float* xr = src + (size_t)row * DM;
    f32x4 xv[4]; float ss = 0.f;
#pragma unroll
    for (int i = 0; i < 4; ++i) { xv[i] = *(const f32x4*)(xr + lane * 4 + 256 * i); ss += xv[i][0] * xv[i][0] + xv[i][1] * xv[i][1] + xv[i][2] * xv[i][2] + xv[i][3] * xv[i][3]; }
    ss = wave_sum(ss);
    const float rs = rsqrtf(ss * (1.f / DM) + EPS);
    const float* sh = modbase + (size_t)v * 6144 + shift_j * 1024; const float* scp = modbase + (size_t)v * 6144 + scale_j * 1024;
#pragma unroll
    for (int i = 0; i < 4; ++i) {
      const int c = lane * 4 + 256 * i;
      const f32x4 w4 = *(const f32x4*)(nw + c), s4 = *(const f32x4*)(sh + c), c4 = *(const f32x4*)(scp + c);
      float y0 = xv[i][0] * rs * w4[0] * (1.f + c4[0]) + s4[0], y1 = xv[i][1] * rs * w4[1] * (1.f + c4[1]) + s4[1];
      float y2 = xv[i][2] * rs * w4[2] * (1.f + c4[2]) + s4[2], y3 = xv[i][3] * rs * w4[3] * (1.f + c4[3]) + s4[3];
      u32x2 o; o[0] = pk2(y0, y1); o[1] = pk2(y2, y3);
      *(u32x2*)(dst + (size_t)row * DM + c) = o;
    }
  }
}

constexpr size_t WS_HQ = (size_t)393 * MiB, WS_HS = (size_t)425 * MiB;
DI void norm_rows_hq(const P& p, const float* __restrict__ nw, const float* __restrict__ modbase) {
  const int lane = otid() & 63, gw = blockIdx.x * (NT / 64) + (otid() >> 6), nw_ = gridDim.x * (NT / 64);
  bf16_t* dst = (bf16_t*)(p.ws + R0); unsigned char* hq = (unsigned char*)(p.ws + WS_HQ); float* hs = (float*)(p.ws + WS_HS);
  for (int row = gw; row < TL; row += nw_) {
    const float* xr = p.out + (size_t)row * DM + lane * 16;
    f32x4 xv[4]; float ss = 0.f;
#pragma unroll
    for (int i = 0; i < 4; ++i) { xv[i] = *(const f32x4*)(xr + 4 * i); ss += xv[i][0] * xv[i][0] + xv[i][1] * xv[i][1] + xv[i][2] * xv[i][2] + xv[i][3] * xv[i][3]; }
    ss = wave_sum(ss);
    const float rs = rsqrtf(ss * (1.f / DM) + EPS);
    const float* sh = modbase + (size_t)(row >> 13) * 6144 + 3 * 1024 + lane * 16; const float* scp = sh + 1024;
    float y[16]; float am = 0.f;
#pragma unroll
    for (int i = 0; i < 4; ++i) {
      const f32x4 w4 = *(const f32x4*)(nw + lane * 16 + 4 * i), s4 = *(const f32x4*)(sh + 4 * i), c4 = *(const f32x4*)(scp + 4 * i);
#pragma unroll
      for (int j = 0; j < 4; ++j) { y[4 * i + j] = xv[i][j] * rs * w4[j] * (1.f + c4[j]) + s4[j]; am = fmaxf(am, fabsf(y[4 * i + j])); }
    }
#pragma unroll
    for (int o = 32; o >= 1; o >>= 1) am = fmaxf(am, __shfl_xor(am, o, 64));
    const float st = am * (1.f / 119.f) + 1e-30f, ist = 1.f / st;
    unsigned h0 = 0u, h1 = 0u, l0 = 0u, l1 = 0u;
    u32x4 b8 = {0u, 0u, 0u, 0u};
#pragma unroll
    for (int j = 0; j < 8; ++j) {
      const int va = (int)fminf(fmaxf(rintf(y[j] * ist), -120.f), 119.f), vb = (int)fminf(fmaxf(rintf(y[8 + j] * ist), -120.f), 119.f);
      b8[j >> 2] |= ((unsigned)va & 255u) << (8 * (j & 3)); b8[2 + (j >> 2)] |= ((unsigned)vb & 255u) << (8 * (j & 3));
      const int ha = (va + 8) >> 4, hb = (vb + 8) >> 4, la = va - 16 * ha, lb = vb - 16 * hb;
      h0 |= ((unsigned)ha & 15u) << (4 * j); h1 |= ((unsigned)hb & 15u) << (4 * j); l0 |= ((unsigned)la & 15u) << (4 * j); l1 |= ((unsigned)lb & 15u) << (4 * j);
    }
    u32x2 vh; vh[0] = h0; vh[1] = h1; *(u32x2*)(hq + (size_t)row * 1024 + lane * 8) = vh;
    u32x2 vl; vl[0] = l0; vl[1] = l1; *(u32x2*)(hq + (size_t)row * 1024 + 512 + lane * 8) = vl;
    *(u32x4*)((unsigned char*)dst + (size_t)row * DM + lane * 16) = b8;
    if (lane == 0) hs[row] = st;
  }
}

constexpr size_t WS_WEFF8 = WS_WIN, WS_SW = WS_WIN + 5 * MiB;
constexpr size_t WS_WIN8 = R2, WS_SWIN = R2 + 4 * MiB;
constexpr size_t WS_HS0 = R2 + 5 * MiB;
DI void quant_rows_i8(const bf16_t* __restrict__ w, int nrows, unsigned char* __restrict__ w8, float* __restrict__ sw) {
  const int lane = otid() & 63, gw = blockIdx.x * (NT / 64) + (otid() >> 6), nw_ = gridDim.x * (NT / 64);
  for (int row = gw; row < nrows; row += nw_) {
    const u32x4 a = *(const u32x4*)(w + (size_t)row * 1024 + lane * 16), b = *(const u32x4*)(w + (size_t)row * 1024 + lane * 16 + 8);
    float v[16]; float am = 0.f;
#pragma unroll
    for (int i = 0; i < 4; ++i) { v[2 * i] = bflo(a[i]); v[2 * i + 1] = bfhi(a[i]); v[8 + 2 * i] = bflo(b[i]); v[9 + 2 * i] = bfhi(b[i]); }
#pragma unroll
    for (int i = 0; i < 16; ++i) am = fmaxf(am, fabsf(v[i]));
#pragma unroll
    for (int o = 32; o >= 1; o >>= 1) am = fmaxf(am, __shfl_xor(am, o, 64));
    const float st = am * (1.f / 127.f) + 1e-30f, ist = 1.f / st;
    u32x4 o8 = {0u, 0u, 0u, 0u};
#pragma unroll
    for (int i = 0; i < 16; ++i) { const int qv = (int)fminf(fmaxf(rintf(v[i] * ist), -127.f), 127.f); o8[i >> 2] |= ((unsigned)qv & 255u) << (8 * (i & 3)); }
    *(u32x4*)(w8 + (size_t)row * 1024 + lane * 16) = o8;
    if (lane == 0) sw[row] = st;
  }
}
DI void norm_rows_i8(const float* __restrict__ src, int row_begin, int nrows, const float* __restrict__ nw, const float* __restrict__ modbase, bool ctx_tail,
                     unsigned char* __restrict__ dst8, float* __restrict__ hs) {
  const int lane = otid() & 63, gw = blockIdx.x * (NT / 64) + (otid() >> 6), nw_ = gridDim.x * (NT / 64);
  for (int row = row_begin + gw; row < nrows; row += nw_) {
    const int v = (ctx_tail && row >= TL) ? 4 : (row >> 13);
    const float* xr = src + (size_t)row * DM + lane * 16;
    f32x4 xv[4]; float ss = 0.f;
#pragma unroll
    for (int i = 0; i < 4; ++i) { xv[i] = *(const f32x4*)(xr + 4 * i); ss += xv[i][0] * xv[i][0] + xv[i][1] * xv[i][1] + xv[i][2] * xv[i][2] + xv[i][3] * xv[i][3]; }
    ss = wave_sum(ss);
    const float rs = rsqrtf(ss * (1.f / DM) + EPS);
    const float* sh = modbase + (size_t)v * 6144 + lane * 16; const float* scp = sh + 1024;
    float y[16]; float am = 0.f;
#pragma unroll
    for (int i = 0; i < 4; ++i) {
      const f32x4 w4 = *(const f32x4*)(nw + lane * 16 + 4 * i), s4 = *(const f32x4*)(sh + 4 * i), c4 = *(const f32x4*)(scp + 4 * i);
#pragma unroll
      for (int j = 0; j < 4; ++j) { y[4 * i + j] = xv[i][j] * rs * w4[j] * (1.f + c4[j]) + s4[j]; am = fmaxf(am, fabsf(y[4 * i + j])); }
    }
#pragma unroll
    for (int o = 32; o >= 1; o >>= 1) am = fmaxf(am, __shfl_xor(am, o, 64));
    const float st = am * (1.f / 127.f) + 1e-30f, ist = 1.f / st;
    u32x4 b8 = {0u, 0u, 0u, 0u};
#pragma unroll
    for (int j = 0; j < 16; ++j) { const int qv = (int)fminf(fmaxf(rintf(y[j] * ist), -127.f), 127.f); b8[j >> 2] |= ((unsigned)qv & 255u) << (8 * (j & 3)); }
    *(u32x4*)(dst8 + (size_t)row * DM + lane * 16) = b8;
    if (lane == 0) hs[row] = st;
  }
}

struct EpiProjV {
  const P* p; int row0, col0;
  DI void operator()(f32x16 (&acc)[2][2], int wm, int wn, int lane) const {
    const int cb = col0 + wn * 64, h = lane >> 5, cl = lane & 31;
    const bool isctx = row0 >= TL;
    bf16_t* o = (bf16_t*)(p->ws + WS_VT);
    const int hv = (cb - 3072) >> 7, dvb = (cb - 3072) & 127;
#pragma unroll
    for (int mt = 0; mt < 2; ++mt)
#pragma unroll
      for (int nt = 0; nt < 2; ++nt)
#pragma unroll
        for (int g = 0; g < 4; ++g) {
          const int row = row0 + wm * 64 + mt * 32 + 8 * g + 4 * h;
          int b, pos; if (!isctx) { b = row >> 13; pos = row & (SEQ - 1); } else { const int rc = row - TL; b = rc >> 8; pos = SEQ + (rc & 255); }
          const int dv = dvb + nt * 32 + cl;
          u32x2 v; v[0] = pk2(acc[mt][nt][4 * g], acc[mt][nt][4 * g + 1]); v[1] = pk2(acc[mt][nt][4 * g + 2], acc[mt][nt][4 * g + 3]);
          *(u32x2*)(o + ((size_t)((b * 4 + hv) * 128 + dv)) * KVL + pos) = v;
        }
  }
};
struct EpiProjS {
  const P* p; int row0, col0;
  DI void operator()(f32x16 (&acc)[2][2], int wm, int wn, int lane) const {
    const int cb = col0 + wn * 64, h = lane >> 5, cl = lane & 31;
    const bool isctx = row0 >= TL;
    char* ws = p->ws;
    if (cb < 2048) {
      const bool isg = cb >= 1536;
      if (isg && isctx) return;
      bf16_t* o = (bf16_t*)(ws + (isg ? WS_GATE : WS_QKVRAW));
      const int pitch = isg ? 512 : 1536, cofs = isg ? cb - 1536 : cb;
#pragma unroll
      for (int mt = 0; mt < 2; ++mt) {
        const int row = row0 + wm * 64 + mt * 32 + cl;
#pragma unroll
        for (int nt = 0; nt < 2; ++nt)
#pragma unroll
          for (int g = 0; g < 4; ++g) {
            float v0 = acc[mt][nt][4 * g], v1 = acc[mt][nt][4 * g + 1], v2 = acc[mt][nt][4 * g + 2], v3 = acc[mt][nt][4 * g + 3];
            if (isg) { v0 = silu_f(v0); v1 = silu_f(v1); v2 = silu_f(v2); v3 = silu_f(v3); }
            u32x2 v; v[0] = pk2(v0, v1); v[1] = pk2(v2, v3);
            *(u32x2*)(o + (size_t)row * pitch + cofs + nt * 32 + 8 * g + 4 * h) = v;
          }
      }
    } else if (cb < 3072) {
      const bool isq = cb < 2560;
      if (isq && isctx) return;
      const float* rope = (const float*)(ws + WS_ROPE);
      bf16_t* o = (bf16_t*)(ws + (isq ? WS_Q : WS_K));
      const int cofs = cb - (isq ? 2048 : 2560);
      const float qs = isq ? 0.125f * 1.4426950408889634f : 1.f;
#pragma unroll
      for (int mt = 0; mt < 2; ++mt) {
        const int row = row0 + wm * 64 + mt * 32 + cl;
        size_t orow; int l = 0;
        if (!isctx) { l = row & (SEQ - 1); orow = isq ? (size_t)row : (size_t)(row >> 13) * KVL + l; }
        else { const int rc = row - TL; orow = (size_t)(rc >> 8) * KVL + SEQ + (rc & 255); }
#pragma unroll
        for (int g = 0; g < 4; ++g) {
          const int d0 = 8 * g + 4 * h;
          float o1[4], o2[4];
          if (!isctx) {
            const f32x4 ca = *(const f32x4*)(rope + ((size_t)l * 32 + d0) * 2), cb2 = *(const f32x4*)(rope + ((size_t)l * 32 + d0) * 2 + 4);
            const float cs[4] = {ca[0], ca[2], cb2[0], cb2[2]}, sn[4] = {ca[1], ca[3], cb2[1], cb2[3]};
#pragma unroll
            for (int r = 0; r < 4; ++r) { const float x1 = acc[mt][0][4 * g + r], x2 = acc[mt][1][4 * g + r]; o1[r] = (x1 * cs[r] - x2 * sn[r]) * qs; o2[r] = (x1 * sn[r] + x2 * cs[r]) * qs; }
          } else {
#pragma unroll
            for (int r = 0; r < 4; ++r) { o1[r] = acc[mt][0][4 * g + r]; o2[r] = acc[mt][1][4 * g + r]; }
          }
          u32x2 v; v[0] = pk2(o1[0], o1[1]); v[1] = pk2(o1[2], o1[3]); *(u32x2*)(o + orow * 512 + cofs + d0) = v;
          v[0] = pk2(o2[0], o2[1]); v[1] = pk2(o2[2], o2[3]); *(u32x2*)(o + orow * 512 + cofs + 32 + d0) = v;
        }
      }
    } else if (cb == 3584) {
      float* o = (float*)(ws + WS_BA);
#pragma unroll
      for (int mt = 0; mt < 2; ++mt) {
        const int row = row0 + wm * 64 + mt * 32 + cl;
#pragma unroll
        for (int g = 0; g < 4; ++g) {
          const int j0 = 8 * g + 4 * h;
          f32x4 y;
#pragma unroll
          for (int r = 0; r < 4; ++r) {
            const int j = j0 + r; const float v = acc[mt][0][4 * g + r];
            if (j0 < 16) y[r] = sigmoid_f(v);
            else { const float z = v + p->dt_bias[j - 16]; const float sp = (z > 20.f) ? z : log1pf(__expf(z)); y[r] = -__expf(p->a_log[j - 16]) * sp; }
          }
          *(f32x4*)(o + (size_t)row * 32 + j0) = y;
        }
      }
    }
  }
};

DI void ph_gemm_proj(const P& p, char* lds) {
  const bf16_t* A = (const bf16_t*)(p.ws + R0); const bf16_t* Bt = (const bf16_t*)(p.ws + WS_WIN);
  const int nM = TA / GBM, nN = NIN / GBN;
  for (int t = blockIdx.x; t < nM * nN; t += gridDim.x) {
    const int pm = t / nN, pn = t % nN;
    RowLin rf{A + (size_t)pm * GBM * DM, (size_t)DM};
    if (pn >= 24 && pn < 28) { EpiProjV ep{&p, pm * GBM, pn * GBN}; gemm_tile<false>(lds, rf, Bt + (size_t)pn * GBN * DM, DM, ep); }
    else { EpiProjS ep{&p, pm * GBM, pn * GBN}; gemm_tile<true>(lds, rf, Bt + (size_t)pn * GBN * DM, DM, ep); }
  }
}


struct PgResid {
  static constexpr bool PERM = true, AFTER_DRAIN = false;
  const float* xin; float* xout; const float* gmod;
  DI void operator()(const pg8::f32x4 (&acc)[2][2][4][2], const pg8::Unit& u, int wr, int wc, int fr, int fq) const {
#pragma unroll
    for (int ai = 0; ai < 2; ++ai)
#pragma unroll
      for (int m = 0; m < 4; ++m) {
        const int row = u.pm * 256 + ai * 128 + wr * 64 + m * 16 + fr;
        const float* gm = gmod + (size_t)(row >> 13) * 6144;
#pragma unroll
        for (int bj = 0; bj < 2; ++bj) {
          const int c0 = u.pn * 256 + bj * 128 + wc * 32 + 8 * fq;
#pragma unroll
          for (int n = 0; n < 2; ++n) {
            const f32x4 xv = *(const f32x4*)(xin + (size_t)row * DM + c0 + 4 * n), g4 = *(const f32x4*)(gm + c0 + 4 * n);
            *(f32x4*)(xout + (size_t)row * DM + c0 + 4 * n) = xv + g4 * acc[ai][bj][m][n];
          }
        }
      }
  }
};
struct PgBf16 {
  static constexpr bool PERM = true, AFTER_DRAIN = false;
  bf16_t* o; int pitch;
  DI void operator()(const pg8::f32x4 (&acc)[2][2][4][2], const pg8::Unit& u, int wr, int wc, int fr, int fq) const {
#pragma unroll
    for (int ai = 0; ai < 2; ++ai)
#pragma unroll
      for (int m = 0; m < 4; ++m) {
        const int row = u.pm * 256 + ai * 128 + wr * 64 + m * 16 + fr;
#pragma unroll
        for (int bj = 0; bj < 2; ++bj) {
          const int c0 = u.pn * 256 + bj * 128 + wc * 32 + 8 * fq;
          const f32x4 v0 = acc[ai][bj][m][0], v1 = acc[ai][bj][m][1];
          u32x4 w; w[0] = pk2(v0[0], v0[1]); w[1] = pk2(v0[2], v0[3]); w[2] = pk2(v1[0], v1[1]); w[3] = pk2(v1[2], v1[3]);
          *(u32x4*)(o + (size_t)row * pitch + c0) = w;
        }
      }
  }
};
struct PgProj {
  static constexpr bool PERM = true, AFTER_DRAIN = false, DEQ = true;
  const P* p;
  DI void deq(pg8::f32x4 (&acc)[2][2][4][2], const pg8::Unit& u, int wr, int wc, int fr, int fq) const {
    const float* srow = (const float*)(p->ws + WS_HS0); const float* scol = (const float*)(p->ws + WS_SWIN);
#pragma unroll
    for (int bj = 0; bj < 2; ++bj) {
      const int c0 = u.pn * 256 + bj * 128 + wc * 32 + 8 * fq;
      const f32x4 sc0 = *(const f32x4*)(scol + c0), sc1 = *(const f32x4*)(scol + c0 + 4);
#pragma unroll
      for (int ai = 0; ai < 2; ++ai)
#pragma unroll
        for (int m = 0; m < 4; ++m) {
          const float sr = srow[u.pm * 256 + ai * 128 + wr * 64 + m * 16 + fr];
          const pg8::v4i_t i0 = __builtin_bit_cast(pg8::v4i_t, acc[ai][bj][m][0]), i1 = __builtin_bit_cast(pg8::v4i_t, acc[ai][bj][m][1]);
#pragma unroll
          for (int r = 0; r < 4; ++r) { acc[ai][bj][m][0][r] = (float)i0[r] * sr * sc0[r]; acc[ai][bj][m][1][r] = (float)i1[r] * sr * sc1[r]; }
        }
    }
  }
  DI void operator()(const pg8::f32x4 (&acc)[2][2][4][2], const pg8::Unit& u, int wr, int wc, int fr, int fq) const {
    char* ws = p->ws;
    const bool isctx = u.pm * 256 >= TL;
#pragma unroll
    for (int bj = 0; bj < 2; ++bj) {
      const int c0 = u.pn * 256 + bj * 128 + wc * 32 + 8 * fq;
      const int cs = u.pn * 256 + bj * 128 + wc * 32;
      if (cs < 2048) {
        const bool isg = cs >= 1536;
        if (isg && isctx) continue;
        bf16_t* o = (bf16_t*)(ws + (isg ? WS_GATE : WS_QKVRAW));
        const int pitch = isg ? 512 : 1536, cofs = isg ? c0 - 1536 : c0;
#pragma unroll
        for (int ai = 0; ai < 2; ++ai)
#pragma unroll
          for (int m = 0; m < 4; ++m) {
            const int row = u.pm * 256 + ai * 128 + wr * 64 + m * 16 + fr;
            f32x4 v0 = acc[ai][bj][m][0], v1 = acc[ai][bj][m][1];
            if (isg) {
#pragma unroll
              for (int r = 0; r < 4; ++r) { v0[r] = silu_f(v0[r]); v1[r] = silu_f(v1[r]); }
            }
            u32x4 w; w[0] = pk2(v0[0], v0[1]); w[1] = pk2(v0[2], v0[3]); w[2] = pk2(v1[0], v1[1]); w[3] = pk2(v1[2], v1[3]);
            *(u32x4*)(o + (size_t)row * pitch + cofs) = w;
          }
      } else if (cs < 3072) {
        const bool isq = cs < 2560;
        if (isq && isctx) continue;
        const float* rope = (const float*)(ws + WS_ROPE);
        bf16_t* o = (bf16_t*)(ws + (isq ? WS_Q : WS_K));
        const int gofs = (c0 & ~63) - (isq ? 2048 : 2560), d0 = ((c0 & 63) >> 3) * 4;
        const float qs = isq ? 0.125f * 1.4426950408889634f : 1.f;
#pragma unroll
        for (int ai = 0; ai < 2; ++ai)
#pragma unroll
          for (int m = 0; m < 4; ++m) {
            const int row = u.pm * 256 + ai * 128 + wr * 64 + m * 16 + fr;
            const f32x4 x1 = acc[ai][bj][m][0], x2 = acc[ai][bj][m][1];
            size_t orow; float o1[4], o2[4];
            if (!isctx) {
              const int l = row & (SEQ - 1);
              orow = isq ? (size_t)row : (size_t)(row >> 13) * KVL + l;
              const f32x4 ca = *(const f32x4*)(rope + ((size_t)l * 32 + d0) * 2), cb2 = *(const f32x4*)(rope + ((size_t)l * 32 + d0) * 2 + 4);
              const float cs4[4] = {ca[0], ca[2], cb2[0], cb2[2]}, sn4[4] = {ca[1], ca[3], cb2[1], cb2[3]};
#pragma unroll
              for (int r = 0; r < 4; ++r) { o1[r] = (x1[r] * cs4[r] - x2[r] * sn4[r]) * qs; o2[r] = (x1[r] * sn4[r] + x2[r] * cs4[r]) * qs; }
            } else {
              const int rc = row - TL; orow = (size_t)(rc >> 8) * KVL + SEQ + (rc & 255);
#pragma unroll
              for (int r = 0; r < 4; ++r) { o1[r] = x1[r]; o2[r] = x2[r]; }
            }
            u32x2 v; v[0] = pk2(o1[0], o1[1]); v[1] = pk2(o1[2], o1[3]); *(u32x2*)(o + orow * 512 + gofs + d0) = v;
            v[0] = pk2(o2[0], o2[1]); v[1] = pk2(o2[2], o2[3]); *(u32x2*)(o + orow * 512 + gofs + 32 + d0) = v;
          }
      } else if (cs < 3584) {
        bf16_t* o = (bf16_t*)(ws + WS_VT);
        const int hv = (c0 - 3072) >> 7, dv0 = (c0 - 3072) & 127;
#pragma unroll
        for (int ai = 0; ai < 2; ++ai)
#pragma unroll
          for (int m = 0; m < 4; ++m) {
            const int row = u.pm * 256 + ai * 128 + wr * 64 + m * 16 + fr;
            int b, pos; if (!isctx) { b = row >> 13; pos = row & (SEQ - 1); } else { const int rc = row - TL; b = rc >> 8; pos = SEQ + (rc & 255); }
            bf16_t* op = o + ((size_t)((b * 4 + hv) * 128 + dv0)) * KVL + pos;
#pragma unroll
            for (int n = 0; n < 2; ++n)
#pragma unroll
              for (int r = 0; r < 4; ++r) op[(size_t)(4 * n + r) * KVL] = (bf16_t)f2bf(acc[ai][bj][m][n][r]);
          }
      } else if (cs == 3584) {
        float* o = (float*)(ws + WS_BA);
        const int j0 = c0 - 3584;
#pragma unroll
        for (int ai = 0; ai < 2; ++ai)
#pragma unroll
          for (int m = 0; m < 4; ++m) {
            const int row = u.pm * 256 + ai * 128 + wr * 64 + m * 16 + fr;
#pragma unroll
            for (int n = 0; n < 2; ++n) {
              f32x4 y;
#pragma unroll
              for (int r = 0; r < 4; ++r) {
                const int j = j0 + 4 * n + r; const float v = acc[ai][bj][m][n][r];
                if (j0 < 16) y[r] = sigmoid_f(v);
                else { const float z = v + p->dt_bias[j - 16]; const float sp = (z > 20.f) ? z : log1pf(__expf(z)); y[r] = -__expf(p->a_log[j - 16]) * sp; }
              }
              *(f32x4*)(o + (size_t)row * 32 + j0 + 4 * n) = y;
            }
          }
      }
    }
  }
};
struct PgScoreI8 {
  static constexpr bool PERM = true, AFTER_DRAIN = false, DEQ = false;
  bf16_t* o; const float* srow; const float* scol;
  DI void operator()(const pg8::f32x4 (&acc)[2][2][4][2], const pg8::Unit& u, int wr, int wc, int fr, int fq) const {
#pragma unroll
    for (int bj = 0; bj < 2; ++bj) {
      const int c0 = u.pn * 256 + bj * 128 + wc * 32 + 8 * fq;
      const f32x4 s0 = *(const f32x4*)(scol + c0), s1 = *(const f32x4*)(scol + c0 + 4);
#pragma unroll
      for (int ai = 0; ai < 2; ++ai)
#pragma unroll
        for (int m = 0; m < 4; ++m) {
          const int row = u.pm * 256 + ai * 128 + wr * 64 + m * 16 + fr;
          const float sr = srow[row];
          const pg8::v4i_t i0 = __builtin_bit_cast(pg8::v4i_t, acc[ai][bj][m][0]), i1 = __builtin_bit_cast(pg8::v4i_t, acc[ai][bj][m][1]);
          u32x4 w;
          w[0] = pk2((float)i0[0] * sr * s0[0], (float)i0[1] * sr * s0[1]); w[1] = pk2((float)i0[2] * sr * s0[2], (float)i0[3] * sr * s0[3]);
          w[2] = pk2((float)i1[0] * sr * s1[0], (float)i1[1] * sr * s1[1]); w[3] = pk2((float)i1[2] * sr * s1[2], (float)i1[3] * sr * s1[3]);
          *(u32x4*)(o + (size_t)row * 2048 + c0) = w;
        }
    }
  }
};
template <class Epi>
DI void pg8_run_i8(char* lds, const void* A8, const void* Bt8, int M, int N, int Kbytes, const Epi& E) {
  pg8::Gemm g{(const pg8::bf16_t*)A8, (const pg8::bf16_t*)Bt8, M, N, Kbytes / 2};
  pg8::StaticOrder S; S.init(M, N, (int)gridDim.x, (int)blockIdx.x);
  pg8::gemm_phase<Epi, pg8::StaticOrder, true, true, true>((PG8_LAS unsigned char*)lds, g, S, E);
}
template <class Epi>
DI void pg8_run(char* lds, const bf16_t* A, const bf16_t* Bt, int M, int N, int K, const Epi& E) {
  pg8::Gemm g{A, Bt, M, N, K};
  pg8::StaticOrder S; S.init(M, N, (int)gridDim.x, (int)blockIdx.x);
  pg8::gemm_phase<Epi, pg8::StaticOrder, true, true>((PG8_LAS unsigned char*)lds, g, S, E);
}

DI void gdn_solve(const float* MT, const float* src  , const float* be, const float* gc  ,
                  int d, int part, int lane, bf16_t* uo) {
  float a[64];
#pragma unroll
  for (int i = 0; i < 64; ++i) {
    const int t = d ? 63 - i : i;
    float v = be[t] * src[t * 68 + lane];
    if (part) v *= __expf(gc[t]);
    a[i] = v;
  }
#pragma unroll
  for (int j = 0; j < 63; ++j) {
    const float xj = a[j];
#pragma unroll
    for (int i4 = ((j + 1) & ~3); i4 < 64; i4 += 4) {
      const f32x4 m = *(const f32x4*)(MT + j * 68 + i4);
#pragma unroll
      for (int q = 0; q < 4; ++q) if (i4 + q > j) a[i4 + q] -= m[q] * xj;
    }
  }
  if (part) {
#pragma unroll
    for (int i = 0; i < 64; ++i) uo[i * 64 + lane] = (bf16_t)f2bf(a[i]);
  } else {
#pragma unroll
    for (int c = 0; c < 8; ++c) {
      u32x4 o; o[0] = pk2(a[8 * c], a[8 * c + 1]); o[1] = pk2(a[8 * c + 2], a[8 * c + 3]); o[2] = pk2(a[8 * c + 4], a[8 * c + 5]); o[3] = pk2(a[8 * c + 6], a[8 * c + 7]);
      *(u32x4*)(uo + lane * 64 + 8 * c) = o;
    }
  }
}

template <int MODE = 0>
DI void ph_gdn_prep(const P& p, char* lds) {
  const int tid0 = otid();
  float* L = (float*)lds;
  constexpr int HSZ = 4 * 64 * 68 + 6 * 64;
  const bf16_t* raw = (const bf16_t*)(p.ws + WS_QKVRAW);
  const float* BA = (const float*)(p.ws + WS_BA);
  bf16_t* qn = (bf16_t*)(p.ws + WS_QN); bf16_t* kn = (bf16_t*)(p.ws + WS_KN);
  float* GC = (float*)(p.ws + WS_GC);
  bf16_t* UW = (bf16_t*)(p.ws + WS_UW);
  for (int it = blockIdx.x; it < NB * NCH * 4; it += gridDim.x) {
    int tid = tid0; asm volatile("" : "+v"(tid));
    const int lane = tid & 63, wave = __builtin_amdgcn_readfirstlane(tid >> 6);
    const int hpair = it & 3, cid = (it >> 2) % NCH, b = it / (4 * NCH);
    const int segbase = (cid < 4) ? TL + b * CTXL : b * SEQ, c0 = (cid < 4) ? cid * 64 : (cid - 4) * 64, seglen = (cid < 4) ? CTXL : SEQ;
    __syncthreads();
    {
      const int t = tid >> 3, c8 = tid & 7, sidx = c0 + t;
      const size_t grow = (size_t)(segbase + sidx);
      const bool hm = sidx - 1 >= 0, hp_ = sidx + 1 < seglen;
#pragma unroll 1
      for (int hh = 0; hh < 2; ++hh) {
        const int head = hpair * 2 + hh;
        float* kf = L + hh * HSZ; float* vf = kf + 64 * 68;
#pragma unroll
        for (int part = 0; part < 3; ++part) {
          const int ch = part * 512 + head * 64 + c8 * 8;
          const u32x4 z4 = {0u, 0u, 0u, 0u};
          const u32x4 rm = hm ? *(const u32x4*)(raw + (grow - 1) * 1536 + ch) : z4;
          const u32x4 r0v = *(const u32x4*)(raw + grow * 1536 + ch);
          const u32x4 rp = hp_ ? *(const u32x4*)(raw + (grow + 1) * 1536 + ch) : z4;
          float v[8]; float ss = 0.f;
#pragma unroll
          for (int w = 0; w < 4; ++w) {
            const f32x2_t w0 = *(const f32x2_t*)(p.conv_w + ch + 2 * w), w1 = *(const f32x2_t*)(p.conv_w + 1536 + ch + 2 * w), w2 = *(const f32x2_t*)(p.conv_w + 3072 + ch + 2 * w);
            v[2 * w] = silu_f(w0[0] * bflo(rm[w]) + w1[0] * bflo(r0v[w]) + w2[0] * bflo(rp[w]));
            v[2 * w + 1] = silu_f(w0[1] * bfhi(rm[w]) + w1[1] * bfhi(r0v[w]) + w2[1] * bfhi(rp[w]));
            ss += v[2 * w] * v[2 * w] + v[2 * w + 1] * v[2 * w + 1];
          }
          if (part < 2) {
            ss += __shfl_xor(ss, 1, 64); ss += __shfl_xor(ss, 2, 64); ss += __shfl_xor(ss, 4, 64);
            const float rn = rsqrtf(ss + EPS) * (part == 0 ? 0.125f : 1.f);
#pragma unroll
            for (int w = 0; w < 8; ++w) v[w] *= rn;
            u32x4 o; o[0] = pk2(v[0], v[1]); o[1] = pk2(v[2], v[3]); o[2] = pk2(v[4], v[5]); o[3] = pk2(v[6], v[7]);
            *(u32x4*)((part == 0 ? qn : kn) + grow * 512 + head * 64 + c8 * 8) = o;
          }
          if (part >= 1) {
            float* dst = (part == 1 ? kf : vf) + t * 68 + c8 * 8;
            *(f32x4*)dst = f32x4{v[0], v[1], v[2], v[3]}; *(f32x4*)(dst + 4) = f32x4{v[4], v[5], v[6], v[7]};
          }
        }
      }
    }
    if (MODE == 2) continue;
    if (wave < 4) {
      const int hh = wave >> 1, d = wave & 1, head = hpair * 2 + hh, t = lane;
      float* be = L + hh * HSZ + 4 * 64 * 68;
      const size_t row = (size_t)(segbase + c0 + t);
      be[d * 64 + t] = BA[row * 32 + d * 8 + head];
      const float g = BA[row * 32 + 16 + d * 8 + head];
      float a = g;
#pragma unroll
      for (int o = 1; o < 64; o <<= 1) {
        const float nb_ = d ? __shfl_down(a, o, 64) : __shfl_up(a, o, 64);
        const bool ok = d ? (lane + o < 64) : (lane >= o);
        a += ok ? nb_ : 0.f;
      }
      be[256 + d * 64 + t] = a;
      GC[((size_t)((b * 8 + head) * 2 + d) * NCH + cid) * 64 + (d ? 63 - t : t)] = a;
    }
    __syncthreads();
    {
      const int hh = wave >> 2, Ln = lane;
      float* kf = L + hh * HSZ; float* M0 = kf + 2 * 64 * 68; float* M1 = kf + 3 * 64 * 68; float* be = kf + 4 * 64 * 68; float* gc = be + 256;
      float a[16];
#pragma unroll
      for (int i = 0; i < 16; ++i) a[i] = 0.f;
#pragma unroll 1
      for (int c = 0; c < 64; c += 4) {
        const f32x4 kv = *(const f32x4*)(kf + Ln * 68 + c);
#pragma unroll
        for (int i = 0; i < 16; ++i) { const f32x4 kr = *(const f32x4*)(kf + ((wave & 3) * 16 + i) * 68 + c); a[i] += kv[0] * kr[0] + kv[1] * kr[1] + kv[2] * kr[2] + kv[3] * kr[3]; }
      }
      const float b0 = be[Ln], b1 = be[64 + Ln], g0 = gc[Ln], g1 = gc[64 + Ln];
#pragma unroll
      for (int i = 0; i < 16; ++i) {
        const int ti = (wave & 3) * 16 + i;
        if (Ln > ti) M0[ti * 68 + Ln] = b0 * a[i] * __expf(g0 - gc[ti]);
        else if (Ln < ti) M1[(63 - ti) * 68 + 63 - Ln] = b1 * a[i] * __expf(g1 - gc[64 + ti]);
      }
    }
    __syncthreads();
    if (MODE == 0) {
      const int hh = wave >> 2, d = (wave >> 1) & 1, part = wave & 1, head = hpair * 2 + hh;
      float* kf = L + hh * HSZ; float* vf = kf + 64 * 68; float* Md = kf + (2 + d) * 64 * 68; float* be = kf + 4 * 64 * 68; float* gc = be + 256;
      bf16_t* uo = UW + (((size_t)((b * 8 + head) * 2 + d) * NCH + cid) * 2 + part) * 4096;
      gdn_solve(Md, part ? kf : vf, be + d * 64, gc + d * 64, d, part, lane, uo);
    }
  }
}

#define MFMA16(a, b, c) __builtin_amdgcn_mfma_f32_16x16x32_bf16((a), (b), (c), 0, 0, 0)
constexpr int SC_LD = 72;
constexpr int SC_T = 64 * SC_LD * 2;
constexpr int SC_STAGE = 5 * SC_T + 1024;
constexpr int SC_KNL = 2 * SC_STAGE, SC_QNL = SC_KNL + SC_T;
DI bf16x8 pack8(const f32x4& a, const f32x4& b) { u32x4 r; r[0] = cvtpk(a[0], a[1]); r[1] = cvtpk(a[2], a[3]); r[2] = cvtpk(b[0], b[1]); r[3] = cvtpk(b[2], b[3]); return __builtin_bit_cast(bf16x8, r); }
DI bf16x8 afrag(const char* tile, int row, int kofs  ) {
  const char* pr = tile + (row * SC_LD + kofs) * 2;
  const u32x2 lo = *(const u32x2*)pr, hi = *(const u32x2*)(pr + 32);
  u32x4 r; r[0] = lo[0]; r[1] = lo[1]; r[2] = hi[0]; r[3] = hi[1];
  return __builtin_bit_cast(bf16x8, r);
}
template <int NOSTORE = 0>
DI void ph_gdn_scan(const P& p, char* lds) {
  const int tid = otid(), lane = tid & 63, wave = __builtin_amdgcn_readfirstlane(tid >> 6);
  const int c = lane & 15, q = lane >> 4;
  const bf16_t* qn = (const bf16_t*)(p.ws + WS_QN); const bf16_t* kn = (const bf16_t*)(p.ws + WS_KN);
  const float* GC = (const float*)(p.ws + WS_GC);
  const bf16_t* UW = (const bf16_t*)(p.ws + WS_UW);
  bf16_t* Ob = (bf16_t*)(p.ws + WS_OBUF);
  for (int it = blockIdx.x; it < 64; it += gridDim.x) {
    const int bhd = it, d = bhd & 1, head = (bhd >> 1) & 7, b = bhd >> 4;
    __syncthreads();
    if (wave >= 4) {
      const int pt = tid - 256;
      const int r0 = pt >> 3, cc = pt & 7;
      u32x4 rW0A, rW1A, rU0A, rU1A, rK0A, rK1A, rQ0A, rQ1A; f32x4 rGA;
      u32x4 rW0B, rW1B, rU0B, rU1B, rK0B, rK1B, rQ0B, rQ1B; f32x4 rGB;
#define SP_CID(n) (d ? ((n) < 4 ? 3 - (n) : 135 - (n)) : (n))
#define SP_LOAD(n, S) do { const int nn_ = (n) < NCH ? (n) : NCH - 1; const int cid_ = SP_CID(nn_); const bool lat_ = cid_ >= 4; const int sb_ = lat_ ? b * SEQ : TL + b * CTXL, c0_ = lat_ ? (cid_ - 4) * 64 : cid_ * 64; \
        const bf16_t* uw_ = UW + ((size_t)(bhd * NCH + cid_) * 2) * 4096; \
        rU0##S = *(const u32x4*)(uw_ + r0 * 64 + cc * 8); rU1##S = *(const u32x4*)(uw_ + (r0 + 32) * 64 + cc * 8); \
        rW0##S = *(const u32x4*)(uw_ + 4096 + r0 * 64 + cc * 8); rW1##S = *(const u32x4*)(uw_ + 4096 + (r0 + 32) * 64 + cc * 8); \
        const int t0_ = d ? 63 - r0 : r0, t1_ = d ? 31 - r0 : r0 + 32; \
        rK0##S = *(const u32x4*)(kn + (size_t)(sb_ + c0_ + t0_) * 512 + head * 64 + cc * 8); rK1##S = *(const u32x4*)(kn + (size_t)(sb_ + c0_ + t1_) * 512 + head * 64 + cc * 8); \
        const bf16_t* qk_ = lat_ ? qn : kn;     \
        rQ0##S = *(const u32x4*)(qk_ + (size_t)(sb_ + c0_ + t0_) * 512 + head * 64 + cc * 8); rQ1##S = *(const u32x4*)(qk_ + (size_t)(sb_ + c0_ + t1_) * 512 + head * 64 + cc * 8); \
        rG##S = *(const f32x4*)(GC + (size_t)(bhd * NCH + cid_) * 64 + (pt & 15) * 4); } while (0)
#define SP_A(n, S) do { char* st_ = lds + ((n) & 1) * SC_STAGE; const int o0_ = (r0 * SC_LD + cc * 8) * 2, o1_ = o0_ + 32 * SC_LD * 2; \
        *(u32x4*)(st_ + o0_) = rW0##S; *(u32x4*)(st_ + o1_) = rW1##S; *(u32x4*)(st_ + SC_T + o0_) = rU0##S; *(u32x4*)(st_ + SC_T + o1_) = rU1##S; \
        *(u32x4*)(lds + SC_KNL + o0_) = rK0##S; *(u32x4*)(lds + SC_KNL + o1_) = rK1##S; \
        *(u32x4*)(lds + SC_QNL + o0_) = rQ0##S; *(u32x4*)(lds + SC_QNL + o1_) = rQ1##S; \
        if (pt < 16) { float* gp_ = (float*)(st_ + 5 * SC_T); *(f32x4*)(gp_ + pt * 4) = rG##S; } } while (0)
#define SP_B(n) do { char* st_ = lds + ((n) & 1) * SC_STAGE; float* gp_ = (float*)(st_ + 5 * SC_T); const bool lat_ = SP_CID((n) < NCH ? (n) : NCH - 1) >= 4; \
        const float gl_ = gp_[63]; \
        if (pt < 64) { const float gi_ = gp_[pt]; gp_[64 + pt] = __expf(gi_); gp_[128 + pt] = __expf(gl_ - gi_); if (pt == 0) gp_[192] = __expf(gl_); } \
        {   \
          const int i_ = pt & 63; \
          _Pragma("unroll") for (int e_ = 0; e_ < 2; ++e_) { const int ch_ = (pt >> 6) * 2 + e_; const u32x4 kv_ = *(const u32x4*)(lds + SC_KNL + (i_ * SC_LD + ch_ * 8) * 2); \
            bf16_t* kt_ = (bf16_t*)(st_ + 2 * SC_T); \
            _Pragma("unroll") for (int w_ = 0; w_ < 4; ++w_) { kt_[(ch_ * 8 + 2 * w_) * SC_LD + i_] = (bf16_t)(kv_[w_] & 0xFFFFu); kt_[(ch_ * 8 + 2 * w_ + 1) * SC_LD + i_] = (bf16_t)(kv_[w_] >> 16); } } } \
        if (lat_) { \
          {   \
            _Pragma("unroll") for (int e_ = 0; e_ < 2; ++e_) { const int rr_ = r0 + 32 * e_; const float sc_ = __expf(gp_[rr_]); const u32x4 qv_ = *(const u32x4*)(lds + SC_QNL + (rr_ * SC_LD + cc * 8) * 2); u32x4 ov_; \
              _Pragma("unroll") for (int w_ = 0; w_ < 4; ++w_) ov_[w_] = cvtpk(bflo(qv_[w_]) * sc_, bfhi(qv_[w_]) * sc_); \
              *(u32x4*)(st_ + 3 * SC_T + (rr_ * SC_LD + cc * 8) * 2) = ov_; } } \
          {   \
            const int jt_ = wave - 4; \
            const bf16x8 ka0_ = *(const bf16x8*)(lds + SC_KNL + ((16 * jt_ + c) * SC_LD + 8 * q) * 2), ka1_ = *(const bf16x8*)(lds + SC_KNL + ((16 * jt_ + c) * SC_LD + 32 + 8 * q) * 2); \
            bf16x8 qb_[4][2]; \
            _Pragma("unroll") for (int it_ = 0; it_ < 4; ++it_) { qb_[it_][0] = *(const bf16x8*)(lds + SC_QNL + ((16 * it_ + c) * SC_LD + 8 * q) * 2); qb_[it_][1] = *(const bf16x8*)(lds + SC_QNL + ((16 * it_ + c) * SC_LD + 32 + 8 * q) * 2); } \
            const f32x4 gj_ = *(const f32x4*)(gp_ + 16 * jt_ + 4 * q); \
            float gi_[4]; _Pragma("unroll") for (int it_ = 0; it_ < 4; ++it_) gi_[it_] = gp_[16 * it_ + c]; \
            _Pragma("unroll") for (int it_ = 0; it_ < 4; ++it_) { \
              f32x4 ac_ = {0.f, 0.f, 0.f, 0.f}; \
              ac_ = MFMA16(ka0_, qb_[it_][0], ac_); ac_ = MFMA16(ka1_, qb_[it_][1], ac_); \
              const int i_ = 16 * it_ + c; \
              _Pragma("unroll") for (int r_ = 0; r_ < 4; ++r_) { const int j_ = 16 * jt_ + 4 * q + r_; const float e_ = __expf(fminf(gi_[it_] - gj_[r_], 0.f)); ac_[r_] = (i_ >= j_) ? ac_[r_] * e_ : 0.f; } \
              u32x2 ov_; ov_[0] = cvtpk(ac_[0], ac_[1]); ov_[1] = cvtpk(ac_[2], ac_[3]); \
              *(u32x2*)(st_ + 4 * SC_T + ((16 * it_ + c) * SC_LD + 16 * jt_ + 4 * q) * 2) = ov_; } } } } while (0)
      SP_LOAD(0, A); SP_LOAD(1, B);
      SP_A(0, A);
      __syncthreads();
      SP_B(0);
      SP_LOAD(2, A);
      __syncthreads();
#define SP_STEP(n, S) do { SP_A((n) + 1, S); SP_LOAD((n) + 3, S);        \
        __syncthreads();                 \
        SP_B((n) + 1); \
        __syncthreads();                 } while (0)
#pragma unroll 1
      for (int n = 0; n < NCH; n += 2) { SP_STEP(n, B); SP_STEP(n + 1, A); }
#undef SP_STEP
#undef SP_LOAD
#undef SP_A
#undef SP_B
    } else {
      f32x4 S[4];
#pragma unroll
      for (int i = 0; i < 4; ++i) S[i] = f32x4{0.f, 0.f, 0.f, 0.f};
      __syncthreads();
      __syncthreads();
#pragma unroll 1
      for (int n = 0; n < NCH; ++n) {
        const int cid = SP_CID(n); const bool lat = cid >= 4;
        const char* st = lds + (n & 1) * SC_STAGE; const float* gp = (const float*)(st + 5 * SC_T);
        bf16x8 Sb[2], Sn[2];
#pragma unroll
        for (int ks = 0; ks < 2; ++ks) {
          Sb[ks] = pack8(S[2 * ks], S[2 * ks + 1]);
          u32x4 t = __builtin_bit_cast(u32x4, Sb[ks]);
#pragma unroll
          for (int w = 0; w < 4; ++w) t[w] ^= 0x80008000u;
          Sn[ks] = __builtin_bit_cast(bf16x8, t);
        }
        u32x2 ur[4]; bf16x8 wf[4][2], kf2[4][2]; f32x4 sc4[4];
#pragma unroll
        for (int mt = 0; mt < 4; ++mt) {
          ur[mt] = *(const u32x2*)(st + SC_T + ((16 * wave + c) * SC_LD + 16 * mt + 4 * q) * 2);
          wf[mt][0] = afrag(st, 16 * mt + c, 4 * q); wf[mt][1] = afrag(st, 16 * mt + c, 32 + 4 * q);
          sc4[mt] = *(const f32x4*)(gp + 128 + 16 * mt + 4 * q);
        }
#pragma unroll
        for (int dt = 0; dt < 4; ++dt) { kf2[dt][0] = afrag(st + 2 * SC_T, 16 * dt + c, 4 * q); kf2[dt][1] = afrag(st + 2 * SC_T, 16 * dt + c, 32 + 4 * q); }
        const float gt = gp[192];
        f32x4 vn[4], vs[4];
#pragma unroll
        for (int mt = 0; mt < 4; ++mt) {
          f32x4 acc = {bflo(ur[mt][0]), bfhi(ur[mt][0]), bflo(ur[mt][1]), bfhi(ur[mt][1])};
          acc = MFMA16(wf[mt][0], Sn[0], acc);
          acc = MFMA16(wf[mt][1], Sn[1], acc);
          vn[mt] = acc;
          vs[mt] = acc * sc4[mt];
        }
        bf16x8 Vn[2], Vs[2];
#pragma unroll
        for (int ks = 0; ks < 2; ++ks) { Vn[ks] = pack8(vn[2 * ks], vn[2 * ks + 1]); Vs[ks] = pack8(vs[2 * ks], vs[2 * ks + 1]); }
        f32x4 Snew[4];
#pragma unroll
        for (int dt = 0; dt < 4; ++dt) {
          f32x4 acc = S[dt] * gt;
          acc = MFMA16(kf2[dt][0], Vs[0], acc);
          acc = MFMA16(kf2[dt][1], Vs[1], acc);
          Snew[dt] = acc;
        }
        __syncthreads();
        if (lat) {
          const int sb = b * SEQ, c0 = (cid - 4) * 64;
          bf16x8 qf[4][2], pf[4][2];
#pragma unroll
          for (int mt = 0; mt < 4; ++mt) {
            qf[mt][0] = afrag(st + 3 * SC_T, 16 * mt + c, 4 * q); qf[mt][1] = afrag(st + 3 * SC_T, 16 * mt + c, 32 + 4 * q);
            pf[mt][0] = afrag(st + 4 * SC_T, 16 * mt + c, 4 * q); pf[mt][1] = afrag(st + 4 * SC_T, 16 * mt + c, 32 + 4 * q);
          }
#pragma unroll
          for (int mt = 0; mt < 4; ++mt) {
            f32x4 o = {0.f, 0.f, 0.f, 0.f};
            o = MFMA16(Sb[0], qf[mt][0], o);
            o = MFMA16(Sb[1], qf[mt][1], o);
            o = MFMA16(Vn[0], pf[mt][0], o);
            o = MFMA16(Vn[1], pf[mt][1], o);
            const int i = 16 * mt + c, t = d ? 63 - i : i;
            u32x2 ov; ov[0] = cvtpk(o[0], o[1]); ov[1] = cvtpk(o[2], o[3]);
            if (!NOSTORE || ov[0] == 0x12345678u) *(u32x2*)(Ob + ((size_t)d * TL + sb + c0 + t) * 512 + head * 64 + 16 * wave + 4 * q) = ov;
          }
        }
#pragma unroll
        for (int dt = 0; dt < 4; ++dt) S[dt] = Snew[dt];
        __syncthreads();
      }
    }
#undef SP_CID
  }
}

constexpr int AT_KROW = 72, AT_VROW = 68;
constexpr int AT_KB = 2 * 64 * AT_KROW * 2, AT_VB = 128 * AT_VROW * 2, AT_STAGE = AT_KB + AT_VB;
DI void ph_attn(const P& p, char* lds) {
  const int tid = otid(), lane = tid & 63, wave = tid >> 6, wq = wave & 3, m = wave >> 2, h = lane >> 5, cl = lane & 31;
  const bf16_t* Qb = (const bf16_t*)(p.ws + WS_Q); const bf16_t* Kb = (const bf16_t*)(p.ws + WS_K); const bf16_t* VT = (const bf16_t*)(p.ws + WS_VT);
  bf16_t* mix = (bf16_t*)(p.ws + WS_MIX);
  for (int it = blockIdx.x; it < NB * 4 * 64; it += gridDim.x) {
    const int qb = it & 63, head = (it >> 6) & 3, b = it >> 8;
    const int qrow = b * SEQ + qb * 128 + wq * 32 + cl;
    bf16x8 qf[4];
#pragma unroll
    for (int kk = 0; kk < 4; ++kk) qf[kk] = *(const bf16x8*)(Qb + (size_t)qrow * 512 + (head * 2 + m) * 64 + kk * 16 + h * 8);
    f32x16 o[4];
#pragma unroll
    for (int i = 0; i < 4; ++i)
#pragma unroll
      for (int r = 0; r < 16; ++r) o[i][r] = 0.f;
    float mrun = -1e30f, lrun = 0.f;
    const bf16_t* kp0 = Kb + ((size_t)b * KVL + (tid >> 4)) * 512 + head * 128 + (tid & 15) * 8;
    const bf16_t* kp1 = kp0 + (size_t)32 * 512;
    const bf16_t* vp0 = VT + ((size_t)((b * 4 + head) * 128 + (tid >> 3))) * KVL + (tid & 7) * 8;
    const bf16_t* vp1 = vp0 + (size_t)64 * KVL;
    const int kw0 = ((((tid & 15) >> 3) * 64 + (tid >> 4)) * AT_KROW + ((tid & 15) & 7) * 8) * 2, kw1 = kw0 + 32 * AT_KROW * 2;
    const int vw0 = AT_KB + ((tid >> 3) * AT_VROW + (tid & 7) * 8) * 2, vw1 = vw0 + 64 * AT_VROW * 2;
    u32x4 rk0, rk1, rv0, rv1;
#define A_GLOAD(kv0) do { rk0 = *(const u32x4*)(kp0 + (size_t)(kv0) * 512); rk1 = *(const u32x4*)(kp1 + (size_t)(kv0) * 512); rv0 = *(const u32x4*)(vp0 + (kv0)); rv1 = *(const u32x4*)(vp1 + (kv0)); } while (0)
#define A_LWRITE(st) do { char* b_ = lds + (st) * AT_STAGE; *(u32x4*)(b_ + kw0) = rk0; *(u32x4*)(b_ + kw1) = rk1; \
      u32x2 t_; t_[0] = rv0[0]; t_[1] = rv0[1]; *(u32x2*)(b_ + vw0) = t_; t_[0] = rv0[2]; t_[1] = rv0[3]; *(u32x2*)(b_ + vw0 + 8) = t_; \
      t_[0] = rv1[0]; t_[1] = rv1[1]; *(u32x2*)(b_ + vw1) = t_; t_[0] = rv1[2]; t_[1] = rv1[3]; *(u32x2*)(b_ + vw1 + 8) = t_; } while (0)
    A_GLOAD(0);
    __syncthreads();
    A_LWRITE(0);
    __syncthreads();
    constexpr int NKT = KVL / 64;
    for (int kt = 0; kt < NKT; ++kt) {
      if (kt + 1 < NKT) A_GLOAD((kt + 1) * 64);
      const char* sb = lds + (kt & 1) * AT_STAGE;
      const char* ks = sb + (m * 64 * AT_KROW) * 2;
      f32x16 st[2];
#pragma unroll
      for (int k2 = 0; k2 < 2; ++k2) {
#pragma unroll
        for (int r = 0; r < 16; ++r) st[k2][r] = 0.f;
#pragma unroll
        for (int kk = 0; kk < 4; ++kk) {
          const bf16x8 a = *(const bf16x8*)(ks + ((k2 * 32 + cl) * AT_KROW + kk * 16 + h * 8) * 2);
          st[k2] = MFMA32(a, qf[kk], st[k2]);
        }
      }
      float mx = fmaxf(st[0][0], st[1][0]);
#pragma unroll
      for (int r = 1; r < 16; ++r) mx = fmaxf(mx, fmaxf(st[0][r], st[1][r]));
      mx = fmaxf(mx, __shfl_xor(mx, 32, 64));
      if (__any(mx > mrun + 8.f)) {
        const float mnew = fmaxf(mrun, mx);
        const float alpha = __builtin_amdgcn_exp2f(mrun - mnew);
        mrun = mnew; lrun *= alpha;
#pragma unroll
        for (int i = 0; i < 4; ++i)
#pragma unroll
          for (int r = 0; r < 16; ++r) o[i][r] *= alpha;
      }
      float rs = 0.f;
#pragma unroll
      for (int k2 = 0; k2 < 2; ++k2)
#pragma unroll
        for (int r = 0; r < 16; ++r) { const float pv = __builtin_amdgcn_exp2f(st[k2][r] - mrun); st[k2][r] = pv; rs += pv; }
      lrun += rs;
      const char* vsb = sb + AT_KB;
#pragma unroll
      for (int k2 = 0; k2 < 2; ++k2)
#pragma unroll
        for (int s = 0; s < 2; ++s) {
          u32x4 pb;
          pb[0] = cvtpk(st[k2][8 * s + 0], st[k2][8 * s + 1]); pb[1] = cvtpk(st[k2][8 * s + 2], st[k2][8 * s + 3]);
          pb[2] = cvtpk(st[k2][8 * s + 4], st[k2][8 * s + 5]); pb[3] = cvtpk(st[k2][8 * s + 6], st[k2][8 * s + 7]);
          const bf16x8 pfrag = __builtin_bit_cast(bf16x8, pb);
#pragma unroll
          for (int dt = 0; dt < 4; ++dt) {
            const char* vr = vsb + ((dt * 32 + cl) * AT_VROW + k2 * 32 + 16 * s + 4 * h) * 2;
            const u32x2 lo = *(const u32x2*)(vr), hi = *(const u32x2*)(vr + 16);
            u32x4 av; av[0] = lo[0]; av[1] = lo[1]; av[2] = hi[0]; av[3] = hi[1];
            o[dt] = MFMA32(__builtin_bit_cast(bf16x8, av), pfrag, o[dt]);
          }
        }
      if (kt + 1 < NKT) A_LWRITE((kt + 1) & 1);
      __syncthreads();
    }
#undef A_GLOAD
#undef A_LWRITE
    const float ltot = lrun + __shfl_xor(lrun, 32, 64);
    const float inv = 1.f / ltot;
    float* X = (float*)lds;
    if (m == 1) {
#pragma unroll
      for (int dt = 0; dt < 4; ++dt)
#pragma unroll
        for (int r = 0; r < 16; ++r) X[(wq * 32 + cl) * 129 + dt * 32 + crow(r, h)] = o[dt][r] * inv;
    }
    __syncthreads();
    if (m == 0) {
      float l1 = 0.f, l2 = 0.f;
      for (int i = 0; i < 64; ++i) { l1 += p.lam_q1[i] * p.lam_k1[i]; l2 += p.lam_q2[i] * p.lam_k2[i]; }
      const float lam = __expf(l1) - __expf(l2) + 0.2f;
      float ss = 0.f;
#pragma unroll
      for (int dt = 0; dt < 4; ++dt)
#pragma unroll
        for (int r = 0; r < 16; ++r) { const float dv = o[dt][r] * inv - lam * X[(wq * 32 + cl) * 129 + dt * 32 + crow(r, h)]; o[dt][r] = dv; ss += dv * dv; }
      ss += __shfl_xor(ss, 32, 64);
      const float rn = rsqrtf(ss * (1.f / 128.f) + EPS) * 0.8f;
#pragma unroll
      for (int dt = 0; dt < 4; ++dt)
#pragma unroll
        for (int g = 0; g < 4; ++g) {
          const int dv = dt * 32 + 8 * g + 4 * h;
          const f32x4 w4 = *(const f32x4*)(p.subln_w + dv);
          u32x2 v; v[0] = pk2(o[dt][4 * g] * rn * w4[0], o[dt][4 * g + 1] * rn * w4[1]); v[1] = pk2(o[dt][4 * g + 2] * rn * w4[2], o[dt][4 * g + 3] * rn * w4[3]);
          *(u32x2*)(mix + (size_t)qrow * DM + 512 + head * 128 + dv) = v;
        }
    }
    __syncthreads();
  }
}

DI void ph_mixout(const P& p) {
  const int lane = otid() & 63, gw = blockIdx.x * (NT / 64) + (otid() >> 6), nw_ = gridDim.x * (NT / 64);
  const bf16_t* Ob = (const bf16_t*)(p.ws + WS_OBUF); const bf16_t* gate = (const bf16_t*)(p.ws + WS_GATE);
  bf16_t* mix = (bf16_t*)(p.ws + WS_MIX);
  for (int row = gw; row < TL; row += nw_) {
    const u32x4 a = *(const u32x4*)(Ob + (size_t)row * 512 + lane * 8), bq = *(const u32x4*)(Ob + ((size_t)TL + row) * 512 + lane * 8);
    const u32x4 gv = *(const u32x4*)(gate + (size_t)row * 512 + lane * 8);
    float v[8]; float ss = 0.f;
#pragma unroll
    for (int i = 0; i < 4; ++i) { v[2 * i] = bflo(a[i]) + bflo(bq[i]); v[2 * i + 1] = bfhi(a[i]) + bfhi(bq[i]); ss += v[2 * i] * v[2 * i] + v[2 * i + 1] * v[2 * i + 1]; }
    ss += __shfl_xor(ss, 1, 64); ss += __shfl_xor(ss, 2, 64); ss += __shfl_xor(ss, 4, 64);
    const float rn = rsqrtf(ss * (1.f / 64.f) + EPS);
    const int c0 = (lane & 7) * 8;
    u32x4 ov;
#pragma unroll
    for (int i = 0; i < 4; ++i) ov[i] = pk2(v[2 * i] * rn * p.gdn_norm_w[c0 + 2 * i] * bflo(gv[i]), v[2 * i + 1] * rn * p.gdn_norm_w[c0 + 2 * i + 1] * bfhi(gv[i]));
    *(u32x4*)(mix + (size_t)row * DM + lane * 8) = ov;
  }
}

struct EpiResid {
  const float* xin; float* xout; const float* gmod  ; int row0, col0;
  DI void operator()(f32x16 (&acc)[2][2], int wm, int wn, int lane) const {
    const int h = lane >> 5, cl = lane & 31;
#pragma unroll
    for (int mt = 0; mt < 2; ++mt) {
      const int row = row0 + wm * 64 + mt * 32 + cl;
      const float* gm = gmod + (size_t)(row >> 13) * 6144;
#pragma unroll
      for (int nt = 0; nt < 2; ++nt)
#pragma unroll
        for (int g = 0; g < 4; ++g) {
          const int col = col0 + wn * 64 + nt * 32 + 8 * g + 4 * h;
          const f32x4 xv = *(const f32x4*)(xin + (size_t)row * DM + col), g4 = *(const f32x4*)(gm + col);
          f32x4 ov;
#pragma unroll
          for (int r = 0; r < 4; ++r) ov[r] = xv[r] + g4[r] * acc[mt][nt][4 * g + r];
          *(f32x4*)(xout + (size_t)row * DM + col) = ov;
        }
    }
  }
};
DI void ph_gemm_resid(const P& p, char* lds, const bf16_t* A, const bf16_t* Bt, const float* xin, const float* gmod) {
  const int nM = TL / GBM, nN = DM / GBN;
  for (int t = blockIdx.x; t < nM * nN; t += gridDim.x) {
    const int pm = t / nN, pn = t % nN;
    RowLin rf{A + (size_t)pm * GBM * DM, (size_t)DM};
    EpiResid ep{xin, p.out, gmod, pm * GBM, pn * GBN};
    gemm_tile<true>(lds, rf, Bt + (size_t)pn * GBN * DM, DM, ep);
  }
}

struct EpiBf16 {
  bf16_t* o; int pitch, row0, col0;
  DI void operator()(f32x16 (&acc)[2][2], int wm, int wn, int lane) const {
    const int h = lane >> 5, cl = lane & 31;
#pragma unroll
    for (int mt = 0; mt < 2; ++mt) {
      const int row = row0 + wm * 64 + mt * 32 + cl;
#pragma unroll
      for (int nt = 0; nt < 2; ++nt)
#pragma unroll
        for (int g = 0; g < 4; ++g) {
          u32x2 v; v[0] = pk2(acc[mt][nt][4 * g], acc[mt][nt][4 * g + 1]); v[1] = pk2(acc[mt][nt][4 * g + 2], acc[mt][nt][4 * g + 3]);
          *(u32x2*)(o + (size_t)row * pitch + col0 + wn * 64 + nt * 32 + 8 * g + 4 * h) = v;
        }
    }
  }
};
DI void ph_gemm_scores(const P& p, char* lds, int layer, size_t sc_off) {
  const bf16_t* A = (const bf16_t*)(p.ws + R0); const bf16_t* Bt = (const bf16_t*)(p.ws + WS_WEFF) + (size_t)layer * 2048 * 1024;
  const int nM = TL / GBM, nN = 2048 / GBN;
  for (int t = blockIdx.x; t < nM * nN; t += gridDim.x) {
    const int pm = t / nN, pn = t % nN;
    RowLin rf{A + (size_t)pm * GBM * DM, (size_t)DM};
    EpiBf16 ep{(bf16_t*)(p.ws + sc_off), 2048, pm * GBM, pn * GBN};
    gemm_tile<true>(lds, rf, Bt + (size_t)pn * GBN * DM, DM, ep);
  }
}

constexpr size_t WS_TSC = WS_BA;
DI void ph_tables(const P& p) {
  const int lane = otid() & 63, gw = blockIdx.x * (NT / 64) + (otid() >> 6), nw_ = gridDim.x * (NT / 64);
  float* tsc = (float*)(p.ws + WS_TSC);
  for (int rr = gw; rr < 4 * 16384; rr += nw_) {
    const int tb = rr >> 14, e = rr & 16383;
    const float* src = ((tb & 1) ? p.peer_v : p.peer_u) + ((size_t)(tb >> 1) * 16384 + e) * 1024 + lane * 16;
    f32x4 v[4]; float ss = 0.f;
#pragma unroll
    for (int i = 0; i < 4; ++i) { v[i] = *(const f32x4*)(src + 4 * i); ss += v[i][0] * v[i][0] + v[i][1] * v[i][1] + v[i][2] * v[i][2] + v[i][3] * v[i][3]; }
    ss = wave_sum(ss);
    const bool isu = (tb & 1) == 0;
    const float sc = (isu ? 0.35f : 0.5f) * sqrtf(ss * (1.f / 1024.f)) + 1e-30f, inv = 1.f / sc;
    unsigned w0 = 0u, w1 = 0u;
    if (isu) {
#pragma unroll
      for (int i = 0; i < 2; ++i)
#pragma unroll
        for (int j = 0; j < 4; ++j) {
          const int qa = (int)fminf(fmaxf(rintf(v[i][j] * inv), -7.f), 7.f), qb = (int)fminf(fmaxf(rintf(v[2 + i][j] * inv), -7.f), 7.f);
          w0 |= ((unsigned)qa & 15u) << (4 * (4 * i + j)); w1 |= ((unsigned)qb & 15u) << (4 * (4 * i + j));
        }
    } else {
      w0 = __builtin_amdgcn_cvt_scalef32_pk_fp4_f32(w0, v[0][0] * inv, v[0][1] * inv, 1.0f, 0);
      w0 = __builtin_amdgcn_cvt_scalef32_pk_fp4_f32(w0, v[0][2] * inv, v[0][3] * inv, 1.0f, 1);
      w0 = __builtin_amdgcn_cvt_scalef32_pk_fp4_f32(w0, v[1][0] * inv, v[1][1] * inv, 1.0f, 2);
      w0 = __builtin_amdgcn_cvt_scalef32_pk_fp4_f32(w0, v[1][2] * inv, v[1][3] * inv, 1.0f, 3);
      w1 = __builtin_amdgcn_cvt_scalef32_pk_fp4_f32(w1, v[2][0] * inv, v[2][1] * inv, 1.0f, 0);
      w1 = __builtin_amdgcn_cvt_scalef32_pk_fp4_f32(w1, v[2][2] * inv, v[2][3] * inv, 1.0f, 1);
      w1 = __builtin_amdgcn_cvt_scalef32_pk_fp4_f32(w1, v[3][0] * inv, v[3][1] * inv, 1.0f, 2);
      w1 = __builtin_amdgcn_cvt_scalef32_pk_fp4_f32(w1, v[3][2] * inv, v[3][3] * inv, 1.0f, 3);
    }
    u32x2 o; o[0] = w0; o[1] = w1;
    unsigned char* dst = (unsigned char*)(p.ws + WS_TAB + (size_t)tb * 8 * MiB);
    *(u32x2*)(dst + ((((size_t)(lane >> 4)) * 16384 + e) << 7) + (lane & 15) * 8) = o;
    if (lane == 0) tsc[tb * 16384 + e] = sc;
  }
}

DI unsigned srt16(unsigned bf) { return (bf & 0x8000u) ? (~bf & 0xFFFFu) : (bf | 0x8000u); }
DI float unsrt16(unsigned s) { const unsigned bf = (s & 0x8000u) ? (s & 0x7FFFu) : (~s & 0xFFFFu); return __uint_as_float(bf << 16); }
DI unsigned ckey(float v, unsigned cid) { unsigned u = __float_as_uint(v); u = (u & 0x80000000u) ? ~u : (u | 0x80000000u); return (u & 0xFFFFFF00u) | (255u - cid); }
DI float unckey(unsigned k) { unsigned u = k & 0xFFFFFF00u; u = (u & 0x80000000u) ? (u & 0x7FFFFFFFu) : ~u; return __uint_as_float(u & 0xFFFFFF00u); }
DI void bsort16(unsigned (&k)[16]) {
#pragma unroll
  for (int sz = 2; sz <= 16; sz <<= 1)
#pragma unroll
    for (int j = sz >> 1; j > 0; j >>= 1)
#pragma unroll
      for (int i = 0; i < 16; ++i) {
        const int l = i ^ j;
        if (l > i) {
          const unsigned a = k[i], b = k[l], mx = a > b ? a : b, mn = a > b ? b : a;
          if ((i & sz) == 0) { k[i] = mx; k[l] = mn; } else { k[i] = mn; k[l] = mx; }
        }
      }
}
DI void bmerge16(unsigned (&k)[16]) {
#pragma unroll
  for (int j = 8; j > 0; j >>= 1)
#pragma unroll
    for (int i = 0; i < 16; ++i) {
      const int l = i ^ j;
      if (l > i) { const unsigned a = k[i], b = k[l]; k[i] = a > b ? a : b; k[l] = a > b ? b : a; }
    }
}
DI void topmerge16(unsigned (&run)[16], const unsigned (&g)[16]) {
#pragma unroll
  for (int i = 0; i < 16; ++i) run[i] = run[i] > g[15 - i] ? run[i] : g[15 - i];
  bmerge16(run);
}
DI void top16_of_128(const bf16_t* __restrict__ r, unsigned (&run)[16]) {
#pragma unroll 1
  for (int g = 0; g < 8; ++g) {
    const u32x4 v0 = *(const u32x4*)(r + g * 16), v1 = *(const u32x4*)(r + g * 16 + 8);
    unsigned k[16];
#pragma unroll
    for (int q = 0; q < 4; ++q) {
      k[2 * q] = (srt16(v0[q] & 0xFFFFu) << 16) | (127u - (g * 16 + 2 * q));
      k[2 * q + 1] = (srt16(v0[q] >> 16) << 16) | (127u - (g * 16 + 2 * q + 1));
      k[8 + 2 * q] = (srt16(v1[q] & 0xFFFFu) << 16) | (127u - (g * 16 + 8 + 2 * q));
      k[8 + 2 * q + 1] = (srt16(v1[q] >> 16) << 16) | (127u - (g * 16 + 8 + 2 * q + 1));
    }
    bsort16(k);
    if (g == 0) {
#pragma unroll
      for (int i = 0; i < 16; ++i) run[i] = k[i];
    } else topmerge16(run, k);
  }
}
DI void ph_topk(const P& p, char* lds, size_t sc_off, size_t ei_off, size_t eg_off) {
  const bf16_t* sc = (const bf16_t*)(p.ws + sc_off); int* EI = (int*)(p.ws + ei_off); float* EG = (float*)(p.ws + eg_off);
  unsigned char* sI = (unsigned char*)lds;
  const int tid = otid();
  const int tpb_ = TL / gridDim.x;
  for (int g = blockIdx.x * tpb_ * 8 + tid; g < (blockIdx.x + 1) * tpb_ * 8; g += NT) {
    const int t = g >> 3, head = g & 7;
    const bf16_t* r1 = sc + (size_t)t * 2048 + head * 256;
    unsigned k1[16], k2[16];
    top16_of_128(r1, k1);
    top16_of_128(r1 + 128, k2);
    float f1[16], f2[16];
#pragma unroll
    for (int i = 0; i < 16; ++i) { f1[i] = unsrt16(k1[i] >> 16); f2[i] = unsrt16(k2[i] >> 16); sI[i * NT + tid] = (unsigned char)(127u - (k1[i] & 127u)); sI[(16 + i) * NT + tid] = (unsigned char)(127u - (k2[i] & 127u)); }
    unsigned cg0[16], cg1[16], cg2[16], cg3[16];
#pragma unroll
    for (int i = 0; i < 16; ++i) { cg3[i] = 0u; }
    cg0[0] = ckey(f1[0] + f2[0], 0);
    cg0[1] = ckey(f1[0] + f2[1], 1);
    cg0[2] = ckey(f1[0] + f2[2], 2);
    cg0[3] = ckey(f1[0] + f2[3], 3);
    cg0[4] = ckey(f1[0] + f2[4], 4);
    cg0[5] = ckey(f1[0] + f2[5], 5);
    cg0[6] = ckey(f1[0] + f2[6], 6);
    cg0[7] = ckey(f1[0] + f2[7], 7);
    cg0[8] = ckey(f1[0] + f2[8], 8);
    cg0[9] = ckey(f1[0] + f2[9], 9);
    cg0[10] = ckey(f1[0] + f2[10], 10);
    cg0[11] = ckey(f1[0] + f2[11], 11);
    cg0[12] = ckey(f1[0] + f2[12], 12);
    cg0[13] = ckey(f1[0] + f2[13], 13);
    cg0[14] = ckey(f1[0] + f2[14], 14);
    cg0[15] = ckey(f1[0] + f2[15], 15);
    cg1[0] = ckey(f1[1] + f2[0], 16);
    cg1[1] = ckey(f1[1] + f2[1], 17);
    cg1[2] = ckey(f1[1] + f2[2], 18);
    cg1[3] = ckey(f1[1] + f2[3], 19);
    cg1[4] = ckey(f1[1] + f2[4], 20);
    cg1[5] = ckey(f1[1] + f2[5], 21);
    cg1[6] = ckey(f1[1] + f2[6], 22);
    cg1[7] = ckey(f1[1] + f2[7], 23);
    cg1[8] = ckey(f1[2] + f2[0], 32);
    cg1[9] = ckey(f1[2] + f2[1], 33);
    cg1[10] = ckey(f1[2] + f2[2], 34);
    cg1[11] = ckey(f1[2] + f2[3], 35);
    cg1[12] = ckey(f1[2] + f2[4], 36);
    cg1[13] = ckey(f1[3] + f2[0], 48);
    cg1[14] = ckey(f1[3] + f2[1], 49);
    cg1[15] = ckey(f1[3] + f2[2], 50);
    cg2[0] = ckey(f1[3] + f2[3], 51);
    cg2[1] = ckey(f1[4] + f2[0], 64);
    cg2[2] = ckey(f1[4] + f2[1], 65);
    cg2[3] = ckey(f1[4] + f2[2], 66);
    cg2[4] = ckey(f1[5] + f2[0], 80);
    cg2[5] = ckey(f1[5] + f2[1], 81);
    cg2[6] = ckey(f1[6] + f2[0], 96);
    cg2[7] = ckey(f1[6] + f2[1], 97);
    cg2[8] = ckey(f1[7] + f2[0], 112);
    cg2[9] = ckey(f1[7] + f2[1], 113);
    cg2[10] = ckey(f1[8] + f2[0], 128);
    cg2[11] = ckey(f1[9] + f2[0], 144);
    cg2[12] = ckey(f1[10] + f2[0], 160);
    cg2[13] = ckey(f1[11] + f2[0], 176);
    cg2[14] = ckey(f1[12] + f2[0], 192);
    cg2[15] = ckey(f1[13] + f2[0], 208);
    cg3[0] = ckey(f1[14] + f2[0], 224);
    cg3[1] = ckey(f1[15] + f2[0], 240);
    bsort16(cg0); bsort16(cg1); bsort16(cg2); bsort16(cg3);
    topmerge16(cg0, cg1); topmerge16(cg2, cg3); topmerge16(cg0, cg2);
    float e[16]; int id[16]; float sum = 0.f; const float s0 = unckey(cg0[0]);
#pragma unroll
    for (int k = 0; k < 16; ++k) {
      const unsigned cid = 255u - (cg0[k] & 255u);
      e[k] = __expf(unckey(cg0[k]) - s0); sum += e[k];
      id[k] = (int)sI[(cid >> 4) * NT + tid] * 128 + (int)sI[(16 + (cid & 15)) * NT + tid];
    }
    const float inv = 1.f / sum;
#pragma unroll
    for (int k = 0; k < 16; k += 4) {
      int4 iv = {id[k], id[k + 1], id[k + 2], id[k + 3]}; f32x4 gv = {e[k] * inv, e[k + 1] * inv, e[k + 2] * inv, e[k + 3] * inv};
      *(int4*)(EI + (size_t)g * 16 + k) = iv; *(f32x4*)(EG + (size_t)g * 16 + k) = gv;
    }
  }
}

DI void fp8x16_to_f32(const u32x4& w, float (&f)[16]) {
#pragma unroll
  for (int i = 0; i < 4; ++i) {
    const f32x2_t lo = __builtin_amdgcn_cvt_pk_f32_fp8((int)w[i], false), hi = __builtin_amdgcn_cvt_pk_f32_fp8((int)w[i], true);
    f[4 * i] = lo[0]; f[4 * i + 1] = lo[1]; f[4 * i + 2] = hi[0]; f[4 * i + 3] = hi[1];
  }
}
DI void block_handoff() {
  asm volatile("s_waitcnt vmcnt(0)" ::: "memory");
  __syncthreads();
  if (otid() == 0) { __builtin_amdgcn_fence(__ATOMIC_ACQUIRE, "agent"); asm volatile("s_waitcnt vmcnt(0)" ::: "memory"); }
  __syncthreads();
}
constexpr int PQ_NS = 4;
#define PQ_BEGIN() \
  const int tid = otid(), lane = tid & 63, wave = tid >> 6, g8 = lane >> 3, c16 = lane & 7; \
  const int tpb_ = TL / gridDim.x; \
  _Pragma("unroll 1") for (int x = 0; x < PQ_NS; ++x) { \
    const int tbeg = blockIdx.x * tpb_ + wave, tend = (blockIdx.x + 1) * tpb_;
#define PQ_END() }
#define FP4X8(wd, o0, o1, o2, o3) do { o0 = __builtin_amdgcn_cvt_scalef32_pk_f32_fp4((wd), 1.0f, 0); o1 = __builtin_amdgcn_cvt_scalef32_pk_f32_fp4((wd), 1.0f, 1); \
                                         o2 = __builtin_amdgcn_cvt_scalef32_pk_f32_fp4((wd), 1.0f, 2); o3 = __builtin_amdgcn_cvt_scalef32_pk_f32_fp4((wd), 1.0f, 3); } while (0)
DI void ph_peer_u(const P& p, char* lds, int layer, size_t ei_off, size_t part_off) {
  for (int rep = 0; rep <= p.lo; ++rep) {
  PQ_BEGIN()
  const unsigned char* hq = (const unsigned char*)(p.ws + WS_HQ) + x * 128 + c16 * 16;
  const float* hs = (const float*)(p.ws + WS_HS);
  const unsigned char* us = (const unsigned char*)(p.ws + WS_TAB + (size_t)(layer * 2) * 8 * MiB) + ((size_t)x * 16384 << 7) + c16 * 16;
  const int* EI = (const int*)(p.ws + ei_off) + g8 * 16;
  unsigned* part = (unsigned*)(p.ws + part_off);
  int4 nid[4]; u32x4 nhh, nhl; float nsc;
#define PU_PREF(tt) do { const int t_ = (tt) < tend ? (tt) : tend - 1; \
    _Pragma("unroll") for (int i = 0; i < 4; ++i) nid[i] = *(const int4*)(EI + (size_t)t_ * 128 + i * 4); \
    nhh = *(const u32x4*)(hq + (size_t)t_ * 1024); nhl = *(const u32x4*)(hq + (size_t)t_ * 1024 + 512); nsc = hs[t_]; } while (0)
  PU_PREF(tbeg);
#pragma unroll 1
  for (int t = tbeg; t < tend; t += NT / 64) {
    int id[16];
#pragma unroll
    for (int i = 0; i < 4; ++i) { id[4 * i] = nid[i].x; id[4 * i + 1] = nid[i].y; id[4 * i + 2] = nid[i].z; id[4 * i + 3] = nid[i].w; }
    const u32x4 hh = nhh, hl = nhl; const float sct = nsc;
    u32x4 ur[16];
#pragma unroll
    for (int i = 0; i < 16; ++i) ur[i] = *(const u32x4*)(us + ((size_t)id[i] << 7));
    float pd[16];
#pragma unroll
    for (int i = 0; i < 16; ++i) {
      int ah = 0, al = 0;
#pragma unroll
      for (int w = 0; w < 4; ++w) { ah = __builtin_amdgcn_sdot8((int)ur[i][w], (int)hh[w], ah, false); al = __builtin_amdgcn_sdot8((int)ur[i][w], (int)hl[w], al, false); }
      pd[i] = (float)(16 * ah + al);
    }
    PU_PREF(t + NT / 64);
    float q8[8], q4[4], q2[2];
    { const bool up = (lane & 4) != 0;
#pragma unroll
      for (int m = 0; m < 8; ++m) { const float keep = up ? pd[8 + m] : pd[m], send = up ? pd[m] : pd[8 + m]; q8[m] = keep + __shfl_xor(send, 4, 64); } }
    { const bool up = (lane & 2) != 0;
#pragma unroll
      for (int m = 0; m < 4; ++m) { const float keep = up ? q8[4 + m] : q8[m], send = up ? q8[m] : q8[4 + m]; q4[m] = keep + __shfl_xor(send, 2, 64); } }
    { const bool up = (lane & 1) != 0;
#pragma unroll
      for (int m = 0; m < 2; ++m) { const float keep = up ? q4[2 + m] : q4[m], send = up ? q4[m] : q4[2 + m]; q2[m] = keep + __shfl_xor(send, 1, 64); } }
    part[((size_t)t * PQ_NS + x) * 64 + lane] = pk2(q2[0] * sct, q2[1] * sct);
  }
  PQ_END()
  }
#undef PU_PREF
}
DI void ph_peer_comb(const P& p, int layer, size_t part_off, size_t ei_off, size_t eg_off, size_t w_off) {
  const unsigned* part = (const unsigned*)(p.ws + part_off); const float* EG = (const float*)(p.ws + eg_off); const int* EI = (const int*)(p.ws + ei_off); float* W = (float*)(p.ws + w_off);
  const float* su = (const float*)(p.ws + WS_TSC) + (size_t)(layer * 2) * 16384; const float* sv = su + 16384;
  const int tpbc_ = TL / gridDim.x;
  for (int g = blockIdx.x * tpbc_ * 64 + otid(); g < (blockIdx.x + 1) * tpbc_ * 64; g += NT) {
    const int t = g >> 6, j = g & 63;
    float d0 = 0.f, d1 = 0.f;
#pragma unroll
    for (int x = 0; x < PQ_NS; ++x) { const unsigned v = part[((size_t)t * PQ_NS + x) * 64 + j]; d0 += bflo(v); d1 += bfhi(v); }
    const f32x2_t gt = *(const f32x2_t*)(EG + (size_t)t * 128 + 2 * j);
    const int e0 = EI[(size_t)t * 128 + 2 * j], e1 = EI[(size_t)t * 128 + 2 * j + 1];
    f32x2_t o; o[0] = gelu_tanh(d0 * su[e0]) * gt[0] * sv[e0]; o[1] = gelu_tanh(d1 * su[e1]) * gt[1] * sv[e1];
    *(f32x2_t*)(W + (size_t)t * 128 + 2 * j) = o;
  }
}
DI void ph_peer_v(const P& p, char* lds, int layer, size_t ei_off, size_t w_off) {
  PQ_BEGIN()
  const unsigned char* vs = (const unsigned char*)(p.ws + WS_TAB + (size_t)(layer * 2 + 1) * 8 * MiB) + ((size_t)x * 16384 << 7) + c16 * 16;
  const int* EI = (const int*)(p.ws + ei_off) + g8 * 16; const float* W = (const float*)(p.ws + w_off) + g8 * 16;
  const float* modb = (const float*)(p.ws + WS_MOD) + (size_t)layer * 5 * 6144;
  const int col = x * 256 + 32 * (lane & 7) + 4 * (lane >> 3);
  int4 nid[4]; f32x4 nw[4];
#define PV_PREF(tt) do { const int t_ = (tt) < tend ? (tt) : tend - 1; \
    _Pragma("unroll") for (int i = 0; i < 4; ++i) { nid[i] = *(const int4*)(EI + (size_t)t_ * 128 + i * 4); nw[i] = *(const f32x4*)(W + (size_t)t_ * 128 + i * 4); } } while (0)
  PV_PREF(tbeg);
#pragma unroll 1
  for (int t = tbeg; t < tend; t += NT / 64) {
    int id[16]; float wv[16];
#pragma unroll
    for (int i = 0; i < 4; ++i) { id[4 * i] = nid[i].x; id[4 * i + 1] = nid[i].y; id[4 * i + 2] = nid[i].z; id[4 * i + 3] = nid[i].w; wv[4 * i] = nw[i][0]; wv[4 * i + 1] = nw[i][1]; wv[4 * i + 2] = nw[i][2]; wv[4 * i + 3] = nw[i][3]; }
    u32x4 vr[16];
#pragma unroll
    for (int i = 0; i < 16; ++i) vr[i] = *(const u32x4*)(vs + ((size_t)id[i] << 7));
    f32x2_t acc2[16];
#pragma unroll
    for (int j = 0; j < 16; ++j) acc2[j] = f32x2_t{0.f, 0.f};
#pragma unroll
    for (int i = 0; i < 16; ++i) {
      const f32x2_t w2 = {wv[i], wv[i]};
#pragma unroll
      for (int w = 0; w < 4; ++w) {
        f32x2_t f0, f1, f2, f3; FP4X8(vr[i][w], f0, f1, f2, f3);
        acc2[4 * w] = f0 * w2 + acc2[4 * w]; acc2[4 * w + 1] = f1 * w2 + acc2[4 * w + 1]; acc2[4 * w + 2] = f2 * w2 + acc2[4 * w + 2]; acc2[4 * w + 3] = f3 * w2 + acc2[4 * w + 3];
      }
    }
    PV_PREF(t + NT / 64);
    float acc[32];
#pragma unroll
    for (int j = 0; j < 16; ++j) { acc[2 * j] = acc2[j][0]; acc[2 * j + 1] = acc2[j][1]; }
    float q16[16], q8[8], q4[4];
    { const bool up = (lane & 32) != 0;
#pragma unroll
      for (int m = 0; m < 16; ++m) { const float keep = up ? acc[16 + m] : acc[m], send = up ? acc[m] : acc[16 + m]; q16[m] = keep + __shfl_xor(send, 32, 64); } }
    { const bool up = (lane & 16) != 0;
#pragma unroll
      for (int m = 0; m < 8; ++m) { const float keep = up ? q16[8 + m] : q16[m], send = up ? q16[m] : q16[8 + m]; q8[m] = keep + __shfl_xor(send, 16, 64); } }
    { const bool up = (lane & 8) != 0;
#pragma unroll
      for (int m = 0; m < 4; ++m) { const float keep = up ? q8[4 + m] : q8[m], send = up ? q8[m] : q8[4 + m]; q4[m] = keep + __shfl_xor(send, 8, 64); } }
    float* xr = p.out + (size_t)t * DM + col;
    const f32x4 xv = *(const f32x4*)xr, g2 = *(const f32x4*)(modb + (size_t)(t >> 13) * 6144 + 5 * 1024 + col);
    f32x4 ov;
#pragma unroll
    for (int m = 0; m < 4; ++m) ov[m] = xv[m] + g2[m] * q4[m];
    *(f32x4*)xr = ov;
  }
  PQ_END()
#undef PV_PREF
}
DI void ph_final_norm(const P& p, int r0, int r1) {
  const int lane = otid() & 63;
  for (int row = r0 + (otid() >> 6); row < r1; row += NT / 64) {
    float* xr = p.out + (size_t)row * DM;
    f32x4 xv[4]; float ss = 0.f;
#pragma unroll
    for (int i = 0; i < 4; ++i) { xv[i] = *(const f32x4*)(xr + lane * 4 + 256 * i); ss += xv[i][0] * xv[i][0] + xv[i][1] * xv[i][1] + xv[i][2] * xv[i][2] + xv[i][3] * xv[i][3]; }
    ss = wave_sum(ss);
    const float rs = rsqrtf(ss * (1.f / DM) + EPS);
#pragma unroll
    for (int i = 0; i < 4; ++i) { const f32x4 w4 = *(const f32x4*)(p.final_norm_w + lane * 4 + 256 * i); *(f32x4*)(xr + lane * 4 + 256 * i) = xv[i] * rs * w4; }
  }
}

struct RowFft0 { const bf16_t* base; DI const bf16_t* operator()(int r) const { return base + ((size_t)128 * (r & 63) + (r >> 6)) * DM; } };
struct EpiFft0 {
  bf16_t* zt; int bg, l20, col0;
  DI void operator()(f32x16 (&acc)[2][2], int wm, int wn, int lane) const {
    const int h = lane >> 5, cl = lane & 31;
#pragma unroll
    for (int mt = 0; mt < 2; ++mt)
#pragma unroll
      for (int nt = 0; nt < 2; ++nt) {
        const int n = col0 + wn * 64 + nt * 32 + cl, ri = n >> 8, mm = n & 255;
#pragma unroll
        for (int g = 0; g < 4; ++g) {
          const int r = wm * 64 + mt * 32 + 8 * g + 4 * h, l1 = r & 63, l2 = l20 + (r >> 6);
          u32x2 v; v[0] = pk2(acc[mt][nt][4 * g], acc[mt][nt][4 * g + 1]); v[1] = pk2(acc[mt][nt][4 * g + 2], acc[mt][nt][4 * g + 3]);
          *(u32x2*)(zt + (((size_t)(bg * 256 + mm) * 128 + l2) * 128 + ri * 64 + l1)) = v;
        }
      }
  }
};
DI void ph_fft0(const P& p, char* lds) {
  const bf16_t* h1 = (const bf16_t*)(p.ws + R0); const bf16_t* Bt = (const bf16_t*)(p.ws + WS_DFT0);
  for (int t = blockIdx.x; t < NB * 4 * 32 * 4; t += gridDim.x) {
    const int pn = t & 3, l2b = (t >> 2) & 31, g = (t >> 7) & 3, b = t >> 9;
    RowFft0 rf{h1 + ((size_t)b * SEQ + l2b * 4) * DM + g * 256};
    EpiFft0 ep{(bf16_t*)(p.ws + WS_ZT), b * 4 + g, l2b * 4, pn * GBN};
    gemm_tile<false>(lds, rf, Bt + (size_t)pn * GBN * 256, 256, ep);
  }
}
struct EpiFft1 {
  bf16_t* a2; int row0;
  DI void operator()(f32x16 (&acc)[2][2], int wm, int wn, int lane) const {
    const int h = lane >> 5, cl = lane & 31, k1 = 32 * wn + cl;
#pragma unroll
    for (int mt = 0; mt < 2; ++mt)
#pragma unroll
      for (int g = 0; g < 4; ++g) {
        const int R = row0 + wm * 64 + mt * 32 + 8 * g + 4 * h, l2 = R & 127, mm = (R >> 7) & 255, bg = R >> 15;
        float yr[4], yi[4];
#pragma unroll
        for (int q = 0; q < 4; ++q) {
          const float fr = (float)((l2 + q) * k1) * (1.f / 8192.f);
          const float cs = __builtin_amdgcn_cosf(fr), sn = __builtin_amdgcn_sinf(fr);
          const float ar = acc[mt][0][4 * g + q], ai = acc[mt][1][4 * g + q];
          yr[q] = ar * cs + ai * sn; yi[q] = ai * cs - ar * sn;
        }
        bf16_t* o = a2 + (((size_t)(bg * 64 + k1) * 256 + mm) * 256 + l2);
        u32x2 v; v[0] = pk2(yr[0], yr[1]); v[1] = pk2(yr[2], yr[3]); *(u32x2*)o = v;
        v[0] = pk2(yi[0], yi[1]); v[1] = pk2(yi[2], yi[3]); *(u32x2*)(o + 128) = v;
      }
  }
};
DI void ph_fft1(const P& p, char* lds) {
  const bf16_t* zt = (const bf16_t*)(p.ws + WS_ZT); const bf16_t* Bt = (const bf16_t*)(p.ws + WS_DFT1);
  const int nM = 16 * 256 * 128 / GBM;
  for (int t = blockIdx.x; t < nM; t += gridDim.x) {
    RowLin rf{zt + (size_t)t * GBM * 128, (size_t)128};
    EpiFft1 ep{(bf16_t*)(p.ws + WS_A2), t * GBM};
    gemm_tile<false>(lds, rf, Bt, 128, ep);
  }
}
struct EpiFft3 {
  bf16_t* fm; int row0;
  DI void operator()(f32x16 (&acc)[2][2], int wm, int wn, int lane) const {
    const int h = lane >> 5, cl = lane & 31;
#pragma unroll
    for (int mt = 0; mt < 2; ++mt)
#pragma unroll
      for (int nt = 0; nt < 2; ++nt) {
        const int k2 = wn * 64 + nt * 32 + cl;
#pragma unroll
        for (int g = 0; g < 4; ++g) {
          const int R = row0 + wm * 64 + mt * 32 + 8 * g + 4 * h, mm = R & 255, k1 = (R >> 8) & 63, bg = R >> 14;
          u32x2 v; v[0] = pk2(acc[mt][nt][4 * g], acc[mt][nt][4 * g + 1]); v[1] = pk2(acc[mt][nt][4 * g + 2], acc[mt][nt][4 * g + 3]);
          *(u32x2*)(fm + ((size_t)((bg >> 2) * SEQ + k1 + 64 * k2)) * DM + (bg & 3) * 256 + mm) = v;
        }
      }
  }
};
DI void ph_fft3(const P& p, char* lds) {
  const bf16_t* a2 = (const bf16_t*)(p.ws + WS_A2); const bf16_t* Bt = (const bf16_t*)(p.ws + WS_DFT3);
  const int nM = 16 * 64 * 256 / GBM;
  for (int t = blockIdx.x; t < nM; t += gridDim.x) {
    RowLin rf{a2 + (size_t)t * GBM * 256, (size_t)256};
    EpiFft3 ep{(bf16_t*)(p.ws + WS_FM), t * GBM};
    gemm_tile<false>(lds, rf, Bt, 256, ep);
  }
}

constexpr int NPHASE = 19;
template <int PH>
DI void run_phase(const P& p, char* lds) {
  const float* modL = (const float*)(p.ws + WS_MOD);
  const int tpb = TL / gridDim.x, t0 = blockIdx.x * tpb, t1 = t0 + tpb;
  if constexpr (PH == 0) ph_setup(p, lds);
  else if constexpr (PH == 1) { norm_rows_i8(p.x, 0, TL, p.norm1_w, modL, false, (unsigned char*)(p.ws + R0), (float*)(p.ws + WS_HS0));
                                norm_rows_i8(p.ctx - (size_t)TL * DM, TL, TA, p.norm1_w, modL, true, (unsigned char*)(p.ws + R0), (float*)(p.ws + WS_HS0));
                                quant_rows_i8((const bf16_t*)(p.ws + WS_WIN), NIN, (unsigned char*)(p.ws + WS_WIN8), (float*)(p.ws + WS_SWIN)); }
  else if constexpr (PH == 2) { PgProj ep{&p}; pg8_run_i8(lds, p.ws + R0, p.ws + WS_WIN8, TA, NIN, 1024, ep); }
  else if constexpr (PH == 3) ph_gdn_prep<0>(p, lds);
  else if constexpr (PH == 4) ph_gdn_scan<0>(p, lds);
  else if constexpr (PH == 5) { ph_attn(p, lds); ph_mixout(p); }
  else if constexpr (PH == 6) { PgResid ep{p.x, p.out, modL + 2 * 1024}; pg8_run(lds, (const bf16_t*)(p.ws + WS_MIX), (const bf16_t*)(p.ws + WS_WOUT), TL, DM, DM, ep); }
  else if constexpr (PH == 7) { norm_rows_hq(p, p.norm2_w, modL); quant_rows_i8((const bf16_t*)(p.ws + WS_WEFF), 4096, (unsigned char*)(p.ws + WS_WEFF8), (float*)(p.ws + WS_SW)); ph_tables(p); }
  else if constexpr (PH == 8) { PgScoreI8 ep{(bf16_t*)(p.ws + WS_SC0), (const float*)(p.ws + WS_HS), (const float*)(p.ws + WS_SW)}; pg8_run_i8(lds, p.ws + R0, p.ws + WS_WEFF8, TL, 2048, 1024, ep); }
  else if constexpr (PH == 9) { ph_topk(p, lds, WS_SC0, WS_EI0, WS_EG0); block_handoff(); ph_peer_u(p, lds, 0, WS_EI0, WS_PART0); }
  else if constexpr (PH == 10) { ph_peer_comb(p, 0, WS_PART0, WS_EI0, WS_EG0, WS_W0); block_handoff(); ph_peer_v(p, lds, 0, WS_EI0, WS_W0); block_handoff();
                                 norm_rows(p.out, t0, t1, p.norm1_w + DM, modL + 5 * 6144, 0, 1, false, (bf16_t*)(p.ws + R0), true); }
  else if constexpr (PH == 11) ph_fft0(p, lds);
  else if constexpr (PH == 12) ph_fft1(p, lds);
  else if constexpr (PH == 13) ph_fft3(p, lds);
  else if constexpr (PH == 14) { PgResid ep{p.out, p.out, modL + 5 * 6144 + 2 * 1024}; pg8_run(lds, (const bf16_t*)(p.ws + WS_FM), (const bf16_t*)(p.ws + WS_WF), TL, DM, DM, ep); }
  else if constexpr (PH == 15) norm_rows_hq(p, p.norm2_w + DM, modL + 5 * 6144);
  else if constexpr (PH == 16) { PgScoreI8 ep{(bf16_t*)(p.ws + WS_SC1), (const float*)(p.ws + WS_HS), (const float*)(p.ws + WS_SW) + 2048}; pg8_run_i8(lds, p.ws + R0, p.ws + WS_WEFF8 + (size_t)2048 * 1024, TL, 2048, 1024, ep); }
  else if constexpr (PH == 17) { ph_topk(p, lds, WS_SC1, WS_EI1, WS_EG1); block_handoff(); ph_peer_u(p, lds, 1, WS_EI1, WS_PART1); }
  else if constexpr (PH == 18) { ph_peer_comb(p, 1, WS_PART1, WS_EI1, WS_EG1, WS_W1); block_handoff(); ph_peer_v(p, lds, 1, WS_EI1, WS_W1); block_handoff(); ph_final_norm(p, t0, t1); }
}
#define XB_TMO      128
#define XB_XCNT(j)  (256  + 64 * (j))
#define XB_XSUB(j)  (1280 + 64 * (j))
#define XB_XGEN(j)  (2304 + 64 * (j))
#define XB_TOP      3328
#define XB_TOPGEN   3392
#define XCD_BAR_WORDS 3456
#define XB_SPIN_CAP (1u << 22)
#define LAS __attribute__((address_space(3)))
#define XB_SPIN(cond, bar) do { unsigned _sp = 0; while (cond) { __builtin_amdgcn_s_sleep(1); \
    if ((++_sp & 255u) == 0u) { if (xb_ld(&(bar)[XB_TMO])) break; if (_sp > XB_SPIN_CAP) { atomicAdd(&(bar)[XB_TMO], 1u); break; } } } } while (0)
struct XcdBarrier { unsigned* bar; unsigned x; volatile LAS unsigned* st; };
DI XcdBarrier xcd_barrier_post(unsigned* bar, volatile LAS unsigned* st) {
  XcdBarrier b; b.bar = bar; b.x = xb_xcc_id(); b.st = st;
  if (threadIdx.x == 0) (void)xb_add(&bar[XB_XCNT(b.x)], 1u);
  return b;
}
DI void xcd_barrier_complete(unsigned* bar, unsigned x, unsigned& nloc, unsigned& nx) {
  const unsigned G = gridDim.x * gridDim.y * gridDim.z;
  unsigned sum, cnt, mine, sp = 0u;
  for (;;) {
    sum = 0u; cnt = 0u; mine = 0u;
#pragma unroll
    for (unsigned j = 0; j < 16; ++j) { const unsigned c = xb_ld(&bar[XB_XCNT(j)]); sum += c; cnt += (c > 0u) ? 1u : 0u; mine = (j == x) ? c : mine; }
    if (sum == G) break;
    __builtin_amdgcn_s_sleep(1);
    if ((++sp & 255u) == 0u) { if (xb_ld(&bar[XB_TMO])) break; if (sp > XB_SPIN_CAP) { atomicAdd(&bar[XB_TMO], 1u); break; } }
  }
  nloc = mine > 0u ? mine : 1u; nx = cnt > 0u ? cnt : 1u;
}
DI void xcd_barrier(const XcdBarrier& b) {
  asm volatile("s_waitcnt vmcnt(0)" ::: "memory");
  __syncthreads();
  if (threadIdx.x == 0) {
    unsigned* bar = b.bar;
    __builtin_amdgcn_s_waitcnt(0);
    unsigned nloc = b.st[0], nx = b.st[1];
    if (nloc == 0u) { xcd_barrier_complete(bar, b.x, nloc, nx); b.st[0] = nloc; b.st[1] = nx; }
    const unsigned old = xb_add(&bar[XB_XSUB(b.x)], 1u);
    const unsigned gen = old / nloc;
    if (old + 1u == (gen + 1u) * nloc) {
      __builtin_amdgcn_fence(__ATOMIC_RELEASE, "agent");
      asm volatile("s_waitcnt vmcnt(0)" ::: "memory");
      const unsigned og = xb_add(&bar[XB_TOP], 1u);
      const unsigned tg = og / nx;
      if (og + 1u == (tg + 1u) * nx) xb_add(&bar[XB_TOPGEN], 1u);
      else XB_SPIN(xb_ld(&bar[XB_TOPGEN]) == tg, bar);
      __builtin_amdgcn_fence(__ATOMIC_ACQUIRE, "agent");
      xb_add(&bar[XB_XGEN(b.x)], 1u);
      asm volatile("s_waitcnt vmcnt(0)" ::: "memory");
    } else {
      XB_SPIN(xb_ld(&bar[XB_XGEN(b.x)]) == gen, bar);
      __builtin_amdgcn_fence(__ATOMIC_ACQUIRE, "agent");
      asm volatile("s_waitcnt vmcnt(0)" ::: "memory");
    }
  }
  __syncthreads();
}

constexpr int EXTRA_PHASE = -1;
constexpr int PROBE_MODE = 0;
template <int PH>
DI void run_all(const P& p, char* lds, const XcdBarrier& bar) {
  run_phase<PH>(p, lds);
  if constexpr (PH == EXTRA_PHASE) {
    xcd_barrier(bar);
    if constexpr (PH == 3) ph_gdn_prep<PROBE_MODE>(p, lds);
    else if constexpr (PH == 4) ph_gdn_scan<PROBE_MODE>(p, lds);
    else run_phase<PH>(p, lds);
  }
  if constexpr (PH + 1 < NPHASE) {
    if constexpr (PH == 0) { cg::this_grid().sync(); }
    else xcd_barrier(bar);
    run_all<PH + 1>(p, lds, bar);
  }
}
__global__ void __launch_bounds__(NT) mega(P p) {
  extern __shared__ __attribute__((aligned(16))) char lds[];
  volatile LAS unsigned* st = (volatile LAS unsigned*)(lds + LDS_BYTES - 16);
  if (threadIdx.x == 0) { st[0] = 0u; st[1] = 0u; }
  __syncthreads();
  XcdBarrier bar = xcd_barrier_post((unsigned*)(p.ws + WS_CTL), st);
  run_all<0>(p, lds, bar);
}

extern "C" void kernel_launch(void* const* d_in, const int* in_sizes, int n_in, void* d_out, int out_size, void* d_ws, size_t ws_size, hipStream_t stream) {
  static int grid = 0;
  if (grid == 0) {
    if (n_in != 25 || ws_size < WS_END) { fprintf(stderr, "kernel_launch: unexpected n_in %d or ws_size %zu\n", n_in, ws_size); grid = -1; return; }
    int dev = 0, cus = 0, per_cu = 0;
    (void)hipGetDevice(&dev); (void)hipDeviceGetAttribute(&cus, hipDeviceAttributeMultiprocessorCount, dev);
    (void)hipFuncSetAttribute((const void*)mega, hipFuncAttributeMaxDynamicSharedMemorySize, LDS_BYTES);
    if (hipOccupancyMaxActiveBlocksPerMultiprocessor(&per_cu, (const void*)mega, NT, LDS_BYTES) != hipSuccess || per_cu < 1) { fprintf(stderr, "kernel_launch: occupancy query failed (%d)\n", per_cu); per_cu = 1; }
    (void)hipGetLastError();
    if (per_cu > 1) per_cu = 1;
    grid = (cus > 0 ? cus : 256) * per_cu;
  }
  if (grid < 0) return;
  (void)hipMemsetAsync((char*)d_ws + WS_CTL, 0, CTL_ZERO_BYTES, stream);
  P p{};
  const float** pf = (const float**)&p;
  for (int i = 0; i < 25; ++i) pf[i] = (const float*)d_in[i];
  p.out = (float*)d_out; p.ws = (char*)d_ws; p.lo = 0; p.hi = NPHASE;
  void* args[] = {&p};
  hipError_t e = hipLaunchCooperativeKernel((const void*)mega, dim3(grid), dim3(NT), args, LDS_BYTES, stream);
  if (e != hipSuccess) fprintf(stderr, "cooperative launch failed: %s (grid %d)\n", hipGetErrorString(e), grid);
}
```

```cpp
#include <hip/hip_runtime.h>
#include <hip/hip_cooperative_groups.h>
#include <cstdio>
#include <cstdint>
namespace cg = cooperative_groups;

#define DI __device__ __forceinline__
typedef unsigned short bf16_t;
typedef short bf16x8 __attribute__((ext_vector_type(8)));
typedef short s16x4 __attribute__((ext_vector_type(4)));
typedef float f32x16 __attribute__((ext_vector_type(16)));
typedef float f32x4 __attribute__((ext_vector_type(4)));
typedef float f32x2_t __attribute__((ext_vector_type(2)));
typedef __bf16 bf16x2_t __attribute__((ext_vector_type(2)));
typedef unsigned u32x4 __attribute__((ext_vector_type(4)));
typedef unsigned u32x2 __attribute__((ext_vector_type(2)));
typedef int v8i_t __attribute__((ext_vector_type(8)));

constexpr int NB = 4, SEQ = 8192, DM = 1024, CTXL = 256;
constexpr int TL = NB * SEQ;
constexpr int TC = NB * CTXL;
constexpr int TA = TL + TC;
constexpr int KVL = SEQ + CTXL;
constexpr int NIN = 3840;
constexpr int NCH = 132;
constexpr float EPS = 1e-6f;
constexpr int NT = 512;

constexpr size_t MiB = 1u << 20;
constexpr size_t WS_CTL = 0, WS_MOD = 64 * 1024, CTL_ZERO_BYTES = 512 * 1024;
constexpr size_t WS_ROPE = 1 * MiB, WS_WIN = 3 * MiB, WS_WOUT = 11 * MiB, WS_WF = 13 * MiB, WS_WEFF = 15 * MiB;
constexpr size_t WS_DFT0 = 23 * MiB, WS_DFT1 = 23 * MiB + 256 * 1024, WS_DFT3 = 23 * MiB + 512 * 1024;
constexpr size_t WS_BA = 24 * MiB, WS_GC = 29 * MiB;
constexpr size_t R0 = 32 * MiB, R1 = 98 * MiB, R2 = 197 * MiB, R3 = 329 * MiB, WS_END = 459 * MiB;
constexpr size_t WS_QN = R0, WS_KN = R0 + 33 * MiB;
constexpr size_t WS_QKVRAW = R1, WS_OBUF = R1;
constexpr size_t WS_UW = R2, WS_MIX = R2;
constexpr size_t WS_GATE = R3, WS_Q = R3 + 32 * MiB, WS_K = R3 + 64 * MiB, WS_VT = R3 + 97 * MiB;
constexpr size_t WS_VROW = WS_END;
constexpr size_t WS_TAB = R3 + 32 * MiB;
constexpr size_t WS_SC0 = R2, WS_EI0 = R1, WS_EG0 = R1 + 16 * MiB, WS_PART0 = 150 * MiB  , WS_W0 = R1 + 32 * MiB  ;
constexpr size_t WS_ZT = R1, WS_A2 = 226 * MiB, WS_FM = R1;
constexpr size_t WS_SC1 = 162 * MiB, WS_EI1 = 290 * MiB, WS_EG1 = 306 * MiB, WS_PART1 = 100 * MiB  , WS_W1 = 322 * MiB;

struct P {
  const float *x, *c, *ctx, *c_ctx, *ada_w, *ada_b, *norm1_w, *norm2_w, *w_in, *conv_w, *a_log, *dt_bias, *gdn_norm_w,
      *lam_q1, *lam_k1, *lam_q2, *lam_k2, *subln_w, *w_out_ab, *w_out_f, *peer_wq, *peer_keys, *peer_u, *peer_v, *final_norm_w;
  float* out; char* ws; int lo, hi;
};

DI unsigned f2bf(float f) { unsigned u = __float_as_uint(f); return (u + 0x7fffu + ((u >> 16) & 1u)) >> 16; }
DI unsigned pk2(float lo, float hi) { return f2bf(lo) | (f2bf(hi) << 16); }
DI unsigned cvtpk(float lo, float hi) { f32x2_t v = {lo, hi}; bf16x2_t b = __builtin_convertvector(v, bf16x2_t); return __builtin_bit_cast(unsigned, b); }
DI float bf2f(unsigned h) { return __uint_as_float(h << 16); }
DI float bflo(unsigned u) { return __uint_as_float(u << 16); }
DI float bfhi(unsigned u) { return __uint_as_float(u & 0xffff0000u); }
DI float wave_sum(float v) {
#pragma unroll
  for (int o = 32; o >= 1; o >>= 1) v += __shfl_xor(v, o, 64);
  return v;
}
DI int otid() { int t = threadIdx.x; asm volatile("" : "+v"(t)); return t; }
DI unsigned xb_ld(unsigned* p)              { return __hip_atomic_load(p, __ATOMIC_RELAXED, __HIP_MEMORY_SCOPE_AGENT); }
DI unsigned xb_add(unsigned* p, unsigned v) { return __hip_atomic_fetch_add(p, v, __ATOMIC_RELAXED, __HIP_MEMORY_SCOPE_AGENT); }
DI unsigned xb_xcc_id() { return (unsigned)__builtin_amdgcn_s_getreg((3 << 11) | 20) & 0xFu; }
DI float silu_f(float v) { return v / (1.f + __expf(-v)); }
DI float sigmoid_f(float v) { return 1.f / (1.f + __expf(-v)); }
DI float gelu_tanh(float v) {
  const float u = 0.7978845608028654f * (v + 0.044715f * v * v * v);
  const float e = __expf(2.f * u);
  const float t = 1.f - 2.f / (e + 1.f);
  return 0.5f * v * (1.f + t);
}
#define MFMA32(a, b, c) __builtin_amdgcn_mfma_f32_32x32x16_bf16((a), (b), (c), 0, 0, 0)

constexpr int GBM = 256, GBN = 128, GBK = 64, GLD = 72;
constexpr int G_A_BYTES = GBM * GLD * 2, G_B_BYTES = GBN * GLD * 2, G_STAGE = G_A_BYTES + G_B_BYTES;
constexpr int LDS_BYTES = 147456;

template <bool SWAP, class RowF, class Epi>
DI void gemm_tile(char* lds, const RowF& rowf, const bf16_t* __restrict__ Bt, const int K, const Epi& epi) {
  const int tid = otid(), lane = tid & 63, wave = tid >> 6, wm = wave >> 1, wn = wave & 1;
  const int lr = tid >> 3, lc = tid & 7;
  const bf16_t* ap0 = rowf(lr) + lc * 8;
  const bf16_t* ap1 = rowf(lr + 64) + lc * 8;
  const bf16_t* ap2 = rowf(lr + 128) + lc * 8;
  const bf16_t* ap3 = rowf(lr + 192) + lc * 8;
  const bf16_t* bp0 = Bt + (size_t)lr * K + lc * 8;
  const bf16_t* bp1 = Bt + (size_t)(lr + 64) * K + lc * 8;
  const int woff = (lr * GLD + lc * 8) * 2;
  u32x4 raX0, raX1, raX2, raX3, rbX0, rbX1, raY0, raY1, raY2, raY3, rbY0, rbY1;
  f32x16 acc[2][2];
#pragma unroll
  for (int i = 0; i < 2; ++i)
#pragma unroll
    for (int j = 0; j < 2; ++j)
#pragma unroll
      for (int r = 0; r < 16; ++r) acc[i][j][r] = 0.f;
  const int nk = K / GBK;
#define G_GLOAD(S, kt_) do { const int k0_ = ((kt_) < nk ? (kt_) : nk - 1) * GBK; \
    ra##S##0 = *(const u32x4*)(ap0 + k0_); ra##S##1 = *(const u32x4*)(ap1 + k0_); ra##S##2 = *(const u32x4*)(ap2 + k0_); ra##S##3 = *(const u32x4*)(ap3 + k0_); \
    rb##S##0 = *(const u32x4*)(bp0 + k0_); rb##S##1 = *(const u32x4*)(bp1 + k0_); } while (0)
#define G_LWRITE(S, st) do { char* b_ = lds + (st) * G_STAGE + woff; *(u32x4*)(b_) = ra##S##0; *(u32x4*)(b_ + 64 * GLD * 2) = ra##S##1; *(u32x4*)(b_ + 128 * GLD * 2) = ra##S##2; *(u32x4*)(b_ + 192 * GLD * 2) = ra##S##3; \
    *(u32x4*)(b_ + G_A_BYTES) = rb##S##0; *(u32x4*)(b_ + G_A_BYTES + 64 * GLD * 2) = rb##S##1; } while (0)
  const int aoff = ((wm * 64 + (lane & 31)) * GLD + (lane >> 5) * 8) * 2;
  const int boff = G_A_BYTES + ((wn * 64 + (lane & 31)) * GLD + (lane >> 5) * 8) * 2;
#define G_COMPUTE(st) do { const char* sb = lds + (st) * G_STAGE; \
    _Pragma("unroll") for (int kk = 0; kk < 4; ++kk) { \
      const bf16x8 a0 = *(const bf16x8*)(sb + aoff + kk * 32); \
      const bf16x8 a1 = *(const bf16x8*)(sb + aoff + 32 * GLD * 2 + kk * 32); \
      const bf16x8 b0 = *(const bf16x8*)(sb + boff + kk * 32); \
      const bf16x8 b1 = *(const bf16x8*)(sb + boff + 32 * GLD * 2 + kk * 32); \
      if (SWAP) { \
        acc[0][0] = MFMA32(b0, a0, acc[0][0]); acc[0][1] = MFMA32(b1, a0, acc[0][1]); \
        acc[1][0] = MFMA32(b0, a1, acc[1][0]); acc[1][1] = MFMA32(b1, a1, acc[1][1]); \
      } else { \
        acc[0][0] = MFMA32(a0, b0, acc[0][0]); acc[0][1] = MFMA32(a0, b1, acc[0][1]); \
        acc[1][0] = MFMA32(a1, b0, acc[1][0]); acc[1][1] = MFMA32(a1, b1, acc[1][1]); \
      } } } while (0)
  G_GLOAD(X, 0); G_GLOAD(Y, 1);
  __syncthreads();
  G_LWRITE(X, 0);
  __syncthreads();
#pragma unroll 1
  for (int kt = 0; kt < nk; kt += 2) {
    G_GLOAD(X, kt + 2);
    G_COMPUTE(0);
    G_LWRITE(Y, 1);
    __syncthreads();
    G_GLOAD(Y, kt + 3);
    G_COMPUTE(1);
    if (kt + 2 < nk) G_LWRITE(X, 0);
    __syncthreads();
  }
  epi(acc, wm, wn, lane);
#undef G_GLOAD
#undef G_LWRITE
#undef G_COMPUTE
}
DI int crow(int reg, int h) { return (reg & 3) + 8 * (reg >> 2) + 4 * h; }

struct RowLin { const bf16_t* base; size_t pitch; DI const bf16_t* operator()(int r) const { return base + (size_t)r * pitch; } };

namespace pg8 {
#define PG8_LAS __attribute__((address_space(3)))
typedef int v4i_t __attribute__((ext_vector_type(4)));
typedef unsigned short bf16_t;
typedef short bf16x8 __attribute__((ext_vector_type(8)));
typedef float f32x4 __attribute__((ext_vector_type(4)));
typedef unsigned u32x4 __attribute__((ext_vector_type(4)));
constexpr int BM = 256, BK = 64, HALF = 128, HTB = HALF * BK * 2  , STAGE_BYTES = 8 * HTB, NXCD = 8, WGM = 8;

__host__ __device__ __forceinline__ int lds_byte(int r, int c) { const int st = (r >> 4) * 2 + (c >> 5), rr = r & 15, cc = c & 31, ob = rr * 64 + cc * 2; return st * 1024 + (ob ^ (((ob >> 9) & 1) << 5)); }
__host__ __device__ __forceinline__ void stage_rc(int b, int& R, int& C) { const int st = b / 1024, sb = b % 1024, swz = sb ^ (((sb >> 9) & 1) << 5); R = (st >> 1) * 16 + swz / 64; C = (st & 1) * 32 + (swz % 64) / 2; }
__host__ __device__ __forceinline__ int perm32(int rho) { const int n = rho >> 4, i = rho & 15; return 8 * (i >> 2) + 4 * n + (i & 3); }

struct Unit { int pm, pn; };
struct Gemm { const bf16_t* A; const bf16_t* Bt; int M, N, K; };

struct StaticOrder {
    int nM, nN, nwg, G, c;
    __host__ __device__ void init(int M, int N, int G_, int c_) { nM = M / BM; nN = N / BM; nwg = nM * nN; G = G_; c = c_; }
    __host__ __device__ bool next(int i, Unit& u) const {
        const long L = (long)i * G + c; if (L >= nwg) return false;
        int wgid = (int)L; { const int q = nwg / NXCD, r = nwg % NXCD, xcd = wgid % NXCD, off = wgid / NXCD; wgid = (xcd < r ? xcd * (q + 1) : r * (q + 1) + (xcd - r) * q) + off; }
        const int nig = WGM * nN, gid = wgid / nig, fm = gid * WGM, gsz = (nM - fm) < WGM ? (nM - fm) : WGM;
        u.pm = fm + ((wgid % nig) % gsz); u.pn = (wgid % nig) / gsz; return true;
    }
    __device__ __forceinline__ void a_ready(const Unit&) const {}
    __device__ __forceinline__ void done(const Unit&) const {}
};
template <class Epi, class Sched, bool ALIGN_EPI = false, bool SP2 = false, bool I8 = false>
__device__ __forceinline__ void gemm_phase(PG8_LAS unsigned char* lds, const Gemm g, const Sched& S, const Epi& E) {
    const int tid = otid(), wid = __builtin_amdgcn_readfirstlane(tid >> 6), lane = tid & 63, wr = wid >> 2, wc = wid & 3, fr = lane & 15, fq = lane >> 4;
    const int K = g.K, nt = K / BK;
    unsigned voffA[2], voffB[2];
#pragma unroll
    for (int i = 0; i < 2; ++i) { int R, C; stage_rc(tid * 16 + i * 8192, R, C); const int Rb = Epi::PERM ? ((R & ~31) + perm32(R & 31)) : R;
        voffA[i] = (unsigned)(R * K + C) * 2u; voffB[i] = (unsigned)(Rb * K + C) * 2u; }
    const size_t kstep = (size_t)(BK * 2);
    const size_t hstep = (size_t)HALF * K * 2;
    const size_t tstep = 2 * hstep;
    const unsigned ldsw = (unsigned)wid * 1024u;
    const int aoff = lds_byte(wr * 64 + fr, fq * 8), boff = lds_byte(wc * 32 + fr, fq * 8);
#define PG8_SA(b, h) (((b) * 2 + (h)) * HTB)
#define PG8_SB(b, h) ((4 + (b) * 2 + (h)) * HTB)
#define PG8_STAGE(bufoff, gbase, voff) do { _Pragma("unroll") for (int _i = 0; _i < 2; ++_i) \
        __builtin_amdgcn_global_load_lds((const unsigned*)((const char*)(gbase) + (voff)[_i]), (PG8_LAS unsigned*)(lds + (bufoff) + ldsw + _i * 8192), 16, 0, 0); } while (0)
#define PG8_LDA(dst, b, h) do { _Pragma("unroll") for (int m = 0; m < 4; ++m) _Pragma("unroll") for (int k = 0; k < 2; ++k) dst[m][k] = *(const PG8_LAS bf16x8*)(lds + PG8_SA(b, h) + aoff + m * 2048 + k * 1024); } while (0)
#define PG8_LDB(dst, b, h) do { _Pragma("unroll") for (int n = 0; n < 2; ++n) _Pragma("unroll") for (int k = 0; k < 2; ++k) dst[n][k] = *(const PG8_LAS bf16x8*)(lds + PG8_SB(b, h) + boff + n * 2048 + k * 1024); } while (0)
#define PG8_MMA(ai, bj, At, Bt) do { __builtin_amdgcn_s_setprio(1); _Pragma("unroll") for (int m = 0; m < 4; ++m) _Pragma("unroll") for (int n = 0; n < 2; ++n) _Pragma("unroll") for (int k = 0; k < 2; ++k) \
        { if constexpr (I8) acc[ai][bj][m][n] = __builtin_bit_cast(f32x4, __builtin_amdgcn_mfma_i32_16x16x64_i8(__builtin_bit_cast(v4i_t, Bt[n][k]), __builtin_bit_cast(v4i_t, At[m][k]), __builtin_bit_cast(v4i_t, acc[ai][bj][m][n]), 0, 0, 0)); \
          else acc[ai][bj][m][n] = __builtin_amdgcn_mfma_f32_16x16x32_bf16(Bt[n][k], At[m][k], acc[ai][bj][m][n], 0, 0, 0); } __builtin_amdgcn_s_setprio(0); } while (0)
#define PG8_WAIT_V(n) asm volatile("s_waitcnt vmcnt(" #n ")" ::: "memory")
#define PG8_WAIT_L(n) asm volatile("s_waitcnt lgkmcnt(" #n ")" ::: "memory")
#define PG8_BAR __builtin_amdgcn_s_barrier()
#define PG8_SCHED __builtin_amdgcn_sched_barrier(0)
    Unit cur, nxt; int ui = 0;
    if (!S.next(0, cur)) return;
    f32x4 acc[2][2][4][2];
#pragma unroll
    for (int a = 0; a < 2; ++a)
#pragma unroll
        for (int b = 0; b < 2; ++b)
#pragma unroll
            for (int m = 0; m < 4; ++m)
#pragma unroll
                for (int n = 0; n < 2; ++n) acc[a][b][m][n] = (f32x4){0.f, 0.f, 0.f, 0.f};
    bf16x8 At[4][2], B0[2][2], B1[2][2];
    const char* cA = (const char*)g.A + (size_t)cur.pm * tstep; const char* cB = (const char*)g.Bt + (size_t)cur.pn * tstep;
    S.a_ready(cur);
    if constexpr (SP2) {
        PG8_STAGE(PG8_SB(0, 0), cB, voffB); PG8_STAGE(PG8_SB(0, 1), cB + hstep, voffB); PG8_STAGE(PG8_SA(0, 0), cA, voffA); PG8_STAGE(PG8_SA(0, 1), cA + hstep, voffA);
        if (wr == 1) PG8_BAR;
        PG8_WAIT_V(2); PG8_BAR;
        PG8_STAGE(PG8_SB(1, 0), cB + kstep, voffB); PG8_STAGE(PG8_SA(1, 0), cA + kstep, voffA); PG8_STAGE(PG8_SB(1, 1), cB + hstep + kstep, voffB);
        PG8_WAIT_V(6); PG8_BAR;
    } else {
        PG8_STAGE(PG8_SB(0, 0), cB, voffB); PG8_STAGE(PG8_SA(0, 0), cA, voffA); PG8_STAGE(PG8_SB(0, 1), cB + hstep, voffB); PG8_STAGE(PG8_SA(0, 1), cA + hstep, voffA);
        if (wr == 1) PG8_BAR;
        PG8_WAIT_V(4); PG8_BAR;
        PG8_STAGE(PG8_SB(1, 0), cB + kstep, voffB); PG8_STAGE(PG8_SA(1, 0), cA + kstep, voffA); PG8_STAGE(PG8_SB(1, 1), cB + hstep + kstep, voffB);
        PG8_WAIT_V(6); PG8_BAR;
    }
    for (;;) {
        const bool has_next = S.next(ui + 1, nxt);
        const char* nA = has_next ? (const char*)g.A + (size_t)nxt.pm * tstep : cA; const char* nB = has_next ? (const char*)g.Bt + (size_t)nxt.pn * tstep : cB;
        for (int t = 0; t < nt; t += 2) {
            const bool last = (t == nt - 2);
            const char* a1 = cA + (size_t)(t + 1) * kstep;
            const char* a2 = last ? nA : cA + (size_t)(t + 2) * kstep; const char* b2 = last ? nB : cB + (size_t)(t + 2) * kstep;
            const char* a3 = a2 + kstep; const char* b3 = b2 + kstep;
            if (last && has_next) S.a_ready(nxt);
            if constexpr (SP2) {
            PG8_LDB(B0, 0, 0); PG8_LDB(B1, 0, 1); PG8_SCHED; PG8_LDA(At, 0, 0); PG8_STAGE(PG8_SA(1, 1), a1 + hstep, voffA);
            PG8_WAIT_V(8); PG8_WAIT_L(0); PG8_BAR; PG8_MMA(0, 0, At, B0); PG8_MMA(0, 1, At, B1); PG8_BAR; PG8_SCHED;
            PG8_LDA(At, 0, 1); PG8_STAGE(PG8_SB(0, 0), b2, voffB); PG8_STAGE(PG8_SB(0, 1), b2 + hstep, voffB); PG8_STAGE(PG8_SA(0, 0), a2, voffA);
            PG8_WAIT_V(8); PG8_WAIT_L(0); PG8_BAR; PG8_MMA(1, 0, At, B0); PG8_MMA(1, 1, At, B1); PG8_BAR; PG8_SCHED;
            PG8_LDB(B0, 1, 0); PG8_LDB(B1, 1, 1); PG8_SCHED; PG8_LDA(At, 1, 0); PG8_STAGE(PG8_SA(0, 1), a2 + hstep, voffA);
            PG8_WAIT_V(8); PG8_WAIT_L(0); PG8_BAR; PG8_MMA(0, 0, At, B0); PG8_MMA(0, 1, At, B1); PG8_BAR; PG8_SCHED;
            PG8_LDA(At, 1, 1); PG8_STAGE(PG8_SB(1, 0), b3, voffB); PG8_STAGE(PG8_SB(1, 1), b3 + hstep, voffB); PG8_STAGE(PG8_SA(1, 0), a3, voffA);
            PG8_WAIT_V(8); PG8_WAIT_L(0); PG8_BAR; PG8_MMA(1, 0, At, B0); PG8_MMA(1, 1, At, B1); PG8_BAR; PG8_SCHED;
            } else {
            PG8_LDB(B0, 0, 0); PG8_SCHED; PG8_LDA(At, 0, 0); PG8_STAGE(PG8_SA(1, 1), a1 + hstep, voffA);
            PG8_WAIT_L(8); PG8_BAR; PG8_WAIT_L(0); PG8_MMA(0, 0, At, B0); PG8_BAR; PG8_SCHED;
            PG8_LDB(B1, 0, 1); PG8_STAGE(PG8_SB(0, 0), b2, voffB);
            PG8_BAR; PG8_WAIT_L(0); PG8_MMA(0, 1, At, B1); PG8_BAR;
            PG8_LDA(At, 0, 1); PG8_STAGE(PG8_SA(0, 0), a2, voffA);
            PG8_BAR; PG8_WAIT_L(0); PG8_MMA(1, 0, At, B0); PG8_BAR; PG8_SCHED;
            PG8_STAGE(PG8_SB(0, 1), b2 + hstep, voffB);
            PG8_WAIT_V(6); PG8_BAR; PG8_MMA(1, 1, At, B1); PG8_BAR;
            PG8_LDB(B0, 1, 0); PG8_SCHED; PG8_LDA(At, 1, 0); PG8_STAGE(PG8_SA(0, 1), a2 + hstep, voffA);
            PG8_WAIT_L(8); PG8_BAR; PG8_WAIT_L(0); PG8_MMA(0, 0, At, B0); PG8_BAR; PG8_SCHED;
            PG8_LDB(B1, 1, 1); PG8_STAGE(PG8_SB(1, 0), b3, voffB);
            PG8_BAR; PG8_WAIT_L(0); PG8_MMA(0, 1, At, B1); PG8_BAR;
            PG8_LDA(At, 1, 1); PG8_STAGE(PG8_SA(1, 0), a3, voffA);
            PG8_BAR; PG8_WAIT_L(0); PG8_MMA(1, 0, At, B0); PG8_BAR; PG8_SCHED;
            PG8_STAGE(PG8_SB(1, 1), b3 + hstep, voffB);
            PG8_WAIT_V(6); PG8_BAR; PG8_MMA(1, 1, At, B1); PG8_BAR;
            }
        }
        if constexpr (ALIGN_EPI) { if (wr == 0) PG8_BAR; }
        if constexpr (I8) { if constexpr (Epi::DEQ) { E.deq(acc, cur, wr, wc, fr, fq); __builtin_amdgcn_sched_barrier(0); } }
        if constexpr (!Epi::AFTER_DRAIN) { E(acc, cur, wr, wc, fr, fq); S.done(cur); }
        if (!has_next) break;
#pragma unroll
        for (int a = 0; a < 2; ++a)
#pragma unroll
            for (int b = 0; b < 2; ++b)
#pragma unroll
                for (int m = 0; m < 4; ++m)
#pragma unroll
                    for (int n = 0; n < 2; ++n) acc[a][b][m][n] = (f32x4){0.f, 0.f, 0.f, 0.f};
        cur = nxt; cA = nA; cB = nB; ++ui;
        if constexpr (ALIGN_EPI) { if (wr == 1) PG8_BAR; }
    }
    PG8_WAIT_V(0);
    if constexpr (!ALIGN_EPI) { if (wr == 0) PG8_BAR; }
    PG8_BAR;
    if constexpr (Epi::AFTER_DRAIN) { E.fused(acc, cur, wr, wc, fr, fq, lds, wid, lane); S.done(cur); }
#undef PG8_SA
#undef PG8_SB
#undef PG8_STAGE
#undef PG8_LDA
#undef PG8_LDB
#undef PG8_MMA
#undef PG8_WAIT_V
#undef PG8_WAIT_L
#undef PG8_BAR
#undef PG8_SCHED
}
}
DI void ph_setup(const P& p, char* lds) {
  const int tid = otid(), nb = gridDim.x, bid = blockIdx.x;
  float* modL = (float*)(p.ws + WS_MOD);
  float* sc = (float*)lds;
  for (int it = bid; it < 192; it += nb) {
    const int layer = it / 96, cb = it % 96;
    const int lane = tid & 63, ks = tid >> 6;
    __syncthreads();
    for (int i = tid; i < 5 * 1024; i += NT) { const int v = i >> 10, k = i & 1023; const float cv = (v < 4) ? p.c[v * 1024 + k] : p.c_ctx[k]; sc[i] = silu_f(cv); }
    __syncthreads();
    const int n = cb * 64 + lane;
    const float* w = p.ada_w + ((size_t)layer * 1024 + ks * 128) * 6144 + n;
    float a0 = 0, a1 = 0, a2 = 0, a3 = 0, a4 = 0;
#pragma unroll 8
    for (int k = 0; k < 128; ++k) { const float wv = w[(size_t)k * 6144]; const int kk = ks * 128 + k; a0 += wv * sc[kk]; a1 += wv * sc[1024 + kk]; a2 += wv * sc[2048 + kk]; a3 += wv * sc[3072 + kk]; a4 += wv * sc[4096 + kk]; }
    float* red = sc + 5 * 1024;
    red[(ks * 5 + 0) * 64 + lane] = a0; red[(ks * 5 + 1) * 64 + lane] = a1; red[(ks * 5 + 2) * 64 + lane] = a2; red[(ks * 5 + 3) * 64 + lane] = a3; red[(ks * 5 + 4) * 64 + lane] = a4;
    __syncthreads();
    if (tid < 320) {
      const int v = tid >> 6, l = tid & 63;
      float sacc = p.ada_b[layer * 6144 + cb * 64 + l];
      for (int k8 = 0; k8 < 8; ++k8) sacc += red[(k8 * 5 + v) * 64 + l];
      modL[(layer * 5 + v) * 6144 + cb * 64 + l] = sacc;
    }
  }
  {
    float* rope = (float*)(p.ws + WS_ROPE);
    for (int i = bid * NT + tid; i < SEQ * 32; i += nb * NT) {
      const int l = i >> 5, d = i & 31;
      const float inv = exp2f(-(float)(2 * (d & 15)) * (13.287712379549449f / 32.f));
      const float pos = (d < 16) ? (float)(l >> 6) : (float)(l & 63);
      float s, c; sincosf(pos * inv, &s, &c);
      rope[2 * i] = c; rope[2 * i + 1] = s;
    }
  }
  {
    float* tl = (float*)lds;
    const int nt_in = (NIN / 64) * 16, nt_o = 16 * 16;
    for (int it = bid; it < nt_in + 2 * nt_o; it += nb) {
      const float* src; bf16_t* dst; int npitch, nb0, kb0, which;
      if (it < nt_in) { which = 0; nb0 = (it / 16) * 64; kb0 = (it % 16) * 64; src = p.w_in; dst = (bf16_t*)(p.ws + WS_WIN); npitch = 3616; }
      else if (it < nt_in + nt_o) { const int j = it - nt_in; which = 1; nb0 = (j / 16) * 64; kb0 = (j % 16) * 64; src = p.w_out_ab; dst = (bf16_t*)(p.ws + WS_WOUT); npitch = 1024; }
      else { const int j = it - nt_in - nt_o; which = 2; nb0 = (j / 16) * 64; kb0 = (j % 16) * 64; src = p.w_out_f; dst = (bf16_t*)(p.ws + WS_WF); npitch = 1024; }
      __syncthreads();
      for (int e = tid; e < 4096; e += NT) {
        const int kk = e >> 6, nn = e & 63; const int n = nb0 + nn;
        int sn = n;
        if (which == 0) {
          if (n < 2048) sn = n;
          else if (n < 3072) { const int pq = n & 63, blk = pq >> 3, e8 = pq & 7; sn = (n & ~63) + 32 + ((e8 < 4) ? 4 * blk + e8 : 32 + 4 * blk + (e8 - 4)); }
          else if (n < 3584) sn = n + 32;
          else if (n < 3616) sn = n - 1536;
          else sn = -1;
        }
        tl[kk * 65 + nn] = (sn >= 0) ? src[(size_t)(kb0 + kk) * npitch + sn] : 0.f;
      }
      __syncthreads();
      for (int e = tid; e < 4096; e += NT) { const int nn = e >> 6, kk = e & 63; dst[(size_t)(nb0 + nn) * 1024 + kb0 + kk] = (bf16_t)f2bf(tl[kk * 65 + nn]); }
    }
  }
  {
    float* kl = (float*)lds;
    float* wl = kl + 128 * 132;
    bf16_t* weff = (bf16_t*)(p.ws + WS_WEFF);
    for (int it = bid; it < 512; it += nb) {
      const int layer = it >> 8, hp = (it >> 4) & 15, kb = it & 15;
      __syncthreads();
      const float* ks = p.peer_keys + ((size_t)(layer * 16 + hp) * 128) * 128;
      for (int e = tid; e < 128 * 128; e += NT) kl[(e >> 7) * 132 + (e & 127)] = ks[e];
      const float* ws_ = p.peer_wq + ((size_t)layer * 1024 + kb * 64) * 2048 + hp * 128;
      for (int e = tid; e < 64 * 128; e += NT) wl[(e >> 7) * 132 + (e & 127)] = ws_[(size_t)(e >> 7) * 2048 + (e & 127)];
      __syncthreads();
      const int key = tid & 127, kq = tid >> 7;
      float a[16];
#pragma unroll
      for (int i = 0; i < 16; ++i) a[i] = 0.f;
      for (int d = 0; d < 128; d += 4) {
        const f32x4 kv = *(const f32x4*)(kl + key * 132 + d);
#pragma unroll
        for (int i = 0; i < 16; ++i) { const f32x4 wv = *(const f32x4*)(wl + (kq * 16 + i) * 132 + d); a[i] += kv[0] * wv[0] + kv[1] * wv[1] + kv[2] * wv[2] + kv[3] * wv[3]; }
      }
      bf16_t* o = weff + ((size_t)layer * 2048 + hp * 128 + key) * 1024 + kb * 64 + kq * 16;
      u32x4 o0, o1;
      o0[0] = pk2(a[0], a[1]); o0[1] = pk2(a[2], a[3]); o0[2] = pk2(a[4], a[5]); o0[3] = pk2(a[6], a[7]);
      o1[0] = pk2(a[8], a[9]); o1[1] = pk2(a[10], a[11]); o1[2] = pk2(a[12], a[13]); o1[3] = pk2(a[14], a[15]);
      *(u32x4*)o = o0; *(u32x4*)(o + 8) = o1;
    }
  }
  {
    bf16_t* d0 = (bf16_t*)(p.ws + WS_DFT0); bf16_t* d1 = (bf16_t*)(p.ws + WS_DFT1); bf16_t* d3 = (bf16_t*)(p.ws + WS_DFT3);
    for (int i = bid * NT + tid; i < 512 * 256; i += nb * NT) {
      const int n = i >> 8, c = i & 255, m = n & 255; const float fr = (float)((m * c) & 255) * (2.f / 256.f);
      d0[i] = (bf16_t)f2bf(n < 256 ? cospif(fr) : -sinpif(fr));
    }
    for (int i = bid * NT + tid; i < 128 * 128; i += nb * NT) {
      const int n = i >> 7, k = i & 127; const int k1 = 32 * (n >> 6) + (n & 31), ro = (n >> 5) & 1, ri = k >> 6, l1 = k & 63;
      const float fr = (float)((k1 * l1) & 63) * (2.f / 64.f); const float cs = cospif(fr), sn = sinpif(fr);
      d1[i] = (bf16_t)f2bf(ro == 0 ? (ri == 0 ? cs : sn) : (ri == 0 ? -sn : cs));
    }
    for (int i = bid * NT + tid; i < 128 * 256; i += nb * NT) {
      const int k2 = i >> 8, k = i & 255, ri = k >> 7, l2 = k & 127; const float fr = (float)((l2 * k2) & 127) * (2.f / 128.f);
      const float scl = 6.905339660024878e-4f;
      d3[i] = (bf16_t)f2bf((ri == 0 ? cospif(fr) : sinpif(fr)) * scl);
    }
  }
}

DI void norm_rows(const float* __restrict__ src, int row_begin, int nrows, const float* __restrict__ nw, const float* __restrict__ modbase  ,
                  int shift_j, int scale_j, bool ctx_tail  , bf16_t* __restrict__ dst, bool blk = false  ) {
  const int lane = otid() & 63, gw = (blk ? 0 : blockIdx.x * (NT / 64)) + (otid() >> 6), nw_ = (blk ? 1 : gridDim.x) * (NT / 64);
  for (int row = row_begin + gw; row < nrows; row += nw_) {
    const int v = (ctx_tail && row >= TL) ? 4 : (row >> 13);
    const float* xr = src + (size_t)row * DM;
    f32x4 xv[4]; float ss = 0.f;
#pragma unroll
    for (int i = 0; i < 4; ++i) { xv[i] = *(const f32x4*)(xr + lane * 4 + 256 * i); ss += xv[i][0] * xv[i][0] + xv[i][1] * xv[i][1] + xv[i][2] * xv[i][2] + xv[i][3] * xv[i][3]; }
    ss = wave_sum(ss);
    const float rs = rsqrtf(ss * (1.f / DM) + EPS);
    const float* sh = modbase + (size_t)v * 6144 + shift_j * 1024; const float* scp = modbase + (size_t)v * 6144 + scale_j * 1024;
#pragma unroll
    for (int i = 0; i < 4; ++i) {
      const int c = lane * 4 + 256 * i;
      const f32x4 w4 = *(const f32x4*)(nw + c), s4 = *(const f32x4*)(sh + c), c4 = *(const f32x4*)(scp + c);
      float y0 = xv[i][0] * rs * w4[0] * (1.f + c4[0]) + s4[0], y1 = xv[i][1] * rs * w4[1] * (1.f + c4[1]) + s4[1];
      float y2 = xv[i][2] * rs * w4[2] * (1.f + c4[2]) + s4[2], y3 = xv[i][3] * rs * w4[3] * (1.f + c4[3]) + s4[3];
      u32x2 o; o[0] = pk2(y0, y1); o[1] = pk2(y2, y3);
      *(u32x2*)(dst + (size_t)row * DM + c) = o;
    }
  }
}

constexpr size_t WS_HQ = (size_t)393 * MiB, WS_HS = (size_t)425 * MiB;
DI void norm_rows_hq(const P& p, const float* __restrict__ nw, const float* __restrict__ modbase) {
  const int lane = otid() & 63, gw = blockIdx.x * (NT / 64) + (otid() >> 6), nw_ = gridDim.x * (NT / 64);
  bf16_t* dst = (bf16_t*)(p.ws + R0); unsigned char* hq = (unsigned char*)(p.ws + WS_HQ); float* hs = (float*)(p.ws + WS_HS);
  for (int row = gw; row < TL; row += nw_) {
    const float* xr = p.out + (size_t)row * DM + lane * 16;
    f32x4 xv[4]; float ss = 0.f;
#pragma unroll
    for (int i = 0; i < 4; ++i) { xv[i] = *(const f32x4*)(xr + 4 * i); ss += xv[i][0] * xv[i][0] + xv[i][1] * xv[i][1] + xv[i][2] * xv[i][2] + xv[i][3] * xv[i][3]; }
    ss = wave_sum(ss);
    const float rs = rsqrtf(ss * (1.f / DM) + EPS);
    const float* sh = modbase + (size_t)(row >> 13) * 6144 + 3 * 1024 + lane * 16; const float* scp = sh + 1024;
    float y[16]; float am = 0.f;
#pragma unroll
    for (int i = 0; i < 4; ++i) {
      const f32x4 w4 = *(const f32x4*)(nw + lane * 16 + 4 * i), s4 = *(const f32x4*)(sh + 4 * i), c4 = *(const f32x4*)(scp + 4 * i);
#pragma unroll
      for (int j = 0; j < 4; ++j) { y[4 * i + j] = xv[i][j] * rs * w4[j] * (1.f + c4[j]) + s4[j]; am = fmaxf(am, fabsf(y[4 * i + j])); }
    }
#pragma unroll
    for (int o = 32; o >= 1; o >>= 1) am = fmaxf(am, __shfl_xor(am, o, 64));
    const float st = am * (1.f / 119.f) + 1e-30f, ist = 1.f / st;
    unsigned h0 = 0u, h1 = 0u, l0 = 0u, l1 = 0u;
    u32x4 b8 = {0u, 0u, 0u, 0u};
#pragma unroll
    for (int j = 0; j < 8; ++j) {
      const int va = (int)fminf(fmaxf(rintf(y[j] * ist), -120.f), 119.f), vb = (int)fminf(fmaxf(rintf(y[8 + j] * ist), -120.f), 119.f);
      b8[j >> 2] |= ((unsigned)va & 255u) << (8 * (j & 3)); b8[2 + (j >> 2)] |= ((unsigned)vb & 255u) << (8 * (j & 3));
      const int ha = (va + 8) >> 4, hb = (vb + 8) >> 4, la = va - 16 * ha, lb = vb - 16 * hb;
      h0 |= ((unsigned)ha & 15u) << (4 * j); h1 |= ((unsigned)hb & 15u) << (4 * j); l0 |= ((unsigned)la & 15u) << (4 * j); l1 |= ((unsigned)lb & 15u) << (4 * j);
    }
    u32x2 vh; vh[0] = h0; vh[1] = h1; *(u32x2*)(hq + (size_t)row * 1024 + lane * 8) = vh;
    u32x2 vl; vl[0] = l0; vl[1] = l1; *(u32x2*)(hq + (size_t)row * 1024 + 512 + lane * 8) = vl;
    *(u32x4*)((unsigned char*)dst + (size_t)row * DM + lane * 16) = b8;
    if (lane == 0) hs[row] = st;
  }
}

constexpr size_t WS_WEFF8 = WS_WIN, WS_SW = WS_WIN + 5 * MiB;
constexpr size_t WS_WIN8 = R2, WS_SWIN = R2 + 4 * MiB;
constexpr size_t WS_HS0 = R2 + 5 * MiB;
DI void quant_rows_i8(const bf16_t* __restrict__ w, int nrows, unsigned char* __restrict__ w8, float* __restrict__ sw) {
  const int lane = otid() & 63, gw = blockIdx.x * (NT / 64) + (otid() >> 6), nw_ = gridDim.x * (NT / 64);
  for (int row = gw; row < nrows; row += nw_) {
    const u32x4 a = *(const u32x4*)(w + (size_t)row * 1024 + lane * 16), b = *(const u32x4*)(w + (size_t)row * 1024 + lane * 16 + 8);
    float v[16]; float am = 0.f;
#pragma unroll
    for (int i = 0; i < 4; ++i) { v[2 * i] = bflo(a[i]); v[2 * i + 1] = bfhi(a[i]); v[8 + 2 * i] = bflo(b[i]); v[9 + 2 * i] = bfhi(b[i]); }
#pragma unroll
    for (int i = 0; i < 16; ++i) am = fmaxf(am, fabsf(v[i]));
#pragma unroll
    for (int o = 32; o >= 1; o >>= 1) am = fmaxf(am, __shfl_xor(am, o, 64));
    const float st = am * (1.f / 127.f) + 1e-30f, ist = 1.f / st;
    u32x4 o8 = {0u, 0u, 0u, 0u};
#pragma unroll
    for (int i = 0; i < 16; ++i) { const int qv = (int)fminf(fmaxf(rintf(v[i] * ist), -127.f), 127.f); o8[i >> 2] |= ((unsigned)qv & 255u) << (8 * (i & 3)); }
    *(u32x4*)(w8 + (size_t)row * 1024 + lane * 16) = o8;
    if (lane == 0) sw[row] = st;
  }
}
DI void norm_rows_i8(const float* __restrict__ src, int row_begin, int nrows, const float* __restrict__ nw, const float* __restrict__ modbase, bool ctx_tail,
                     unsigned char* __restrict__ dst8, float* __restrict__ hs) {
  const int lane = otid() & 63, gw = blockIdx.x * (NT / 64) + (otid() >> 6), nw_ = gridDim.x * (NT / 64);
  for (int row = row_begin + gw; row < nrows; row += nw_) {
    const int v = (ctx_tail && row >= TL) ? 4 : (row >> 13);
    const float* xr = src + (size_t)row * DM + lane * 16;
    f32x4 xv[4]; float ss = 0.f;
#pragma unroll
    for (int i = 0; i < 4; ++i) { xv[i] = *(const f32x4*)(xr + 4 * i); ss += xv[i][0] * xv[i][0] + xv[i][1] * xv[i][1] + xv[i][2] * xv[i][2] + xv[i][3] * xv[i][3]; }
    ss = wave_sum(ss);
    const float rs = rsqrtf(ss * (1.f / DM) + EPS);
    const float* sh = modbase + (size_t)v * 6144 + lane * 16; const float* scp = sh + 1024;
    float y[16]; float am = 0.f;
#pragma unroll
    for (int i = 0; i < 4; ++i) {
      const f32x4 w4 = *(const f32x4*)(nw + lane * 16 + 4 * i), s4 = *(const f32x4*)(sh + 4 * i), c4 = *(const f32x4*)(scp + 4 * i);
#pragma unroll
      for (int j = 0; j < 4; ++j) { y[4 * i + j] = xv[i][j] * rs * w4[j] * (1.f + c4[j]) + s4[j]; am = fmaxf(am, fabsf(y[4 * i + j])); }
    }
#pragma unroll
    for (int o = 32; o >= 1; o >>= 1) am = fmaxf(am, __shfl_xor(am, o, 64));
    const float st = am * (1.f / 127.f) + 1e-30f, ist = 1.f / st;
    u32x4 b8 = {0u, 0u, 0u, 0u};
#pragma unroll
    for (int j = 0; j < 16; ++j) { const int qv = (int)fminf(fmaxf(rintf(y[j] * ist), -127.f), 127.f); b8[j >> 2] |= ((unsigned)qv & 255u) << (8 * (j & 3)); }
    *(u32x4*)(dst8 + (size_t)row * DM + lane * 16) = b8;
    if (lane == 0) hs[row] = st;
  }
}

struct EpiProjV {
  const P* p; int row0, col0;
  DI void operator()(f32x16 (&acc)[2][2], int wm, int wn, int lane) const {
    const int cb = col0 + wn * 64, h = lane >> 5, cl = lane & 31;
    const bool isctx = row0 >= TL;
    bf16_t* o = (bf16_t*)(p->ws + WS_VT);
    const int hv = (cb - 3072) >> 7, dvb = (cb - 3072) & 127;
#pragma unroll
    for (int mt = 0; mt < 2; ++mt)
#pragma unroll
      for (int nt = 0; nt < 2; ++nt)
#pragma unroll
        for (int g = 0; g < 4; ++g) {
          const int row = row0 + wm * 64 + mt * 32 + 8 * g + 4 * h;
          int b, pos; if (!isctx) { b = row >> 13; pos = row & (SEQ - 1); } else { const int rc = row - TL; b = rc >> 8; pos = SEQ + (rc & 255); }
          const int dv = dvb + nt * 32 + cl;
          u32x2 v; v[0] = pk2(acc[mt][nt][4 * g], acc[mt][nt][4 * g + 1]); v[1] = pk2(acc[mt][nt][4 * g + 2], acc[mt][nt][4 * g + 3]);
          *(u32x2*)(o + ((size_t)((b * 4 + hv) * 128 + dv)) * KVL + pos) = v;
        }
  }
};
struct EpiProjS {
  const P* p; int row0, col0;
  DI void operator()(f32x16 (&acc)[2][2], int wm, int wn, int lane) const {
    const int cb = col0 + wn * 64, h = lane >> 5, cl = lane & 31;
    const bool isctx = row0 >= TL;
    char* ws = p->ws;
    if (cb < 2048) {
      const bool isg = cb >= 1536;
      if (isg && isctx) return;
      bf16_t* o = (bf16_t*)(ws + (isg ? WS_GATE : WS_QKVRAW));
      const int pitch = isg ? 512 : 1536, cofs = isg ? cb - 1536 : cb;
#pragma unroll
      for (int mt = 0; mt < 2; ++mt) {
        const int row = row0 + wm * 64 + mt * 32 + cl;
#pragma unroll
        for (int nt = 0; nt < 2; ++nt)
#pragma unroll
          for (int g = 0; g < 4; ++g) {
            float v0 = acc[mt][nt][4 * g], v1 = acc[mt][nt][4 * g + 1], v2 = acc[mt][nt][4 * g + 2], v3 = acc[mt][nt][4 * g + 3];
            if (isg) { v0 = silu_f(v0); v1 = silu_f(v1); v2 = silu_f(v2); v3 = silu_f(v3); }
            u32x2 v; v[0] = pk2(v0, v1); v[1] = pk2(v2, v3);
            *(u32x2*)(o + (size_t)row * pitch + cofs + nt * 32 + 8 * g + 4 * h) = v;
          }
      }
    } else if (cb < 3072) {
      const bool isq = cb < 2560;
      if (isq && isctx) return;
      const float* rope = (const float*)(ws + WS_ROPE);
      bf16_t* o = (bf16_t*)(ws + (isq ? WS_Q : WS_K));
      const int cofs = cb - (isq ? 2048 : 2560);
      const float qs = isq ? 0.125f * 1.4426950408889634f : 1.f;
#pragma unroll
      for (int mt = 0; mt < 2; ++mt) {
        const int row = row0 + wm * 64 + mt * 32 + cl;
        size_t orow; int l = 0;
        if (!isctx) { l = row & (SEQ - 1); orow = isq ? (size_t)row : (size_t)(row >> 13) * KVL + l; }
        else { const int rc = row - TL; orow = (size_t)(rc >> 8) * KVL + SEQ + (rc & 255); }
#pragma unroll
        for (int g = 0; g < 4; ++g) {
          const int d0 = 8 * g + 4 * h;
          float o1[4], o2[4];
          if (!isctx) {
            const f32x4 ca = *(const f32x4*)(rope + ((size_t)l * 32 + d0) * 2), cb2 = *(const f32x4*)(rope + ((size_t)l * 32 + d0) * 2 + 4);
            const float cs[4] = {ca[0], ca[2], cb2[0], cb2[2]}, sn[4] = {ca[1], ca[3], cb2[1], cb2[3]};
#pragma unroll
            for (int r = 0; r < 4; ++r) { const float x1 = acc[mt][0][4 * g + r], x2 = acc[mt][1][4 * g + r]; o1[r] = (x1 * cs[r] - x2 * sn[r]) * qs; o2[r] = (x1 * sn[r] + x2 * cs[r]) * qs; }
          } else {
#pragma unroll
            for (int r = 0; r < 4; ++r) { o1[r] = acc[mt][0][4 * g + r]; o2[r] = acc[mt][1][4 * g + r]; }
          }
          u32x2 v; v[0] = pk2(o1[0], o1[1]); v[1] = pk2(o1[2], o1[3]); *(u32x2*)(o + orow * 512 + cofs + d0) = v;
          v[0] = pk2(o2[0], o2[1]); v[1] = pk2(o2[2], o2[3]); *(u32x2*)(o + orow * 512 + cofs + 32 + d0) = v;
        }
      }
    } else if (cb == 3584) {
      float* o = (float*)(ws + WS_BA);
#pragma unroll
      for (int mt = 0; mt < 2; ++mt) {
        const int row = row0 + wm * 64 + mt * 32 + cl;
#pragma unroll
        for (int g = 0; g < 4; ++g) {
          const int j0 = 8 * g + 4 * h;
          f32x4 y;
#pragma unroll
          for (int r = 0; r < 4; ++r) {
            const int j = j0 + r; const float v = acc[mt][0][4 * g + r];
            if (j0 < 16) y[r] = sigmoid_f(v);
            else { const float z = v + p->dt_bias[j - 16]; const float sp = (z > 20.f) ? z : log1pf(__expf(z)); y[r] = -__expf(p->a_log[j - 16]) * sp; }
          }
          *(f32x4*)(o + (size_t)row * 32 + j0) = y;
        }
      }
    }
  }
};

DI void ph_gemm_proj(const P& p, char* lds) {
  const bf16_t* A = (const bf16_t*)(p.ws + R0); const bf16_t* Bt = (const bf16_t*)(p.ws + WS_WIN);
  const int nM = TA / GBM, nN = NIN / GBN;
  for (int t = blockIdx.x; t < nM * nN; t += gridDim.x) {
    const int pm = t / nN, pn = t % nN;
    RowLin rf{A + (size_t)pm * GBM * DM, (size_t)DM};
    if (pn >= 24 && pn < 28) { EpiProjV ep{&p, pm * GBM, pn * GBN}; gemm_tile<false>(lds, rf, Bt + (size_t)pn * GBN * DM, DM, ep); }
    else { EpiProjS ep{&p, pm * GBM, pn * GBN}; gemm_tile<true>(lds, rf, Bt + (size_t)pn * GBN * DM, DM, ep); }
  }
}


struct PgResid {
  static constexpr bool PERM = true, AFTER_DRAIN = false;
  const float* xin; float* xout; const float* gmod;
  DI void operator()(const pg8::f32x4 (&acc)[2][2][4][2], const pg8::Unit& u, int wr, int wc, int fr, int fq) const {
#pragma unroll
    for (int ai = 0; ai < 2; ++ai)
#pragma unroll
      for (int m = 0; m < 4; ++m) {
        const int row = u.pm * 256 + ai * 128 + wr * 64 + m * 16 + fr;
        const float* gm = gmod + (size_t)(row >> 13) * 6144;
#pragma unroll
        for (int bj = 0; bj < 2; ++bj) {
          const int c0 = u.pn * 256 + bj * 128 + wc * 32 + 8 * fq;
#pragma unroll
          for (int n = 0; n < 2; ++n) {
            const f32x4 xv = *(const f32x4*)(xin + (size_t)row * DM + c0 + 4 * n), g4 = *(const f32x4*)(gm + c0 + 4 * n);
            *(f32x4*)(xout + (size_t)row * DM + c0 + 4 * n) = xv + g4 * acc[ai][bj][m][n];
          }
        }
      }
  }
};
struct PgBf16 {
  static constexpr bool PERM = true, AFTER_DRAIN = false;
  bf16_t* o; int pitch;
  DI void operator()(const pg8::f32x4 (&acc)[2][2][4][2], const pg8::Unit& u, int wr, int wc, int fr, int fq) const {
#pragma unroll
    for (int ai = 0; ai < 2; ++ai)
#pragma unroll
      for (int m = 0; m < 4; ++m) {
        const int row = u.pm * 256 + ai * 128 + wr * 64 + m * 16 + fr;
#pragma unroll
        for (int bj = 0; bj < 2; ++bj) {
          const int c0 = u.pn * 256 + bj * 128 + wc * 32 + 8 * fq;
          const f32x4 v0 = acc[ai][bj][m][0], v1 = acc[ai][bj][m][1];
          u32x4 w; w[0] = pk2(v0[0], v0[1]); w[1] = pk2(v0[2], v0[3]); w[2] = pk2(v1[0], v1[1]); w[3] = pk2(v1[2], v1[3]);
          *(u32x4*)(o + (size_t)row * pitch + c0) = w;
        }
      }
  }
};
struct PgProj {
  static constexpr bool PERM = true, AFTER_DRAIN = false, DEQ = true;
  const P* p;
  DI void deq(pg8::f32x4 (&acc)[2][2][4][2], const pg8::Unit& u, int wr, int wc, int fr, int fq) const {
    const float* srow = (const float*)(p->ws + WS_HS0); const float* scol = (const float*)(p->ws + WS_SWIN);
#pragma unroll
    for (int bj = 0; bj < 2; ++bj) {
      const int c0 = u.pn * 256 + bj * 128 + wc * 32 + 8 * fq;
      const f32x4 sc0 = *(const f32x4*)(scol + c0), sc1 = *(const f32x4*)(scol + c0 + 4);
#pragma unroll
      for (int ai = 0; ai < 2; ++ai)
#pragma unroll
        for (int m = 0; m < 4; ++m) {
          const float sr = srow[u.pm * 256 + ai * 128 + wr * 64 + m * 16 + fr];
          const pg8::v4i_t i0 = __builtin_bit_cast(pg8::v4i_t, acc[ai][bj][m][0]), i1 = __builtin_bit_cast(pg8::v4i_t, acc[ai][bj][m][1]);
#pragma unroll
          for (int r = 0; r < 4; ++r) { acc[ai][bj][m][0][r] = (float)i0[r] * sr * sc0[r]; acc[ai][bj][m][1][r] = (float)i1[r] * sr * sc1[r]; }
        }
    }
  }
  DI void operator()(const pg8::f32x4 (&acc)[2][2][4][2], const pg8::Unit& u, int wr, int wc, int fr, int fq) const {
    char* ws = p->ws;
    const bool isctx = u.pm * 256 >= TL;
#pragma unroll
    for (int bj = 0; bj < 2; ++bj) {
      const int c0 = u.pn * 256 + bj * 128 + wc * 32 + 8 * fq;
      const int cs = u.pn * 256 + bj * 128 + wc * 32;
      if (cs < 2048) {
        const bool isg = cs >= 1536;
        if (isg && isctx) continue;
        bf16_t* o = (bf16_t*)(ws + (isg ? WS_GATE : WS_QKVRAW));
        const int pitch = isg ? 512 : 1536, cofs = isg ? c0 - 1536 : c0;
#pragma unroll
        for (int ai = 0; ai < 2; ++ai)
#pragma unroll
          for (int m = 0; m < 4; ++m) {
            const int row = u.pm * 256 + ai * 128 + wr * 64 + m * 16 + fr;
            f32x4 v0 = acc[ai][bj][m][0], v1 = acc[ai][bj][m][1];
            if (isg) {
#pragma unroll
              for (int r = 0; r < 4; ++r) { v0[r] = silu_f(v0[r]); v1[r] = silu_f(v1[r]); }
            }
            u32x4 w; w[0] = pk2(v0[0], v0[1]); w[1] = pk2(v0[2], v0[3]); w[2] = pk2(v1[0], v1[1]); w[3] = pk2(v1[2], v1[3]);
            *(u32x4*)(o + (size_t)row * pitch + cofs) = w;
          }
      } else if (cs < 3072) {
        const bool isq = cs < 2560;
        if (isq && isctx) continue;
        const float* rope = (const float*)(ws + WS_ROPE);
        bf16_t* o = (bf16_t*)(ws + (isq ? WS_Q : WS_K));
        const int gofs = (c0 & ~63) - (isq ? 2048 : 2560), d0 = ((c0 & 63) >> 3) * 4;
        const float qs = isq ? 0.125f * 1.4426950408889634f : 1.f;
#pragma unroll
        for (int ai = 0; ai < 2; ++ai)
#pragma unroll
          for (int m = 0; m < 4; ++m) {
            const int row = u.pm * 256 + ai * 128 + wr * 64 + m * 16 + fr;
            const f32x4 x1 = acc[ai][bj][m][0], x2 = acc[ai][bj][m][1];
            size_t orow; float o1[4], o2[4];
            if (!isctx) {
              const int l = row & (SEQ - 1);
              orow = isq ? (size_t)row : (size_t)(row >> 13) * KVL + l;
              const f32x4 ca = *(const f32x4*)(rope + ((size_t)l * 32 + d0) * 2), cb2 = *(const f32x4*)(rope + ((size_t)l * 32 + d0) * 2 + 4);
              const float cs4[4] = {ca[0], ca[2], cb2[0], cb2[2]}, sn4[4] = {ca[1], ca[3], cb2[1], cb2[3]};
#pragma unroll
              for (int r = 0; r < 4; ++r) { o1[r] = (x1[r] * cs4[r] - x2[r] * sn4[r]) * qs; o2[r] = (x1[r] * sn4[r] + x2[r] * cs4[r]) * qs; }
            } else {
              const int rc = row - TL; orow = (size_t)(rc >> 8) * KVL + SEQ + (rc & 255);
#pragma unroll
              for (int r = 0; r < 4; ++r) { o1[r] = x1[r]; o2[r] = x2[r]; }
            }
            u32x2 v; v[0] = pk2(o1[0], o1[1]); v[1] = pk2(o1[2], o1[3]); *(u32x2*)(o + orow * 512 + gofs + d0) = v;
            v[0] = pk2(o2[0], o2[1]); v[1] = pk2(o2[2], o2[3]); *(u32x2*)(o + orow * 512 + gofs + 32 + d0) = v;
          }
      } else if (cs < 3584) {
        bf16_t* o = (bf16_t*)(ws + WS_VROW);
#pragma unroll
        for (int ai = 0; ai < 2; ++ai)
#pragma unroll
          for (int m = 0; m < 4; ++m) {
            const int row = u.pm * 256 + ai * 128 + wr * 64 + m * 16 + fr;
            size_t orow; if (!isctx) orow = (size_t)(row >> 13) * KVL + (row & (SEQ - 1)); else { const int rc = row - TL; orow = (size_t)(rc >> 8) * KVL + SEQ + (rc & 255); }
            const f32x4 v0 = acc[ai][bj][m][0], v1 = acc[ai][bj][m][1];
            u32x4 w; w[0] = cvtpk(v0[0], v0[1]); w[1] = cvtpk(v0[2], v0[3]); w[2] = cvtpk(v1[0], v1[1]); w[3] = cvtpk(v1[2], v1[3]);
            *(u32x4*)(o + orow * 512 + (c0 - 3072)) = w;
          }
      } else if (cs == 3584) {
        float* o = (float*)(ws + WS_BA);
        const int j0 = c0 - 3584;
#pragma unroll
        for (int ai = 0; ai < 2; ++ai)
#pragma unroll
          for (int m = 0; m < 4; ++m) {
            const int row = u.pm * 256 + ai * 128 + wr * 64 + m * 16 + fr;
#pragma unroll
            for (int n = 0; n < 2; ++n) {
              f32x4 y;
#pragma unroll
              for (int r = 0; r < 4; ++r) {
                const int j = j0 + 4 * n + r; const float v = acc[ai][bj][m][n][r];
                if (j0 < 16) y[r] = sigmoid_f(v);
                else { const float z = v + p->dt_bias[j - 16]; const float sp = (z > 20.f) ? z : log1pf(__expf(z)); y[r] = -__expf(p->a_log[j - 16]) * sp; }
              }
              *(f32x4*)(o + (size_t)row * 32 + j0 + 4 * n) = y;
            }
          }
      }
    }
  }
};
struct PgScoreI8 {
  static constexpr bool PERM = true, AFTER_DRAIN = false, DEQ = false;
  bf16_t* o; const float* srow; const float* scol;
  DI void operator()(const pg8::f32x4 (&acc)[2][2][4][2], const pg8::Unit& u, int wr, int wc, int fr, int fq) const {
#pragma unroll
    for (int bj = 0; bj < 2; ++bj) {
      const int c0 = u.pn * 256 + bj * 128 + wc * 32 + 8 * fq;
      const f32x4 s0 = *(const f32x4*)(scol + c0), s1 = *(const f32x4*)(scol + c0 + 4);
#pragma unroll
      for (int ai = 0; ai < 2; ++ai)
#pragma unroll
        for (int m = 0; m < 4; ++m) {
          const int row = u.pm * 256 + ai * 128 + wr * 64 + m * 16 + fr;
          const float sr = srow[row];
          const pg8::v4i_t i0 = __builtin_bit_cast(pg8::v4i_t, acc[ai][bj][m][0]), i1 = __builtin_bit_cast(pg8::v4i_t, acc[ai][bj][m][1]);
          u32x4 w;
          w[0] = pk2((float)i0[0] * sr * s0[0], (float)i0[1] * sr * s0[1]); w[1] = pk2((float)i0[2] * sr * s0[2], (float)i0[3] * sr * s0[3]);
          w[2] = pk2((float)i1[0] * sr * s1[0], (float)i1[1] * sr * s1[1]); w[3] = pk2((float)i1[2] * sr * s1[2], (float)i1[3] * sr * s1[3]);
          *(u32x4*)(o + (size_t)row * 2048 + c0) = w;
        }
    }
  }
};
template <class Epi>
DI void pg8_run_i8(char* lds, const void* A8, const void* Bt8, int M, int N, int Kbytes, const Epi& E) {
  pg8::Gemm g{(const pg8::bf16_t*)A8, (const pg8::bf16_t*)Bt8, M, N, Kbytes / 2};
  pg8::StaticOrder S; S.init(M, N, (int)gridDim.x, (int)blockIdx.x);
  pg8::gemm_phase<Epi, pg8::StaticOrder, true, true, true>((PG8_LAS unsigned char*)lds, g, S, E);
}
template <class Epi>
DI void pg8_run(char* lds, const bf16_t* A, const bf16_t* Bt, int M, int N, int K, const Epi& E) {
  pg8::Gemm g{A, Bt, M, N, K};
  pg8::StaticOrder S; S.init(M, N, (int)gridDim.x, (int)blockIdx.x);
  pg8::gemm_phase<Epi, pg8::StaticOrder, true, true>((PG8_LAS unsigned char*)lds, g, S, E);
}

DI void gdn_solve(const float* MT, const float* src  , const float* be, const float* gc  ,
                  int d, int part, int lane, bf16_t* uo) {
  float a[64];
#pragma unroll
  for (int i = 0; i < 64; ++i) {
    const int t = d ? 63 - i : i;
    float v = be[t] * src[t * 68 + lane];
    if (part) v *= __expf(gc[t]);
    a[i] = v;
  }
#pragma unroll
  for (int j = 0; j < 63; ++j) {
    const float xj = a[j];
#pragma unroll
    for (int i4 = ((j + 1) & ~3); i4 < 64; i4 += 4) {
      const f32x4 m = *(const f32x4*)(MT + j * 68 + i4);
#pragma unroll
      for (int q = 0; q < 4; ++q) if (i4 + q > j) a[i4 + q] -= m[q] * xj;
    }
  }
  if (part) {
#pragma unroll
    for (int i = 0; i < 64; ++i) uo[i * 64 + lane] = (bf16_t)f2bf(a[i]);
  } else {
#pragma unroll
    for (int c = 0; c < 8; ++c) {
      u32x4 o; o[0] = pk2(a[8 * c], a[8 * c + 1]); o[1] = pk2(a[8 * c + 2], a[8 * c + 3]); o[2] = pk2(a[8 * c + 4], a[8 * c + 5]); o[3] = pk2(a[8 * c + 6], a[8 * c + 7]);
      *(u32x4*)(uo + lane * 64 + 8 * c) = o;
    }
  }
}

template <int MODE = 0>
DI void ph_gdn_prep(const P& p, char* lds) {
  const int tid0 = otid();
  float* L = (float*)lds;
  constexpr int HSZ = 4 * 64 * 68 + 6 * 64;
  const bf16_t* raw = (const bf16_t*)(p.ws + WS_QKVRAW);
  const float* BA = (const float*)(p.ws + WS_BA);
  bf16_t* qn = (bf16_t*)(p.ws + WS_QN); bf16_t* kn = (bf16_t*)(p.ws + WS_KN);
  float* GC = (float*)(p.ws + WS_GC);
  bf16_t* UW = (bf16_t*)(p.ws + WS_UW);
  for (int it = blockIdx.x; it < NB * NCH * 4; it += gridDim.x) {
    int tid = tid0; asm volatile("" : "+v"(tid));
    const int lane = tid & 63, wave = __builtin_amdgcn_readfirstlane(tid >> 6);
    const int hpair = it & 3, cid = (it >> 2) % NCH, b = it / (4 * NCH);
    const int segbase = (cid < 4) ? TL + b * CTXL : b * SEQ, c0 = (cid < 4) ? cid * 64 : (cid - 4) * 64, seglen = (cid < 4) ? CTXL : SEQ;
    __syncthreads();
    {
      const int t = tid >> 3, c8 = tid & 7, sidx = c0 + t;
      const size_t grow = (size_t)(segbase + sidx);
      const bool hm = sidx - 1 >= 0, hp_ = sidx + 1 < seglen;
#pragma unroll 1
      for (int hh = 0; hh < 2; ++hh) {
        const int head = hpair * 2 + hh;
        float* kf = L + hh * HSZ; float* vf = kf + 64 * 68;
#pragma unroll
        for (int part = 0; part < 3; ++part) {
          const int ch = part * 512 + head * 64 + c8 * 8;
          const u32x4 z4 = {0u, 0u, 0u, 0u};
          const u32x4 rm = hm ? *(const u32x4*)(raw + (grow - 1) * 1536 + ch) : z4;
          const u32x4 r0v = *(const u32x4*)(raw + grow * 1536 + ch);
          const u32x4 rp = hp_ ? *(const u32x4*)(raw + (grow + 1) * 1536 + ch) : z4;
          float v[8]; float ss = 0.f;
#pragma unroll
          for (int w = 0; w < 4; ++w) {
            const f32x2_t w0 = *(const f32x2_t*)(p.conv_w + ch + 2 * w), w1 = *(const f32x2_t*)(p.conv_w + 1536 + ch + 2 * w), w2 = *(const f32x2_t*)(p.conv_w + 3072 + ch + 2 * w);
            v[2 * w] = silu_f(w0[0] * bflo(rm[w]) + w1[0] * bflo(r0v[w]) + w2[0] * bflo(rp[w]));
            v[2 * w + 1] = silu_f(w0[1] * bfhi(rm[w]) + w1[1] * bfhi(r0v[w]) + w2[1] * bfhi(rp[w]));
            ss += v[2 * w] * v[2 * w] + v[2 * w + 1] * v[2 * w + 1];
          }
          if (part < 2) {
            ss += __shfl_xor(ss, 1, 64); ss += __shfl_xor(ss, 2, 64); ss += __shfl_xor(ss, 4, 64);
            const float rn = rsqrtf(ss + EPS) * (part == 0 ? 0.125f : 1.f);
#pragma unroll
            for (int w = 0; w < 8; ++w) v[w] *= rn;
            u32x4 o; o[0] = pk2(v[0], v[1]); o[1] = pk2(v[2], v[3]); o[2] = pk2(v[4], v[5]); o[3] = pk2(v[6], v[7]);
            *(u32x4*)((part == 0 ? qn : kn) + grow * 512 + head * 64 + c8 * 8) = o;
          }
          if (part >= 1) {
            float* dst = (part == 1 ? kf : vf) + t * 68 + c8 * 8;
            *(f32x4*)dst = f32x4{v[0], v[1], v[2], v[3]}; *(f32x4*)(dst + 4) = f32x4{v[4], v[5], v[6], v[7]};
          }
        }
      }
    }
    if (MODE == 2) continue;
    if (wave < 4) {
      const int hh = wave >> 1, d = wave & 1, head = hpair * 2 + hh, t = lane;
      float* be = L + hh * HSZ + 4 * 64 * 68;
      const size_t row = (size_t)(segbase + c0 + t);
      be[d * 64 + t] = BA[row * 32 + d * 8 + head];
      const float g = BA[row * 32 + 16 + d * 8 + head];
      float a = g;
#pragma unroll
      for (int o = 1; o < 64; o <<= 1) {
        const float nb_ = d ? __shfl_down(a, o, 64) : __shfl_up(a, o, 64);
        const bool ok = d ? (lane + o < 64) : (lane >= o);
        a += ok ? nb_ : 0.f;
      }
      be[256 + d * 64 + t] = a;
      GC[((size_t)((b * 8 + head) * 2 + d) * NCH + cid) * 64 + (d ? 63 - t : t)] = a;
    }
    __syncthreads();
    {
      const int hh = wave >> 2, Ln = lane;
      float* kf = L + hh * HSZ; float* M0 = kf + 2 * 64 * 68; float* M1 = kf + 3 * 64 * 68; float* be = kf + 4 * 64 * 68; float* gc = be + 256;
      float a[16];
#pragma unroll
      for (int i = 0; i < 16; ++i) a[i] = 0.f;
#pragma unroll 1
      for (int c = 0; c < 64; c += 4) {
        const f32x4 kv = *(const f32x4*)(kf + Ln * 68 + c);
#pragma unroll
        for (int i = 0; i < 16; ++i) { const f32x4 kr = *(const f32x4*)(kf + ((wave & 3) * 16 + i) * 68 + c); a[i] += kv[0] * kr[0] + kv[1] * kr[1] + kv[2] * kr[2] + kv[3] * kr[3]; }
      }
      const float b0 = be[Ln], b1 = be[64 + Ln], g0 = gc[Ln], g1 = gc[64 + Ln];
#pragma unroll
      for (int i = 0; i < 16; ++i) {
        const int ti = (wave & 3) * 16 + i;
        if (Ln > ti) M0[ti * 68 + Ln] = b0 * a[i] * __expf(g0 - gc[ti]);
        else if (Ln < ti) M1[(63 - ti) * 68 + 63 - Ln] = b1 * a[i] * __expf(g1 - gc[64 + ti]);
      }
    }
    __syncthreads();
    if (MODE == 0) {
      const int hh = wave >> 2, d = (wave >> 1) & 1, part = wave & 1, head = hpair * 2 + hh;
      float* kf = L + hh * HSZ; float* vf = kf + 64 * 68; float* Md = kf + (2 + d) * 64 * 68; float* be = kf + 4 * 64 * 68; float* gc = be + 256;
      bf16_t* uo = UW + (((size_t)((b * 8 + head) * 2 + d) * NCH + cid) * 2 + part) * 4096;
      gdn_solve(Md, part ? kf : vf, be + d * 64, gc + d * 64, d, part, lane, uo);
    }
  }
}

#define MFMA16(a, b, c) __builtin_amdgcn_mfma_f32_16x16x32_bf16((a), (b), (c), 0, 0, 0)
constexpr int SC_LD = 72;
constexpr int SC_T = 64 * SC_LD * 2;
constexpr int SC_STAGE = 5 * SC_T + 1024;
constexpr int SC_KNL = 2 * SC_STAGE, SC_QNL = SC_KNL + SC_T;
DI bf16x8 pack8(const f32x4& a, const f32x4& b) { u32x4 r; r[0] = cvtpk(a[0], a[1]); r[1] = cvtpk(a[2], a[3]); r[2] = cvtpk(b[0], b[1]); r[3] = cvtpk(b[2], b[3]); return __builtin_bit_cast(bf16x8, r); }
DI bf16x8 afrag(const char* tile, int row, int kofs  ) {
  const char* pr = tile + (row * SC_LD + kofs) * 2;
  const u32x2 lo = *(const u32x2*)pr, hi = *(const u32x2*)(pr + 32);
  u32x4 r; r[0] = lo[0]; r[1] = lo[1]; r[2] = hi[0]; r[3] = hi[1];
  return __builtin_bit_cast(bf16x8, r);
}
template <int NOSTORE = 0>
DI void ph_gdn_scan(const P& p, char* lds) {
  const int tid = otid(), lane = tid & 63, wave = __builtin_amdgcn_readfirstlane(tid >> 6);
  const int c = lane & 15, q = lane >> 4;
  const bf16_t* qn = (const bf16_t*)(p.ws + WS_QN); const bf16_t* kn = (const bf16_t*)(p.ws + WS_KN);
  const float* GC = (const float*)(p.ws + WS_GC);
  const bf16_t* UW = (const bf16_t*)(p.ws + WS_UW);
  bf16_t* Ob = (bf16_t*)(p.ws + WS_OBUF);
  for (int it = blockIdx.x; it < 64; it += gridDim.x) {
    const int bhd = it, d = bhd & 1, head = (bhd >> 1) & 7, b = bhd >> 4;
    __syncthreads();
    if (wave >= 4) {
      const int pt = tid - 256;
      const int r0 = pt >> 3, cc = pt & 7;
      u32x4 rW0A, rW1A, rU0A, rU1A, rK0A, rK1A, rQ0A, rQ1A; f32x4 rGA;
      u32x4 rW0B, rW1B, rU0B, rU1B, rK0B, rK1B, rQ0B, rQ1B; f32x4 rGB;
#define SP_CID(n) (d ? ((n) < 4 ? 3 - (n) : 135 - (n)) : (n))
#define SP_LOAD(n, S) do { const int nn_ = (n) < NCH ? (n) : NCH - 1; const int cid_ = SP_CID(nn_); const bool lat_ = cid_ >= 4; const int sb_ = lat_ ? b * SEQ : TL + b * CTXL, c0_ = lat_ ? (cid_ - 4) * 64 : cid_ * 64; \
        const bf16_t* uw_ = UW + ((size_t)(bhd * NCH + cid_) * 2) * 4096; \
        rU0##S = *(const u32x4*)(uw_ + r0 * 64 + cc * 8); rU1##S = *(const u32x4*)(uw_ + (r0 + 32) * 64 + cc * 8); \
        rW0##S = *(const u32x4*)(uw_ + 4096 + r0 * 64 + cc * 8); rW1##S = *(const u32x4*)(uw_ + 4096 + (r0 + 32) * 64 + cc * 8); \
        const int t0_ = d ? 63 - r0 : r0, t1_ = d ? 31 - r0 : r0 + 32; \
        rK0##S = *(const u32x4*)(kn + (size_t)(sb_ + c0_ + t0_) * 512 + head * 64 + cc * 8); rK1##S = *(const u32x4*)(kn + (size_t)(sb_ + c0_ + t1_) * 512 + head * 64 + cc * 8); \
        const bf16_t* qk_ = lat_ ? qn : kn;     \
        rQ0##S = *(const u32x4*)(qk_ + (size_t)(sb_ + c0_ + t0_) * 512 + head * 64 + cc * 8); rQ1##S = *(const u32x4*)(qk_ + (size_t)(sb_ + c0_ + t1_) * 512 + head * 64 + cc * 8); \
        rG##S = *(const f32x4*)(GC + (size_t)(bhd * NCH + cid_) * 64 + (pt & 15) * 4); } while (0)
#define SP_A(n, S) do { char* st_ = lds + ((n) & 1) * SC_STAGE; const int o0_ = (r0 * SC_LD + cc * 8) * 2, o1_ = o0_ + 32 * SC_LD * 2; \
        *(u32x4*)(st_ + o0_) = rW0##S; *(u32x4*)(st_ + o1_) = rW1##S; *(u32x4*)(st_ + SC_T + o0_) = rU0##S; *(u32x4*)(st_ + SC_T + o1_) = rU1##S; \
        *(u32x4*)(lds + SC_KNL + o0_) = rK0##S; *(u32x4*)(lds + SC_KNL + o1_) = rK1##S; \
        *(u32x4*)(lds + SC_QNL + o0_) = rQ0##S; *(u32x4*)(lds + SC_QNL + o1_) = rQ1##S; \
        if (pt < 16) { float* gp_ = (float*)(st_ + 5 * SC_T); *(f32x4*)(gp_ + pt * 4) = rG##S; } } while (0)
#define SP_B(n) do { char* st_ = lds + ((n) & 1) * SC_STAGE; float* gp_ = (float*)(st_ + 5 * SC_T); const bool lat_ = SP_CID((n) < NCH ? (n) : NCH - 1) >= 4; \
        const float gl_ = gp_[63]; \
        if (pt < 64) { const float gi_ = gp_[pt]; gp_[64 + pt] = __expf(gi_); gp_[128 + pt] = __expf(gl_ - gi_); if (pt == 0) gp_[192] = __expf(gl_); } \
        {   \
          const int i_ = pt & 63; \
          _Pragma("unroll") for (int e_ = 0; e_ < 2; ++e_) { const int ch_ = (pt >> 6) * 2 + e_; const u32x4 kv_ = *(const u32x4*)(lds + SC_KNL + (i_ * SC_LD + ch_ * 8) * 2); \
            bf16_t* kt_ = (bf16_t*)(st_ + 2 * SC_T); \
            _Pragma("unroll") for (int w_ = 0; w_ < 4; ++w_) { kt_[(ch_ * 8 + 2 * w_) * SC_LD + i_] = (bf16_t)(kv_[w_] & 0xFFFFu); kt_[(ch_ * 8 + 2 * w_ + 1) * SC_LD + i_] = (bf16_t)(kv_[w_] >> 16); } } } \
        if (lat_) { \
          {   \
            _Pragma("unroll") for (int e_ = 0; e_ < 2; ++e_) { const int rr_ = r0 + 32 * e_; const float sc_ = __expf(gp_[rr_]); const u32x4 qv_ = *(const u32x4*)(lds + SC_QNL + (rr_ * SC_LD + cc * 8) * 2); u32x4 ov_; \
              _Pragma("unroll") for (int w_ = 0; w_ < 4; ++w_) ov_[w_] = cvtpk(bflo(qv_[w_]) * sc_, bfhi(qv_[w_]) * sc_); \
              *(u32x4*)(st_ + 3 * SC_T + (rr_ * SC_LD + cc * 8) * 2) = ov_; } } \
          {   \
            const int jt_ = wave - 4; \
            const bf16x8 ka0_ = *(const bf16x8*)(lds + SC_KNL + ((16 * jt_ + c) * SC_LD + 8 * q) * 2), ka1_ = *(const bf16x8*)(lds + SC_KNL + ((16 * jt_ + c) * SC_LD + 32 + 8 * q) * 2); \
            bf16x8 qb_[4][2]; \
            _Pragma("unroll") for (int it_ = 0; it_ < 4; ++it_) { qb_[it_][0] = *(const bf16x8*)(lds + SC_QNL + ((16 * it_ + c) * SC_LD + 8 * q) * 2); qb_[it_][1] = *(const bf16x8*)(lds + SC_QNL + ((16 * it_ + c) * SC_LD + 32 + 8 * q) * 2); } \
            const f32x4 gj_ = *(const f32x4*)(gp_ + 16 * jt_ + 4 * q); \
            float gi_[4]; _Pragma("unroll") for (int it_ = 0; it_ < 4; ++it_) gi_[it_] = gp_[16 * it_ + c]; \
            _Pragma("unroll") for (int it_ = 0; it_ < 4; ++it_) { \
              f32x4 ac_ = {0.f, 0.f, 0.f, 0.f}; \
              ac_ = MFMA16(ka0_, qb_[it_][0], ac_); ac_ = MFMA16(ka1_, qb_[it_][1], ac_); \
              const int i_ = 16 * it_ + c; \
              _Pragma("unroll") for (int r_ = 0; r_ < 4; ++r_) { const int j_ = 16 * jt_ + 4 * q + r_; const float e_ = __expf(fminf(gi_[it_] - gj_[r_], 0.f)); ac_[r_] = (i_ >= j_) ? ac_[r_] * e_ : 0.f; } \
              u32x2 ov_; ov_[0] = cvtpk(ac_[0], ac_[1]); ov_[1] = cvtpk(ac_[2], ac_[3]); \
              *(u32x2*)(st_ + 4 * SC_T + ((16 * it_ + c) * SC_LD + 16 * jt_ + 4 * q) * 2) = ov_; } } } } while (0)
      SP_LOAD(0, A); SP_LOAD(1, B);
      SP_A(0, A);
      __syncthreads();
      SP_B(0);
      SP_LOAD(2, A);
      __syncthreads();
#define SP_STEP(n, S) do { SP_A((n) + 1, S); SP_LOAD((n) + 3, S);        \
        __syncthreads();                 \
        SP_B((n) + 1); \
        __syncthreads();                 } while (0)
#pragma unroll 1
      for (int n = 0; n < NCH; n += 2) { SP_STEP(n, B); SP_STEP(n + 1, A); }
#undef SP_STEP
#undef SP_LOAD
#undef SP_A
#undef SP_B
    } else {
      f32x4 S[4];
#pragma unroll
      for (int i = 0; i < 4; ++i) S[i] = f32x4{0.f, 0.f, 0.f, 0.f};
      __syncthreads();
      __syncthreads();
#pragma unroll 1
      for (int n = 0; n < NCH; ++n) {
        const int cid = SP_CID(n); const bool lat = cid >= 4;
        const char* st = lds + (n & 1) * SC_STAGE; const float* gp = (const float*)(st + 5 * SC_T);
        bf16x8 Sb[2], Sn[2];
#pragma unroll
        for (int ks = 0; ks < 2; ++ks) {
          Sb[ks] = pack8(S[2 * ks], S[2 * ks + 1]);
          u32x4 t = __builtin_bit_cast(u32x4, Sb[ks]);
#pragma unroll
          for (int w = 0; w < 4; ++w) t[w] ^= 0x80008000u;
          Sn[ks] = __builtin_bit_cast(bf16x8, t);
        }
        u32x2 ur[4]; bf16x8 wf[4][2], kf2[4][2]; f32x4 sc4[4];
#pragma unroll
        for (int mt = 0; mt < 4; ++mt) {
          ur[mt] = *(const u32x2*)(st + SC_T + ((16 * wave + c) * SC_LD + 16 * mt + 4 * q) * 2);
          wf[mt][0] = afrag(st, 16 * mt + c, 4 * q); wf[mt][1] = afrag(st, 16 * mt + c, 32 + 4 * q);
          sc4[mt] = *(const f32x4*)(gp + 128 + 16 * mt + 4 * q);
        }
#pragma unroll
        for (int dt = 0; dt < 4; ++dt) { kf2[dt][0] = afrag(st + 2 * SC_T, 16 * dt + c, 4 * q); kf2[dt][1] = afrag(st + 2 * SC_T, 16 * dt + c, 32 + 4 * q); }
        const float gt = gp[192];
        f32x4 vn[4], vs[4];
#pragma unroll
        for (int mt = 0; mt < 4; ++mt) {
          f32x4 acc = {bflo(ur[mt][0]), bfhi(ur[mt][0]), bflo(ur[mt][1]), bfhi(ur[mt][1])};
          acc = MFMA16(wf[mt][0], Sn[0], acc);
          acc = MFMA16(wf[mt][1], Sn[1], acc);
          vn[mt] = acc;
          vs[mt] = acc * sc4[mt];
        }
        bf16x8 Vn[2], Vs[2];
#pragma unroll
        for (int ks = 0; ks < 2; ++ks) { Vn[ks] = pack8(vn[2 * ks], vn[2 * ks + 1]); Vs[ks] = pack8(vs[2 * ks], vs[2 * ks + 1]); }
        f32x4 Snew[4];
#pragma unroll
        for (int dt = 0; dt < 4; ++dt) {
          f32x4 acc = S[dt] * gt;
          acc = MFMA16(kf2[dt][0], Vs[0], acc);
          acc = MFMA16(kf2[dt][1], Vs[1], acc);
          Snew[dt] = acc;
        }
        __syncthreads();
        if (lat) {
          const int sb = b * SEQ, c0 = (cid - 4) * 64;
          bf16x8 qf[4][2], pf[4][2];
#pragma unroll
          for (int mt = 0; mt < 4; ++mt) {
            qf[mt][0] = afrag(st + 3 * SC_T, 16 * mt + c, 4 * q); qf[mt][1] = afrag(st + 3 * SC_T, 16 * mt + c, 32 + 4 * q);
            pf[mt][0] = afrag(st + 4 * SC_T, 16 * mt + c, 4 * q); pf[mt][1] = afrag(st + 4 * SC_T, 16 * mt + c, 32 + 4 * q);
          }
#pragma unroll
          for (int mt = 0; mt < 4; ++mt) {
            f32x4 o = {0.f, 0.f, 0.f, 0.f};
            o = MFMA16(Sb[0], qf[mt][0], o);
            o = MFMA16(Sb[1], qf[mt][1], o);
            o = MFMA16(Vn[0], pf[mt][0], o);
            o = MFMA16(Vn[1], pf[mt][1], o);
            const int i = 16 * mt + c, t = d ? 63 - i : i;
            u32x2 ov; ov[0] = cvtpk(o[0], o[1]); ov[1] = cvtpk(o[2], o[3]);
            if (!NOSTORE || ov[0] == 0x12345678u) *(u32x2*)(Ob + ((size_t)d * TL + sb + c0 + t) * 512 + head * 64 + 16 * wave + 4 * q) = ov;
          }
        }
#pragma unroll
        for (int dt = 0; dt < 4; ++dt) S[dt] = Snew[dt];
        __syncthreads();
      }
    }
#undef SP_CID
  }
}

constexpr int VT_PITCH = 1024 + 16;
DI void ph_vt8(const P& p, char* lds) {
  const int tid = otid();
  const bf16_t* vrow = (const bf16_t*)(p.ws + WS_VROW); unsigned char* vt8 = (unsigned char*)(p.ws + WS_VT);
  const int nb = (int)gridDim.x - 64;
  for (int tile = (int)blockIdx.x - 64; tile < NB * (KVL / 64); tile += nb) {
    const int b = tile / (KVL / 64), kb = tile - b * (KVL / 64);
    __syncthreads();
#pragma unroll
    for (int i = 0; i < 8; ++i) { const int e = tid + 512 * i, key = e >> 6, ch = e & 63; *(u32x4*)(lds + key * VT_PITCH + ch * 16) = *(const u32x4*)(vrow + ((size_t)b * KVL + kb * 64 + key) * 512 + ch * 8); }
    __syncthreads();
    unsigned char* dst = vt8 + ((size_t)b * 512 + tid) * KVL + kb * 64;
#pragma unroll
    for (int q4 = 0; q4 < 4; ++q4) {
      u32x4 o;
#pragma unroll
      for (int w = 0; w < 4; ++w) {
        const int D = 4 * q4 + w, h = D >> 3, k2 = (D >> 2) & 1, g = D & 3, kbase = 32 * k2 + 8 * g + 4 * h;
        float v[4];
#pragma unroll
        for (int j = 0; j < 4; ++j) v[j] = fminf(fmaxf(bf2f(*(const unsigned short*)(lds + (kbase + j) * VT_PITCH + tid * 2)) * 16.f, -448.f), 448.f);
        int wd = __builtin_amdgcn_cvt_pk_fp8_f32(v[0], v[1], 0, false);
        wd = __builtin_amdgcn_cvt_pk_fp8_f32(v[2], v[3], wd, true);
        o[w] = (unsigned)wd;
      }
      *(u32x4*)(dst + 16 * q4) = o;
    }
  }
}

constexpr int AT_KROW = 72, AT_VROW = 68;
constexpr int AT_V8ROW = 80;
constexpr int AT_KB = 2 * 64 * AT_KROW * 2, AT_VB = 128 * AT_V8ROW, AT_STAGE = AT_KB + AT_VB;
DI void ph_attn(const P& p, char* lds) {
  const int tid = otid(), lane = tid & 63, wave = tid >> 6, wq = wave & 3, m = wave >> 2, h = lane >> 5, cl = lane & 31;
  const bf16_t* Qb = (const bf16_t*)(p.ws + WS_Q); const bf16_t* Kb = (const bf16_t*)(p.ws + WS_K); const unsigned char* VT = (const unsigned char*)(p.ws + WS_VT);
  bf16_t* mix = (bf16_t*)(p.ws + WS_MIX);
  for (int it = blockIdx.x; it < NB * 4 * 64; it += gridDim.x) {
    const int qb = it & 63, head = (it >> 6) & 3, b = it >> 8;
    const int qrow = b * SEQ + qb * 128 + wq * 32 + cl;
    bf16x8 qf[4];
#pragma unroll
    for (int kk = 0; kk < 4; ++kk) qf[kk] = *(const bf16x8*)(Qb + (size_t)qrow * 512 + (head * 2 + m) * 64 + kk * 16 + h * 8);
    f32x16 o[4];
#pragma unroll
    for (int i = 0; i < 4; ++i)
#pragma unroll
      for (int r = 0; r < 16; ++r) o[i][r] = 0.f;
    float mrun = -1e30f, lrun = 0.f;
    const bf16_t* kp0 = Kb + ((size_t)b * KVL + (tid >> 4)) * 512 + head * 128 + (tid & 15) * 8;
    const bf16_t* kp1 = kp0 + (size_t)32 * 512;
    const unsigned char* vp0 = VT + ((size_t)((b * 4 + head) * 128 + (tid >> 2))) * KVL + (tid & 3) * 16;
    const int kw0 = ((((tid & 15) >> 3) * 64 + (tid >> 4)) * AT_KROW + ((tid & 15) & 7) * 8) * 2, kw1 = kw0 + 32 * AT_KROW * 2;
    const int vw0 = AT_KB + (tid >> 2) * AT_V8ROW + (tid & 3) * 16;
    u32x4 rk0, rk1, rv0;
#define A_GLOAD(kv0) do { rk0 = *(const u32x4*)(kp0 + (size_t)(kv0) * 512); rk1 = *(const u32x4*)(kp1 + (size_t)(kv0) * 512); rv0 = *(const u32x4*)(vp0 + (kv0)); } while (0)
#define A_LWRITE(st) do { char* b_ = lds + (st) * AT_STAGE; *(u32x4*)(b_ + kw0) = rk0; *(u32x4*)(b_ + kw1) = rk1; *(u32x4*)(b_ + vw0) = rv0; } while (0)
    A_GLOAD(0);
    __syncthreads();
    A_LWRITE(0);
    __syncthreads();
    constexpr int NKT = KVL / 64;
    for (int kt = 0; kt < NKT; ++kt) {
      if (kt + 1 < NKT) A_GLOAD((kt + 1) * 64);
      const char* sb = lds + (kt & 1) * AT_STAGE;
      const char* ks = sb + (m * 64 * AT_KROW) * 2;
      f32x16 st[2];
#pragma unroll
      for (int k2 = 0; k2 < 2; ++k2) {
#pragma unroll
        for (int r = 0; r < 16; ++r) st[k2][r] = 0.f;
#pragma unroll
        for (int kk = 0; kk < 4; ++kk) {
          const bf16x8 a = *(const bf16x8*)(ks + ((k2 * 32 + cl) * AT_KROW + kk * 16 + h * 8) * 2);
          st[k2] = MFMA32(a, qf[kk], st[k2]);
        }
      }
      float mx = fmaxf(st[0][0], st[1][0]);
#pragma unroll
      for (int r = 1; r < 16; ++r) mx = fmaxf(mx, fmaxf(st[0][r], st[1][r]));
      mx = fmaxf(mx, __shfl_xor(mx, 32, 64));
      if (__any(mx > mrun + 8.f)) {
        const float mnew = fmaxf(mrun, mx);
        const float alpha = __builtin_amdgcn_exp2f(mrun - mnew);
        mrun = mnew; lrun *= alpha;
#pragma unroll
        for (int i = 0; i < 4; ++i)
#pragma unroll
          for (int r = 0; r < 16; ++r) o[i][r] *= alpha;
      }
      float rs = 0.f;
#pragma unroll
      for (int k2 = 0; k2 < 2; ++k2)
#pragma unroll
        for (int r = 0; r < 16; ++r) { const float pv = __builtin_amdgcn_exp2f(st[k2][r] - mrun); st[k2][r] = pv; rs += pv; }
      lrun += rs;
      const char* vsb = sb + AT_KB;
      v8i_t pb;
#pragma unroll
      for (int k2 = 0; k2 < 2; ++k2)
#pragma unroll
        for (int g = 0; g < 4; ++g) {
          int wd = __builtin_amdgcn_cvt_pk_fp8_f32(st[k2][4 * g], st[k2][4 * g + 1], 0, false);
          pb[4 * k2 + g] = __builtin_amdgcn_cvt_pk_fp8_f32(st[k2][4 * g + 2], st[k2][4 * g + 3], wd, true);
        }
#pragma unroll
      for (int dt = 0; dt < 4; ++dt) {
        const char* vr = vsb + (dt * 32 + cl) * AT_V8ROW + 32 * h;
        const u32x4 lo = *(const u32x4*)(vr), hi = *(const u32x4*)(vr + 16);
        v8i_t av; av[0] = lo[0]; av[1] = lo[1]; av[2] = lo[2]; av[3] = lo[3]; av[4] = hi[0]; av[5] = hi[1]; av[6] = hi[2]; av[7] = hi[3];
        o[dt] = __builtin_amdgcn_mfma_scale_f32_32x32x64_f8f6f4(av, pb, o[dt], 0, 0, 0, 127, 0, 127);
      }
      if (kt + 1 < NKT) A_LWRITE((kt + 1) & 1);
      __syncthreads();
    }
#undef A_GLOAD
#undef A_LWRITE
    const float ltot = lrun + __shfl_xor(lrun, 32, 64);
    const float inv = 0.0625f / ltot;
    float* X = (float*)lds;
    if (m == 1) {
#pragma unroll
      for (int dt = 0; dt < 4; ++dt)
#pragma unroll
        for (int r = 0; r < 16; ++r) X[(wq * 32 + cl) * 129 + dt * 32 + crow(r, h)] = o[dt][r] * inv;
    }
    __syncthreads();
    if (m == 0) {
      float l1 = 0.f, l2 = 0.f;
      for (int i = 0; i < 64; ++i) { l1 += p.lam_q1[i] * p.lam_k1[i]; l2 += p.lam_q2[i] * p.lam_k2[i]; }
      const float lam = __expf(l1) - __expf(l2) + 0.2f;
      float ss = 0.f;
#pragma unroll
      for (int dt = 0; dt < 4; ++dt)
#pragma unroll
        for (int r = 0; r < 16; ++r) { const float dv = o[dt][r] * inv - lam * X[(wq * 32 + cl) * 129 + dt * 32 + crow(r, h)]; o[dt][r] = dv; ss += dv * dv; }
      ss += __shfl_xor(ss, 32, 64);
      const float rn = rsqrtf(ss * (1.f / 128.f) + EPS) * 0.8f;
#pragma unroll
      for (int dt = 0; dt < 4; ++dt)
#pragma unroll
        for (int g = 0; g < 4; ++g) {
          const int dv = dt * 32 + 8 * g + 4 * h;
          const f32x4 w4 = *(const f32x4*)(p.subln_w + dv);
          u32x2 v; v[0] = pk2(o[dt][4 * g] * rn * w4[0], o[dt][4 * g + 1] * rn * w4[1]); v[1] = pk2(o[dt][4 * g + 2] * rn * w4[2], o[dt][4 * g + 3] * rn * w4[3]);
          *(u32x2*)(mix + (size_t)qrow * DM + 512 + head * 128 + dv) = v;
        }
    }
    __syncthreads();
  }
}

DI void ph_mixout(const P& p) {
  const int lane = otid() & 63, gw = blockIdx.x * (NT / 64) + (otid() >> 6), nw_ = gridDim.x * (NT / 64);
  const bf16_t* Ob = (const bf16_t*)(p.ws + WS_OBUF); const bf16_t* gate = (const bf16_t*)(p.ws + WS_GATE);
  bf16_t* mix = (bf16_t*)(p.ws + WS_MIX);
  for (int row = gw; row < TL; row += nw_) {
    const u32x4 a = *(const u32x4*)(Ob + (size_t)row * 512 + lane * 8), bq = *(const u32x4*)(Ob + ((size_t)TL + row) * 512 + lane * 8);
    const u32x4 gv = *(const u32x4*)(gate + (size_t)row * 512 + lane * 8);
    float v[8]; float ss = 0.f;
#pragma unroll
    for (int i = 0; i < 4; ++i) { v[2 * i] = bflo(a[i]) + bflo(bq[i]); v[2 * i + 1] = bfhi(a[i]) + bfhi(bq[i]); ss += v[2 * i] * v[2 * i] + v[2 * i + 1] * v[2 * i + 1]; }
    ss += __shfl_xor(ss, 1, 64); ss += __shfl_xor(ss, 2, 64); ss += __shfl_xor(ss, 4, 64);
    const float rn = rsqrtf(ss * (1.f / 64.f) + EPS);
    const int c0 = (lane & 7) * 8;
    u32x4 ov;
#pragma unroll
    for (int i = 0; i < 4; ++i) ov[i] = pk2(v[2 * i] * rn * p.gdn_norm_w[c0 + 2 * i] * bflo(gv[i]), v[2 * i + 1] * rn * p.gdn_norm_w[c0 + 2 * i + 1] * bfhi(gv[i]));
    *(u32x4*)(mix + (size_t)row * DM + lane * 8) = ov;
  }
}

struct EpiResid {
  const float* xin; float* xout; const float* gmod  ; int row0, col0;
  DI void operator()(f32x16 (&acc)[2][2], int wm, int wn, int lane) const {
    const int h = lane >> 5, cl = lane & 31;
#pragma unroll
    for (int mt = 0; mt < 2; ++mt) {
      const int row = row0 + wm * 64 + mt * 32 + cl;
      const float* gm = gmod + (size_t)(row >> 13) * 6144;
#pragma unroll
      for (int nt = 0; nt < 2; ++nt)
#pragma unroll
        for (int g = 0; g < 4; ++g) {
          const int col = col0 + wn * 64 + nt * 32 + 8 * g + 4 * h;
          const f32x4 xv = *(const f32x4*)(xin + (size_t)row * DM + col), g4 = *(const f32x4*)(gm + col);
          f32x4 ov;
#pragma unroll
          for (int r = 0; r < 4; ++r) ov[r] = xv[r] + g4[r] * acc[mt][nt][4 * g + r];
          *(f32x4*)(xout + (size_t)row * DM + col) = ov;
        }
    }
  }
};
DI void ph_gemm_resid(const P& p, char* lds, const bf16_t* A, const bf16_t* Bt, const float* xin, const float* gmod) {
  const int nM = TL / GBM, nN = DM / GBN;
  for (int t = blockIdx.x; t < nM * nN; t += gridDim.x) {
    const int pm = t / nN, pn = t % nN;
    RowLin rf{A + (size_t)pm * GBM * DM, (size_t)DM};
    EpiResid ep{xin, p.out, gmod, pm * GBM, pn * GBN};
    gemm_tile<true>(lds, rf, Bt + (size_t)pn * GBN * DM, DM, ep);
  }
}

struct EpiBf16 {
  bf16_t* o; int pitch, row0, col0;
  DI void operator()(f32x16 (&acc)[2][2], int wm, int wn, int lane) const {
    const int h = lane >> 5, cl = lane & 31;
#pragma unroll
    for (int mt = 0; mt < 2; ++mt) {
      const int row = row0 + wm * 64 + mt * 32 + cl;
#pragma unroll
      for (int nt = 0; nt < 2; ++nt)
#pragma unroll
        for (int g = 0; g < 4; ++g) {
          u32x2 v; v[0] = pk2(acc[mt][nt][4 * g], acc[mt][nt][4 * g + 1]); v[1] = pk2(acc[mt][nt][4 * g + 2], acc[mt][nt][4 * g + 3]);
          *(u32x2*)(o + (size_t)row * pitch + col0 + wn * 64 + nt * 32 + 8 * g + 4 * h) = v;
        }
    }
  }
};
DI void ph_gemm_scores(const P& p, char* lds, int layer, size_t sc_off) {
  const bf16_t* A = (const bf16_t*)(p.ws + R0); const bf16_t* Bt = (const bf16_t*)(p.ws + WS_WEFF) + (size_t)layer * 2048 * 1024;
  const int nM = TL / GBM, nN = 2048 / GBN;
  for (int t = blockIdx.x; t < nM * nN; t += gridDim.x) {
    const int pm = t / nN, pn = t % nN;
    RowLin rf{A + (size_t)pm * GBM * DM, (size_t)DM};
    EpiBf16 ep{(bf16_t*)(p.ws + sc_off), 2048, pm * GBM, pn * GBN};
    gemm_tile<true>(lds, rf, Bt + (size_t)pn * GBN * DM, DM, ep);
  }
}

constexpr size_t WS_TSC = WS_BA;
DI void ph_tables(const P& p) {
  const int lane = otid() & 63, gw = blockIdx.x * (NT / 64) + (otid() >> 6), nw_ = gridDim.x * (NT / 64);
  float* tsc = (float*)(p.ws + WS_TSC);
  for (int rr = gw; rr < 4 * 16384; rr += nw_) {
    const int tb = rr >> 14, e = rr & 16383;
    const float* src = ((tb & 1) ? p.peer_v : p.peer_u) + ((size_t)(tb >> 1) * 16384 + e) * 1024 + lane * 16;
    f32x4 v[4]; float ss = 0.f;
#pragma unroll
    for (int i = 0; i < 4; ++i) { v[i] = *(const f32x4*)(src + 4 * i); ss += v[i][0] * v[i][0] + v[i][1] * v[i][1] + v[i][2] * v[i][2] + v[i][3] * v[i][3]; }
    ss = wave_sum(ss);
    const bool isu = (tb & 1) == 0;
    const float sc = (isu ? 0.35f : 0.5f) * sqrtf(ss * (1.f / 1024.f)) + 1e-30f, inv = 1.f / sc;
    unsigned w0 = 0u, w1 = 0u;
    if (isu) {
#pragma unroll
      for (int i = 0; i < 2; ++i)
#pragma unroll
        for (int j = 0; j < 4; ++j) {
          const int qa = (int)fminf(fmaxf(rintf(v[i][j] * inv), -7.f), 7.f), qb = (int)fminf(fmaxf(rintf(v[2 + i][j] * inv), -7.f), 7.f);
          w0 |= ((unsigned)qa & 15u) << (4 * (4 * i + j)); w1 |= ((unsigned)qb & 15u) << (4 * (4 * i + j));
        }
    } else {
      w0 = __builtin_amdgcn_cvt_scalef32_pk_fp4_f32(w0, v[0][0] * inv, v[0][1] * inv, 1.0f, 0);
      w0 = __builtin_amdgcn_cvt_scalef32_pk_fp4_f32(w0, v[0][2] * inv, v[0][3] * inv, 1.0f, 1);
      w0 = __builtin_amdgcn_cvt_scalef32_pk_fp4_f32(w0, v[1][0] * inv, v[1][1] * inv, 1.0f, 2);
      w0 = __builtin_amdgcn_cvt_scalef32_pk_fp4_f32(w0, v[1][2] * inv, v[1][3] * inv, 1.0f, 3);
      w1 = __builtin_amdgcn_cvt_scalef32_pk_fp4_f32(w1, v[2][0] * inv, v[2][1] * inv, 1.0f, 0);
      w1 = __builtin_amdgcn_cvt_scalef32_pk_fp4_f32(w1, v[2][2] * inv, v[2][3] * inv, 1.0f, 1);
      w1 = __builtin_amdgcn_cvt_scalef32_pk_fp4_f32(w1, v[3][0] * inv, v[3][1] * inv, 1.0f, 2);
      w1 = __builtin_amdgcn_cvt_scalef32_pk_fp4_f32(w1, v[3][2] * inv, v[3][3] * inv, 1.0f, 3);
    }
    u32x2 o; o[0] = w0; o[1] = w1;
    unsigned char* dst = (unsigned char*)(p.ws + WS_TAB + (size_t)tb * 8 * MiB);
    *(u32x2*)(dst + ((((size_t)(lane >> 4)) * 16384 + e) << 7) + (lane & 15) * 8) = o;
    if (lane == 0) tsc[tb * 16384 + e] = sc;
  }
}

DI unsigned srt16(unsigned bf) { return (bf & 0x8000u) ? (~bf & 0xFFFFu) : (bf | 0x8000u); }
DI float unsrt16(unsigned s) { const unsigned bf = (s & 0x8000u) ? (s & 0x7FFFu) : (~s & 0xFFFFu); return __uint_as_float(bf << 16); }
DI unsigned ckey(float v, unsigned cid) { unsigned u = __float_as_uint(v); u = (u & 0x80000000u) ? ~u : (u | 0x80000000u); return (u & 0xFFFFFF00u) | (255u - cid); }
DI float unckey(unsigned k) { unsigned u = k & 0xFFFFFF00u; u = (u & 0x80000000u) ? (u & 0x7FFFFFFFu) : ~u; return __uint_as_float(u & 0xFFFFFF00u); }
DI void bsort16(unsigned (&k)[16]) {
#pragma unroll
  for (int sz = 2; sz <= 16; sz <<= 1)
#pragma unroll
    for (int j = sz >> 1; j > 0; j >>= 1)
#pragma unroll
      for (int i = 0; i < 16; ++i) {
        const int l = i ^ j;
        if (l > i) {
          const unsigned a = k[i], b = k[l], mx = a > b ? a : b, mn = a > b ? b : a;
          if ((i & sz) == 0) { k[i] = mx; k[l] = mn; } else { k[i] = mn; k[l] = mx; }
        }
      }
}
DI void bmerge16(unsigned (&k)[16]) {
#pragma unroll
  for (int j = 8; j > 0; j >>= 1)
#pragma unroll
    for (int i = 0; i < 16; ++i) {
      const int l = i ^ j;
      if (l > i) { const unsigned a = k[i], b = k[l]; k[i] = a > b ? a : b; k[l] = a > b ? b : a; }
    }
}
DI void topmerge16(unsigned (&run)[16], const unsigned (&g)[16]) {
#pragma unroll
  for (int i = 0; i < 16; ++i) run[i] = run[i] > g[15 - i] ? run[i] : g[15 - i];
  bmerge16(run);
}
DI void top16_of_128(const bf16_t* __restrict__ r, unsigned (&run)[16]) {
#pragma unroll 1
  for (int g = 0; g < 8; ++g) {
    const u32x4 v0 = *(const u32x4*)(r + g * 16), v1 = *(const u32x4*)(r + g * 16 + 8);
    unsigned k[16];
#pragma unroll
    for (int q = 0; q < 4; ++q) {
      k[2 * q] = (srt16(v0[q] & 0xFFFFu) << 16) | (127u - (g * 16 + 2 * q));
      k[2 * q + 1] = (srt16(v0[q] >> 16) << 16) | (127u - (g * 16 + 2 * q + 1));
      k[8 + 2 * q] = (srt16(v1[q] & 0xFFFFu) << 16) | (127u - (g * 16 + 8 + 2 * q));
      k[8 + 2 * q + 1] = (srt16(v1[q] >> 16) << 16) | (127u - (g * 16 + 8 + 2 * q + 1));
    }
    bsort16(k);
    if (g == 0) {
#pragma unroll
      for (int i = 0; i < 16; ++i) run[i] = k[i];
    } else topmerge16(run, k);
  }
}
DI void ph_topk(const P& p, char* lds, size_t sc_off, size_t ei_off, size_t eg_off) {
  const bf16_t* sc = (const bf16_t*)(p.ws + sc_off); int* EI = (int*)(p.ws + ei_off); float* EG = (float*)(p.ws + eg_off);
  unsigned char* sI = (unsigned char*)lds;
  const int tid = otid();
  const int tpb_ = TL / gridDim.x;
  for (int g = blockIdx.x * tpb_ * 8 + tid; g < (blockIdx.x + 1) * tpb_ * 8; g += NT) {
    const int t = g >> 3, head = g & 7;
    const bf16_t* r1 = sc + (size_t)t * 2048 + head * 256;
    unsigned k1[16], k2[16];
    top16_of_128(r1, k1);
    top16_of_128(r1 + 128, k2);
    float f1[16], f2[16];
#pragma unroll
    for (int i = 0; i < 16; ++i) { f1[i] = unsrt16(k1[i] >> 16); f2[i] = unsrt16(k2[i] >> 16); sI[i * NT + tid] = (unsigned char)(127u - (k1[i] & 127u)); sI[(16 + i) * NT + tid] = (unsigned char)(127u - (k2[i] & 127u)); }
    unsigned cg0[16], cg1[16], cg2[16], cg3[16];
#pragma unroll
    for (int i = 0; i < 16; ++i) { cg3[i] = 0u; }
    cg0[0] = ckey(f1[0] + f2[0], 0);
    cg0[1] = ckey(f1[0] + f2[1], 1);
    cg0[2] = ckey(f1[0] + f2[2], 2);
    cg0[3] = ckey(f1[0] + f2[3], 3);
    cg0[4] = ckey(f1[0] + f2[4], 4);
    cg0[5] = ckey(f1[0] + f2[5], 5);
    cg0[6] = ckey(f1[0] + f2[6], 6);
    cg0[7] = ckey(f1[0] + f2[7], 7);
    cg0[8] = ckey(f1[0] + f2[8], 8);
    cg0[9] = ckey(f1[0] + f2[9], 9);
    cg0[10] = ckey(f1[0] + f2[10], 10);
    cg0[11] = ckey(f1[0] + f2[11], 11);
    cg0[12] = ckey(f1[0] + f2[12], 12);
    cg0[13] = ckey(f1[0] + f2[13], 13);
    cg0[14] = ckey(f1[0] + f2[14], 14);
    cg0[15] = ckey(f1[0] + f2[15], 15);
    cg1[0] = ckey(f1[1] + f2[0], 16);
    cg1[1] = ckey(f1[1] + f2[1], 17);
    cg1[2] = ckey(f1[1] + f2[2], 18);
    cg1[3] = ckey(f1[1] + f2[3], 19);
    cg1[4] = ckey(f1[1] + f2[4], 20);
    cg1[5] = ckey(f1[1] + f2[5], 21);
    cg1[6] = ckey(f1[1] + f2[6], 22);
    cg1[7] = ckey(f1[1] + f2[7], 23);
    cg1[8] = ckey(f1[2] + f2[0], 32);
    cg1[9] = ckey(f1[2] + f2[1], 33);
    cg1[10] = ckey(f1[2] + f2[2], 34);
    cg1[11] = ckey(f1[2] + f2[3], 35);
    cg1[12] = ckey(f1[2] + f2[4], 36);
    cg1[13] = ckey(f1[3] + f2[0], 48);
    cg1[14] = ckey(f1[3] + f2[1], 49);
    cg1[15] = ckey(f1[3] + f2[2], 50);
    cg2[0] = ckey(f1[3] + f2[3], 51);
    cg2[1] = ckey(f1[4] + f2[0], 64);
    cg2[2] = ckey(f1[4] + f2[1], 65);
    cg2[3] = ckey(f1[4] + f2[2], 66);
    cg2[4] = ckey(f1[5] + f2[0], 80);
    cg2[5] = ckey(f1[5] + f2[1], 81);
    cg2[6] = ckey(f1[6] + f2[0], 96);
    cg2[7] = ckey(f1[6] + f2[1], 97);
    cg2[8] = ckey(f1[7] + f2[0], 112);
    cg2[9] = ckey(f1[7] + f2[1], 113);
    cg2[10] = ckey(f1[8] + f2[0], 128);
    cg2[11] = ckey(f1[9] + f2[0], 144);
    cg2[12] = ckey(f1[10] + f2[0], 160);
    cg2[13] = ckey(f1[11] + f2[0], 176);
    cg2[14] = ckey(f1[12] + f2[0], 192);
    cg2[15] = ckey(f1[13] + f2[0], 208);
    cg3[0] = ckey(f1[14] + f2[0], 224);
    cg3[1] = ckey(f1[15] + f2[0], 240);
    bsort16(cg0); bsort16(cg1); bsort16(cg2); bsort16(cg3);
    topmerge16(cg0, cg1); topmerge16(cg2, cg3); topmerge16(cg0, cg2);
    float e[16]; int id[16]; float sum = 0.f; const float s0 = unckey(cg0[0]);
#pragma unroll
    for (int k = 0; k < 16; ++k) {
      const unsigned cid = 255u - (cg0[k] & 255u);
      e[k] = __expf(unckey(cg0[k]) - s0); sum += e[k];
      id[k] = (int)sI[(cid >> 4) * NT + tid] * 128 + (int)sI[(16 + (cid & 15)) * NT + tid];
    }
    const float inv = 1.f / sum;
#pragma unroll
    for (int k = 0; k < 16; k += 4) {
      int4 iv = {id[k], id[k + 1], id[k + 2], id[k + 3]}; f32x4 gv = {e[k] * inv, e[k + 1] * inv, e[k + 2] * inv, e[k + 3] * inv};
      *(int4*)(EI + (size_t)g * 16 + k) = iv; *(f32x4*)(EG + (size_t)g * 16 + k) = gv;
    }
  }
}

DI void fp8x16_to_f32(const u32x4& w, float (&f)[16]) {
#pragma unroll
  for (int i = 0; i < 4; ++i) {
    const f32x2_t lo = __builtin_amdgcn_cvt_pk_f32_fp8((int)w[i], false), hi = __builtin_amdgcn_cvt_pk_f32_fp8((int)w[i], true);
    f[4 * i] = lo[0]; f[4 * i + 1] = lo[1]; f[4 * i + 2] = hi[0]; f[4 * i + 3] = hi[1];
  }
}
DI void block_handoff() {
  asm volatile("s_waitcnt vmcnt(0)" ::: "memory");
  __syncthreads();
  if (otid() == 0) { __builtin_amdgcn_fence(__ATOMIC_ACQUIRE, "agent"); asm volatile("s_waitcnt vmcnt(0)" ::: "memory"); }
  __syncthreads();
}
constexpr int PQ_NS = 4;
#define PQ_BEGIN() \
  const int tid = otid(), lane = tid & 63, wave = tid >> 6, g8 = lane >> 3, c16 = lane & 7; \
  const int tpb_ = TL / gridDim.x; \
  _Pragma("unroll 1") for (int x = 0; x < PQ_NS; ++x) { \
    const int tbeg = blockIdx.x * tpb_ + wave, tend = (blockIdx.x + 1) * tpb_;
#define PQ_END() }
#define FP4X8(wd, o0, o1, o2, o3) do { o0 = __builtin_amdgcn_cvt_scalef32_pk_f32_fp4((wd), 1.0f, 0); o1 = __builtin_amdgcn_cvt_scalef32_pk_f32_fp4((wd), 1.0f, 1); \
                                         o2 = __builtin_amdgcn_cvt_scalef32_pk_f32_fp4((wd), 1.0f, 2); o3 = __builtin_amdgcn_cvt_scalef32_pk_f32_fp4((wd), 1.0f, 3); } while (0)
DI void ph_peer_u(const P& p, char* lds, int layer, size_t ei_off, size_t part_off) {
  for (int rep = 0; rep <= p.lo; ++rep) {
  PQ_BEGIN()
  const unsigned char* hq = (const unsigned char*)(p.ws + WS_HQ) + x * 128 + c16 * 16;
  const float* hs = (const float*)(p.ws + WS_HS);
  const unsigned char* us = (const unsigned char*)(p.ws + WS_TAB + (size_t)(layer * 2) * 8 * MiB) + ((size_t)x * 16384 << 7) + c16 * 16;
  const int* EI = (const int*)(p.ws + ei_off) + g8 * 16;
  unsigned* part = (unsigned*)(p.ws + part_off);
  int4 nid[4]; u32x4 nhh, nhl; float nsc;
#define PU_PREF(tt) do { const int t_ = (tt) < tend ? (tt) : tend - 1; \
    _Pragma("unroll") for (int i = 0; i < 4; ++i) nid[i] = *(const int4*)(EI + (size_t)t_ * 128 + i * 4); \
    nhh = *(const u32x4*)(hq + (size_t)t_ * 1024); nhl = *(const u32x4*)(hq + (size_t)t_ * 1024 + 512); nsc = hs[t_]; } while (0)
  PU_PREF(tbeg);
#pragma unroll 1
  for (int t = tbeg; t < tend; t += NT / 64) {
    int id[16];
#pragma unroll
    for (int i = 0; i < 4; ++i) { id[4 * i] = nid[i].x; id[4 * i + 1] = nid[i].y; id[4 * i + 2] = nid[i].z; id[4 * i + 3] = nid[i].w; }
    const u32x4 hh = nhh, hl = nhl; const float sct = nsc;
    u32x4 ur[16];
#pragma unroll
    for (int i = 0; i < 16; ++i) ur[i] = *(const u32x4*)(us + ((size_t)id[i] << 7));
    float pd[16];
#pragma unroll
    for (int i = 0; i < 16; ++i) {
      int ah = 0, al = 0;
#pragma unroll
      for (int w = 0; w < 4; ++w) { ah = __builtin_amdgcn_sdot8((int)ur[i][w], (int)hh[w], ah, false); al = __builtin_amdgcn_sdot8((int)ur[i][w], (int)hl[w], al, false); }
      pd[i] = (float)(16 * ah + al);
    }
    PU_PREF(t + NT / 64);
    float q8[8], q4[4], q2[2];
    { const bool up = (lane & 4) != 0;
#pragma unroll
      for (int m = 0; m < 8; ++m) { const float keep = up ? pd[8 + m] : pd[m], send = up ? pd[m] : pd[8 + m]; q8[m] = keep + __shfl_xor(send, 4, 64); } }
    { const bool up = (lane & 2) != 0;
#pragma unroll
      for (int m = 0; m < 4; ++m) { const float keep = up ? q8[4 + m] : q8[m], send = up ? q8[m] : q8[4 + m]; q4[m] = keep + __shfl_xor(send, 2, 64); } }
    { const bool up = (lane & 1) != 0;
#pragma unroll
      for (int m = 0; m < 2; ++m) { const float keep = up ? q4[2 + m] : q4[m], send = up ? q4[m] : q4[2 + m]; q2[m] = keep + __shfl_xor(send, 1, 64); } }
    part[((size_t)t * PQ_NS + x) * 64 + lane] = pk2(q2[0] * sct, q2[1] * sct);
  }
  PQ_END()
  }
#undef PU_PREF
}
DI void ph_peer_comb(const P& p, int layer, size_t part_off, size_t ei_off, size_t eg_off, size_t w_off) {
  const unsigned* part = (const unsigned*)(p.ws + part_off); const float* EG = (const float*)(p.ws + eg_off); const int* EI = (const int*)(p.ws + ei_off); float* W = (float*)(p.ws + w_off);
  const float* su = (const float*)(p.ws + WS_TSC) + (size_t)(layer * 2) * 16384; const float* sv = su + 16384;
  const int tpbc_ = TL / gridDim.x;
  for (int g = blockIdx.x * tpbc_ * 64 + otid(); g < (blockIdx.x + 1) * tpbc_ * 64; g += NT) {
    const int t = g >> 6, j = g & 63;
    float d0 = 0.f, d1 = 0.f;
#pragma unroll
    for (int x = 0; x < PQ_NS; ++x) { const unsigned v = part[((size_t)t * PQ_NS + x) * 64 + j]; d0 += bflo(v); d1 += bfhi(v); }
    const f32x2_t gt = *(const f32x2_t*)(EG + (size_t)t * 128 + 2 * j);
    const int e0 = EI[(size_t)t * 128 + 2 * j], e1 = EI[(size_t)t * 128 + 2 * j + 1];
    f32x2_t o; o[0] = gelu_tanh(d0 * su[e0]) * gt[0] * sv[e0]; o[1] = gelu_tanh(d1 * su[e1]) * gt[1] * sv[e1];
    *(f32x2_t*)(W + (size_t)t * 128 + 2 * j) = o;
  }
}
DI void ph_peer_v(const P& p, char* lds, int layer, size_t ei_off, size_t w_off) {
  PQ_BEGIN()
  const unsigned char* vs = (const unsigned char*)(p.ws + WS_TAB + (size_t)(layer * 2 + 1) * 8 * MiB) + ((size_t)x * 16384 << 7) + c16 * 16;
  const int* EI = (const int*)(p.ws + ei_off) + g8 * 16; const float* W = (const float*)(p.ws + w_off) + g8 * 16;
  const float* modb = (const float*)(p.ws + WS_MOD) + (size_t)layer * 5 * 6144;
  const int col = x * 256 + 32 * (lane & 7) + 4 * (lane >> 3);
  int4 nid[4]; f32x4 nw[4];
#define PV_PREF(tt) do { const int t_ = (tt) < tend ? (tt) : tend - 1; \
    _Pragma("unroll") for (int i = 0; i < 4; ++i) { nid[i] = *(const int4*)(EI + (size_t)t_ * 128 + i * 4); nw[i] = *(const f32x4*)(W + (size_t)t_ * 128 + i * 4); } } while (0)
  PV_PREF(tbeg);
#pragma unroll 1
  for (int t = tbeg; t < tend; t += NT / 64) {
    int id[16]; float wv[16];
#pragma unroll
    for (int i = 0; i < 4; ++i) { id[4 * i] = nid[i].x; id[4 * i + 1] = nid[i].y; id[4 * i + 2] = nid[i].z; id[4 * i + 3] = nid[i].w; wv[4 * i] = nw[i][0]; wv[4 * i + 1] = nw[i][1]; wv[4 * i + 2] = nw[i][2]; wv[4 * i + 3] = nw[i][3]; }
    u32x4 vr[16];
#pragma unroll
    for (int i = 0; i < 16; ++i) vr[i] = *(const u32x4*)(vs + ((size_t)id[i] << 7));
    f32x2_t acc2[16];
#pragma unroll
    for (int j = 0; j < 16; ++j) acc2[j] = f32x2_t{0.f, 0.f};
#pragma unroll
    for (int i = 0; i < 16; ++i) {
      const f32x2_t w2 = {wv[i], wv[i]};
#pragma unroll
      for (int w = 0; w < 4; ++w) {
        f32x2_t f0, f1, f2, f3; FP4X8(vr[i][w], f0, f1, f2, f3);
        acc2[4 * w] = f0 * w2 + acc2[4 * w]; acc2[4 * w + 1] = f1 * w2 + acc2[4 * w + 1]; acc2[4 * w + 2] = f2 * w2 + acc2[4 * w + 2]; acc2[4 * w + 3] = f3 * w2 + acc2[4 * w + 3];
      }
    }
    PV_PREF(t + NT / 64);
    float acc[32];
#pragma unroll
    for (int j = 0; j < 16; ++j) { acc[2 * j] = acc2[j][0]; acc[2 * j + 1] = acc2[j][1]; }
    float q16[16], q8[8], q4[4];
    { const bool up = (lane & 32) != 0;
#pragma unroll
      for (int m = 0; m < 16; ++m) { const float keep = up ? acc[16 + m] : acc[m], send = up ? acc[m] : acc[16 + m]; q16[m] = keep + __shfl_xor(send, 32, 64); } }
    { const bool up = (lane & 16) != 0;
#pragma unroll
      for (int m = 0; m < 8; ++m) { const float keep = up ? q16[8 + m] : q16[m], send = up ? q16[m] : q16[8 + m]; q8[m] = keep + __shfl_xor(send, 16, 64); } }
    { const bool up = (lane & 8) != 0;
#pragma unroll
      for (int m = 0; m < 4; ++m) { const float keep = up ? q8[4 + m] : q8[m], send = up ? q8[m] : q8[4 + m]; q4[m] = keep + __shfl_xor(send, 8, 64); } }
    float* xr = p.out + (size_t)t * DM + col;
    const f32x4 xv = *(const f32x4*)xr, g2 = *(const f32x4*)(modb + (size_t)(t >> 13) * 6144 + 5 * 1024 + col);
    f32x4 ov;
#pragma unroll
    for (int m = 0; m < 4; ++m) ov[m] = xv[m] + g2[m] * q4[m];
    *(f32x4*)xr = ov;
  }
  PQ_END()
#undef PV_PREF
}
DI void ph_final_norm(const P& p, int r0, int r1) {
  const int lane = otid() & 63;
  for (int row = r0 + (otid() >> 6); row < r1; row += NT / 64) {
    float* xr = p.out + (size_t)row * DM;
    f32x4 xv[4]; float ss = 0.f;
#pragma unroll
    for (int i = 0; i < 4; ++i) { xv[i] = *(const f32x4*)(xr + lane * 4 + 256 * i); ss += xv[i][0] * xv[i][0] + xv[i][1] * xv[i][1] + xv[i][2] * xv[i][2] + xv[i][3] * xv[i][3]; }
    ss = wave_sum(ss);
    const float rs = rsqrtf(ss * (1.f / DM) + EPS);
#pragma unroll
    for (int i = 0; i < 4; ++i) { const f32x4 w4 = *(const f32x4*)(p.final_norm_w + lane * 4 + 256 * i); *(f32x4*)(xr + lane * 4 + 256 * i) = xv[i] * rs * w4; }
  }
}

struct RowFft0 { const bf16_t* base; DI const bf16_t* operator()(int r) const { return base + ((size_t)128 * (r & 63) + (r >> 6)) * DM; } };
struct EpiFft0 {
  bf16_t* zt; int bg, l20, col0;
  DI void operator()(f32x16 (&acc)[2][2], int wm, int wn, int lane) const {
    const int h = lane >> 5, cl = lane & 31;
#pragma unroll
    for (int mt = 0; mt < 2; ++mt)
#pragma unroll
      for (int nt = 0; nt < 2; ++nt) {
        const int n = col0 + wn * 64 + nt * 32 + cl, ri = n >> 8, mm = n & 255;
#pragma unroll
        for (int g = 0; g < 4; ++g) {
          const int r = wm * 64 + mt * 32 + 8 * g + 4 * h, l1 = r & 63, l2 = l20 + (r >> 6);
          u32x2 v; v[0] = pk2(acc[mt][nt][4 * g], acc[mt][nt][4 * g + 1]); v[1] = pk2(acc[mt][nt][4 * g + 2], acc[mt][nt][4 * g + 3]);
          *(u32x2*)(zt + (((size_t)(bg * 256 + mm) * 128 + l2) * 128 + ri * 64 + l1)) = v;
        }
      }
  }
};
DI void ph_fft0(const P& p, char* lds) {
  const bf16_t* h1 = (const bf16_t*)(p.ws + R0); const bf16_t* Bt = (const bf16_t*)(p.ws + WS_DFT0);
  for (int t = blockIdx.x; t < NB * 4 * 32 * 4; t += gridDim.x) {
    const int pn = t & 3, l2b = (t >> 2) & 31, g = (t >> 7) & 3, b = t >> 9;
    RowFft0 rf{h1 + ((size_t)b * SEQ + l2b * 4) * DM + g * 256};
    EpiFft0 ep{(bf16_t*)(p.ws + WS_ZT), b * 4 + g, l2b * 4, pn * GBN};
    gemm_tile<false>(lds, rf, Bt + (size_t)pn * GBN * 256, 256, ep);
  }
}
struct EpiFft1 {
  bf16_t* a2; int row0;
  DI void operator()(f32x16 (&acc)[2][2], int wm, int wn, int lane) const {
    const int h = lane >> 5, cl = lane & 31, k1 = 32 * wn + cl;
#pragma unroll
    for (int mt = 0; mt < 2; ++mt)
#pragma unroll
      for (int g = 0; g < 4; ++g) {
        const int R = row0 + wm * 64 + mt * 32 + 8 * g + 4 * h, l2 = R & 127, mm = (R >> 7) & 255, bg = R >> 15;
        float yr[4], yi[4];
#pragma unroll
        for (int q = 0; q < 4; ++q) {
          const float fr = (float)((l2 + q) * k1) * (1.f / 8192.f);
          const float cs = __builtin_amdgcn_cosf(fr), sn = __builtin_amdgcn_sinf(fr);
          const float ar = acc[mt][0][4 * g + q], ai = acc[mt][1][4 * g + q];
          yr[q] = ar * cs + ai * sn; yi[q] = ai * cs - ar * sn;
        }
        bf16_t* o = a2 + (((size_t)(bg * 64 + k1) * 256 + mm) * 256 + l2);
        u32x2 v; v[0] = pk2(yr[0], yr[1]); v[1] = pk2(yr[2], yr[3]); *(u32x2*)o = v;
        v[0] = pk2(yi[0], yi[1]); v[1] = pk2(yi[2], yi[3]); *(u32x2*)(o + 128) = v;
      }
  }
};
DI void ph_fft1(const P& p, char* lds) {
  const bf16_t* zt = (const bf16_t*)(p.ws + WS_ZT); const bf16_t* Bt = (const bf16_t*)(p.ws + WS_DFT1);
  const int nM = 16 * 256 * 128 / GBM;
  for (int t = blockIdx.x; t < nM; t += gridDim.x) {
    RowLin rf{zt + (size_t)t * GBM * 128, (size_t)128};
    EpiFft1 ep{(bf16_t*)(p.ws + WS_A2), t * GBM};
    gemm_tile<false>(lds, rf, Bt, 128, ep);
  }
}
struct EpiFft3 {
  bf16_t* fm; int row0;
  DI void operator()(f32x16 (&acc)[2][2], int wm, int wn, int lane) const {
    const int h = lane >> 5, cl = lane & 31;
#pragma unroll
    for (int mt = 0; mt < 2; ++mt)
#pragma unroll
      for (int nt = 0; nt < 2; ++nt) {
        const int k2 = wn * 64 + nt * 32 + cl;
#pragma unroll
        for (int g = 0; g < 4; ++g) {
          const int R = row0 + wm * 64 + mt * 32 + 8 * g + 4 * h, mm = R & 255, k1 = (R >> 8) & 63, bg = R >> 14;
          u32x2 v; v[0] = pk2(acc[mt][nt][4 * g], acc[mt][nt][4 * g + 1]); v[1] = pk2(acc[mt][nt][4 * g + 2], acc[mt][nt][4 * g + 3]);
          *(u32x2*)(fm + ((size_t)((bg >> 2) * SEQ + k1 + 64 * k2)) * DM + (bg & 3) * 256 + mm) = v;
        }
      }
  }
};
DI void ph_fft3(const P& p, char* lds) {
  const bf16_t* a2 = (const bf16_t*)(p.ws + WS_A2); const bf16_t* Bt = (const bf16_t*)(p.ws + WS_DFT3);
  const int nM = 16 * 64 * 256 / GBM;
  for (int t = blockIdx.x; t < nM; t += gridDim.x) {
    RowLin rf{a2 + (size_t)t * GBM * 256, (size_t)256};
    EpiFft3 ep{(bf16_t*)(p.ws + WS_FM), t * GBM};
    gemm_tile<false>(lds, rf, Bt, 256, ep);
  }
}

constexpr int NPHASE = 19;
template <int PH>
DI void run_phase(const P& p, char* lds) {
  const float* modL = (const float*)(p.ws + WS_MOD);
  const int tpb = TL / gridDim.x, t0 = blockIdx.x * tpb, t1 = t0 + tpb;
  if constexpr (PH == 0) ph_setup(p, lds);
  else if constexpr (PH == 1) { norm_rows_i8(p.x, 0, TL, p.norm1_w, modL, false, (unsigned char*)(p.ws + R0), (float*)(p.ws + WS_HS0));
                                norm_rows_i8(p.ctx - (size_t)TL * DM, TL, TA, p.norm1_w, modL, true, (unsigned char*)(p.ws + R0), (float*)(p.ws + WS_HS0));
                                quant_rows_i8((const bf16_t*)(p.ws + WS_WIN), NIN, (unsigned char*)(p.ws + WS_WIN8), (float*)(p.ws + WS_SWIN)); }
  else if constexpr (PH == 2) { PgProj ep{&p}; pg8_run_i8(lds, p.ws + R0, p.ws + WS_WIN8, TA, NIN, 1024, ep); }
  else if constexpr (PH == 3) ph_gdn_prep<0>(p, lds);
  else if constexpr (PH == 4) { if (blockIdx.x >= 64) ph_vt8(p, lds); else ph_gdn_scan<0>(p, lds); }
  else if constexpr (PH == 5) { ph_attn(p, lds); ph_mixout(p); }
  else if constexpr (PH == 6) { PgResid ep{p.x, p.out, modL + 2 * 1024}; pg8_run(lds, (const bf16_t*)(p.ws + WS_MIX), (const bf16_t*)(p.ws + WS_WOUT), TL, DM, DM, ep); }
  else if constexpr (PH == 7) { norm_rows_hq(p, p.norm2_w, modL); quant_rows_i8((const bf16_t*)(p.ws + WS_WEFF), 4096, (unsigned char*)(p.ws + WS_WEFF8), (float*)(p.ws + WS_SW)); ph_tables(p); }
  else if constexpr (PH == 8) { PgScoreI8 ep{(bf16_t*)(p.ws + WS_SC0), (const float*)(p.ws + WS_HS), (const float*)(p.ws + WS_SW)}; pg8_run_i8(lds, p.ws + R0, p.ws + WS_WEFF8, TL, 2048, 1024, ep); }
  else if constexpr (PH == 9) { ph_topk(p, lds, WS_SC0, WS_EI0, WS_EG0); block_handoff(); ph_peer_u(p, lds, 0, WS_EI0, WS_PART0); }
  else if constexpr (PH == 10) { ph_peer_comb(p, 0, WS_PART0, WS_EI0, WS_EG0, WS_W0); block_handoff(); ph_peer_v(p, lds, 0, WS_EI0, WS_W0); block_handoff();
                                 norm_rows(p.out, t0, t1, p.norm1_w + DM, modL + 5 * 6144, 0, 1, false, (bf16_t*)(p.ws + R0), true); }
  else if constexpr (PH == 11) ph_fft0(p, lds);
  else if constexpr (PH == 12) ph_fft1(p, lds);
  else if constexpr (PH == 13) ph_fft3(p, lds);
  else if constexpr (PH == 14) { PgResid ep{p.out, p.out, modL + 5 * 6144 + 2 * 1024}; pg8_run(lds, (const bf16_t*)(p.ws + WS_FM), (const bf16_t*)(p.ws + WS_WF), TL, DM, DM, ep); }
  else if constexpr (PH == 15) norm_rows_hq(p, p.norm2_w + DM, modL + 5 * 6144);
  else if constexpr (PH == 16) { PgScoreI8 ep{(bf16_t*)(p.ws + WS_SC1), (const float*)(p.ws + WS_HS), (const float*)(p.ws + WS_SW) + 2048}; pg8_run_i8(lds, p.ws + R0, p.ws + WS_WEFF8 + (size_t)2048 * 1024, TL, 2048, 1024, ep); }
  else if constexpr (PH == 17) { ph_topk(p, lds, WS_SC1, WS_EI1, WS_EG1); block_handoff(); ph_peer_u(p, lds, 1, WS_EI1, WS_PART1); }
  else if constexpr (PH == 18) { ph_peer_comb(p, 1, WS_PART1, WS_EI1, WS_EG1, WS_W1); block_handoff(); ph_peer_v(p, lds, 1, WS_EI1, WS_W1); block_handoff(); ph_final_norm(p, t0, t1); }
}
#define XB_TMO      128
#define XB_XCNT(j)  (256  + 64 * (j))
#define XB_XSUB(j)  (1280 + 64 * (j))
#define XB_XGEN(j)  (2304 + 64 * (j))
#define XB_TOP      3328
#define XB_TOPGEN   3392
#define XCD_BAR_WORDS 3456
#define XB_SPIN_CAP (1u << 22)
#define LAS __attribute__((address_space(3)))
#define XB_SPIN(cond, bar) do { unsigned _sp = 0; while (cond) { __builtin_amdgcn_s_sleep(1); \
    if ((++_sp & 255u) == 0u) { if (xb_ld(&(bar)[XB_TMO])) break; if (_sp > XB_SPIN_CAP) { atomicAdd(&(bar)[XB_TMO], 1u); break; } } } } while (0)
struct XcdBarrier { unsigned* bar; unsigned x; volatile LAS unsigned* st; };
DI XcdBarrier xcd_barrier_post(unsigned* bar, volatile LAS unsigned* st) {
  XcdBarrier b; b.bar = bar; b.x = xb_xcc_id(); b.st = st;
  if (threadIdx.x == 0) (void)xb_add(&bar[XB_XCNT(b.x)], 1u);
  return b;
}
DI void xcd_barrier_complete(unsigned* bar, unsigned x, unsigned& nloc, unsigned& nx) {
  const unsigned G = gridDim.x * gridDim.y * gridDim.z;
  unsigned sum, cnt, mine, sp = 0u;
  for (;;) {
    sum = 0u; cnt = 0u; mine = 0u;
#pragma unroll
    for (unsigned j = 0; j < 16; ++j) { const unsigned c = xb_ld(&bar[XB_XCNT(j)]); sum += c; cnt += (c > 0u) ? 1u : 0u; mine = (j == x) ? c : mine; }
    if (sum == G) break;
    __builtin_amdgcn_s_sleep(1);
    if ((++sp & 255u) == 0u) { if (xb_ld(&bar[XB_TMO])) break; if (sp > XB_SPIN_CAP) { atomicAdd(&bar[XB_TMO], 1u); break; } }
  }
  nloc = mine > 0u ? mine : 1u; nx = cnt > 0u ? cnt : 1u;
}
DI void xcd_barrier(const XcdBarrier& b) {
  asm volatile("s_waitcnt vmcnt(0)" ::: "memory");
  __syncthreads();
  if (threadIdx.x == 0) {
    unsigned* bar = b.bar;
    __builtin_amdgcn_s_waitcnt(0);
    unsigned nloc = b.st[0], nx = b.st[1];
    if (nloc == 0u) { xcd_barrier_complete(bar, b.x, nloc, nx); b.st[0] = nloc; b.st[1] = nx; }
    const unsigned old = xb_add(&bar[XB_XSUB(b.x)], 1u);
    const unsigned gen = old / nloc;
    if (old + 1u == (gen + 1u) * nloc) {
      __builtin_amdgcn_fence(__ATOMIC_RELEASE, "agent");
      asm volatile("s_waitcnt vmcnt(0)" ::: "memory");
      const unsigned og = xb_add(&bar[XB_TOP], 1u);
      const unsigned tg = og / nx;
      if (og + 1u == (tg + 1u) * nx) xb_add(&bar[XB_TOPGEN], 1u);
      else XB_SPIN(xb_ld(&bar[XB_TOPGEN]) == tg, bar);
      __builtin_amdgcn_fence(__ATOMIC_ACQUIRE, "agent");
      xb_add(&bar[XB_XGEN(b.x)], 1u);
      asm volatile("s_waitcnt vmcnt(0)" ::: "memory");
    } else {
      XB_SPIN(xb_ld(&bar[XB_XGEN(b.x)]) == gen, bar);
      __builtin_amdgcn_fence(__ATOMIC_ACQUIRE, "agent");
      asm volatile("s_waitcnt vmcnt(0)" ::: "memory");
    }
  }
  __syncthreads();
}

constexpr int EXTRA_PHASE = -1;
constexpr int PROBE_MODE = 0;
template <int PH>
DI void run_all(const P& p, char* lds, const XcdBarrier& bar) {
  run_phase<PH>(p, lds);
  if constexpr (PH == EXTRA_PHASE) {
    xcd_barrier(bar);
    if constexpr (PH == 3) ph_gdn_prep<PROBE_MODE>(p, lds);
    else if constexpr (PH == 4) ph_gdn_scan<PROBE_MODE>(p, lds);
    else run_phase<PH>(p, lds);
  }
  if constexpr (PH + 1 < NPHASE) {
    if constexpr (PH == 0) { cg::this_grid().sync(); }
    else xcd_barrier(bar);
    run_all<PH + 1>(p, lds, bar);
  }
}
__global__ void __launch_bounds__(NT) mega(P p) {
  extern __shared__ __attribute__((aligned(16))) char lds[];
  volatile LAS unsigned* st = (volatile LAS unsigned*)(lds + LDS_BYTES - 16);
  if (threadIdx.x == 0) { st[0] = 0u; st[1] = 0u; }
  __syncthreads();
  XcdBarrier bar = xcd_barrier_post((unsigned*)(p.ws + WS_CTL), st);
  run_all<0>(p, lds, bar);
}

extern "C" void kernel_launch(void* const* d_in, const int* in_sizes, int n_in, void* d_out, int out_size, void* d_ws, size_t ws_size, hipStream_t stream) {
  static int grid = 0;
  if (grid == 0) {
    if (n_in != 25 || ws_size < WS_END) { fprintf(stderr, "kernel_launch: unexpected n_in %d or ws_size %zu\n", n_in, ws_size); grid = -1; return; }
    int dev = 0, cus = 0, per_cu = 0;
    (void)hipGetDevice(&dev); (void)hipDeviceGetAttribute(&cus, hipDeviceAttributeMultiprocessorCount, dev);
    (void)hipFuncSetAttribute((const void*)mega, hipFuncAttributeMaxDynamicSharedMemorySize, LDS_BYTES);
    if (hipOccupancyMaxActiveBlocksPerMultiprocessor(&per_cu, (const void*)mega, NT, LDS_BYTES) != hipSuccess || per_cu < 1) { fprintf(stderr, "kernel_launch: occupancy query failed (%d)\n", per_cu); per_cu = 1; }
    (void)hipGetLastError();
    if (per_cu > 1) per_cu = 1;
    grid = (cus > 0 ? cus : 256) * per_cu;
  }
  if (grid < 0) return;
  (void)hipMemsetAsync((char*)d_ws + WS_CTL, 0, CTL_ZERO_BYTES, stream);
  P p{};
  const float** pf = (const float**)&p;
  for (int i = 0; i < 25; ++i) pf[i] = (const float*)d_in[i];
  p.out = (float*)d_out; p.ws = (char*)d_ws; p.lo = 0; p.hi = NPHASE;
  void* args[] = {&p};
  hipError_t e = hipLaunchCooperativeKernel((const void*)mega, dim3(grid), dim3(NT), args, LDS_BYTES, stream);
  if (e != hipSuccess) fprintf(stderr, "cooperative launch failed: %s (grid %d)\n", hipGetErrorString(e), grid);
}
```

```cpp
#include <hip/hip_runtime.h>
#include <hip/hip_cooperative_groups.h>
#include <cstdio>
#include <cstdint>
namespace cg = cooperative_groups;

#define DI __device__ __forceinline__
typedef unsigned short bf16_t;
typedef short bf16x8 __attribute__((ext_vector_type(8)));
typedef short s16x4 __attribute__((ext_vector_type(4)));
typedef float f32x16 __attribute__((ext_vector_type(16)));
typedef float f32x4 __attribute__((ext_vector_type(4)));
typedef float f32x2_t __attribute__((ext_vector_type(2)));
typedef __bf16 bf16x2_t __attribute__((ext_vector_type(2)));
typedef unsigned u32x4 __attribute__((ext_vector_type(4)));
typedef unsigned u32x2 __attribute__((ext_vector_type(2)));
typedef int v8i_t __attribute__((ext_vector_type(8)));

constexpr int NB = 4, SEQ = 8192, DM = 1024, CTXL = 256;
constexpr int TL = NB * SEQ;
constexpr int TC = NB * CTXL;
constexpr int TA = TL + TC;
constexpr int KVL = SEQ + CTXL;
constexpr int NIN = 3840;
constexpr int NCH = 132;
constexpr float EPS = 1e-6f;
constexpr int NT = 512;

constexpr size_t MiB = 1u << 20;
constexpr size_t WS_CTL = 0, WS_MOD = 64 * 1024, CTL_ZERO_BYTES = 512 * 1024;
constexpr size_t WS_ROPE = 1 * MiB, WS_WIN = 3 * MiB, WS_WOUT = 11 * MiB, WS_WF = 13 * MiB, WS_WEFF = 15 * MiB;
constexpr size_t WS_DFT0 = 23 * MiB, WS_DFT1 = 23 * MiB + 256 * 1024, WS_DFT3 = 23 * MiB + 512 * 1024;
constexpr size_t WS_BA = 24 * MiB, WS_GC = 29 * MiB;
constexpr size_t R0 = 32 * MiB, R1 = 98 * MiB, R2 = 197 * MiB, R3 = 329 * MiB, WS_END = 459 * MiB;
constexpr size_t WS_QN = R0, WS_KN = R0 + 33 * MiB;
constexpr size_t WS_QKVRAW = R1, WS_OBUF = R1;
constexpr size_t WS_UW = R2, WS_MIX = R2;
constexpr size_t WS_GATE = R3, WS_Q = R3 + 32 * MiB, WS_K = R3 + 64 * MiB, WS_VT = R3 + 97 * MiB;
constexpr size_t WS_VROW = WS_END;
constexpr size_t WS_Q8 = 162 * MiB, WS_K8 = 178 * MiB;
constexpr size_t WS_TAB = R3 + 32 * MiB;
constexpr size_t WS_SC0 = R2, WS_EI0 = R1, WS_EG0 = R1 + 16 * MiB, WS_PART0 = 150 * MiB  , WS_W0 = R1 + 32 * MiB  ;
constexpr size_t WS_ZT = R1, WS_A2 = 226 * MiB, WS_FM = R1;
constexpr size_t WS_SC1 = 162 * MiB, WS_EI1 = 290 * MiB, WS_EG1 = 306 * MiB, WS_PART1 = 100 * MiB  , WS_W1 = 322 * MiB;

struct P {
  const float *x, *c, *ctx, *c_ctx, *ada_w, *ada_b, *norm1_w, *norm2_w, *w_in, *conv_w, *a_log, *dt_bias, *gdn_norm_w,
      *lam_q1, *lam_k1, *lam_q2, *lam_k2, *subln_w, *w_out_ab, *w_out_f, *peer_wq, *peer_keys, *peer_u, *peer_v, *final_norm_w;
  float* out; char* ws; int lo, hi;
};

DI unsigned f2bf(float f) { unsigned u = __float_as_uint(f); return (u + 0x7fffu + ((u >> 16) & 1u)) >> 16; }
DI unsigned pk2(float lo, float hi) { return f2bf(lo) | (f2bf(hi) << 16); }
DI unsigned cvtpk(float lo, float hi) { f32x2_t v = {lo, hi}; bf16x2_t b = __builtin_convertvector(v, bf16x2_t); return __builtin_bit_cast(unsigned, b); }
DI float bf2f(unsigned h) { return __uint_as_float(h << 16); }
DI float bflo(unsigned u) { return __uint_as_float(u << 16); }
DI float bfhi(unsigned u) { return __uint_as_float(u & 0xffff0000u); }
DI float wave_sum(float v) {
#pragma unroll
  for (int o = 32; o >= 1; o >>= 1) v += __shfl_xor(v, o, 64);
  return v;
}
DI int otid() { int t = threadIdx.x; asm volatile("" : "+v"(t)); return t; }
DI unsigned xb_ld(unsigned* p)              { return __hip_atomic_load(p, __ATOMIC_RELAXED, __HIP_MEMORY_SCOPE_AGENT); }
DI unsigned xb_add(unsigned* p, unsigned v) { return __hip_atomic_fetch_add(p, v, __ATOMIC_RELAXED, __HIP_MEMORY_SCOPE_AGENT); }
DI unsigned xb_xcc_id() { return (unsigned)__builtin_amdgcn_s_getreg((3 << 11) | 20) & 0xFu; }
DI float silu_f(float v) { return v / (1.f + __expf(-v)); }
DI float sigmoid_f(float v) { return 1.f / (1.f + __expf(-v)); }
DI float gelu_tanh(float v) {
  const float u = 0.7978845608028654f * (v + 0.044715f * v * v * v);
  const float e = __expf(2.f * u);
  const float t = 1.f - 2.f / (e + 1.f);
  return 0.5f * v * (1.f + t);
}
#define MFMA32(a, b, c) __builtin_amdgcn_mfma_f32_32x32x16_bf16((a), (b), (c), 0, 0, 0)

constexpr int GBM = 256, GBN = 128, GBK = 64, GLD = 72;
constexpr int G_A_BYTES = GBM * GLD * 2, G_B_BYTES = GBN * GLD * 2, G_STAGE = G_A_BYTES + G_B_BYTES;
constexpr int LDS_BYTES = 147456;

template <bool SWAP, class RowF, class Epi>
DI void gemm_tile(char* lds, const RowF& rowf, const bf16_t* __restrict__ Bt, const int K, const Epi& epi) {
  const int tid = otid(), lane = tid & 63, wave = tid >> 6, wm = wave >> 1, wn = wave & 1;
  const int lr = tid >> 3, lc = tid & 7;
  const bf16_t* ap0 = rowf(lr) + lc * 8;
  const bf16_t* ap1 = rowf(lr + 64) + lc * 8;
  const bf16_t* ap2 = rowf(lr + 128) + lc * 8;
  const bf16_t* ap3 = rowf(lr + 192) + lc * 8;
  const bf16_t* bp0 = Bt + (size_t)lr * K + lc * 8;
  const bf16_t* bp1 = Bt + (size_t)(lr + 64) * K + lc * 8;
  const int woff = (lr * GLD + lc * 8) * 2;
  u32x4 raX0, raX1, raX2, raX3, rbX0, rbX1, raY0, raY1, raY2, raY3, rbY0, rbY1;
  f32x16 acc[2][2];
#pragma unroll
  for (int i = 0; i < 2; ++i)
#pragma unroll
    for (int j = 0; j < 2; ++j)
#pragma unroll
      for (int r = 0; r < 16; ++r) acc[i][j][r] = 0.f;
  const int nk = K / GBK;
#define G_GLOAD(S, kt_) do { const int k0_ = ((kt_) < nk ? (kt_) : nk - 1) * GBK; \
    ra##S##0 = *(const u32x4*)(ap0 + k0_); ra##S##1 = *(const u32x4*)(ap1 + k0_); ra##S##2 = *(const u32x4*)(ap2 + k0_); ra##S##3 = *(const u32x4*)(ap3 + k0_); \
    rb##S##0 = *(const u32x4*)(bp0 + k0_); rb##S##1 = *(const u32x4*)(bp1 + k0_); } while (0)
#define G_LWRITE(S, st) do { char* b_ = lds + (st) * G_STAGE + woff; *(u32x4*)(b_) = ra##S##0; *(u32x4*)(b_ + 64 * GLD * 2) = ra##S##1; *(u32x4*)(b_ + 128 * GLD * 2) = ra##S##2; *(u32x4*)(b_ + 192 * GLD * 2) = ra##S##3; \
    *(u32x4*)(b_ + G_A_BYTES) = rb##S##0; *(u32x4*)(b_ + G_A_BYTES + 64 * GLD * 2) = rb##S##1; } while (0)
  const int aoff = ((wm * 64 + (lane & 31)) * GLD + (lane >> 5) * 8) * 2;
  const int boff = G_A_BYTES + ((wn * 64 + (lane & 31)) * GLD + (lane >> 5) * 8) * 2;
#define G_COMPUTE(st) do { const char* sb = lds + (st) * G_STAGE; \
    _Pragma("unroll") for (int kk = 0; kk < 4; ++kk) { \
      const bf16x8 a0 = *(const bf16x8*)(sb + aoff + kk * 32); \
      const bf16x8 a1 = *(const bf16x8*)(sb + aoff + 32 * GLD * 2 + kk * 32); \
      const bf16x8 b0 = *(const bf16x8*)(sb + boff + kk * 32); \
      const bf16x8 b1 = *(const bf16x8*)(sb + boff + 32 * GLD * 2 + kk * 32); \
      if (SWAP) { \
        acc[0][0] = MFMA32(b0, a0, acc[0][0]); acc[0][1] = MFMA32(b1, a0, acc[0][1]); \
        acc[1][0] = MFMA32(b0, a1, acc[1][0]); acc[1][1] = MFMA32(b1, a1, acc[1][1]); \
      } else { \
        acc[0][0] = MFMA32(a0, b0, acc[0][0]); acc[0][1] = MFMA32(a0, b1, acc[0][1]); \
        acc[1][0] = MFMA32(a1, b0, acc[1][0]); acc[1][1] = MFMA32(a1, b1, acc[1][1]); \
      } } } while (0)
  G_GLOAD(X, 0); G_GLOAD(Y, 1);
  __syncthreads();
  G_LWRITE(X, 0);
  __syncthreads();
#pragma unroll 1
  for (int kt = 0; kt < nk; kt += 2) {
    G_GLOAD(X, kt + 2);
    G_COMPUTE(0);
    G_LWRITE(Y, 1);
    __syncthreads();
    G_GLOAD(Y, kt + 3);
    G_COMPUTE(1);
    if (kt + 2 < nk) G_LWRITE(X, 0);
    __syncthreads();
  }
  epi(acc, wm, wn, lane);
#undef G_GLOAD
#undef G_LWRITE
#undef G_COMPUTE
}
DI int crow(int reg, int h) { return (reg & 3) + 8 * (reg >> 2) + 4 * h; }

struct RowLin { const bf16_t* base; size_t pitch; DI const bf16_t* operator()(int r) const { return base + (size_t)r * pitch; } };

namespace pg8 {
#define PG8_LAS __attribute__((address_space(3)))
typedef int v4i_t __attribute__((ext_vector_type(4)));
typedef unsigned short bf16_t;
typedef short bf16x8 __attribute__((ext_vector_type(8)));
typedef float f32x4 __attribute__((ext_vector_type(4)));
typedef unsigned u32x4 __attribute__((ext_vector_type(4)));
constexpr int BM = 256, BK = 64, HALF = 128, HTB = HALF * BK * 2  , STAGE_BYTES = 8 * HTB, NXCD = 8, WGM = 8;

__host__ __device__ __forceinline__ int lds_byte(int r, int c) { const int st = (r >> 4) * 2 + (c >> 5), rr = r & 15, cc = c & 31, ob = rr * 64 + cc * 2; return st * 1024 + (ob ^ (((ob >> 9) & 1) << 5)); }
__host__ __device__ __forceinline__ void stage_rc(int b, int& R, int& C) { const int st = b / 1024, sb = b % 1024, swz = sb ^ (((sb >> 9) & 1) << 5); R = (st >> 1) * 16 + swz / 64; C = (st & 1) * 32 + (swz % 64) / 2; }
__host__ __device__ __forceinline__ int perm32(int rho) { const int n = rho >> 4, i = rho & 15; return 8 * (i >> 2) + 4 * n + (i & 3); }

struct Unit { int pm, pn; };
struct Gemm { const bf16_t* A; const bf16_t* Bt; int M, N, K; };

struct StaticOrder {
    int nM, nN, nwg, G, c;
    __host__ __device__ void init(int M, int N, int G_, int c_) { nM = M / BM; nN = N / BM; nwg = nM * nN; G = G_; c = c_; }
    __host__ __device__ bool next(int i, Unit& u) const {
        const long L = (long)i * G + c; if (L >= nwg) return false;
        int wgid = (int)L; { const int q = nwg / NXCD, r = nwg % NXCD, xcd = wgid % NXCD, off = wgid / NXCD; wgid = (xcd < r ? xcd * (q + 1) : r * (q + 1) + (xcd - r) * q) + off; }
        const int nig = WGM * nN, gid = wgid / nig, fm = gid * WGM, gsz = (nM - fm) < WGM ? (nM - fm) : WGM;
        u.pm = fm + ((wgid % nig) % gsz); u.pn = (wgid % nig) / gsz; return true;
    }
    __device__ __forceinline__ void a_ready(const Unit&) const {}
    __device__ __forceinline__ void done(const Unit&) const {}
};
template <class Epi, class Sched, bool ALIGN_EPI = false, bool SP2 = false, bool I8 = false>
__device__ __forceinline__ void gemm_phase(PG8_LAS unsigned char* lds, const Gemm g, const Sched& S, const Epi& E) {
    const int tid = otid(), wid = __builtin_amdgcn_readfirstlane(tid >> 6), lane = tid & 63, wr = wid >> 2, wc = wid & 3, fr = lane & 15, fq = lane >> 4;
    const int K = g.K, nt = K / BK;
    unsigned voffA[2], voffB[2];
#pragma unroll
    for (int i = 0; i < 2; ++i) { int R, C; stage_rc(tid * 16 + i * 8192, R, C); const int Rb = Epi::PERM ? ((R & ~31) + perm32(R & 31)) : R;
        voffA[i] = (unsigned)(R * K + C) * 2u; voffB[i] = (unsigned)(Rb * K + C) * 2u; }
    const size_t kstep = (size_t)(BK * 2);
    const size_t hstep = (size_t)HALF * K * 2;
    const size_t tstep = 2 * hstep;
    const unsigned ldsw = (unsigned)wid * 1024u;
    const int aoff = lds_byte(wr * 64 + fr, fq * 8), boff = lds_byte(wc * 32 + fr, fq * 8);
#define PG8_SA(b, h) (((b) * 2 + (h)) * HTB)
#define PG8_SB(b, h) ((4 + (b) * 2 + (h)) * HTB)
#define PG8_STAGE(bufoff, gbase, voff) do { _Pragma("unroll") for (int _i = 0; _i < 2; ++_i) \
        __builtin_amdgcn_global_load_lds((const unsigned*)((const char*)(gbase) + (voff)[_i]), (PG8_LAS unsigned*)(lds + (bufoff) + ldsw + _i * 8192), 16, 0, 0); } while (0)
#define PG8_LDA(dst, b, h) do { _Pragma("unroll") for (int m = 0; m < 4; ++m) _Pragma("unroll") for (int k = 0; k < 2; ++k) dst[m][k] = *(const PG8_LAS bf16x8*)(lds + PG8_SA(b, h) + aoff + m * 2048 + k * 1024); } while (0)
#define PG8_LDB(dst, b, h) do { _Pragma("unroll") for (int n = 0; n < 2; ++n) _Pragma("unroll") for (int k = 0; k < 2; ++k) dst[n][k] = *(const PG8_LAS bf16x8*)(lds + PG8_SB(b, h) + boff + n * 2048 + k * 1024); } while (0)
#define PG8_MMA(ai, bj, At, Bt) do { __builtin_amdgcn_s_setprio(1); _Pragma("unroll") for (int m = 0; m < 4; ++m) _Pragma("unroll") for (int n = 0; n < 2; ++n) _Pragma("unroll") for (int k = 0; k < 2; ++k) \
        { if constexpr (I8) acc[ai][bj][m][n] = __builtin_bit_cast(f32x4, __builtin_amdgcn_mfma_i32_16x16x64_i8(__builtin_bit_cast(v4i_t, Bt[n][k]), __builtin_bit_cast(v4i_t, At[m][k]), __builtin_bit_cast(v4i_t, acc[ai][bj][m][n]), 0, 0, 0)); \
          else acc[ai][bj][m][n] = __builtin_amdgcn_mfma_f32_16x16x32_bf16(Bt[n][k], At[m][k], acc[ai][bj][m][n], 0, 0, 0); } __builtin_amdgcn_s_setprio(0); } while (0)
#define PG8_WAIT_V(n) asm volatile("s_waitcnt vmcnt(" #n ")" ::: "memory")
#define PG8_WAIT_L(n) asm volatile("s_waitcnt lgkmcnt(" #n ")" ::: "memory")
#define PG8_BAR __builtin_amdgcn_s_barrier()
#define PG8_SCHED __builtin_amdgcn_sched_barrier(0)
    Unit cur, nxt; int ui = 0;
    if (!S.next(0, cur)) return;
    f32x4 acc[2][2][4][2];
#pragma unroll
    for (int a = 0; a < 2; ++a)
#pragma unroll
        for (int b = 0; b < 2; ++b)
#pragma unroll
            for (int m = 0; m < 4; ++m)
#pragma unroll
                for (int n = 0; n < 2; ++n) acc[a][b][m][n] = (f32x4){0.f, 0.f, 0.f, 0.f};
    bf16x8 At[4][2], B0[2][2], B1[2][2];
    const char* cA = (const char*)g.A + (size_t)cur.pm * tstep; const char* cB = (const char*)g.Bt + (size_t)cur.pn * tstep;
    S.a_ready(cur);
    if constexpr (SP2) {
        PG8_STAGE(PG8_SB(0, 0), cB, voffB); PG8_STAGE(PG8_SB(0, 1), cB + hstep, voffB); PG8_STAGE(PG8_SA(0, 0), cA, voffA); PG8_STAGE(PG8_SA(0, 1), cA + hstep, voffA);
        if (wr == 1) PG8_BAR;
        PG8_WAIT_V(2); PG8_BAR;
        PG8_STAGE(PG8_SB(1, 0), cB + kstep, voffB); PG8_STAGE(PG8_SA(1, 0), cA + kstep, voffA); PG8_STAGE(PG8_SB(1, 1), cB + hstep + kstep, voffB);
        PG8_WAIT_V(6); PG8_BAR;
    } else {
        PG8_STAGE(PG8_SB(0, 0), cB, voffB); PG8_STAGE(PG8_SA(0, 0), cA, voffA); PG8_STAGE(PG8_SB(0, 1), cB + hstep, voffB); PG8_STAGE(PG8_SA(0, 1), cA + hstep, voffA);
        if (wr == 1) PG8_BAR;
        PG8_WAIT_V(4); PG8_BAR;
        PG8_STAGE(PG8_SB(1, 0), cB + kstep, voffB); PG8_STAGE(PG8_SA(1, 0), cA + kstep, voffA); PG8_STAGE(PG8_SB(1, 1), cB + hstep + kstep, voffB);
        PG8_WAIT_V(6); PG8_BAR;
    }
    for (;;) {
        const bool has_next = S.next(ui + 1, nxt);
        const char* nA = has_next ? (const char*)g.A + (size_t)nxt.pm * tstep : cA; const char* nB = has_next ? (const char*)g.Bt + (size_t)nxt.pn * tstep : cB;
        for (int t = 0; t < nt; t += 2) {
            const bool last = (t == nt - 2);
            const char* a1 = cA + (size_t)(t + 1) * kstep;
            const char* a2 = last ? nA : cA + (size_t)(t + 2) * kstep; const char* b2 = last ? nB : cB + (size_t)(t + 2) * kstep;
            const char* a3 = a2 + kstep; const char* b3 = b2 + kstep;
            if (last && has_next) S.a_ready(nxt);
            if constexpr (SP2) {
            PG8_LDB(B0, 0, 0); PG8_LDB(B1, 0, 1); PG8_SCHED; PG8_LDA(At, 0, 0); PG8_STAGE(PG8_SA(1, 1), a1 + hstep, voffA);
            PG8_WAIT_V(8); PG8_WAIT_L(0); PG8_BAR; PG8_MMA(0, 0, At, B0); PG8_MMA(0, 1, At, B1); PG8_BAR; PG8_SCHED;
            PG8_LDA(At, 0, 1); PG8_STAGE(PG8_SB(0, 0), b2, voffB); PG8_STAGE(PG8_SB(0, 1), b2 + hstep, voffB); PG8_STAGE(PG8_SA(0, 0), a2, voffA);
            PG8_WAIT_V(8); PG8_WAIT_L(0); PG8_BAR; PG8_MMA(1, 0, At, B0); PG8_MMA(1, 1, At, B1); PG8_BAR; PG8_SCHED;
            PG8_LDB(B0, 1, 0); PG8_LDB(B1, 1, 1); PG8_SCHED; PG8_LDA(At, 1, 0); PG8_STAGE(PG8_SA(0, 1), a2 + hstep, voffA);
            PG8_WAIT_V(8); PG8_WAIT_L(0); PG8_BAR; PG8_MMA(0, 0, At, B0); PG8_MMA(0, 1, At, B1); PG8_BAR; PG8_SCHED;
            PG8_LDA(At, 1, 1); PG8_STAGE(PG8_SB(1, 0), b3, voffB); PG8_STAGE(PG8_SB(1, 1), b3 + hstep, voffB); PG8_STAGE(PG8_SA(1, 0), a3, voffA);
            PG8_WAIT_V(8); PG8_WAIT_L(0); PG8_BAR; PG8_MMA(1, 0, At, B0); PG8_MMA(1, 1, At, B1); PG8_BAR; PG8_SCHED;
            } else {
            PG8_LDB(B0, 0, 0); PG8_SCHED; PG8_LDA(At, 0, 0); PG8_STAGE(PG8_SA(1, 1), a1 + hstep, voffA);
            PG8_WAIT_L(8); PG8_BAR; PG8_WAIT_L(0); PG8_MMA(0, 0, At, B0); PG8_BAR; PG8_SCHED;
            PG8_LDB(B1, 0, 1); PG8_STAGE(PG8_SB(0, 0), b2, voffB);
            PG8_BAR; PG8_WAIT_L(0); PG8_MMA(0, 1, At, B1); PG8_BAR;
            PG8_LDA(At, 0, 1); PG8_STAGE(PG8_SA(0, 0), a2, voffA);
            PG8_BAR; PG8_WAIT_L(0); PG8_MMA(1, 0, At, B0); PG8_BAR; PG8_SCHED;
            PG8_STAGE(PG8_SB(0, 1), b2 + hstep, voffB);
            PG8_WAIT_V(6); PG8_BAR; PG8_MMA(1, 1, At, B1); PG8_BAR;
            PG8_LDB(B0, 1, 0); PG8_SCHED; PG8_LDA(At, 1, 0); PG8_STAGE(PG8_SA(0, 1), a2 + hstep, voffA);
            PG8_WAIT_L(8); PG8_BAR; PG8_WAIT_L(0); PG8_MMA(0, 0, At, B0); PG8_BAR; PG8_SCHED;
            PG8_LDB(B1, 1, 1); PG8_STAGE(PG8_SB(1, 0), b3, voffB);
            PG8_BAR; PG8_WAIT_L(0); PG8_MMA(0, 1, At, B1); PG8_BAR;
            PG8_LDA(At, 1, 1); PG8_STAGE(PG8_SA(1, 0), a3, voffA);
            PG8_BAR; PG8_WAIT_L(0); PG8_MMA(1, 0, At, B0); PG8_BAR; PG8_SCHED;
            PG8_STAGE(PG8_SB(1, 1), b3 + hstep, voffB);
            PG8_WAIT_V(6); PG8_BAR; PG8_MMA(1, 1, At, B1); PG8_BAR;
            }
        }
        if constexpr (ALIGN_EPI) { if (wr == 0) PG8_BAR; }
        if constexpr (I8) { if constexpr (Epi::DEQ) { E.deq(acc, cur, wr, wc, fr, fq); __builtin_amdgcn_sched_barrier(0); } }
        if constexpr (!Epi::AFTER_DRAIN) { E(acc, cur, wr, wc, fr, fq); S.done(cur); }
        if (!has_next) break;
#pragma unroll
        for (int a = 0; a < 2; ++a)
#pragma unroll
            for (int b = 0; b < 2; ++b)
#pragma unroll
                for (int m = 0; m < 4; ++m)
#pragma unroll
                    for (int n = 0; n < 2; ++n) acc[a][b][m][n] = (f32x4){0.f, 0.f, 0.f, 0.f};
        cur = nxt; cA = nA; cB = nB; ++ui;
        if constexpr (ALIGN_EPI) { if (wr == 1) PG8_BAR; }
    }
    PG8_WAIT_V(0);
    if constexpr (!ALIGN_EPI) { if (wr == 0) PG8_BAR; }
    PG8_BAR;
    if constexpr (Epi::AFTER_DRAIN) { E.fused(acc, cur, wr, wc, fr, fq, lds, wid, lane); S.done(cur); }
#undef PG8_SA
#undef PG8_SB
#undef PG8_STAGE
#undef PG8_LDA
#undef PG8_LDB
#undef PG8_MMA
#undef PG8_WAIT_V
#undef PG8_WAIT_L
#undef PG8_BAR
#undef PG8_SCHED
}
}
DI void ph_setup(const P& p, char* lds) {
  const int tid = otid(), nb = gridDim.x, bid = blockIdx.x;
  float* modL = (float*)(p.ws + WS_MOD);
  float* sc = (float*)lds;
  for (int it = bid; it < 192; it += nb) {
    const int layer = it / 96, cb = it % 96;
    const int lane = tid & 63, ks = tid >> 6;
    __syncthreads();
    for (int i = tid; i < 5 * 1024; i += NT) { const int v = i >> 10, k = i & 1023; const float cv = (v < 4) ? p.c[v * 1024 + k] : p.c_ctx[k]; sc[i] = silu_f(cv); }
    __syncthreads();
    const int n = cb * 64 + lane;
    const float* w = p.ada_w + ((size_t)layer * 1024 + ks * 128) * 6144 + n;
    float a0 = 0, a1 = 0, a2 = 0, a3 = 0, a4 = 0;
#pragma unroll 8
    for (int k = 0; k < 128; ++k) { const float wv = w[(size_t)k * 6144]; const int kk = ks * 128 + k; a0 += wv * sc[kk]; a1 += wv * sc[1024 + kk]; a2 += wv * sc[2048 + kk]; a3 += wv * sc[3072 + kk]; a4 += wv * sc[4096 + kk]; }
    float* red = sc + 5 * 1024;
    red[(ks * 5 + 0) * 64 + lane] = a0; red[(ks * 5 + 1) * 64 + lane] = a1; red[(ks * 5 + 2) * 64 + lane] = a2; red[(ks * 5 + 3) * 64 + lane] = a3; red[(ks * 5 + 4) * 64 + lane] = a4;
    __syncthreads();
    if (tid < 320) {
      const int v = tid >> 6, l = tid & 63;
      float sacc = p.ada_b[layer * 6144 + cb * 64 + l];
      for (int k8 = 0; k8 < 8; ++k8) sacc += red[(k8 * 5 + v) * 64 + l];
      modL[(layer * 5 + v) * 6144 + cb * 64 + l] = sacc;
    }
  }
  {
    float* rope = (float*)(p.ws + WS_ROPE);
    for (int i = bid * NT + tid; i < SEQ * 32; i += nb * NT) {
      const int l = i >> 5, d = i & 31;
      const float inv = exp2f(-(float)(2 * (d & 15)) * (13.287712379549449f / 32.f));
      const float pos = (d < 16) ? (float)(l >> 6) : (float)(l & 63);
      float s, c; sincosf(pos * inv, &s, &c);
      rope[2 * i] = c; rope[2 * i + 1] = s;
    }
  }
  {
    float* tl = (float*)lds;
    const int nt_in = (NIN / 64) * 16, nt_o = 16 * 16;
    for (int it = bid; it < nt_in + 2 * nt_o; it += nb) {
      const float* src; bf16_t* dst; int npitch, nb0, kb0, which;
      if (it < nt_in) { which = 0; nb0 = (it / 16) * 64; kb0 = (it % 16) * 64; src = p.w_in; dst = (bf16_t*)(p.ws + WS_WIN); npitch = 3616; }
      else if (it < nt_in + nt_o) { const int j = it - nt_in; which = 1; nb0 = (j / 16) * 64; kb0 = (j % 16) * 64; src = p.w_out_ab; dst = (bf16_t*)(p.ws + WS_WOUT); npitch = 1024; }
      else { const int j = it - nt_in - nt_o; which = 2; nb0 = (j / 16) * 64; kb0 = (j % 16) * 64; src = p.w_out_f; dst = (bf16_t*)(p.ws + WS_WF); npitch = 1024; }
      __syncthreads();
      for (int e = tid; e < 4096; e += NT) {
        const int kk = e >> 6, nn = e & 63; const int n = nb0 + nn;
        int sn = n;
        if (which == 0) {
          if (n < 2048) sn = n;
          else if (n < 3072) { const int pq = n & 63, blk = pq >> 3, e8 = pq & 7; sn = (n & ~63) + 32 + ((e8 < 4) ? 4 * blk + e8 : 32 + 4 * blk + (e8 - 4)); }
          else if (n < 3584) sn = n + 32;
          else if (n < 3616) sn = n - 1536;
          else sn = -1;
        }
        tl[kk * 65 + nn] = (sn >= 0) ? src[(size_t)(kb0 + kk) * npitch + sn] : 0.f;
      }
      __syncthreads();
      for (int e = tid; e < 4096; e += NT) { const int nn = e >> 6, kk = e & 63; dst[(size_t)(nb0 + nn) * 1024 + kb0 + kk] = (bf16_t)f2bf(tl[kk * 65 + nn]); }
    }
  }
  {
    float* kl = (float*)lds;
    float* wl = kl + 128 * 132;
    bf16_t* weff = (bf16_t*)(p.ws + WS_WEFF);
    for (int it = bid; it < 512; it += nb) {
      const int layer = it >> 8, hp = (it >> 4) & 15, kb = it & 15;
      __syncthreads();
      const float* ks = p.peer_keys + ((size_t)(layer * 16 + hp) * 128) * 128;
      for (int e = tid; e < 128 * 128; e += NT) kl[(e >> 7) * 132 + (e & 127)] = ks[e];
      const float* ws_ = p.peer_wq + ((size_t)layer * 1024 + kb * 64) * 2048 + hp * 128;
      for (int e = tid; e < 64 * 128; e += NT) wl[(e >> 7) * 132 + (e & 127)] = ws_[(size_t)(e >> 7) * 2048 + (e & 127)];
      __syncthreads();
      const int key = tid & 127, kq = tid >> 7;
      float a[16];
#pragma unroll
      for (int i = 0; i < 16; ++i) a[i] = 0.f;
      for (int d = 0; d < 128; d += 4) {
        const f32x4 kv = *(const f32x4*)(kl + key * 132 + d);
#pragma unroll
        for (int i = 0; i < 16; ++i) { const f32x4 wv = *(const f32x4*)(wl + (kq * 16 + i) * 132 + d); a[i] += kv[0] * wv[0] + kv[1] * wv[1] + kv[2] * wv[2] + kv[3] * wv[3]; }
      }
      bf16_t* o = weff + ((size_t)layer * 2048 + hp * 128 + key) * 1024 + kb * 64 + kq * 16;
      u32x4 o0, o1;
      o0[0] = pk2(a[0], a[1]); o0[1] = pk2(a[2], a[3]); o0[2] = pk2(a[4], a[5]); o0[3] = pk2(a[6], a[7]);
      o1[0] = pk2(a[8], a[9]); o1[1] = pk2(a[10], a[11]); o1[2] = pk2(a[12], a[13]); o1[3] = pk2(a[14], a[15]);
      *(u32x4*)o = o0; *(u32x4*)(o + 8) = o1;
    }
  }
  {
    bf16_t* d0 = (bf16_t*)(p.ws + WS_DFT0); bf16_t* d1 = (bf16_t*)(p.ws + WS_DFT1); bf16_t* d3 = (bf16_t*)(p.ws + WS_DFT3);
    for (int i = bid * NT + tid; i < 512 * 256; i += nb * NT) {
      const int n = i >> 8, c = i & 255, m = n & 255; const float fr = (float)((m * c) & 255) * (2.f / 256.f);
      d0[i] = (bf16_t)f2bf(n < 256 ? cospif(fr) : -sinpif(fr));
    }
    for (int i = bid * NT + tid; i < 128 * 128; i += nb * NT) {
      const int n = i >> 7, k = i & 127; const int k1 = 32 * (n >> 6) + (n & 31), ro = (n >> 5) & 1, ri = k >> 6, l1 = k & 63;
      const float fr = (float)((k1 * l1) & 63) * (2.f / 64.f); const float cs = cospif(fr), sn = sinpif(fr);
      d1[i] = (bf16_t)f2bf(ro == 0 ? (ri == 0 ? cs : sn) : (ri == 0 ? -sn : cs));
    }
    for (int i = bid * NT + tid; i < 128 * 256; i += nb * NT) {
      const int k2 = i >> 8, k = i & 255, ri = k >> 7, l2 = k & 127; const float fr = (float)((l2 * k2) & 127) * (2.f / 128.f);
      const float scl = 6.905339660024878e-4f;
      d3[i] = (bf16_t)f2bf((ri == 0 ? cospif(fr) : sinpif(fr)) * scl);
    }
  }
}

DI void norm_rows(const float* __restrict__ src, int row_begin, int nrows, const float* __restrict__ nw, const float* __restrict__ modbase  ,
                  int shift_j, int scale_j, bool ctx_tail  , bf16_t* __restrict__ dst, bool blk = false  ) {
  const int lane = otid() & 63, gw = (blk ? 0 : blockIdx.x * (NT / 64)) + (otid() >> 6), nw_ = (blk ? 1 : gridDim.x) * (NT / 64);
  for (int row = row_begin + gw; row < nrows; row += nw_) {
    const int v = (ctx_tail && row >= TL) ? 4 : (row >> 13);
    const float* xr = src + (size_t)row * DM;
    f32x4 xv[4]; float ss = 0.f;
#pragma unroll
    for (int i = 0; i < 4; ++i) { xv[i] = *(const f32x4*)(xr + lane * 4 + 256 * i); ss += xv[i][0] * xv[i][0] + xv[i][1] * xv[i][1] + xv[i][2] * xv[i][2] + xv[i][3] * xv[i][3]; }
    ss = wave_sum(ss);
    const float rs = rsqrtf(ss * (1.f / DM) + EPS);
    const float* sh = modbase + (size_t)v * 6144 + shift_j * 1024; const float* scp = modbase + (size_t)v * 6144 + scale_j * 1024;
#pragma unroll
    for (int i = 0; i < 4; ++i) {
      const int c = lane * 4 + 256 * i;
      const f32x4 w4 = *(const f32x4*)(nw + c), s4 = *(const f32x4*)(sh + c), c4 = *(const f32x4*)(scp + c);
      float y0 = xv[i][0] * rs * w4[0] * (1.f + c4[0]) + s4[0], y1 = xv[i][1] * rs * w4[1] * (1.f + c4[1]) + s4[1];
      float y2 = xv[i][2] * rs * w4[2] * (1.f + c4[2]) + s4[2], y3 = xv[i][3] * rs * w4[3] * (1.f + c4[3]) + s4[3];
      u32x2 o; o[0] = pk2(y0, y1); o[1] = pk2(y2, y3);
      *(u32x2*)(dst + (size_t)row * DM + c) = o;
    }
  }
}

constexpr size_t WS_HQ = (size_t)393 * MiB, WS_HS = (size_t)425 * MiB;
DI void norm_rows_hq(const P& p, const float* __restrict__ nw, const float* __restrict__ modbase) {
  const int lane = otid() & 63, gw = blockIdx.x * (NT / 64) + (otid() >> 6), nw_ = gridDim.x * (NT / 64);
  bf16_t* dst = (bf16_t*)(p.ws + R0); unsigned char* hq = (unsigned char*)(p.ws + WS_HQ); float* hs = (float*)(p.ws + WS_HS);
  for (int row = gw; row < TL; row += nw_) {
    const float* xr = p.out + (size_t)row * DM + lane * 16;
    f32x4 xv[4]; float ss = 0.f;
#pragma unroll
    for (int i = 0; i < 4; ++i) { xv[i] = *(const f32x4*)(xr + 4 * i); ss += xv[i][0] * xv[i][0] + xv[i][1] * xv[i][1] + xv[i][2] * xv[i][2] + xv[i][3] * xv[i][3]; }
    ss = wave_sum(ss);
    const float rs = rsqrtf(ss * (1.f / DM) + EPS);
    const float* sh = modbase + (size_t)(row >> 13) * 6144 + 3 * 1024 + lane * 16; const float* scp = sh + 1024;
    float y[16]; float am = 0.f;
#pragma unroll
    for (int i = 0; i < 4; ++i) {
      const f32x4 w4 = *(const f32x4*)(nw + lane * 16 + 4 * i), s4 = *(const f32x4*)(sh + 4 * i), c4 = *(const f32x4*)(scp + 4 * i);
#pragma unroll
      for (int j = 0; j < 4; ++j) { y[4 * i + j] = xv[i][j] * rs * w4[j] * (1.f + c4[j]) + s4[j]; am = fmaxf(am, fabsf(y[4 * i + j])); }
    }
#pragma unroll
    for (int o = 32; o >= 1; o >>= 1) am = fmaxf(am, __shfl_xor(am, o, 64));
    const float st = am * (1.f / 119.f) + 1e-30f, ist = 1.f / st;
    unsigned h0 = 0u, h1 = 0u, l0 = 0u, l1 = 0u;
    u32x4 b8 = {0u, 0u, 0u, 0u};
#pragma unroll
    for (int j = 0; j < 8; ++j) {
      const int va = (int)fminf(fmaxf(rintf(y[j] * ist), -120.f), 119.f), vb = (int)fminf(fmaxf(rintf(y[8 + j] * ist), -120.f), 119.f);
      b8[j >> 2] |= ((unsigned)va & 255u) << (8 * (j & 3)); b8[2 + (j >> 2)] |= ((unsigned)vb & 255u) << (8 * (j & 3));
      const int ha = (va + 8) >> 4, hb = (vb + 8) >> 4, la = va - 16 * ha, lb = vb - 16 * hb;
      h0 |= ((unsigned)ha & 15u) << (4 * j); h1 |= ((unsigned)hb & 15u) << (4 * j); l0 |= ((unsigned)la & 15u) << (4 * j); l1 |= ((unsigned)lb & 15u) << (4 * j);
    }
    u32x2 vh; vh[0] = h0; vh[1] = h1; *(u32x2*)(hq + (size_t)row * 1024 + lane * 8) = vh;
    u32x2 vl; vl[0] = l0; vl[1] = l1; *(u32x2*)(hq + (size_t)row * 1024 + 512 + lane * 8) = vl;
    *(u32x4*)((unsigned char*)dst + (size_t)row * DM + lane * 16) = b8;
    if (lane == 0) hs[row] = st;
  }
}

constexpr size_t WS_WEFF8 = WS_WIN, WS_SW = WS_WIN + 5 * MiB;
constexpr size_t WS_WIN8 = R2, WS_SWIN = R2 + 4 * MiB;
constexpr size_t WS_HS0 = R2 + 5 * MiB;
DI void quant_rows_i8(const bf16_t* __restrict__ w, int nrows, unsigned char* __restrict__ w8, float* __restrict__ sw) {
  const int lane = otid() & 63, gw = blockIdx.x * (NT / 64) + (otid() >> 6), nw_ = gridDim.x * (NT / 64);
  for (int row = gw; row < nrows; row += nw_) {
    const u32x4 a = *(const u32x4*)(w + (size_t)row * 1024 + lane * 16), b = *(const u32x4*)(w + (size_t)row * 1024 + lane * 16 + 8);
    float v[16]; float am = 0.f;
#pragma unroll
    for (int i = 0; i < 4; ++i) { v[2 * i] = bflo(a[i]); v[2 * i + 1] = bfhi(a[i]); v[8 + 2 * i] = bflo(b[i]); v[9 + 2 * i] = bfhi(b[i]); }
#pragma unroll
    for (int i = 0; i < 16; ++i) am = fmaxf(am, fabsf(v[i]));
#pragma unroll
    for (int o = 32; o >= 1; o >>= 1) am = fmaxf(am, __shfl_xor(am, o, 64));
    const float st = am * (1.f / 127.f) + 1e-30f, ist = 1.f / st;
    u32x4 o8 = {0u, 0u, 0u, 0u};
#pragma unroll
    for (int i = 0; i < 16; ++i) { const int qv = (int)fminf(fmaxf(rintf(v[i] * ist), -127.f), 127.f); o8[i >> 2] |= ((unsigned)qv & 255u) << (8 * (i & 3)); }
    *(u32x4*)(w8 + (size_t)row * 1024 + lane * 16) = o8;
    if (lane == 0) sw[row] = st;
  }
}
DI void norm_rows_i8(const float* __restrict__ src, int row_begin, int nrows, const float* __restrict__ nw, const float* __restrict__ modbase, bool ctx_tail,
                     unsigned char* __restrict__ dst8, float* __restrict__ hs) {
  const int lane = otid() & 63, gw = blockIdx.x * (NT / 64) + (otid() >> 6), nw_ = gridDim.x * (NT / 64);
  for (int row = row_begin + gw; row < nrows; row += nw_) {
    const int v = (ctx_tail && row >= TL) ? 4 : (row >> 13);
    const float* xr = src + (size_t)row * DM + lane * 16;
    f32x4 xv[4]; float ss = 0.f;
#pragma unroll
    for (int i = 0; i < 4; ++i) { xv[i] = *(const f32x4*)(xr + 4 * i); ss += xv[i][0] * xv[i][0] + xv[i][1] * xv[i][1] + xv[i][2] * xv[i][2] + xv[i][3] * xv[i][3]; }
    ss = wave_sum(ss);
    const float rs = rsqrtf(ss * (1.f / DM) + EPS);
    const float* sh = modbase + (size_t)v * 6144 + lane * 16; const float* scp = sh + 1024;
    float y[16]; float am = 0.f;
#pragma unroll
    for (int i = 0; i < 4; ++i) {
      const f32x4 w4 = *(const f32x4*)(nw + lane * 16 + 4 * i), s4 = *(const f32x4*)(sh + 4 * i), c4 = *(const f32x4*)(scp + 4 * i);
#pragma unroll
      for (int j = 0; j < 4; ++j) { y[4 * i + j] = xv[i][j] * rs * w4[j] * (1.f + c4[j]) + s4[j]; am = fmaxf(am, fabsf(y[4 * i + j])); }
    }
#pragma unroll
    for (int o = 32; o >= 1; o >>= 1) am = fmaxf(am, __shfl_xor(am, o, 64));
    const float st = am * (1.f / 127.f) + 1e-30f, ist = 1.f / st;
    u32x4 b8 = {0u, 0u, 0u, 0u};
#pragma unroll
    for (int j = 0; j < 16; ++j) { const int qv = (int)fminf(fmaxf(rintf(y[j] * ist), -127.f), 127.f); b8[j >> 2] |= ((unsigned)qv & 255u) << (8 * (j & 3)); }
    *(u32x4*)(dst8 + (size_t)row * DM + lane * 16) = b8;
    if (lane == 0) hs[row] = st;
  }
}

struct EpiProjV {
  const P* p; int row0, col0;
  DI void operator()(f32x16 (&acc)[2][2], int wm, int wn, int lane) const {
    const int cb = col0 + wn * 64, h = lane >> 5, cl = lane & 31;
    const bool isctx = row0 >= TL;
    bf16_t* o = (bf16_t*)(p->ws + WS_VT);
    const int hv = (cb - 3072) >> 7, dvb = (cb - 3072) & 127;
#pragma unroll
    for (int mt = 0; mt < 2; ++mt)
#pragma unroll
      for (int nt = 0; nt < 2; ++nt)
#pragma unroll
        for (int g = 0; g < 4; ++g) {
          const int row = row0 + wm * 64 + mt * 32 + 8 * g + 4 * h;
          int b, pos; if (!isctx) { b = row >> 13; pos = row & (SEQ - 1); } else { const int rc = row - TL; b = rc >> 8; pos = SEQ + (rc & 255); }
          const int dv = dvb + nt * 32 + cl;
          u32x2 v; v[0] = pk2(acc[mt][nt][4 * g], acc[mt][nt][4 * g + 1]); v[1] = pk2(acc[mt][nt][4 * g + 2], acc[mt][nt][4 * g + 3]);
          *(u32x2*)(o + ((size_t)((b * 4 + hv) * 128 + dv)) * KVL + pos) = v;
        }
  }
};
struct EpiProjS {
  const P* p; int row0, col0;
  DI void operator()(f32x16 (&acc)[2][2], int wm, int wn, int lane) const {
    const int cb = col0 + wn * 64, h = lane >> 5, cl = lane & 31;
    const bool isctx = row0 >= TL;
    char* ws = p->ws;
    if (cb < 2048) {
      const bool isg = cb >= 1536;
      if (isg && isctx) return;
      bf16_t* o = (bf16_t*)(ws + (isg ? WS_GATE : WS_QKVRAW));
      const int pitch = isg ? 512 : 1536, cofs = isg ? cb - 1536 : cb;
#pragma unroll
      for (int mt = 0; mt < 2; ++mt) {
        const int row = row0 + wm * 64 + mt * 32 + cl;
#pragma unroll
        for (int nt = 0; nt < 2; ++nt)
#pragma unroll
          for (int g = 0; g < 4; ++g) {
            float v0 = acc[mt][nt][4 * g], v1 = acc[mt][nt][4 * g + 1], v2 = acc[mt][nt][4 * g + 2], v3 = acc[mt][nt][4 * g + 3];
            if (isg) { v0 = silu_f(v0); v1 = silu_f(v1); v2 = silu_f(v2); v3 = silu_f(v3); }
            u32x2 v; v[0] = pk2(v0, v1); v[1] = pk2(v2, v3);
            *(u32x2*)(o + (size_t)row * pitch + cofs + nt * 32 + 8 * g + 4 * h) = v;
          }
      }
    } else if (cb < 3072) {
      const bool isq = cb < 2560;
      if (isq && isctx) return;
      const float* rope = (const float*)(ws + WS_ROPE);
      bf16_t* o = (bf16_t*)(ws + (isq ? WS_Q : WS_K));
      const int cofs = cb - (isq ? 2048 : 2560);
      const float qs = isq ? 0.125f * 1.4426950408889634f : 1.f;
#pragma unroll
      for (int mt = 0; mt < 2; ++mt) {
        const int row = row0 + wm * 64 + mt * 32 + cl;
        size_t orow; int l = 0;
        if (!isctx) { l = row & (SEQ - 1); orow = isq ? (size_t)row : (size_t)(row >> 13) * KVL + l; }
        else { const int rc = row - TL; orow = (size_t)(rc >> 8) * KVL + SEQ + (rc & 255); }
#pragma unroll
        for (int g = 0; g < 4; ++g) {
          const int d0 = 8 * g + 4 * h;
          float o1[4], o2[4];
          if (!isctx) {
            const f32x4 ca = *(const f32x4*)(rope + ((size_t)l * 32 + d0) * 2), cb2 = *(const f32x4*)(rope + ((size_t)l * 32 + d0) * 2 + 4);
            const float cs[4] = {ca[0], ca[2], cb2[0], cb2[2]}, sn[4] = {ca[1], ca[3], cb2[1], cb2[3]};
#pragma unroll
            for (int r = 0; r < 4; ++r) { const float x1 = acc[mt][0][4 * g + r], x2 = acc[mt][1][4 * g + r]; o1[r] = (x1 * cs[r] - x2 * sn[r]) * qs; o2[r] = (x1 * sn[r] + x2 * cs[r]) * qs; }
          } else {
#pragma unroll
            for (int r = 0; r < 4; ++r) { o1[r] = acc[mt][0][4 * g + r]; o2[r] = acc[mt][1][4 * g + r]; }
          }
          u32x2 v; v[0] = pk2(o1[0], o1[1]); v[1] = pk2(o1[2], o1[3]); *(u32x2*)(o + orow * 512 + cofs + d0) = v;
          v[0] = pk2(o2[0], o2[1]); v[1] = pk2(o2[2], o2[3]); *(u32x2*)(o + orow * 512 + cofs + 32 + d0) = v;
        }
      }
    } else if (cb == 3584) {
      float* o = (float*)(ws + WS_BA);
#pragma unroll
      for (int mt = 0; mt < 2; ++mt) {
        const int row = row0 + wm * 64 + mt * 32 + cl;
#pragma unroll
        for (int g = 0; g < 4; ++g) {
          const int j0 = 8 * g + 4 * h;
          f32x4 y;
#pragma unroll
          for (int r = 0; r < 4; ++r) {
            const int j = j0 + r; const float v = acc[mt][0][4 * g + r];
            if (j0 < 16) y[r] = sigmoid_f(v);
            else { const float z = v + p->dt_bias[j - 16]; const float sp = (z > 20.f) ? z : log1pf(__expf(z)); y[r] = -__expf(p->a_log[j - 16]) * sp; }
          }
          *(f32x4*)(o + (size_t)row * 32 + j0) = y;
        }
      }
    }
  }
};

DI void ph_gemm_proj(const P& p, char* lds) {
  const bf16_t* A = (const bf16_t*)(p.ws + R0); const bf16_t* Bt = (const bf16_t*)(p.ws + WS_WIN);
  const int nM = TA / GBM, nN = NIN / GBN;
  for (int t = blockIdx.x; t < nM * nN; t += gridDim.x) {
    const int pm = t / nN, pn = t % nN;
    RowLin rf{A + (size_t)pm * GBM * DM, (size_t)DM};
    if (pn >= 24 && pn < 28) { EpiProjV ep{&p, pm * GBM, pn * GBN}; gemm_tile<false>(lds, rf, Bt + (size_t)pn * GBN * DM, DM, ep); }
    else { EpiProjS ep{&p, pm * GBM, pn * GBN}; gemm_tile<true>(lds, rf, Bt + (size_t)pn * GBN * DM, DM, ep); }
  }
}


struct PgResid {
  static constexpr bool PERM = true, AFTER_DRAIN = false;
  const float* xin; float* xout; const float* gmod;
  DI void operator()(const pg8::f32x4 (&acc)[2][2][4][2], const pg8::Unit& u, int wr, int wc, int fr, int fq) const {
#pragma unroll
    for (int ai = 0; ai < 2; ++ai)
#pragma unroll
      for (int m = 0; m < 4; ++m) {
        const int row = u.pm * 256 + ai * 128 + wr * 64 + m * 16 + fr;
        const float* gm = gmod + (size_t)(row >> 13) * 6144;
#pragma unroll
        for (int bj = 0; bj < 2; ++bj) {
          const int c0 = u.pn * 256 + bj * 128 + wc * 32 + 8 * fq;
#pragma unroll
          for (int n = 0; n < 2; ++n) {
            const f32x4 xv = *(const f32x4*)(xin + (size_t)row * DM + c0 + 4 * n), g4 = *(const f32x4*)(gm + c0 + 4 * n);
            *(f32x4*)(xout + (size_t)row * DM + c0 + 4 * n) = xv + g4 * acc[ai][bj][m][n];
          }
        }
      }
  }
};
struct PgBf16 {
  static constexpr bool PERM = true, AFTER_DRAIN = false;
  bf16_t* o; int pitch;
  DI void operator()(const pg8::f32x4 (&acc)[2][2][4][2], const pg8::Unit& u, int wr, int wc, int fr, int fq) const {
#pragma unroll
    for (int ai = 0; ai < 2; ++ai)
#pragma unroll
      for (int m = 0; m < 4; ++m) {
        const int row = u.pm * 256 + ai * 128 + wr * 64 + m * 16 + fr;
#pragma unroll
        for (int bj = 0; bj < 2; ++bj) {
          const int c0 = u.pn * 256 + bj * 128 + wc * 32 + 8 * fq;
          const f32x4 v0 = acc[ai][bj][m][0], v1 = acc[ai][bj][m][1];
          u32x4 w; w[0] = pk2(v0[0], v0[1]); w[1] = pk2(v0[2], v0[3]); w[2] = pk2(v1[0], v1[1]); w[3] = pk2(v1[2], v1[3]);
          *(u32x4*)(o + (size_t)row * pitch + c0) = w;
        }
      }
  }
};
struct PgProj {
  static constexpr bool PERM = true, AFTER_DRAIN = false, DEQ = true;
  const P* p;
  DI void deq(pg8::f32x4 (&acc)[2][2][4][2], const pg8::Unit& u, int wr, int wc, int fr, int fq) const {
    const float* srow = (const float*)(p->ws + WS_HS0); const float* scol = (const float*)(p->ws + WS_SWIN);
#pragma unroll
    for (int bj = 0; bj < 2; ++bj) {
      const int c0 = u.pn * 256 + bj * 128 + wc * 32 + 8 * fq;
      const f32x4 sc0 = *(const f32x4*)(scol + c0), sc1 = *(const f32x4*)(scol + c0 + 4);
#pragma unroll
      for (int ai = 0; ai < 2; ++ai)
#pragma unroll
        for (int m = 0; m < 4; ++m) {
          const float sr = srow[u.pm * 256 + ai * 128 + wr * 64 + m * 16 + fr];
          const pg8::v4i_t i0 = __builtin_bit_cast(pg8::v4i_t, acc[ai][bj][m][0]), i1 = __builtin_bit_cast(pg8::v4i_t, acc[ai][bj][m][1]);
#pragma unroll
          for (int r = 0; r < 4; ++r) { acc[ai][bj][m][0][r] = (float)i0[r] * sr * sc0[r]; acc[ai][bj][m][1][r] = (float)i1[r] * sr * sc1[r]; }
        }
    }
  }
  DI void operator()(const pg8::f32x4 (&acc)[2][2][4][2], const pg8::Unit& u, int wr, int wc, int fr, int fq) const {
    char* ws = p->ws;
    const bool isctx = u.pm * 256 >= TL;
#pragma unroll
    for (int bj = 0; bj < 2; ++bj) {
      const int c0 = u.pn * 256 + bj * 128 + wc * 32 + 8 * fq;
      const int cs = u.pn * 256 + bj * 128 + wc * 32;
      if (cs < 2048) {
        const bool isg = cs >= 1536;
        if (isg && isctx) continue;
        bf16_t* o = (bf16_t*)(ws + (isg ? WS_GATE : WS_QKVRAW));
        const int pitch = isg ? 512 : 1536, cofs = isg ? c0 - 1536 : c0;
#pragma unroll
        for (int ai = 0; ai < 2; ++ai)
#pragma unroll
          for (int m = 0; m < 4; ++m) {
            const int row = u.pm * 256 + ai * 128 + wr * 64 + m * 16 + fr;
            f32x4 v0 = acc[ai][bj][m][0], v1 = acc[ai][bj][m][1];
            if (isg) {
#pragma unroll
              for (int r = 0; r < 4; ++r) { v0[r] = silu_f(v0[r]); v1[r] = silu_f(v1[r]); }
            }
            u32x4 w; w[0] = pk2(v0[0], v0[1]); w[1] = pk2(v0[2], v0[3]); w[2] = pk2(v1[0], v1[1]); w[3] = pk2(v1[2], v1[3]);
            *(u32x4*)(o + (size_t)row * pitch + cofs) = w;
          }
      } else if (cs < 3072) {
        const bool isq = cs < 2560;
        if (isq && isctx) continue;
        const float* rope = (const float*)(ws + WS_ROPE);
        bf16_t* o = (bf16_t*)(ws + (isq ? WS_Q : WS_K));
        const int gofs = (c0 & ~63) - (isq ? 2048 : 2560), d0 = ((c0 & 63) >> 3) * 4;
        const float qs = isq ? 0.125f * 1.4426950408889634f : 1.f;
#pragma unroll
        for (int ai = 0; ai < 2; ++ai)
#pragma unroll
          for (int m = 0; m < 4; ++m) {
            const int row = u.pm * 256 + ai * 128 + wr * 64 + m * 16 + fr;
            const f32x4 x1 = acc[ai][bj][m][0], x2 = acc[ai][bj][m][1];
            size_t orow; float o1[4], o2[4];
            if (!isctx) {
              const int l = row & (SEQ - 1);
              orow = isq ? (size_t)row : (size_t)(row >> 13) * KVL + l;
              const f32x4 ca = *(const f32x4*)(rope + ((size_t)l * 32 + d0) * 2), cb2 = *(const f32x4*)(rope + ((size_t)l * 32 + d0) * 2 + 4);
              const float cs4[4] = {ca[0], ca[2], cb2[0], cb2[2]}, sn4[4] = {ca[1], ca[3], cb2[1], cb2[3]};
#pragma unroll
              for (int r = 0; r < 4; ++r) { o1[r] = (x1[r] * cs4[r] - x2[r] * sn4[r]) * qs; o2[r] = (x1[r] * sn4[r] + x2[r] * cs4[r]) * qs; }
            } else {
              const int rc = row - TL; orow = (size_t)(rc >> 8) * KVL + SEQ + (rc & 255);
#pragma unroll
              for (int r = 0; r < 4; ++r) { o1[r] = x1[r]; o2[r] = x2[r]; }
            }
            u32x2 v; v[0] = pk2(o1[0], o1[1]); v[1] = pk2(o1[2], o1[3]); *(u32x2*)(o + orow * 512 + gofs + d0) = v;
            v[0] = pk2(o2[0], o2[1]); v[1] = pk2(o2[2], o2[3]); *(u32x2*)(o + orow * 512 + gofs + 32 + d0) = v;
          }
      } else if (cs < 3584) {
        bf16_t* o = (bf16_t*)(ws + WS_VROW);
#pragma unroll
        for (int ai = 0; ai < 2; ++ai)
#pragma unroll
          for (int m = 0; m < 4; ++m) {
            const int row = u.pm * 256 + ai * 128 + wr * 64 + m * 16 + fr;
            size_t orow; if (!isctx) orow = (size_t)(row >> 13) * KVL + (row & (SEQ - 1)); else { const int rc = row - TL; orow = (size_t)(rc >> 8) * KVL + SEQ + (rc & 255); }
            const f32x4 v0 = acc[ai][bj][m][0], v1 = acc[ai][bj][m][1];
            u32x4 w; w[0] = cvtpk(v0[0], v0[1]); w[1] = cvtpk(v0[2], v0[3]); w[2] = cvtpk(v1[0], v1[1]); w[3] = cvtpk(v1[2], v1[3]);
            *(u32x4*)(o + orow * 512 + (c0 - 3072)) = w;
          }
      } else if (cs == 3584) {
        float* o = (float*)(ws + WS_BA);
        const int j0 = c0 - 3584;
#pragma unroll
        for (int ai = 0; ai < 2; ++ai)
#pragma unroll
          for (int m = 0; m < 4; ++m) {
            const int row = u.pm * 256 + ai * 128 + wr * 64 + m * 16 + fr;
#pragma unroll
            for (int n = 0; n < 2; ++n) {
              f32x4 y;
#pragma unroll
              for (int r = 0; r < 4; ++r) {
                const int j = j0 + 4 * n + r; const float v = acc[ai][bj][m][n][r];
                if (j0 < 16) y[r] = sigmoid_f(v);
                else { const float z = v + p->dt_bias[j - 16]; const float sp = (z > 20.f) ? z : log1pf(__expf(z)); y[r] = -__expf(p->a_log[j - 16]) * sp; }
              }
              *(f32x4*)(o + (size_t)row * 32 + j0 + 4 * n) = y;
            }
          }
      }
    }
  }
};
struct PgScoreI8 {
  static constexpr bool PERM = true, AFTER_DRAIN = false, DEQ = false;
  bf16_t* o; const float* srow; const float* scol;
  DI void operator()(const pg8::f32x4 (&acc)[2][2][4][2], const pg8::Unit& u, int wr, int wc, int fr, int fq) const {
#pragma unroll
    for (int bj = 0; bj < 2; ++bj) {
      const int c0 = u.pn * 256 + bj * 128 + wc * 32 + 8 * fq;
      const f32x4 s0 = *(const f32x4*)(scol + c0), s1 = *(const f32x4*)(scol + c0 + 4);
#pragma unroll
      for (int ai = 0; ai < 2; ++ai)
#pragma unroll
        for (int m = 0; m < 4; ++m) {
          const int row = u.pm * 256 + ai * 128 + wr * 64 + m * 16 + fr;
          const float sr = srow[row];
          const pg8::v4i_t i0 = __builtin_bit_cast(pg8::v4i_t, acc[ai][bj][m][0]), i1 = __builtin_bit_cast(pg8::v4i_t, acc[ai][bj][m][1]);
          u32x4 w;
          w[0] = pk2((float)i0[0] * sr * s0[0], (float)i0[1] * sr * s0[1]); w[1] = pk2((float)i0[2] * sr * s0[2], (float)i0[3] * sr * s0[3]);
          w[2] = pk2((float)i1[0] * sr * s1[0], (float)i1[1] * sr * s1[1]); w[3] = pk2((float)i1[2] * sr * s1[2], (float)i1[3] * sr * s1[3]);
          *(u32x4*)(o + (size_t)row * 2048 + c0) = w;
        }
    }
  }
};
template <class Epi>
DI void pg8_run_i8(char* lds, const void* A8, const void* Bt8, int M, int N, int Kbytes, const Epi& E) {
  pg8::Gemm g{(const pg8::bf16_t*)A8, (const pg8::bf16_t*)Bt8, M, N, Kbytes / 2};
  pg8::StaticOrder S; S.init(M, N, (int)gridDim.x, (int)blockIdx.x);
  pg8::gemm_phase<Epi, pg8::StaticOrder, true, true, true>((PG8_LAS unsigned char*)lds, g, S, E);
}
template <class Epi>
DI void pg8_run(char* lds, const bf16_t* A, const bf16_t* Bt, int M, int N, int K, const Epi& E) {
  pg8::Gemm g{A, Bt, M, N, K};
  pg8::StaticOrder S; S.init(M, N, (int)gridDim.x, (int)blockIdx.x);
  pg8::gemm_phase<Epi, pg8::StaticOrder, true, true>((PG8_LAS unsigned char*)lds, g, S, E);
}

DI void gdn_solve(const float* MT, const float* src  , const float* be, const float* gc  ,
                  int d, int part, int lane, bf16_t* uo) {
  float a[64];
#pragma unroll
  for (int i = 0; i < 64; ++i) {
    const int t = d ? 63 - i : i;
    float v = be[t] * src[t * 68 + lane];
    if (part) v *= __expf(gc[t]);
    a[i] = v;
  }
#pragma unroll
  for (int j = 0; j < 63; ++j) {
    const float xj = a[j];
#pragma unroll
    for (int i4 = ((j + 1) & ~3); i4 < 64; i4 += 4) {
      const f32x4 m = *(const f32x4*)(MT + j * 68 + i4);
#pragma unroll
      for (int q = 0; q < 4; ++q) if (i4 + q > j) a[i4 + q] -= m[q] * xj;
    }
  }
  if (part) {
#pragma unroll
    for (int i = 0; i < 64; ++i) uo[i * 64 + lane] = (bf16_t)f2bf(a[i]);
  } else {
#pragma unroll
    for (int c = 0; c < 8; ++c) {
      u32x4 o; o[0] = pk2(a[8 * c], a[8 * c + 1]); o[1] = pk2(a[8 * c + 2], a[8 * c + 3]); o[2] = pk2(a[8 * c + 4], a[8 * c + 5]); o[3] = pk2(a[8 * c + 6], a[8 * c + 7]);
      *(u32x4*)(uo + lane * 64 + 8 * c) = o;
    }
  }
}

template <int MODE = 0>
DI void ph_gdn_prep(const P& p, char* lds) {
  const int tid0 = otid();
  float* L = (float*)lds;
  constexpr int HSZ = 4 * 64 * 68 + 6 * 64;
  const bf16_t* raw = (const bf16_t*)(p.ws + WS_QKVRAW);
  const float* BA = (const float*)(p.ws + WS_BA);
  bf16_t* qn = (bf16_t*)(p.ws + WS_QN); bf16_t* kn = (bf16_t*)(p.ws + WS_KN);
  float* GC = (float*)(p.ws + WS_GC);
  bf16_t* UW = (bf16_t*)(p.ws + WS_UW);
  for (int it = blockIdx.x; it < NB * NCH * 4; it += gridDim.x) {
    int tid = tid0; asm volatile("" : "+v"(tid));
    const int lane = tid & 63, wave = __builtin_amdgcn_readfirstlane(tid >> 6);
    const int hpair = it & 3, cid = (it >> 2) % NCH, b = it / (4 * NCH);
    const int segbase = (cid < 4) ? TL + b * CTXL : b * SEQ, c0 = (cid < 4) ? cid * 64 : (cid - 4) * 64, seglen = (cid < 4) ? CTXL : SEQ;
    __syncthreads();
    {
      const int t = tid >> 3, c8 = tid & 7, sidx = c0 + t;
      const size_t grow = (size_t)(segbase + sidx);
      const bool hm = sidx - 1 >= 0, hp_ = sidx + 1 < seglen;
#pragma unroll 1
      for (int hh = 0; hh < 2; ++hh) {
        const int head = hpair * 2 + hh;
        float* kf = L + hh * HSZ; float* vf = kf + 64 * 68;
#pragma unroll
        for (int part = 0; part < 3; ++part) {
          const int ch = part * 512 + head * 64 + c8 * 8;
          const u32x4 z4 = {0u, 0u, 0u, 0u};
          const u32x4 rm = hm ? *(const u32x4*)(raw + (grow - 1) * 1536 + ch) : z4;
          const u32x4 r0v = *(const u32x4*)(raw + grow * 1536 + ch);
          const u32x4 rp = hp_ ? *(const u32x4*)(raw + (grow + 1) * 1536 + ch) : z4;
          float v[8]; float ss = 0.f;
#pragma unroll
          for (int w = 0; w < 4; ++w) {
            const f32x2_t w0 = *(const f32x2_t*)(p.conv_w + ch + 2 * w), w1 = *(const f32x2_t*)(p.conv_w + 1536 + ch + 2 * w), w2 = *(const f32x2_t*)(p.conv_w + 3072 + ch + 2 * w);
            v[2 * w] = silu_f(w0[0] * bflo(rm[w]) + w1[0] * bflo(r0v[w]) + w2[0] * bflo(rp[w]));
            v[2 * w + 1] = silu_f(w0[1] * bfhi(rm[w]) + w1[1] * bfhi(r0v[w]) + w2[1] * bfhi(rp[w]));
            ss += v[2 * w] * v[2 * w] + v[2 * w + 1] * v[2 * w + 1];
          }
          if (part < 2) {
            ss += __shfl_xor(ss, 1, 64); ss += __shfl_xor(ss, 2, 64); ss += __shfl_xor(ss, 4, 64);
            const float rn = rsqrtf(ss + EPS) * (part == 0 ? 0.125f : 1.f);
#pragma unroll
            for (int w = 0; w < 8; ++w) v[w] *= rn;
            u32x4 o; o[0] = pk2(v[0], v[1]); o[1] = pk2(v[2], v[3]); o[2] = pk2(v[4], v[5]); o[3] = pk2(v[6], v[7]);
            *(u32x4*)((part == 0 ? qn : kn) + grow * 512 + head * 64 + c8 * 8) = o;
          }
          if (part >= 1) {
            float* dst = (part == 1 ? kf : vf) + t * 68 + c8 * 8;
            *(f32x4*)dst = f32x4{v[0], v[1], v[2], v[3]}; *(f32x4*)(dst + 4) = f32x4{v[4], v[5], v[6], v[7]};
          }
        }
      }
    }
    if (MODE == 2) continue;
    if (wave < 4) {
      const int hh = wave >> 1, d = wave & 1, head = hpair * 2 + hh, t = lane;
      float* be = L + hh * HSZ + 4 * 64 * 68;
      const size_t row = (size_t)(segbase + c0 + t);
      be[d * 64 + t] = BA[row * 32 + d * 8 + head];
      const float g = BA[row * 32 + 16 + d * 8 + head];
      float a = g;
#pragma unroll
      for (int o = 1; o < 64; o <<= 1) {
        const float nb_ = d ? __shfl_down(a, o, 64) : __shfl_up(a, o, 64);
        const bool ok = d ? (lane + o < 64) : (lane >= o);
        a += ok ? nb_ : 0.f;
      }
      be[256 + d * 64 + t] = a;
      GC[((size_t)((b * 8 + head) * 2 + d) * NCH + cid) * 64 + (d ? 63 - t : t)] = a;
    }
    __syncthreads();
    {
      const int hh = wave >> 2, Ln = lane;
      float* kf = L + hh * HSZ; float* M0 = kf + 2 * 64 * 68; float* M1 = kf + 3 * 64 * 68; float* be = kf + 4 * 64 * 68; float* gc = be + 256;
      float a[16];
#pragma unroll
      for (int i = 0; i < 16; ++i) a[i] = 0.f;
#pragma unroll 1
      for (int c = 0; c < 64; c += 4) {
        const f32x4 kv = *(const f32x4*)(kf + Ln * 68 + c);
#pragma unroll
        for (int i = 0; i < 16; ++i) { const f32x4 kr = *(const f32x4*)(kf + ((wave & 3) * 16 + i) * 68 + c); a[i] += kv[0] * kr[0] + kv[1] * kr[1] + kv[2] * kr[2] + kv[3] * kr[3]; }
      }
      const float b0 = be[Ln], b1 = be[64 + Ln], g0 = gc[Ln], g1 = gc[64 + Ln];
#pragma unroll
      for (int i = 0; i < 16; ++i) {
        const int ti = (wave & 3) * 16 + i;
        if (Ln > ti) M0[ti * 68 + Ln] = b0 * a[i] * __expf(g0 - gc[ti]);
        else if (Ln < ti) M1[(63 - ti) * 68 + 63 - Ln] = b1 * a[i] * __expf(g1 - gc[64 + ti]);
      }
    }
    __syncthreads();
    if (MODE == 0) {
      const int hh = wave >> 2, d = (wave >> 1) & 1, part = wave & 1, head = hpair * 2 + hh;
      float* kf = L + hh * HSZ; float* vf = kf + 64 * 68; float* Md = kf + (2 + d) * 64 * 68; float* be = kf + 4 * 64 * 68; float* gc = be + 256;
      bf16_t* uo = UW + (((size_t)((b * 8 + head) * 2 + d) * NCH + cid) * 2 + part) * 4096;
      gdn_solve(Md, part ? kf : vf, be + d * 64, gc + d * 64, d, part, lane, uo);
    }
  }
}

#define MFMA16(a, b, c) __builtin_amdgcn_mfma_f32_16x16x32_bf16((a), (b), (c), 0, 0, 0)
constexpr int SC_LD = 72;
constexpr int SC_T = 64 * SC_LD * 2;
constexpr int SC_STAGE = 5 * SC_T + 1024;
constexpr int SC_KNL = 2 * SC_STAGE, SC_QNL = SC_KNL + SC_T;
DI bf16x8 pack8(const f32x4& a, const f32x4& b) { u32x4 r; r[0] = cvtpk(a[0], a[1]); r[1] = cvtpk(a[2], a[3]); r[2] = cvtpk(b[0], b[1]); r[3] = cvtpk(b[2], b[3]); return __builtin_bit_cast(bf16x8, r); }
DI bf16x8 afrag(const char* tile, int row, int kofs  ) {
  const char* pr = tile + (row * SC_LD + kofs) * 2;
  const u32x2 lo = *(const u32x2*)pr, hi = *(const u32x2*)(pr + 32);
  u32x4 r; r[0] = lo[0]; r[1] = lo[1]; r[2] = hi[0]; r[3] = hi[1];
  return __builtin_bit_cast(bf16x8, r);
}
template <int NOSTORE = 0>
DI void ph_gdn_scan(const P& p, char* lds) {
  const int tid = otid(), lane = tid & 63, wave = __builtin_amdgcn_readfirstlane(tid >> 6);
  const int c = lane & 15, q = lane >> 4;
  const bf16_t* qn = (const bf16_t*)(p.ws + WS_QN); const bf16_t* kn = (const bf16_t*)(p.ws + WS_KN);
  const float* GC = (const float*)(p.ws + WS_GC);
  const bf16_t* UW = (const bf16_t*)(p.ws + WS_UW);
  bf16_t* Ob = (bf16_t*)(p.ws + WS_OBUF);
  for (int it = blockIdx.x; it < 64; it += gridDim.x) {
    const int bhd = it, d = bhd & 1, head = (bhd >> 1) & 7, b = bhd >> 4;
    __syncthreads();
    if (wave >= 4) {
      const int pt = tid - 256;
      const int r0 = pt >> 3, cc = pt & 7;
      u32x4 rW0A, rW1A, rU0A, rU1A, rK0A, rK1A, rQ0A, rQ1A; f32x4 rGA;
      u32x4 rW0B, rW1B, rU0B, rU1B, rK0B, rK1B, rQ0B, rQ1B; f32x4 rGB;
#define SP_CID(n) (d ? ((n) < 4 ? 3 - (n) : 135 - (n)) : (n))
#define SP_LOAD(n, S) do { const int nn_ = (n) < NCH ? (n) : NCH - 1; const int cid_ = SP_CID(nn_); const bool lat_ = cid_ >= 4; const int sb_ = lat_ ? b * SEQ : TL + b * CTXL, c0_ = lat_ ? (cid_ - 4) * 64 : cid_ * 64; \
        const bf16_t* uw_ = UW + ((size_t)(bhd * NCH + cid_) * 2) * 4096; \
        rU0##S = *(const u32x4*)(uw_ + r0 * 64 + cc * 8); rU1##S = *(const u32x4*)(uw_ + (r0 + 32) * 64 + cc * 8); \
        rW0##S = *(const u32x4*)(uw_ + 4096 + r0 * 64 + cc * 8); rW1##S = *(const u32x4*)(uw_ + 4096 + (r0 + 32) * 64 + cc * 8); \
        const int t0_ = d ? 63 - r0 : r0, t1_ = d ? 31 - r0 : r0 + 32; \
        rK0##S = *(const u32x4*)(kn + (size_t)(sb_ + c0_ + t0_) * 512 + head * 64 + cc * 8); rK1##S = *(const u32x4*)(kn + (size_t)(sb_ + c0_ + t1_) * 512 + head * 64 + cc * 8); \
        const bf16_t* qk_ = lat_ ? qn : kn;     \
        rQ0##S = *(const u32x4*)(qk_ + (size_t)(sb_ + c0_ + t0_) * 512 + head * 64 + cc * 8); rQ1##S = *(const u32x4*)(qk_ + (size_t)(sb_ + c0_ + t1_) * 512 + head * 64 + cc * 8); \
        rG##S = *(const f32x4*)(GC + (size_t)(bhd * NCH + cid_) * 64 + (pt & 15) * 4); } while (0)
#define SP_A(n, S) do { char* st_ = lds + ((n) & 1) * SC_STAGE; const int o0_ = (r0 * SC_LD + cc * 8) * 2, o1_ = o0_ + 32 * SC_LD * 2; \
        *(u32x4*)(st_ + o0_) = rW0##S; *(u32x4*)(st_ + o1_) = rW1##S; *(u32x4*)(st_ + SC_T + o0_) = rU0##S; *(u32x4*)(st_ + SC_T + o1_) = rU1##S; \
        *(u32x4*)(lds + SC_KNL + o0_) = rK0##S; *(u32x4*)(lds + SC_KNL + o1_) = rK1##S; \
        *(u32x4*)(lds + SC_QNL + o0_) = rQ0##S; *(u32x4*)(lds + SC_QNL + o1_) = rQ1##S; \
        if (pt < 16) { float* gp_ = (float*)(st_ + 5 * SC_T); *(f32x4*)(gp_ + pt * 4) = rG##S; } } while (0)
#define SP_B(n) do { char* st_ = lds + ((n) & 1) * SC_STAGE; float* gp_ = (float*)(st_ + 5 * SC_T); const bool lat_ = SP_CID((n) < NCH ? (n) : NCH - 1) >= 4; \
        const float gl_ = gp_[63]; \
        if (pt < 64) { const float gi_ = gp_[pt]; gp_[64 + pt] = __expf(gi_); gp_[128 + pt] = __expf(gl_ - gi_); if (pt == 0) gp_[192] = __expf(gl_); } \
        {   \
          const int i_ = pt & 63; \
          _Pragma("unroll") for (int e_ = 0; e_ < 2; ++e_) { const int ch_ = (pt >> 6) * 2 + e_; const u32x4 kv_ = *(const u32x4*)(lds + SC_KNL + (i_ * SC_LD + ch_ * 8) * 2); \
            bf16_t* kt_ = (bf16_t*)(st_ + 2 * SC_T); \
            _Pragma("unroll") for (int w_ = 0; w_ < 4; ++w_) { kt_[(ch_ * 8 + 2 * w_) * SC_LD + i_] = (bf16_t)(kv_[w_] & 0xFFFFu); kt_[(ch_ * 8 + 2 * w_ + 1) * SC_LD + i_] = (bf16_t)(kv_[w_] >> 16); } } } \
        if (lat_) { \
          {   \
            _Pragma("unroll") for (int e_ = 0; e_ < 2; ++e_) { const int rr_ = r0 + 32 * e_; const float sc_ = __expf(gp_[rr_]); const u32x4 qv_ = *(const u32x4*)(lds + SC_QNL + (rr_ * SC_LD + cc * 8) * 2); u32x4 ov_; \
              _Pragma("unroll") for (int w_ = 0; w_ < 4; ++w_) ov_[w_] = cvtpk(bflo(qv_[w_]) * sc_, bfhi(qv_[w_]) * sc_); \
              *(u32x4*)(st_ + 3 * SC_T + (rr_ * SC_LD + cc * 8) * 2) = ov_; } } \
          {   \
            const int jt_ = wave - 4; \
            const bf16x8 ka0_ = *(const bf16x8*)(lds + SC_KNL + ((16 * jt_ + c) * SC_LD + 8 * q) * 2), ka1_ = *(const bf16x8*)(lds + SC_KNL + ((16 * jt_ + c) * SC_LD + 32 + 8 * q) * 2); \
            bf16x8 qb_[4][2]; \
            _Pragma("unroll") for (int it_ = 0; it_ < 4; ++it_) { qb_[it_][0] = *(const bf16x8*)(lds + SC_QNL + ((16 * it_ + c) * SC_LD + 8 * q) * 2); qb_[it_][1] = *(const bf16x8*)(lds + SC_QNL + ((16 * it_ + c) * SC_LD + 32 + 8 * q) * 2); } \
            const f32x4 gj_ = *(const f32x4*)(gp_ + 16 * jt_ + 4 * q); \
            float gi_[4]; _Pragma("unroll") for (int it_ = 0; it_ < 4; ++it_) gi_[it_] = gp_[16 * it_ + c]; \
            _Pragma("unroll") for (int it_ = 0; it_ < 4; ++it_) { \
              f32x4 ac_ = {0.f, 0.f, 0.f, 0.f}; \
              ac_ = MFMA16(ka0_, qb_[it_][0], ac_); ac_ = MFMA16(ka1_, qb_[it_][1], ac_); \
              const int i_ = 16 * it_ + c; \
              _Pragma("unroll") for (int r_ = 0; r_ < 4; ++r_) { const int j_ = 16 * jt_ + 4 * q + r_; const float e_ = __expf(fminf(gi_[it_] - gj_[r_], 0.f)); ac_[r_] = (i_ >= j_) ? ac_[r_] * e_ : 0.f; } \
              u32x2 ov_; ov_[0] = cvtpk(ac_[0], ac_[1]); ov_[1] = cvtpk(ac_[2], ac_[3]); \
              *(u32x2*)(st_ + 4 * SC_T + ((16 * it_ + c) * SC_LD + 16 * jt_ + 4 * q) * 2) = ov_; } } } } while (0)
      SP_LOAD(0, A); SP_LOAD(1, B);
      SP_A(0, A);
      __syncthreads();
      SP_B(0);
      SP_LOAD(2, A);
      __syncthreads();
#define SP_STEP(n, S) do { SP_A((n) + 1, S); SP_LOAD((n) + 3, S);        \
        __syncthreads();                 \
        SP_B((n) + 1); \
        __syncthreads();                 } while (0)
#pragma unroll 1
      for (int n = 0; n < NCH; n += 2) { SP_STEP(n, B); SP_STEP(n + 1, A); }
#undef SP_STEP
#undef SP_LOAD
#undef SP_A
#undef SP_B
    } else {
      f32x4 S[4];
#pragma unroll
      for (int i = 0; i < 4; ++i) S[i] = f32x4{0.f, 0.f, 0.f, 0.f};
      __syncthreads();
      __syncthreads();
#pragma unroll 1
      for (int n = 0; n < NCH; ++n) {
        const int cid = SP_CID(n); const bool lat = cid >= 4;
        const char* st = lds + (n & 1) * SC_STAGE; const float* gp = (const float*)(st + 5 * SC_T);
        bf16x8 Sb[2], Sn[2];
#pragma unroll
        for (int ks = 0; ks < 2; ++ks) {
          Sb[ks] = pack8(S[2 * ks], S[2 * ks + 1]);
          u32x4 t = __builtin_bit_cast(u32x4, Sb[ks]);
#pragma unroll
          for (int w = 0; w < 4; ++w) t[w] ^= 0x80008000u;
          Sn[ks] = __builtin_bit_cast(bf16x8, t);
        }
        u32x2 ur[4]; bf16x8 wf[4][2], kf2[4][2]; f32x4 sc4[4];
#pragma unroll
        for (int mt = 0; mt < 4; ++mt) {
          ur[mt] = *(const u32x2*)(st + SC_T + ((16 * wave + c) * SC_LD + 16 * mt + 4 * q) * 2);
          wf[mt][0] = afrag(st, 16 * mt + c, 4 * q); wf[mt][1] = afrag(st, 16 * mt + c, 32 + 4 * q);
          sc4[mt] = *(const f32x4*)(gp + 128 + 16 * mt + 4 * q);
        }
#pragma unroll
        for (int dt = 0; dt < 4; ++dt) { kf2[dt][0] = afrag(st + 2 * SC_T, 16 * dt + c, 4 * q); kf2[dt][1] = afrag(st + 2 * SC_T, 16 * dt + c, 32 + 4 * q); }
        const float gt = gp[192];
        f32x4 vn[4], vs[4];
#pragma unroll
        for (int mt = 0; mt < 4; ++mt) {
          f32x4 acc = {bflo(ur[mt][0]), bfhi(ur[mt][0]), bflo(ur[mt][1]), bfhi(ur[mt][1])};
          acc = MFMA16(wf[mt][0], Sn[0], acc);
          acc = MFMA16(wf[mt][1], Sn[1], acc);
          vn[mt] = acc;
          vs[mt] = acc * sc4[mt];
        }
        bf16x8 Vn[2], Vs[2];
#pragma unroll
        for (int ks = 0; ks < 2; ++ks) { Vn[ks] = pack8(vn[2 * ks], vn[2 * ks + 1]); Vs[ks] = pack8(vs[2 * ks], vs[2 * ks + 1]); }
        f32x4 Snew[4];
#pragma unroll
        for (int dt = 0; dt < 4; ++dt) {
          f32x4 acc = S[dt] * gt;
          acc = MFMA16(kf2[dt][0], Vs[0], acc);
          acc = MFMA16(kf2[dt][1], Vs[1], acc);
          Snew[dt] = acc;
        }
        __syncthreads();
        if (lat) {
          const int sb = b * SEQ, c0 = (cid - 4) * 64;
          bf16x8 qf[4][2], pf[4][2];
#pragma unroll
          for (int mt = 0; mt < 4; ++mt) {
            qf[mt][0] = afrag(st + 3 * SC_T, 16 * mt + c, 4 * q); qf[mt][1] = afrag(st + 3 * SC_T, 16 * mt + c, 32 + 4 * q);
            pf[mt][0] = afrag(st + 4 * SC_T, 16 * mt + c, 4 * q); pf[mt][1] = afrag(st + 4 * SC_T, 16 * mt + c, 32 + 4 * q);
          }
#pragma unroll
          for (int mt = 0; mt < 4; ++mt) {
            f32x4 o = {0.f, 0.f, 0.f, 0.f};
            o = MFMA16(Sb[0], qf[mt][0], o);
            o = MFMA16(Sb[1], qf[mt][1], o);
            o = MFMA16(Vn[0], pf[mt][0], o);
            o = MFMA16(Vn[1], pf[mt][1], o);
            const int i = 16 * mt + c, t = d ? 63 - i : i;
            u32x2 ov; ov[0] = cvtpk(o[0], o[1]); ov[1] = cvtpk(o[2], o[3]);
            if (!NOSTORE || ov[0] == 0x12345678u) *(u32x2*)(Ob + ((size_t)d * TL + sb + c0 + t) * 512 + head * 64 + 16 * wave + 4 * q) = ov;
          }
        }
#pragma unroll
        for (int dt = 0; dt < 4; ++dt) S[dt] = Snew[dt];
        __syncthreads();
      }
    }
#undef SP_CID
  }
}

constexpr int VT_PITCH = 1024 + 16;
DI void ph_vt8(const P& p, char* lds) {
  const int tid = otid();
  const bf16_t* vrow = (const bf16_t*)(p.ws + WS_VROW); unsigned char* vt8 = (unsigned char*)(p.ws + WS_VT);
  const int nb = (int)gridDim.x - 64;
  for (int tile = (int)blockIdx.x - 64; tile < NB * (KVL / 64); tile += nb) {
    const int b = tile / (KVL / 64), kb = tile - b * (KVL / 64);
    __syncthreads();
#pragma unroll
    for (int i = 0; i < 8; ++i) { const int e = tid + 512 * i, key = e >> 6, ch = e & 63; *(u32x4*)(lds + key * VT_PITCH + ch * 16) = *(const u32x4*)(vrow + ((size_t)b * KVL + kb * 64 + key) * 512 + ch * 8); }
    __syncthreads();
    unsigned char* dst = vt8 + ((size_t)b * 512 + tid) * KVL + kb * 64;
#pragma unroll
    for (int q4 = 0; q4 < 4; ++q4) {
      u32x4 o;
#pragma unroll
      for (int w = 0; w < 4; ++w) {
        const int D = 4 * q4 + w, h = D >> 3, k2 = (D >> 2) & 1, g = D & 3, kbase = 32 * k2 + 8 * g + 4 * h;
        float v[4];
#pragma unroll
        for (int j = 0; j < 4; ++j) v[j] = fminf(fmaxf(bf2f(*(const unsigned short*)(lds + (kbase + j) * VT_PITCH + tid * 2)) * 16.f, -448.f), 448.f);
        int wd = __builtin_amdgcn_cvt_pk_fp8_f32(v[0], v[1], 0, false);
        wd = __builtin_amdgcn_cvt_pk_fp8_f32(v[2], v[3], wd, true);
        o[w] = (unsigned)wd;
      }
      *(u32x4*)(dst + 16 * q4) = o;
    }
  }
}

DI void cvt_fp8(const bf16_t* __restrict__ src, unsigned char* __restrict__ dst, int n16, float scale) {
  const int nb = (int)gridDim.x - 64;
  for (int i = ((int)blockIdx.x - 64) * NT + otid(); i < n16; i += nb * NT) {
    const u32x4 a = *(const u32x4*)(src + (size_t)i * 16), b = *(const u32x4*)(src + (size_t)i * 16 + 8);
    u32x4 o;
#pragma unroll
    for (int w = 0; w < 2; ++w) {
      int wd = __builtin_amdgcn_cvt_pk_fp8_f32(fminf(fmaxf(bflo(a[2 * w]) * scale, -448.f), 448.f), fminf(fmaxf(bfhi(a[2 * w]) * scale, -448.f), 448.f), 0, false);
      o[w] = (unsigned)__builtin_amdgcn_cvt_pk_fp8_f32(fminf(fmaxf(bflo(a[2 * w + 1]) * scale, -448.f), 448.f), fminf(fmaxf(bfhi(a[2 * w + 1]) * scale, -448.f), 448.f), wd, true);
      wd = __builtin_amdgcn_cvt_pk_fp8_f32(fminf(fmaxf(bflo(b[2 * w]) * scale, -448.f), 448.f), fminf(fmaxf(bfhi(b[2 * w]) * scale, -448.f), 448.f), 0, false);
      o[2 + w] = (unsigned)__builtin_amdgcn_cvt_pk_fp8_f32(fminf(fmaxf(bflo(b[2 * w + 1]) * scale, -448.f), 448.f), fminf(fmaxf(bfhi(b[2 * w + 1]) * scale, -448.f), 448.f), wd, true);
    }
    *(u32x4*)(dst + (size_t)i * 16) = o;
  }
}

constexpr int AT_KROW = 72, AT_VROW = 68;
constexpr int AT_V8ROW = 80;
constexpr int AT_KB = 2 * 64 * AT_V8ROW, AT_VB = 128 * AT_V8ROW, AT_STAGE = AT_KB + AT_VB;
DI void ph_attn(const P& p, char* lds) {
  const int tid = otid(), lane = tid & 63, wave = tid >> 6, wq = wave & 3, m = wave >> 2, h = lane >> 5, cl = lane & 31;
  const unsigned char* Qb = (const unsigned char*)(p.ws + WS_Q8); const unsigned char* Kb = (const unsigned char*)(p.ws + WS_K8); const unsigned char* VT = (const unsigned char*)(p.ws + WS_VT);
  bf16_t* mix = (bf16_t*)(p.ws + WS_MIX);
  for (int it = blockIdx.x; it < NB * 4 * 64; it += gridDim.x) {
    const int qb = it & 63, head = (it >> 6) & 3, b = it >> 8;
    const int qrow = b * SEQ + qb * 128 + wq * 32 + cl;
    v8i_t qf;
    { const u32x4 lo = *(const u32x4*)(Qb + (size_t)qrow * 512 + (head * 2 + m) * 64 + 32 * h), hi = *(const u32x4*)(Qb + (size_t)qrow * 512 + (head * 2 + m) * 64 + 32 * h + 16);
      qf[0] = lo[0]; qf[1] = lo[1]; qf[2] = lo[2]; qf[3] = lo[3]; qf[4] = hi[0]; qf[5] = hi[1]; qf[6] = hi[2]; qf[7] = hi[3]; }
    f32x16 o[4];
#pragma unroll
    for (int i = 0; i < 4; ++i)
#pragma unroll
      for (int r = 0; r < 16; ++r) o[i][r] = 0.f;
    float mrun = -1e30f, lrun = 0.f;
    const unsigned char* kp0 = Kb + ((size_t)b * KVL + (tid >> 3)) * 512 + head * 128 + (tid & 7) * 16;
    const unsigned char* vp0 = VT + ((size_t)((b * 4 + head) * 128 + (tid >> 2))) * KVL + (tid & 3) * 16;
    const int kw0 = (((tid & 7) >> 2) * 64 + (tid >> 3)) * AT_V8ROW + (tid & 3) * 16;
    const int vw0 = AT_KB + (tid >> 2) * AT_V8ROW + (tid & 3) * 16;
    u32x4 rk0, rv0;
#define A_GLOAD(kv0) do { rk0 = *(const u32x4*)(kp0 + (size_t)(kv0) * 512); rv0 = *(const u32x4*)(vp0 + (kv0)); } while (0)
#define A_LWRITE(st) do { char* b_ = lds + (st) * AT_STAGE; *(u32x4*)(b_ + kw0) = rk0; *(u32x4*)(b_ + vw0) = rv0; } while (0)
    A_GLOAD(0);
    __syncthreads();
    A_LWRITE(0);
    __syncthreads();
    constexpr int NKT = KVL / 64;
    for (int kt = 0; kt < NKT; ++kt) {
      if (kt + 1 < NKT) A_GLOAD((kt + 1) * 64);
      const char* sb = lds + (kt & 1) * AT_STAGE;
      const char* ks = sb + m * 64 * AT_V8ROW;
      f32x16 st[2];
#pragma unroll
      for (int k2 = 0; k2 < 2; ++k2) {
        f32x16 z;
#pragma unroll
        for (int r = 0; r < 16; ++r) z[r] = 0.f;
        const char* kr = ks + (k2 * 32 + cl) * AT_V8ROW + 32 * h;
        const u32x4 lo = *(const u32x4*)(kr), hi = *(const u32x4*)(kr + 16);
        v8i_t ak; ak[0] = lo[0]; ak[1] = lo[1]; ak[2] = lo[2]; ak[3] = lo[3]; ak[4] = hi[0]; ak[5] = hi[1]; ak[6] = hi[2]; ak[7] = hi[3];
        st[k2] = __builtin_amdgcn_mfma_scale_f32_32x32x64_f8f6f4(ak, qf, z, 0, 0, 0, 123  , 0, 121  );
      }
      float mx = fmaxf(st[0][0], st[1][0]);
#pragma unroll
      for (int r = 1; r < 16; ++r) mx = fmaxf(mx, fmaxf(st[0][r], st[1][r]));
      mx = fmaxf(mx, __shfl_xor(mx, 32, 64));
      if (__any(mx > mrun + 8.f)) {
        const float mnew = fmaxf(mrun, mx);
        const float alpha = __builtin_amdgcn_exp2f(mrun - mnew);
        mrun = mnew; lrun *= alpha;
#pragma unroll
        for (int i = 0; i < 4; ++i)
#pragma unroll
          for (int r = 0; r < 16; ++r) o[i][r] *= alpha;
      }
      float rs = 0.f;
#pragma unroll
      for (int k2 = 0; k2 < 2; ++k2)
#pragma unroll
        for (int r = 0; r < 16; ++r) { const float pv = __builtin_amdgcn_exp2f(st[k2][r] - mrun); st[k2][r] = pv; rs += pv; }
      lrun += rs;
      const char* vsb = sb + AT_KB;
      v8i_t pb;
#pragma unroll
      for (int k2 = 0; k2 < 2; ++k2)
#pragma unroll
        for (int g = 0; g < 4; ++g) {
          int wd = __builtin_amdgcn_cvt_pk_fp8_f32(st[k2][4 * g], st[k2][4 * g + 1], 0, false);
          pb[4 * k2 + g] = __builtin_amdgcn_cvt_pk_fp8_f32(st[k2][4 * g + 2], st[k2][4 * g + 3], wd, true);
        }
#pragma unroll
      for (int dt = 0; dt < 4; ++dt) {
        const char* vr = vsb + (dt * 32 + cl) * AT_V8ROW + 32 * h;
        const u32x4 lo = *(const u32x4*)(vr), hi = *(const u32x4*)(vr + 16);
        v8i_t av; av[0] = lo[0]; av[1] = lo[1]; av[2] = lo[2]; av[3] = lo[3]; av[4] = hi[0]; av[5] = hi[1]; av[6] = hi[2]; av[7] = hi[3];
        o[dt] = __builtin_amdgcn_mfma_scale_f32_32x32x64_f8f6f4(av, pb, o[dt], 0, 0, 0, 127, 0, 127);
      }
      if (kt + 1 < NKT) A_LWRITE((kt + 1) & 1);
      __syncthreads();
    }
#undef A_GLOAD
#undef A_LWRITE
    const float ltot = lrun + __shfl_xor(lrun, 32, 64);
    const float inv = 0.0625f / ltot;
    float* X = (float*)lds;
    if (m == 1) {
#pragma unroll
      for (int dt = 0; dt < 4; ++dt)
#pragma unroll
        for (int r = 0; r < 16; ++r) X[(wq * 32 + cl) * 129 + dt * 32 + crow(r, h)] = o[dt][r] * inv;
    }
    __syncthreads();
    if (m == 0) {
      float l1 = 0.f, l2 = 0.f;
      for (int i = 0; i < 64; ++i) { l1 += p.lam_q1[i] * p.lam_k1[i]; l2 += p.lam_q2[i] * p.lam_k2[i]; }
      const float lam = __expf(l1) - __expf(l2) + 0.2f;
      float ss = 0.f;
#pragma unroll
      for (int dt = 0; dt < 4; ++dt)
#pragma unroll
        for (int r = 0; r < 16; ++r) { const float dv = o[dt][r] * inv - lam * X[(wq * 32 + cl) * 129 + dt * 32 + crow(r, h)]; o[dt][r] = dv; ss += dv * dv; }
      ss += __shfl_xor(ss, 32, 64);
      const float rn = rsqrtf(ss * (1.f / 128.f) + EPS) * 0.8f;
#pragma unroll
      for (int dt = 0; dt < 4; ++dt)
#pragma unroll
        for (int g = 0; g < 4; ++g) {
          const int dv = dt * 32 + 8 * g + 4 * h;
          const f32x4 w4 = *(const f32x4*)(p.subln_w + dv);
          u32x2 v; v[0] = pk2(o[dt][4 * g] * rn * w4[0], o[dt][4 * g + 1] * rn * w4[1]); v[1] = pk2(o[dt][4 * g + 2] * rn * w4[2], o[dt][4 * g + 3] * rn * w4[3]);
          *(u32x2*)(mix + (size_t)qrow * DM + 512 + head * 128 + dv) = v;
        }
    }
    __syncthreads();
  }
}

DI void ph_mixout(const P& p) {
  const int lane = otid() & 63, gw = blockIdx.x * (NT / 64) + (otid() >> 6), nw_ = gridDim.x * (NT / 64);
  const bf16_t* Ob = (const bf16_t*)(p.ws + WS_OBUF); const bf16_t* gate = (const bf16_t*)(p.ws + WS_GATE);
  bf16_t* mix = (bf16_t*)(p.ws + WS_MIX);
  for (int row = gw; row < TL; row += nw_) {
    const u32x4 a = *(const u32x4*)(Ob + (size_t)row * 512 + lane * 8), bq = *(const u32x4*)(Ob + ((size_t)TL + row) * 512 + lane * 8);
    const u32x4 gv = *(const u32x4*)(gate + (size_t)row * 512 + lane * 8);
    float v[8]; float ss = 0.f;
#pragma unroll
    for (int i = 0; i < 4; ++i) { v[2 * i] = bflo(a[i]) + bflo(bq[i]); v[2 * i + 1] = bfhi(a[i]) + bfhi(bq[i]); ss += v[2 * i] * v[2 * i] + v[2 * i + 1] * v[2 * i + 1]; }
    ss += __shfl_xor(ss, 1, 64); ss += __shfl_xor(ss, 2, 64); ss += __shfl_xor(ss, 4, 64);
    const float rn = rsqrtf(ss * (1.f / 64.f) + EPS);
    const int c0 = (lane & 7) * 8;
    u32x4 ov;
#pragma unroll
    for (int i = 0; i < 4; ++i) ov[i] = pk2(v[2 * i] * rn * p.gdn_norm_w[c0 + 2 * i] * bflo(gv[i]), v[2 * i + 1] * rn * p.gdn_norm_w[c0 + 2 * i + 1] * bfhi(gv[i]));
    *(u32x4*)(mix + (size_t)row * DM + lane * 8) = ov;
  }
}

struct EpiResid {
  const float* xin; float* xout; const float* gmod  ; int row0, col0;
  DI void operator()(f32x16 (&acc)[2][2], int wm, int wn, int lane) const {
    const int h = lane >> 5, cl = lane & 31;
#pragma unroll
    for (int mt = 0; mt < 2; ++mt) {
      const int row = row0 + wm * 64 + mt * 32 + cl;
      const float* gm = gmod + (size_t)(row >> 13) * 6144;
#pragma unroll
      for (int nt = 0; nt < 2; ++nt)
#pragma unroll
        for (int g = 0; g < 4; ++g) {
          const int col = col0 + wn * 64 + nt * 32 + 8 * g + 4 * h;
          const f32x4 xv = *(const f32x4*)(xin + (size_t)row * DM + col), g4 = *(const f32x4*)(gm + col);
          f32x4 ov;
#pragma unroll
          for (int r = 0; r < 4; ++r) ov[r] = xv[r] + g4[r] * acc[mt][nt][4 * g + r];
          *(f32x4*)(xout + (size_t)row * DM + col) = ov;
        }
    }
  }
};
DI void ph_gemm_resid(const P& p, char* lds, const bf16_t* A, const bf16_t* Bt, const float* xin, const float* gmod) {
  const int nM = TL / GBM, nN = DM / GBN;
  for (int t = blockIdx.x; t < nM * nN; t += gridDim.x) {
    const int pm = t / nN, pn = t % nN;
    RowLin rf{A + (size_t)pm * GBM * DM, (size_t)DM};
    EpiResid ep{xin, p.out, gmod, pm * GBM, pn * GBN};
    gemm_tile<true>(lds, rf, Bt + (size_t)pn * GBN * DM, DM, ep);
  }
}

struct EpiBf16 {
  bf16_t* o; int pitch, row0, col0;
  DI void operator()(f32x16 (&acc)[2][2], int wm, int wn, int lane) const {
    const int h = lane >> 5, cl = lane & 31;
#pragma unroll
    for (int mt = 0; mt < 2; ++mt) {
      const int row = row0 + wm * 64 + mt * 32 + cl;
#pragma unroll
      for (int nt = 0; nt < 2; ++nt)
#pragma unroll
        for (int g = 0; g < 4; ++g) {
          u32x2 v; v[0] = pk2(acc[mt][nt][4 * g], acc[mt][nt][4 * g + 1]); v[1] = pk2(acc[mt][nt][4 * g + 2], acc[mt][nt][4 * g + 3]);
          *(u32x2*)(o + (size_t)row * pitch + col0 + wn * 64 + nt * 32 + 8 * g + 4 * h) = v;
        }
    }
  }
};
DI void ph_gemm_scores(const P& p, char* lds, int layer, size_t sc_off) {
  const bf16_t* A = (const bf16_t*)(p.ws + R0); const bf16_t* Bt = (const bf16_t*)(p.ws + WS_WEFF) + (size_t)layer * 2048 * 1024;
  const int nM = TL / GBM, nN = 2048 / GBN;
  for (int t = blockIdx.x; t < nM * nN; t += gridDim.x) {
    const int pm = t / nN, pn = t % nN;
    RowLin rf{A + (size_t)pm * GBM * DM, (size_t)DM};
    EpiBf16 ep{(bf16_t*)(p.ws + sc_off), 2048, pm * GBM, pn * GBN};
    gemm_tile<true>(lds, rf, Bt + (size_t)pn * GBN * DM, DM, ep);
  }
}

constexpr size_t WS_TSC = WS_BA;
DI void ph_tables(const P& p) {
  const int lane = otid() & 63, gw = blockIdx.x * (NT / 64) + (otid() >> 6), nw_ = gridDim.x * (NT / 64);
  float* tsc = (float*)(p.ws + WS_TSC);
  for (int rr = gw; rr < 4 * 16384; rr += nw_) {
    const int tb = rr >> 14, e = rr & 16383;
    const float* src = ((tb & 1) ? p.peer_v : p.peer_u) + ((size_t)(tb >> 1) * 16384 + e) * 1024 + lane * 16;
    f32x4 v[4]; float ss = 0.f;
#pragma unroll
    for (int i = 0; i < 4; ++i) { v[i] = *(const f32x4*)(src + 4 * i); ss += v[i][0] * v[i][0] + v[i][1] * v[i][1] + v[i][2] * v[i][2] + v[i][3] * v[i][3]; }
    ss = wave_sum(ss);
    const bool isu = (tb & 1) == 0;
    const float sc = (isu ? 0.35f : 0.5f) * sqrtf(ss * (1.f / 1024.f)) + 1e-30f, inv = 1.f / sc;
    unsigned w0 = 0u, w1 = 0u;
    if (isu) {
#pragma unroll
      for (int i = 0; i < 2; ++i)
#pragma unroll
        for (int j = 0; j < 4; ++j) {
          const int qa = (int)fminf(fmaxf(rintf(v[i][j] * inv), -7.f), 7.f), qb = (int)fminf(fmaxf(rintf(v[2 + i][j] * inv), -7.f), 7.f);
          w0 |= ((unsigned)qa & 15u) << (4 * (4 * i + j)); w1 |= ((unsigned)qb & 15u) << (4 * (4 * i + j));
        }
    } else {
      w0 = __builtin_amdgcn_cvt_scalef32_pk_fp4_f32(w0, v[0][0] * inv, v[0][1] * inv, 1.0f, 0);
      w0 = __builtin_amdgcn_cvt_scalef32_pk_fp4_f32(w0, v[0][2] * inv, v[0][3] * inv, 1.0f, 1);
      w0 = __builtin_amdgcn_cvt_scalef32_pk_fp4_f32(w0, v[1][0] * inv, v[1][1] * inv, 1.0f, 2);
      w0 = __builtin_amdgcn_cvt_scalef32_pk_fp4_f32(w0, v[1][2] * inv, v[1][3] * inv, 1.0f, 3);
      w1 = __builtin_amdgcn_cvt_scalef32_pk_fp4_f32(w1, v[2][0] * inv, v[2][1] * inv, 1.0f, 0);
      w1 = __builtin_amdgcn_cvt_scalef32_pk_fp4_f32(w1, v[2][2] * inv, v[2][3] * inv, 1.0f, 1);
      w1 = __builtin_amdgcn_cvt_scalef32_pk_fp4_f32(w1, v[3][0] * inv, v[3][1] * inv, 1.0f, 2);
      w1 = __builtin_amdgcn_cvt_scalef32_pk_fp4_f32(w1, v[3][2] * inv, v[3][3] * inv, 1.0f, 3);
    }
    u32x2 o; o[0] = w0; o[1] = w1;
    unsigned char* dst = (unsigned char*)(p.ws + WS_TAB + (size_t)tb * 8 * MiB);
    *(u32x2*)(dst + ((((size_t)(lane >> 4)) * 16384 + e) << 7) + (lane & 15) * 8) = o;
    if (lane == 0) tsc[tb * 16384 + e] = sc;
  }
}

DI unsigned srt16(unsigned bf) { return (bf & 0x8000u) ? (~bf & 0xFFFFu) : (bf | 0x8000u); }
DI float unsrt16(unsigned s) { const unsigned bf = (s & 0x8000u) ? (s & 0x7FFFu) : (~s & 0xFFFFu); return __uint_as_float(bf << 16); }
DI unsigned ckey(float v, unsigned cid) { unsigned u = __float_as_uint(v); u = (u & 0x80000000u) ? ~u : (u | 0x80000000u); return (u & 0xFFFFFF00u) | (255u - cid); }
DI float unckey(unsigned k) { unsigned u = k & 0xFFFFFF00u; u = (u & 0x80000000u) ? (u & 0x7FFFFFFFu) : ~u; return __uint_as_float(u & 0xFFFFFF00u); }
DI void bsort16(unsigned (&k)[16]) {
#pragma unroll
  for (int sz = 2; sz <= 16; sz <<= 1)
#pragma unroll
    for (int j = sz >> 1; j > 0; j >>= 1)
#pragma unroll
      for (int i = 0; i < 16; ++i) {
        const int l = i ^ j;
        if (l > i) {
          const unsigned a = k[i], b = k[l], mx = a > b ? a : b, mn = a > b ? b : a;
          if ((i & sz) == 0) { k[i] = mx; k[l] = mn; } else { k[i] = mn; k[l] = mx; }
        }
      }
}
DI void bmerge16(unsigned (&k)[16]) {
#pragma unroll
  for (int j = 8; j > 0; j >>= 1)
#pragma unroll
    for (int i = 0; i < 16; ++i) {
      const int l = i ^ j;
      if (l > i) { const unsigned a = k[i], b = k[l]; k[i] = a > b ? a : b; k[l] = a > b ? b : a; }
    }
}
DI void topmerge16(unsigned (&run)[16], const unsigned (&g)[16]) {
#pragma unroll
  for (int i = 0; i < 16; ++i) run[i] = run[i] > g[15 - i] ? run[i] : g[15 - i];
  bmerge16(run);
}
DI void top16_of_128(const bf16_t* __restrict__ r, unsigned (&run)[16]) {
#pragma unroll 1
  for (int g = 0; g < 8; ++g) {
    const u32x4 v0 = *(const u32x4*)(r + g * 16), v1 = *(const u32x4*)(r + g * 16 + 8);
    unsigned k[16];
#pragma unroll
    for (int q = 0; q < 4; ++q) {
      k[2 * q] = (srt16(v0[q] & 0xFFFFu) << 16) | (127u - (g * 16 + 2 * q));
      k[2 * q + 1] = (srt16(v0[q] >> 16) << 16) | (127u - (g * 16 + 2 * q + 1));
      k[8 + 2 * q] = (srt16(v1[q] & 0xFFFFu) << 16) | (127u - (g * 16 + 8 + 2 * q));
      k[8 + 2 * q + 1] = (srt16(v1[q] >> 16) << 16) | (127u - (g * 16 + 8 + 2 * q + 1));
    }
    bsort16(k);
    if (g == 0) {
#pragma unroll
      for (int i = 0; i < 16; ++i) run[i] = k[i];
    } else topmerge16(run, k);
  }
}
DI void ph_topk(const P& p, char* lds, size_t sc_off, size_t ei_off, size_t eg_off) {
  const bf16_t* sc = (const bf16_t*)(p.ws + sc_off); int* EI = (int*)(p.ws + ei_off); float* EG = (float*)(p.ws + eg_off);
  unsigned char* sI = (unsigned char*)lds;
  const int tid = otid();
  const int tpb_ = TL / gridDim.x;
  for (int g = blockIdx.x * tpb_ * 8 + tid; g < (blockIdx.x + 1) * tpb_ * 8; g += NT) {
    const int t = g >> 3, head = g & 7;
    const bf16_t* r1 = sc + (size_t)t * 2048 + head * 256;
    unsigned k1[16], k2[16];
    top16_of_128(r1, k1);
    top16_of_128(r1 + 128, k2);
    float f1[16], f2[16];
#pragma unroll
    for (int i = 0; i < 16; ++i) { f1[i] = unsrt16(k1[i] >> 16); f2[i] = unsrt16(k2[i] >> 16); sI[i * NT + tid] = (unsigned char)(127u - (k1[i] & 127u)); sI[(16 + i) * NT + tid] = (unsigned char)(127u - (k2[i] & 127u)); }
    unsigned cg0[16], cg1[16], cg2[16], cg3[16];
#pragma unroll
    for (int i = 0; i < 16; ++i) { cg3[i] = 0u; }
    cg0[0] = ckey(f1[0] + f2[0], 0);
    cg0[1] = ckey(f1[0] + f2[1], 1);
    cg0[2] = ckey(f1[0] + f2[2], 2);
    cg0[3] = ckey(f1[0] + f2[3], 3);
    cg0[4] = ckey(f1[0] + f2[4], 4);
    cg0[5] = ckey(f1[0] + f2[5], 5);
    cg0[6] = ckey(f1[0] + f2[6], 6);
    cg0[7] = ckey(f1[0] + f2[7], 7);
    cg0[8] = ckey(f1[0] + f2[8], 8);
    cg0[9] = ckey(f1[0] + f2[9], 9);
    cg0[10] = ckey(f1[0] + f2[10], 10);
    cg0[11] = ckey(f1[0] + f2[11], 11);
    cg0[12] = ckey(f1[0] + f2[12], 12);
    cg0[13] = ckey(f1[0] + f2[13], 13);
    cg0[14] = ckey(f1[0] + f2[14], 14);
    cg0[15] = ckey(f1[0] + f2[15], 15);
    cg1[0] = ckey(f1[1] + f2[0], 16);
    cg1[1] = ckey(f1[1] + f2[1], 17);
    cg1[2] = ckey(f1[1] + f2[2], 18);
    cg1[3] = ckey(f1[1] + f2[3], 19);
    cg1[4] = ckey(f1[1] + f2[4], 20);
    cg1[5] = ckey(f1[1] + f2[5], 21);
    cg1[6] = ckey(f1[1] + f2[6], 22);
    cg1[7] = ckey(f1[1] + f2[7], 23);
    cg1[8] = ckey(f1[2] + f2[0], 32);
    cg1[9] = ckey(f1[2] + f2[1], 33);
    cg1[10] = ckey(f1[2] + f2[2], 34);
    cg1[11] = ckey(f1[2] + f2[3], 35);
    cg1[12] = ckey(f1[2] + f2[4], 36);
    cg1[13] = ckey(f1[3] + f2[0], 48);
    cg1[14] = ckey(f1[3] + f2[1], 49);
    cg1[15] = ckey(f1[3] + f2[2], 50);
    cg2[0] = ckey(f1[3] + f2[3], 51);
    cg2[1] = ckey(f1[4] + f2[0], 64);
    cg2[2] = ckey(f1[4] + f2[1], 65);
    cg2[3] = ckey(f1[4] + f2[2], 66);
    cg2[4] = ckey(f1[5] + f2[0], 80);
    cg2[5] = ckey(f1[5] + f2[1], 81);
    cg2[6] = ckey(f1[6] + f2[0], 96);
    cg2[7] = ckey(f1[6] + f2[1], 97);
    cg2[8] = ckey(f1[7] + f2[0], 112);
    cg2[9] = ckey(f1[7] + f2[1], 113);
    cg2[10] = ckey(f1[8] + f2[0], 128);
    cg2[11] = ckey(f1[9] + f2[0], 144);
    cg2[12] = ckey(f1[10] + f2[0], 160);
    cg2[13] = ckey(f1[11] + f2[0], 176);
    cg2[14] = ckey(f1[12] + f2[0], 192);
    cg2[15] = ckey(f1[13] + f2[0], 208);
    cg3[0] = ckey(f1[14] + f2[0], 224);
    cg3[1] = ckey(f1[15] + f2[0], 240);
    bsort16(cg0); bsort16(cg1); bsort16(cg2); bsort16(cg3);
    topmerge16(cg0, cg1); topmerge16(cg2, cg3); topmerge16(cg0, cg2);
    float e[16]; int id[16]; float sum = 0.f; const float s0 = unckey(cg0[0]);
#pragma unroll
    for (int k = 0; k < 16; ++k) {
      const unsigned cid = 255u - (cg0[k] & 255u);
      e[k] = __expf(unckey(cg0[k]) - s0); sum += e[k];
      id[k] = (int)sI[(cid >> 4) * NT + tid] * 128 + (int)sI[(16 + (cid & 15)) * NT + tid];
    }
    const float inv = 1.f / sum;
#pragma unroll
    for (int k = 0; k < 16; k += 4) {
      int4 iv = {id[k], id[k + 1], id[k + 2], id[k + 3]}; f32x4 gv = {e[k] * inv, e[k + 1] * inv, e[k + 2] * inv, e[k + 3] * inv};
      *(int4*)(EI + (size_t)g * 16 + k) = iv; *(f32x4*)(EG + (size_t)g * 16 + k) = gv;
    }
  }
}

DI void fp8x16_to_f32(const u32x4& w, float (&f)[16]) {
#pragma unroll
  for (int i = 0; i < 4; ++i) {
    const f32x2_t lo = __builtin_amdgcn_cvt_pk_f32_fp8((int)w[i], false), hi = __builtin_amdgcn_cvt_pk_f32_fp8((int)w[i], true);
    f[4 * i] = lo[0]; f[4 * i + 1] = lo[1]; f[4 * i + 2] = hi[0]; f[4 * i + 3] = hi[1];
  }
}
DI void block_handoff() {
  asm volatile("s_waitcnt vmcnt(0)" ::: "memory");
  __syncthreads();
  if (otid() == 0) { __builtin_amdgcn_fence(__ATOMIC_ACQUIRE, "agent"); asm volatile("s_waitcnt vmcnt(0)" ::: "memory"); }
  __syncthreads();
}
constexpr int PQ_NS = 4;
#define PQ_BEGIN() \
  const int tid = otid(), lane = tid & 63, wave = tid >> 6, g8 = lane >> 3, c16 = lane & 7; \
  const int tpb_ = TL / gridDim.x; \
  _Pragma("unroll 1") for (int x = 0; x < PQ_NS; ++x) { \
    const int tbeg = blockIdx.x * tpb_ + wave, tend = (blockIdx.x + 1) * tpb_;
#define PQ_END() }
#define FP4X8(wd, o0, o1, o2, o3) do { o0 = __builtin_amdgcn_cvt_scalef32_pk_f32_fp4((wd), 1.0f, 0); o1 = __builtin_amdgcn_cvt_scalef32_pk_f32_fp4((wd), 1.0f, 1); \
                                         o2 = __builtin_amdgcn_cvt_scalef32_pk_f32_fp4((wd), 1.0f, 2); o3 = __builtin_amdgcn_cvt_scalef32_pk_f32_fp4((wd), 1.0f, 3); } while (0)
DI void ph_peer_u(const P& p, char* lds, int layer, size_t ei_off, size_t part_off) {
  for (int rep = 0; rep <= p.lo; ++rep) {
  PQ_BEGIN()
  const unsigned char* hq = (const unsigned char*)(p.ws + WS_HQ) + x * 128 + c16 * 16;
  const float* hs = (const float*)(p.ws + WS_HS);
  const unsigned char* us = (const unsigned char*)(p.ws + WS_TAB + (size_t)(layer * 2) * 8 * MiB) + ((size_t)x * 16384 << 7) + c16 * 16;
  const int* EI = (const int*)(p.ws + ei_off) + g8 * 16;
  unsigned* part = (unsigned*)(p.ws + part_off);
  int4 nid[4]; u32x4 nhh, nhl; float nsc;
#define PU_PREF(tt) do { const int t_ = (tt) < tend ? (tt) : tend - 1; \
    _Pragma("unroll") for (int i = 0; i < 4; ++i) nid[i] = *(const int4*)(EI + (size_t)t_ * 128 + i * 4); \
    nhh = *(const u32x4*)(hq + (size_t)t_ * 1024); nhl = *(const u32x4*)(hq + (size_t)t_ * 1024 + 512); nsc = hs[t_]; } while (0)
  PU_PREF(tbeg);
#pragma unroll 1
  for (int t = tbeg; t < tend; t += NT / 64) {
    int id[16];
#pragma unroll
    for (int i = 0; i < 4; ++i) { id[4 * i] = nid[i].x; id[4 * i + 1] = nid[i].y; id[4 * i + 2] = nid[i].z; id[4 * i + 3] = nid[i].w; }
    const u32x4 hh = nhh, hl = nhl; const float sct = nsc;
    u32x4 ur[16];
#pragma unroll
    for (int i = 0; i < 16; ++i) ur[i] = *(const u32x4*)(us + ((size_t)id[i] << 7));
    float pd[16];
#pragma unroll
    for (int i = 0; i < 16; ++i) {
      int ah = 0, al = 0;
#pragma unroll
      for (int w = 0; w < 4; ++w) { ah = __builtin_amdgcn_sdot8((int)ur[i][w], (int)hh[w], ah, false); al = __builtin_amdgcn_sdot8((int)ur[i][w], (int)hl[w], al, false); }
      pd[i] = (float)(16 * ah + al);
    }
    PU_PREF(t + NT / 64);
    float q8[8], q4[4], q2[2];
    { const bool up = (lane & 4) != 0;
#pragma unroll
      for (int m = 0; m < 8; ++m) { const float keep = up ? pd[8 + m] : pd[m], send = up ? pd[m] : pd[8 + m]; q8[m] = keep + __shfl_xor(send, 4, 64); } }
    { const bool up = (lane & 2) != 0;
#pragma unroll
      for (int m = 0; m < 4; ++m) { const float keep = up ? q8[4 + m] : q8[m], send = up ? q8[m] : q8[4 + m]; q4[m] = keep + __shfl_xor(send, 2, 64); } }
    { const bool up = (lane & 1) != 0;
#pragma unroll
      for (int m = 0; m < 2; ++m) { const float keep = up ? q4[2 + m] : q4[m], send = up ? q4[m] : q4[2 + m]; q2[m] = keep + __shfl_xor(send, 1, 64); } }
    part[((size_t)t * PQ_NS + x) * 64 + lane] = pk2(q2[0] * sct, q2[1] * sct);
  }
  PQ_END()
  }
#undef PU_PREF
}
DI void ph_peer_comb(const P& p, int layer, size_t part_off, size_t ei_off, size_t eg_off, size_t w_off) {
  const unsigned* part = (const unsigned*)(p.ws + part_off); const float* EG = (const float*)(p.ws + eg_off); const int* EI = (const int*)(p.ws + ei_off); float* W = (float*)(p.ws + w_off);
  const float* su = (const float*)(p.ws + WS_TSC) + (size_t)(layer * 2) * 16384; const float* sv = su + 16384;
  const int tpbc_ = TL / gridDim.x;
  for (int g = blockIdx.x * tpbc_ * 64 + otid(); g < (blockIdx.x + 1) * tpbc_ * 64; g += NT) {
    const int t = g >> 6, j = g & 63;
    float d0 = 0.f, d1 = 0.f;
#pragma unroll
    for (int x = 0; x < PQ_NS; ++x) { const unsigned v = part[((size_t)t * PQ_NS + x) * 64 + j]; d0 += bflo(v); d1 += bfhi(v); }
    const f32x2_t gt = *(const f32x2_t*)(EG + (size_t)t * 128 + 2 * j);
    const int e0 = EI[(size_t)t * 128 + 2 * j], e1 = EI[(size_t)t * 128 + 2 * j + 1];
    f32x2_t o; o[0] = gelu_tanh(d0 * su[e0]) * gt[0] * sv[e0]; o[1] = gelu_tanh(d1 * su[e1]) * gt[1] * sv[e1];
    *(f32x2_t*)(W + (size_t)t * 128 + 2 * j) = o;
  }
}
DI void ph_peer_v(const P& p, char* lds, int layer, size_t ei_off, size_t w_off) {
  PQ_BEGIN()
  const unsigned char* vs = (const unsigned char*)(p.ws + WS_TAB + (size_t)(layer * 2 + 1) * 8 * MiB) + ((size_t)x * 16384 << 7) + c16 * 16;
  const int* EI = (const int*)(p.ws + ei_off) + g8 * 16; const float* W = (const float*)(p.ws + w_off) + g8 * 16;
  const float* modb = (const float*)(p.ws + WS_MOD) + (size_t)layer * 5 * 6144;
  const int col = x * 256 + 32 * (lane & 7) + 4 * (lane >> 3);
  int4 nid[4]; f32x4 nw[4];
#define PV_PREF(tt) do { const int t_ = (tt) < tend ? (tt) : tend - 1; \
    _Pragma("unroll") for (int i = 0; i < 4; ++i) { nid[i] = *(const int4*)(EI + (size_t)t_ * 128 + i * 4); nw[i] = *(const f32x4*)(W + (size_t)t_ * 128 + i * 4); } } while (0)
  PV_PREF(tbeg);
#pragma unroll 1
  for (int t = tbeg; t < tend; t += NT / 64) {
    int id[16]; float wv[16];
#pragma unroll
    for (int i = 0; i < 4; ++i) { id[4 * i] = nid[i].x; id[4 * i + 1] = nid[i].y; id[4 * i + 2] = nid[i].z; id[4 * i + 3] = nid[i].w; wv[4 * i] = nw[i][0]; wv[4 * i + 1] = nw[i][1]; wv[4 * i + 2] = nw[i][2]; wv[4 * i + 3] = nw[i][3]; }
    u32x4 vr[16];
#pragma unroll
    for (int i = 0; i < 16; ++i) vr[i] = *(const u32x4*)(vs + ((size_t)id[i] << 7));
    f32x2_t acc2[16];
#pragma unroll
    for (int j = 0; j < 16; ++j) acc2[j] = f32x2_t{0.f, 0.f};
#pragma unroll
    for (int i = 0; i < 16; ++i) {
      const f32x2_t w2 = {wv[i], wv[i]};
#pragma unroll
      for (int w = 0; w < 4; ++w) {
        f32x2_t f0, f1, f2, f3; FP4X8(vr[i][w], f0, f1, f2, f3);
        acc2[4 * w] = f0 * w2 + acc2[4 * w]; acc2[4 * w + 1] = f1 * w2 + acc2[4 * w + 1]; acc2[4 * w + 2] = f2 * w2 + acc2[4 * w + 2]; acc2[4 * w + 3] = f3 * w2 + acc2[4 * w + 3];
      }
    }
    PV_PREF(t + NT / 64);
    float acc[32];
#pragma unroll
    for (int j = 0; j < 16; ++j) { acc[2 * j] = acc2[j][0]; acc[2 * j + 1] = acc2[j][1]; }
    float q16[16], q8[8], q4[4];
    { const bool up = (lane & 32) != 0;
#pragma unroll
      for (int m = 0; m < 16; ++m) { const float keep = up ? acc[16 + m] : acc[m], send = up ? acc[m] : acc[16 + m]; q16[m] = keep + __shfl_xor(send, 32, 64); } }
    { const bool up = (lane & 16) != 0;
#pragma unroll
      for (int m = 0; m < 8; ++m) { const float keep = up ? q16[8 + m] : q16[m], send = up ? q16[m] : q16[8 + m]; q8[m] = keep + __shfl_xor(send, 16, 64); } }
    { const bool up = (lane & 8) != 0;
#pragma unroll
      for (int m = 0; m < 4; ++m) { const float keep = up ? q8[4 + m] : q8[m], send = up ? q8[m] : q8[4 + m]; q4[m] = keep + __shfl_xor(send, 8, 64); } }
    float* xr = p.out + (size_t)t * DM + col;
    const f32x4 xv = *(const f32x4*)xr, g2 = *(const f32x4*)(modb + (size_t)(t >> 13) * 6144 + 5 * 1024 + col);
    f32x4 ov;
#pragma unroll
    for (int m = 0; m < 4; ++m) ov[m] = xv[m] + g2[m] * q4[m];
    *(f32x4*)xr = ov;
  }
  PQ_END()
#undef PV_PREF
}
DI void ph_final_norm(const P& p, int r0, int r1) {
  const int lane = otid() & 63;
  for (int row = r0 + (otid() >> 6); row < r1; row += NT / 64) {
    float* xr = p.out + (size_t)row * DM;
    f32x4 xv[4]; float ss = 0.f;
#pragma unroll
    for (int i = 0; i < 4; ++i) { xv[i] = *(const f32x4*)(xr + lane * 4 + 256 * i); ss += xv[i][0] * xv[i][0] + xv[i][1] * xv[i][1] + xv[i][2] * xv[i][2] + xv[i][3] * xv[i][3]; }
    ss = wave_sum(ss);
    const float rs = rsqrtf(ss * (1.f / DM) + EPS);
#pragma unroll
    for (int i = 0; i < 4; ++i) { const f32x4 w4 = *(const f32x4*)(p.final_norm_w + lane * 4 + 256 * i); *(f32x4*)(xr + lane * 4 + 256 * i) = xv[i] * rs * w4; }
  }
}

struct RowFft0 { const bf16_t* base; DI const bf16_t* operator()(int r) const { return base + ((size_t)128 * (r & 63) + (r >> 6)) * DM; } };
struct EpiFft0 {
  bf16_t* zt; int bg, l20, col0;
  DI void operator()(f32x16 (&acc)[2][2], int wm, int wn, int lane) const {
    const int h = lane >> 5, cl = lane & 31;
#pragma unroll
    for (int mt = 0; mt < 2; ++mt)
#pragma unroll
      for (int nt = 0; nt < 2; ++nt) {
        const int n = col0 + wn * 64 + nt * 32 + cl, ri = n >> 8, mm = n & 255;
#pragma unroll
        for (int g = 0; g < 4; ++g) {
          const int r = wm * 64 + mt * 32 + 8 * g + 4 * h, l1 = r & 63, l2 = l20 + (r >> 6);
          u32x2 v; v[0] = pk2(acc[mt][nt][4 * g], acc[mt][nt][4 * g + 1]); v[1] = pk2(acc[mt][nt][4 * g + 2], acc[mt][nt][4 * g + 3]);
          *(u32x2*)(zt + (((size_t)(bg * 256 + mm) * 128 + l2) * 128 + ri * 64 + l1)) = v;
        }
      }
  }
};
DI void ph_fft0(const P& p, char* lds) {
  const bf16_t* h1 = (const bf16_t*)(p.ws + R0); const bf16_t* Bt = (const bf16_t*)(p.ws + WS_DFT0);
  for (int t = blockIdx.x; t < NB * 4 * 32 * 4; t += gridDim.x) {
    const int pn = t & 3, l2b = (t >> 2) & 31, g = (t >> 7) & 3, b = t >> 9;
    RowFft0 rf{h1 + ((size_t)b * SEQ + l2b * 4) * DM + g * 256};
    EpiFft0 ep{(bf16_t*)(p.ws + WS_ZT), b * 4 + g, l2b * 4, pn * GBN};
    gemm_tile<false>(lds, rf, Bt + (size_t)pn * GBN * 256, 256, ep);
  }
}
struct EpiFft1 {
  bf16_t* a2; int row0;
  DI void operator()(f32x16 (&acc)[2][2], int wm, int wn, int lane) const {
    const int h = lane >> 5, cl = lane & 31, k1 = 32 * wn + cl;
#pragma unroll
    for (int mt = 0; mt < 2; ++mt)
#pragma unroll
      for (int g = 0; g < 4; ++g) {
        const int R = row0 + wm * 64 + mt * 32 + 8 * g + 4 * h, l2 = R & 127, mm = (R >> 7) & 255, bg = R >> 15;
        float yr[4], yi[4];
#pragma unroll
        for (int q = 0; q < 4; ++q) {
          const float fr = (float)((l2 + q) * k1) * (1.f / 8192.f);
          const float cs = __builtin_amdgcn_cosf(fr), sn = __builtin_amdgcn_sinf(fr);
          const float ar = acc[mt][0][4 * g + q], ai = acc[mt][1][4 * g + q];
          yr[q] = ar * cs + ai * sn; yi[q] = ai * cs - ar * sn;
        }
        bf16_t* o = a2 + (((size_t)(bg * 64 + k1) * 256 + mm) * 256 + l2);
        u32x2 v; v[0] = pk2(yr[0], yr[1]); v[1] = pk2(yr[2], yr[3]); *(u32x2*)o = v;
        v[0] = pk2(yi[0], yi[1]); v[1] = pk2(yi[2], yi[3]); *(u32x2*)(o + 128) = v;
      }
  }
};
DI void ph_fft1(const P& p, char* lds) {
  const bf16_t* zt = (const bf16_t*)(p.ws + WS_ZT); const bf16_t* Bt = (const bf16_t*)(p.ws + WS_DFT1);
  const int nM = 16 * 256 * 128 / GBM;
  for (int t = blockIdx.x; t < nM; t += gridDim.x) {
    RowLin rf{zt + (size_t)t * GBM * 128, (size_t)128};
    EpiFft1 ep{(bf16_t*)(p.ws + WS_A2), t * GBM};
    gemm_tile<false>(lds, rf, Bt, 128, ep);
  }
}
struct EpiFft3 {
  bf16_t* fm; int row0;
  DI void operator()(f32x16 (&acc)[2][2], int wm, int wn, int lane) const {
    const int h = lane >> 5, cl = lane & 31;
#pragma unroll
    for (int mt = 0; mt < 2; ++mt)
#pragma unroll
      for (int nt = 0; nt < 2; ++nt) {
        const int k2 = wn * 64 + nt * 32 + cl;
#pragma unroll
        for (int g = 0; g < 4; ++g) {
          const int R = row0 + wm * 64 + mt * 32 + 8 * g + 4 * h, mm = R & 255, k1 = (R >> 8) & 63, bg = R >> 14;
          u32x2 v; v[0] = pk2(acc[mt][nt][4 * g], acc[mt][nt][4 * g + 1]); v[1] = pk2(acc[mt][nt][4 * g + 2], acc[mt][nt][4 * g + 3]);
          *(u32x2*)(fm + ((size_t)((bg >> 2) * SEQ + k1 + 64 * k2)) * DM + (bg & 3) * 256 + mm) = v;
        }
      }
  }
};
DI void ph_fft3(const P& p, char* lds) {
  const bf16_t* a2 = (const bf16_t*)(p.ws + WS_A2); const bf16_t* Bt = (const bf16_t*)(p.ws + WS_DFT3);
  const int nM = 16 * 64 * 256 / GBM;
  for (int t = blockIdx.x; t < nM; t += gridDim.x) {
    RowLin rf{a2 + (size_t)t * GBM * 256, (size_t)256};
    EpiFft3 ep{(bf16_t*)(p.ws + WS_FM), t * GBM};
    gemm_tile<false>(lds, rf, Bt, 256, ep);
  }
}

constexpr int NPHASE = 19;
template <int PH>
DI void run_phase(const P& p, char* lds) {
  const float* modL = (const float*)(p.ws + WS_MOD);
  const int tpb = TL / gridDim.x, t0 = blockIdx.x * tpb, t1 = t0 + tpb;
  if constexpr (PH == 0) ph_setup(p, lds);
  else if constexpr (PH == 1) { norm_rows_i8(p.x, 0, TL, p.norm1_w, modL, false, (unsigned char*)(p.ws + R0), (float*)(p.ws + WS_HS0));
                                norm_rows_i8(p.ctx - (size_t)TL * DM, TL, TA, p.norm1_w, modL, true, (unsigned char*)(p.ws + R0), (float*)(p.ws + WS_HS0));
                                quant_rows_i8((const bf16_t*)(p.ws + WS_WIN), NIN, (unsigned char*)(p.ws + WS_WIN8), (float*)(p.ws + WS_SWIN)); }
  else if constexpr (PH == 2) { PgProj ep{&p}; pg8_run_i8(lds, p.ws + R0, p.ws + WS_WIN8, TA, NIN, 1024, ep); }
  else if constexpr (PH == 3) ph_gdn_prep<0>(p, lds);
  else if constexpr (PH == 4) { if (blockIdx.x >= 64) { ph_vt8(p, lds); cvt_fp8((const bf16_t*)(p.ws + WS_Q), (unsigned char*)(p.ws + WS_Q8), TL * 512 / 16, 64.f);
                                                        cvt_fp8((const bf16_t*)(p.ws + WS_K), (unsigned char*)(p.ws + WS_K8), NB * KVL * 512 / 16, 16.f); }
                                else ph_gdn_scan<0>(p, lds); }
  else if constexpr (PH == 5) { ph_attn(p, lds); ph_mixout(p); }
  else if constexpr (PH == 6) { PgResid ep{p.x, p.out, modL + 2 * 1024}; pg8_run(lds, (const bf16_t*)(p.ws + WS_MIX), (const bf16_t*)(p.ws + WS_WOUT), TL, DM, DM, ep); }
  else if constexpr (PH == 7) { norm_rows_hq(p, p.norm2_w, modL); quant_rows_i8((const bf16_t*)(p.ws + WS_WEFF), 4096, (unsigned char*)(p.ws + WS_WEFF8), (float*)(p.ws + WS_SW)); ph_tables(p); }
  else if constexpr (PH == 8) { PgScoreI8 ep{(bf16_t*)(p.ws + WS_SC0), (const float*)(p.ws + WS_HS), (const float*)(p.ws + WS_SW)}; pg8_run_i8(lds, p.ws + R0, p.ws + WS_WEFF8, TL, 2048, 1024, ep); }
  else if constexpr (PH == 9) { ph_topk(p, lds, WS_SC0, WS_EI0, WS_EG0); block_handoff(); ph_peer_u(p, lds, 0, WS_EI0, WS_PART0); }
  else if constexpr (PH == 10) { ph_peer_comb(p, 0, WS_PART0, WS_EI0, WS_EG0, WS_W0); block_handoff(); ph_peer_v(p, lds, 0, WS_EI0, WS_W0); block_handoff();
                                 norm_rows(p.out, t0, t1, p.norm1_w + DM, modL + 5 * 6144, 0, 1, false, (bf16_t*)(p.ws + R0), true); }
  else if constexpr (PH == 11) ph_fft0(p, lds);
  else if constexpr (PH == 12) ph_fft1(p, lds);
  else if constexpr (PH == 13) ph_fft3(p, lds);
  else if constexpr (PH == 14) { PgResid ep{p.out, p.out, modL + 5 * 6144 + 2 * 1024}; pg8_run(lds, (const bf16_t*)(p.ws + WS_FM), (const bf16_t*)(p.ws + WS_WF), TL, DM, DM, ep); }
  else if constexpr (PH == 15) norm_rows_hq(p, p.norm2_w + DM, modL + 5 * 6144);
  else if constexpr (PH == 16) { PgScoreI8 ep{(bf16_t*)(p.ws + WS_SC1), (const float*)(p.ws + WS_HS), (const float*)(p.ws + WS_SW) + 2048}; pg8_run_i8(lds, p.ws + R0, p.ws + WS_WEFF8 + (size_t)2048 * 1024, TL, 2048, 1024, ep); }
  else if constexpr (PH == 17) { ph_topk(p, lds, WS_SC1, WS_EI1, WS_EG1); block_handoff(); ph_peer_u(p, lds, 1, WS_EI1, WS_PART1); }
  else if constexpr (PH == 18) { ph_peer_comb(p, 1, WS_PART1, WS_EI1, WS_EG1, WS_W1); block_handoff(); ph_peer_v(p, lds, 1, WS_EI1, WS_W1); block_handoff(); ph_final_norm(p, t0, t1); }
}
#define XB_TMO      128
#define XB_XCNT(j)  (256  + 64 * (j))
#define XB_XSUB(j)  (1280 + 64 * (j))
#define XB_XGEN(j)  (2304 + 64 * (j))
#define XB_TOP      3328
#define XB_TOPGEN   3392
#define XCD_BAR_WORDS 3456
#define XB_SPIN_CAP (1u << 22)
#define LAS __attribute__((address_space(3)))
#define XB_SPIN(cond, bar) do { unsigned _sp = 0; while (cond) { __builtin_amdgcn_s_sleep(1); \
    if ((++_sp & 255u) == 0u) { if (xb_ld(&(bar)[XB_TMO])) break; if (_sp > XB_SPIN_CAP) { atomicAdd(&(bar)[XB_TMO], 1u); break; } } } } while (0)
struct XcdBarrier { unsigned* bar; unsigned x; volatile LAS unsigned* st; };
DI XcdBarrier xcd_barrier_post(unsigned* bar, volatile LAS unsigned* st) {
  XcdBarrier b; b.bar = bar; b.x = xb_xcc_id(); b.st = st;
  if (threadIdx.x == 0) (void)xb_add(&bar[XB_XCNT(b.x)], 1u);
  return b;
}
DI void xcd_barrier_complete(unsigned* bar, unsigned x, unsigned& nloc, unsigned& nx) {
  const unsigned G = gridDim.x * gridDim.y * gridDim.z;
  unsigned sum, cnt, mine, sp = 0u;
  for (;;) {
    sum = 0u; cnt = 0u; mine = 0u;
#pragma unroll
    for (unsigned j = 0; j < 16; ++j) { const unsigned c = xb_ld(&bar[XB_XCNT(j)]); sum += c; cnt += (c > 0u) ? 1u : 0u; mine = (j == x) ? c : mine; }
    if (sum == G) break;
    __builtin_amdgcn_s_sleep(1);
    if ((++sp & 255u) == 0u) { if (xb_ld(&bar[XB_TMO])) break; if (sp > XB_SPIN_CAP) { atomicAdd(&bar[XB_TMO], 1u); break; } }
  }
  nloc = mine > 0u ? mine : 1u; nx = cnt > 0u ? cnt : 1u;
}
DI void xcd_barrier(const XcdBarrier& b) {
  asm volatile("s_waitcnt vmcnt(0)" ::: "memory");
  __syncthreads();
  if (threadIdx.x == 0) {
    unsigned* bar = b.bar;
    __builtin_amdgcn_s_waitcnt(0);
    unsigned nloc = b.st[0], nx = b.st[1];
    if (nloc == 0u) { xcd_barrier_complete(bar, b.x, nloc, nx); b.st[0] = nloc; b.st[1] = nx; }
    const unsigned old = xb_add(&bar[XB_XSUB(b.x)], 1u);
    const unsigned gen = old / nloc;
    if (old + 1u == (gen + 1u) * nloc) {
      __builtin_amdgcn_fence(__ATOMIC_RELEASE, "agent");
      asm volatile("s_waitcnt vmcnt(0)" ::: "memory");
      const unsigned og = xb_add(&bar[XB_TOP], 1u);
      const unsigned tg = og / nx;
      if (og + 1u == (tg + 1u) * nx) xb_add(&bar[XB_TOPGEN], 1u);
      else XB_SPIN(xb_ld(&bar[XB_TOPGEN]) == tg, bar);
      __builtin_amdgcn_fence(__ATOMIC_ACQUIRE, "agent");
      xb_add(&bar[XB_XGEN(b.x)], 1u);
      asm volatile("s_waitcnt vmcnt(0)" ::: "memory");
    } else {
      XB_SPIN(xb_ld(&bar[XB_XGEN(b.x)]) == gen, bar);
      __builtin_amdgcn_fence(__ATOMIC_ACQUIRE, "agent");
      asm volatile("s_waitcnt vmcnt(0)" ::: "memory");
    }
  }
  __syncthreads();
}

constexpr int EXTRA_PHASE = -1;
constexpr int PROBE_MODE = 0;
template <int PH>
DI void run_all(const P& p, char* lds, const XcdBarrier& bar) {
  run_phase<PH>(p, lds);
  if constexpr (PH == EXTRA_PHASE) {
    xcd_barrier(bar);
    if constexpr (PH == 3) ph_gdn_prep<PROBE_MODE>(p, lds);
    else if constexpr (PH == 4) ph_gdn_scan<PROBE_MODE>(p, lds);
    else run_phase<PH>(p, lds);
  }
  if constexpr (PH + 1 < NPHASE) {
    if constexpr (PH == 0) { cg::this_grid().sync(); }
    else xcd_barrier(bar);
    run_all<PH + 1>(p, lds, bar);
  }
}
__global__ void __launch_bounds__(NT) mega(P p) {
  extern __shared__ __attribute__((aligned(16))) char lds[];
  volatile LAS unsigned* st = (volatile LAS unsigned*)(lds + LDS_BYTES - 16);
  if (threadIdx.x == 0) { st[0] = 0u; st[1] = 0u; }
  __syncthreads();
  XcdBarrier bar = xcd_barrier_post((unsigned*)(p.ws + WS_CTL), st);
  run_all<0>(p, lds, bar);
}

extern "C" void kernel_launch(void* const* d_in, const int* in_sizes, int n_in, void* d_out, int out_size, void* d_ws, size_t ws_size, hipStream_t stream) {
  static int grid = 0;
  if (grid == 0) {
    if (n_in != 25 || ws_size < WS_END) { fprintf(stderr, "kernel_launch: unexpected n_in %d or ws_size %zu\n", n_in, ws_size); grid = -1; return; }
    int dev = 0, cus = 0, per_cu = 0;
    (void)hipGetDevice(&dev); (void)hipDeviceGetAttribute(&cus, hipDeviceAttributeMultiprocessorCount, dev);
    (void)hipFuncSetAttribute((const void*)mega, hipFuncAttributeMaxDynamicSharedMemorySize, LDS_BYTES);
    if (hipOccupancyMaxActiveBlocksPerMultiprocessor(&per_cu, (const void*)mega, NT, LDS_BYTES) != hipSuccess || per_cu < 1) { fprintf(stderr, "kernel_launch: occupancy query failed (%d)\n", per_cu); per_cu = 1; }
    (void)hipGetLastError();
    if (per_cu > 1) per_cu = 1;
    grid = (cus > 0 ? cus : 256) * per_cu;
  }
  if (grid < 0) return;
  (void)hipMemsetAsync((char*)d_ws + WS_CTL, 0, CTL_ZERO_BYTES, stream);
  P p{};
  const float** pf = (const float**)&p;
  for (int i = 0; i < 25; ++i) pf[i] = (const float*)d_in[i];
  p.out = (float*)d_out; p.ws = (char*)d_ws; p.lo = 0; p.hi = NPHASE;
  void* args[] = {&p};
  hipError_t e = hipLaunchCooperativeKernel((const void*)mega, dim3(grid), dim3(NT), args, LDS_BYTES, stream);
  if (e != hipSuccess) fprintf(stderr, "cooperative launch failed: %s (grid %d)\n", hipGetErrorString(e), grid);
}
```

```cpp
#include <hip/hip_runtime.h>
#include <hip/hip_cooperative_groups.h>
#include <cstdio>
#include <cstdint>
namespace cg = cooperative_groups;

#define DI __device__ __forceinline__
typedef unsigned short bf16_t;
typedef short bf16x8 __attribute__((ext_vector_type(8)));
typedef short s16x4 __attribute__((ext_vector_type(4)));
typedef float f32x16 __attribute__((ext_vector_type(16)));
typedef float f32x4 __attribute__((ext_vector_type(4)));
typedef float f32x2_t __attribute__((ext_vector_type(2)));
typedef __bf16 bf16x2_t __attribute__((ext_vector_type(2)));
typedef unsigned u32x4 __attribute__((ext_vector_type(4)));
typedef unsigned u32x2 __attribute__((ext_vector_type(2)));
typedef int v8i_t __attribute__((ext_vector_type(8)));

constexpr int NB = 4, SEQ = 8192, DM = 1024, CTXL = 256;
constexpr int TL = NB * SEQ;
constexpr int TC = NB * CTXL;
constexpr int TA = TL + TC;
constexpr int KVL = SEQ + CTXL;
constexpr int NIN = 3840;
constexpr int NCH = 132;
constexpr float EPS = 1e-6f;
constexpr int NT = 512;

constexpr size_t MiB = 1u << 20;
constexpr size_t WS_CTL = 0, WS_MOD = 64 * 1024, CTL_ZERO_BYTES = 512 * 1024;
constexpr size_t WS_ROPE = 1 * MiB, WS_WIN = 3 * MiB, WS_WOUT = 11 * MiB, WS_WF = 13 * MiB, WS_WEFF = 15 * MiB;
constexpr size_t WS_DFT0 = 23 * MiB, WS_DFT1 = 23 * MiB + 256 * 1024, WS_DFT3 = 23 * MiB + 512 * 1024;
constexpr size_t WS_BA = 24 * MiB, WS_GC = 29 * MiB;
constexpr size_t R0 = 32 * MiB, R1 = 98 * MiB, R2 = 197 * MiB, R3 = 329 * MiB, WS_END = 459 * MiB;
constexpr size_t WS_QN = R0, WS_KN = R0 + 33 * MiB;
constexpr size_t WS_QKVRAW = R1, WS_OBUF = R1;
constexpr size_t WS_UW = R2, WS_MIX = R2;
constexpr size_t WS_GATE = R3, WS_Q = R3 + 32 * MiB, WS_K = R3 + 64 * MiB, WS_VT = R3 + 97 * MiB;
constexpr size_t WS_VROW = WS_END;
constexpr size_t WS_Q8 = 162 * MiB, WS_K8 = 178 * MiB;
constexpr size_t WS_TAB = R3 + 32 * MiB;
constexpr size_t WS_SC0 = R2, WS_EI0 = R1, WS_EG0 = R1 + 16 * MiB, WS_PART0 = 150 * MiB  , WS_W0 = R1 + 32 * MiB  ;
constexpr size_t WS_ZT = R1, WS_A2 = 226 * MiB, WS_FM = R1;
constexpr size_t WS_SC1 = 162 * MiB, WS_EI1 = 290 * MiB, WS_EG1 = 306 * MiB, WS_PART1 = 100 * MiB  , WS_W1 = 322 * MiB;

struct P {
  const float *x, *c, *ctx, *c_ctx, *ada_w, *ada_b, *norm1_w, *norm2_w, *w_in, *conv_w, *a_log, *dt_bias, *gdn_norm_w,
      *lam_q1, *lam_k1, *lam_q2, *lam_k2, *subln_w, *w_out_ab, *w_out_f, *peer_wq, *peer_keys, *peer_u, *peer_v, *final_norm_w;
  float* out; char* ws; int lo, hi;
};

DI unsigned f2bf(float f) { unsigned u = __float_as_uint(f); return (u + 0x7fffu + ((u >> 16) & 1u)) >> 16; }
DI unsigned pk2(float lo, float hi) { return f2bf(lo) | (f2bf(hi) << 16); }
DI unsigned cvtpk(float lo, float hi) { f32x2_t v = {lo, hi}; bf16x2_t b = __builtin_convertvector(v, bf16x2_t); return __builtin_bit_cast(unsigned, b); }
DI float bf2f(unsigned h) { return __uint_as_float(h << 16); }
DI float bflo(unsigned u) { return __uint_as_float(u << 16); }
DI float bfhi(unsigned u) { return __uint_as_float(u & 0xffff0000u); }
DI float wave_sum(float v) {
#pragma unroll
  for (int o = 32; o >= 1; o >>= 1) v += __shfl_xor(v, o, 64);
  return v;
}
DI int otid() { int t = threadIdx.x; asm volatile("" : "+v"(t)); return t; }
DI unsigned xb_ld(unsigned* p)              { return __hip_atomic_load(p, __ATOMIC_RELAXED, __HIP_MEMORY_SCOPE_AGENT); }
DI unsigned xb_add(unsigned* p, unsigned v) { return __hip_atomic_fetch_add(p, v, __ATOMIC_RELAXED, __HIP_MEMORY_SCOPE_AGENT); }
DI unsigned xb_xcc_id() { return (unsigned)__builtin_amdgcn_s_getreg((3 << 11) | 20) & 0xFu; }
DI float silu_f(float v) { return v / (1.f + __expf(-v)); }
DI float sigmoid_f(float v) { return 1.f / (1.f + __expf(-v)); }
DI float gelu_tanh(float v) {
  const float u = 0.7978845608028654f * (v + 0.044715f * v * v * v);
  const float e = __expf(2.f * u);
  const float t = 1.f - 2.f / (e + 1.f);
  return 0.5f * v * (1.f + t);
}
#define MFMA32(a, b, c) __builtin_amdgcn_mfma_f32_32x32x16_bf16((a), (b), (c), 0, 0, 0)

constexpr int GBM = 256, GBN = 128, GBK = 64, GLD = 72;
constexpr int G_A_BYTES = GBM * GLD * 2, G_B_BYTES = GBN * GLD * 2, G_STAGE = G_A_BYTES + G_B_BYTES;
constexpr int LDS_BYTES = 147456;

template <bool SWAP, class RowF, class Epi>
DI void gemm_tile(char* lds, const RowF& rowf, const bf16_t* __restrict__ Bt, const int K, const Epi& epi) {
  const int tid = otid(), lane = tid & 63, wave = tid >> 6, wm = wave >> 1, wn = wave & 1;
  const int lr = tid >> 3, lc = tid & 7;
  const bf16_t* ap0 = rowf(lr) + lc * 8;
  const bf16_t* ap1 = rowf(lr + 64) + lc * 8;
  const bf16_t* ap2 = rowf(lr + 128) + lc * 8;
  const bf16_t* ap3 = rowf(lr + 192) + lc * 8;
  const bf16_t* bp0 = Bt + (size_t)lr * K + lc * 8;
  const bf16_t* bp1 = Bt + (size_t)(lr + 64) * K + lc * 8;
  const int woff = (lr * GLD + lc * 8) * 2;
  u32x4 raX0, raX1, raX2, raX3, rbX0, rbX1, raY0, raY1, raY2, raY3, rbY0, rbY1;
  f32x16 acc[2][2];
#pragma unroll
  for (int i = 0; i < 2; ++i)
#pragma unroll
    for (int j = 0; j < 2; ++j)
#pragma unroll
      for (int r = 0; r < 16; ++r) acc[i][j][r] = 0.f;
  const int nk = K / GBK;
#define G_GLOAD(S, kt_) do { const int k0_ = ((kt_) < nk ? (kt_) : nk - 1) * GBK; \
    ra##S##0 = *(const u32x4*)(ap0 + k0_); ra##S##1 = *(const u32x4*)(ap1 + k0_); ra##S##2 = *(const u32x4*)(ap2 + k0_); ra##S##3 = *(const u32x4*)(ap3 + k0_); \
    rb##S##0 = *(const u32x4*)(bp0 + k0_); rb##S##1 = *(const u32x4*)(bp1 + k0_); } while (0)
#define G_LWRITE(S, st) do { char* b_ = lds + (st) * G_STAGE + woff; *(u32x4*)(b_) = ra##S##0; *(u32x4*)(b_ + 64 * GLD * 2) = ra##S##1; *(u32x4*)(b_ + 128 * GLD * 2) = ra##S##2; *(u32x4*)(b_ + 192 * GLD * 2) = ra##S##3; \
    *(u32x4*)(b_ + G_A_BYTES) = rb##S##0; *(u32x4*)(b_ + G_A_BYTES + 64 * GLD * 2) = rb##S##1; } while (0)
  const int aoff = ((wm * 64 + (lane & 31)) * GLD + (lane >> 5) * 8) * 2;
  const int boff = G_A_BYTES + ((wn * 64 + (lane & 31)) * GLD + (lane >> 5) * 8) * 2;
#define G_COMPUTE(st) do { const char* sb = lds + (st) * G_STAGE; \
    _Pragma("unroll") for (int kk = 0; kk < 4; ++kk) { \
      const bf16x8 a0 = *(const bf16x8*)(sb + aoff + kk * 32); \
      const bf16x8 a1 = *(const bf16x8*)(sb + aoff + 32 * GLD * 2 + kk * 32); \
      const bf16x8 b0 = *(const bf16x8*)(sb + boff + kk * 32); \
      const bf16x8 b1 = *(const bf16x8*)(sb + boff + 32 * GLD * 2 + kk * 32); \
      if (SWAP) { \
        acc[0][0] = MFMA32(b0, a0, acc[0][0]); acc[0][1] = MFMA32(b1, a0, acc[0][1]); \
        acc[1][0] = MFMA32(b0, a1, acc[1][0]); acc[1][1] = MFMA32(b1, a1, acc[1][1]); \
      } else { \
        acc[0][0] = MFMA32(a0, b0, acc[0][0]); acc[0][1] = MFMA32(a0, b1, acc[0][1]); \
        acc[1][0] = MFMA32(a1, b0, acc[1][0]); acc[1][1] = MFMA32(a1, b1, acc[1][1]); \
      } } } while (0)
  G_GLOAD(X, 0); G_GLOAD(Y, 1);
  __syncthreads();
  G_LWRITE(X, 0);
  __syncthreads();
#pragma unroll 1
  for (int kt = 0; kt < nk; kt += 2) {
    G_GLOAD(X, kt + 2);
    G_COMPUTE(0);
    G_LWRITE(Y, 1);
    __syncthreads();
    G_GLOAD(Y, kt + 3);
    G_COMPUTE(1);
    if (kt + 2 < nk) G_LWRITE(X, 0);
    __syncthreads();
  }
  epi(acc, wm, wn, lane);
#undef G_GLOAD
#undef G_LWRITE
#undef G_COMPUTE
}
DI int crow(int reg, int h) { return (reg & 3) + 8 * (reg >> 2) + 4 * h; }

struct RowLin { const bf16_t* base; size_t pitch; DI const bf16_t* operator()(int r) const { return base + (size_t)r * pitch; } };

namespace pg8 {
#define PG8_LAS __attribute__((address_space(3)))
typedef int v4i_t __attribute__((ext_vector_type(4)));
typedef unsigned short bf16_t;
typedef short bf16x8 __attribute__((ext_vector_type(8)));
typedef float f32x4 __attribute__((ext_vector_type(4)));
typedef unsigned u32x4 __attribute__((ext_vector_type(4)));
constexpr int BM = 256, BK = 64, HALF = 128, HTB = HALF * BK * 2  , STAGE_BYTES = 8 * HTB, NXCD = 8, WGM = 8;

__host__ __device__ __forceinline__ int lds_byte(int r, int c) { const int st = (r >> 4) * 2 + (c >> 5), rr = r & 15, cc = c & 31, ob = rr * 64 + cc * 2; return st * 1024 + (ob ^ (((ob >> 9) & 1) << 5)); }
__host__ __device__ __forceinline__ void stage_rc(int b, int& R, int& C) { const int st = b / 1024, sb = b % 1024, swz = sb ^ (((sb >> 9) & 1) << 5); R = (st >> 1) * 16 + swz / 64; C = (st & 1) * 32 + (swz % 64) / 2; }
__host__ __device__ __forceinline__ int perm32(int rho) { const int n = rho >> 4, i = rho & 15; return 8 * (i >> 2) + 4 * n + (i & 3); }

struct Unit { int pm, pn; };
struct Gemm { const bf16_t* A; const bf16_t* Bt; int M, N, K; };

struct StaticOrder {
    int nM, nN, nwg, G, c;
    __host__ __device__ void init(int M, int N, int G_, int c_) { nM = M / BM; nN = N / BM; nwg = nM * nN; G = G_; c = c_; }
    __host__ __device__ bool next(int i, Unit& u) const {
        const long L = (long)i * G + c; if (L >= nwg) return false;
        int wgid = (int)L; { const int q = nwg / NXCD, r = nwg % NXCD, xcd = wgid % NXCD, off = wgid / NXCD; wgid = (xcd < r ? xcd * (q + 1) : r * (q + 1) + (xcd - r) * q) + off; }
        const int nig = WGM * nN, gid = wgid / nig, fm = gid * WGM, gsz = (nM - fm) < WGM ? (nM - fm) : WGM;
        u.pm = fm + ((wgid % nig) % gsz); u.pn = (wgid % nig) / gsz; return true;
    }
    __device__ __forceinline__ void a_ready(const Unit&) const {}
    __device__ __forceinline__ void done(const Unit&) const {}
};
template <class Epi, class Sched, bool ALIGN_EPI = false, bool SP2 = false, bool I8 = false>
__device__ __forceinline__ void gemm_phase(PG8_LAS unsigned char* lds, const Gemm g, const Sched& S, const Epi& E) {
    const int tid = otid(), wid = __builtin_amdgcn_readfirstlane(tid >> 6), lane = tid & 63, wr = wid >> 2, wc = wid & 3, fr = lane & 15, fq = lane >> 4;
    const int K = g.K, nt = K / BK;
    unsigned voffA[2], voffB[2];
#pragma unroll
    for (int i = 0; i < 2; ++i) { int R, C; stage_rc(tid * 16 + i * 8192, R, C); const int Rb = Epi::PERM ? ((R & ~31) + perm32(R & 31)) : R;
        voffA[i] = (unsigned)(R * K + C) * 2u; voffB[i] = (unsigned)(Rb * K + C) * 2u; }
    const size_t kstep = (size_t)(BK * 2);
    const size_t hstep = (size_t)HALF * K * 2;
    const size_t tstep = 2 * hstep;
    const unsigned ldsw = (unsigned)wid * 1024u;
    const int aoff = lds_byte(wr * 64 + fr, fq * 8), boff = lds_byte(wc * 32 + fr, fq * 8);
#define PG8_SA(b, h) (((b) * 2 + (h)) * HTB)
#define PG8_SB(b, h) ((4 + (b) * 2 + (h)) * HTB)
#define PG8_STAGE(bufoff, gbase, voff) do { _Pragma("unroll") for (int _i = 0; _i < 2; ++_i) \
        __builtin_amdgcn_global_load_lds((const unsigned*)((const char*)(gbase) + (voff)[_i]), (PG8_LAS unsigned*)(lds + (bufoff) + ldsw + _i * 8192), 16, 0, 0); } while (0)
#define PG8_LDA(dst, b, h) do { _Pragma("unroll") for (int m = 0; m < 4; ++m) _Pragma("unroll") for (int k = 0; k < 2; ++k) dst[m][k] = *(const PG8_LAS bf16x8*)(lds + PG8_SA(b, h) + aoff + m * 2048 + k * 1024); } while (0)
#define PG8_LDB(dst, b, h) do { _Pragma("unroll") for (int n = 0; n < 2; ++n) _Pragma("unroll") for (int k = 0; k < 2; ++k) dst[n][k] = *(const PG8_LAS bf16x8*)(lds + PG8_SB(b, h) + boff + n * 2048 + k * 1024); } while (0)
#define PG8_MMA(ai, bj, At, Bt) do { __builtin_amdgcn_s_setprio(1); _Pragma("unroll") for (int m = 0; m < 4; ++m) _Pragma("unroll") for (int n = 0; n < 2; ++n) _Pragma("unroll") for (int k = 0; k < 2; ++k) \
        { if constexpr (I8) acc[ai][bj][m][n] = __builtin_bit_cast(f32x4, __builtin_amdgcn_mfma_i32_16x16x64_i8(__builtin_bit_cast(v4i_t, Bt[n][k]), __builtin_bit_cast(v4i_t, At[m][k]), __builtin_bit_cast(v4i_t, acc[ai][bj][m][n]), 0, 0, 0)); \
          else acc[ai][bj][m][n] = __builtin_amdgcn_mfma_f32_16x16x32_bf16(Bt[n][k], At[m][k], acc[ai][bj][m][n], 0, 0, 0); } __builtin_amdgcn_s_setprio(0); } while (0)
#define PG8_WAIT_V(n) asm volatile("s_waitcnt vmcnt(" #n ")" ::: "memory")
#define PG8_WAIT_L(n) asm volatile("s_waitcnt lgkmcnt(" #n ")" ::: "memory")
#define PG8_BAR __builtin_amdgcn_s_barrier()
#define PG8_SCHED __builtin_amdgcn_sched_barrier(0)
    Unit cur, nxt; int ui = 0;
    if (!S.next(0, cur)) return;
    f32x4 acc[2][2][4][2];
#pragma unroll
    for (int a = 0; a < 2; ++a)
#pragma unroll
        for (int b = 0; b < 2; ++b)
#pragma unroll
            for (int m = 0; m < 4; ++m)
#pragma unroll
                for (int n = 0; n < 2; ++n) acc[a][b][m][n] = (f32x4){0.f, 0.f, 0.f, 0.f};
    bf16x8 At[4][2], B0[2][2], B1[2][2];
    const char* cA = (const char*)g.A + (size_t)cur.pm * tstep; const char* cB = (const char*)g.Bt + (size_t)cur.pn * tstep;
    S.a_ready(cur);
    if constexpr (SP2) {
        PG8_STAGE(PG8_SB(0, 0), cB, voffB); PG8_STAGE(PG8_SB(0, 1), cB + hstep, voffB); PG8_STAGE(PG8_SA(0, 0), cA, voffA); PG8_STAGE(PG8_SA(0, 1), cA + hstep, voffA);
        if (wr == 1) PG8_BAR;
        PG8_WAIT_V(2); PG8_BAR;
        PG8_STAGE(PG8_SB(1, 0), cB + kstep, voffB); PG8_STAGE(PG8_SA(1, 0), cA + kstep, voffA); PG8_STAGE(PG8_SB(1, 1), cB + hstep + kstep, voffB);
        PG8_WAIT_V(6); PG8_BAR;
    } else {
        PG8_STAGE(PG8_SB(0, 0), cB, voffB); PG8_STAGE(PG8_SA(0, 0), cA, voffA); PG8_STAGE(PG8_SB(0, 1), cB + hstep, voffB); PG8_STAGE(PG8_SA(0, 1), cA + hstep, voffA);
        if (wr == 1) PG8_BAR;
        PG8_WAIT_V(4); PG8_BAR;
        PG8_STAGE(PG8_SB(1, 0), cB + kstep, voffB); PG8_STAGE(PG8_SA(1, 0), cA + kstep, voffA); PG8_STAGE(PG8_SB(1, 1), cB + hstep + kstep, voffB);
        PG8_WAIT_V(6); PG8_BAR;
    }
    for (;;) {
        const bool has_next = S.next(ui + 1, nxt);
        const char* nA = has_next ? (const char*)g.A + (size_t)nxt.pm * tstep : cA; const char* nB = has_next ? (const char*)g.Bt + (size_t)nxt.pn * tstep : cB;
        for (int t = 0; t < nt; t += 2) {
            const bool last = (t == nt - 2);
            const char* a1 = cA + (size_t)(t + 1) * kstep;
            const char* a2 = last ? nA : cA + (size_t)(t + 2) * kstep; const char* b2 = last ? nB : cB + (size_t)(t + 2) * kstep;
            const char* a3 = a2 + kstep; const char* b3 = b2 + kstep;
            if (last && has_next) S.a_ready(nxt);
            if constexpr (SP2) {
            PG8_LDB(B0, 0, 0); PG8_LDB(B1, 0, 1); PG8_SCHED; PG8_LDA(At, 0, 0); PG8_STAGE(PG8_SA(1, 1), a1 + hstep, voffA);
            PG8_WAIT_V(8); PG8_WAIT_L(0); PG8_BAR; PG8_MMA(0, 0, At, B0); PG8_MMA(0, 1, At, B1); PG8_BAR; PG8_SCHED;
            PG8_LDA(At, 0, 1); PG8_STAGE(PG8_SB(0, 0), b2, voffB); PG8_STAGE(PG8_SB(0, 1), b2 + hstep, voffB); PG8_STAGE(PG8_SA(0, 0), a2, voffA);
            PG8_WAIT_V(8); PG8_WAIT_L(0); PG8_BAR; PG8_MMA(1, 0, At, B0); PG8_MMA(1, 1, At, B1); PG8_BAR; PG8_SCHED;
            PG8_LDB(B0, 1, 0); PG8_LDB(B1, 1, 1); PG8_SCHED; PG8_LDA(At, 1, 0); PG8_STAGE(PG8_SA(0, 1), a2 + hstep, voffA);
            PG8_WAIT_V(8); PG8_WAIT_L(0); PG8_BAR; PG8_MMA(0, 0, At, B0); PG8_MMA(0, 1, At, B1); PG8_BAR; PG8_SCHED;
            PG8_LDA(At, 1, 1); PG8_STAGE(PG8_SB(1, 0), b3, voffB); PG8_STAGE(PG8_SB(1, 1), b3 + hstep, voffB); PG8_STAGE(PG8_SA(1, 0), a3, voffA);
            PG8_WAIT_V(8); PG8_WAIT_L(0); PG8_BAR; PG8_MMA(1, 0, At, B0); PG8_MMA(1, 1, At, B1); PG8_BAR; PG8_SCHED;
            } else {
            PG8_LDB(B0, 0, 0); PG8_SCHED; PG8_LDA(At, 0, 0); PG8_STAGE(PG8_SA(1, 1), a1 + hstep, voffA);
            PG8_WAIT_L(8); PG8_BAR; PG8_WAIT_L(0); PG8_MMA(0, 0, At, B0); PG8_BAR; PG8_SCHED;
            PG8_LDB(B1, 0, 1); PG8_STAGE(PG8_SB(0, 0), b2, voffB);
            PG8_BAR; PG8_WAIT_L(0); PG8_MMA(0, 1, At, B1); PG8_BAR;
            PG8_LDA(At, 0, 1); PG8_STAGE(PG8_SA(0, 0), a2, voffA);
            PG8_BAR; PG8_WAIT_L(0); PG8_MMA(1, 0, At, B0); PG8_BAR; PG8_SCHED;
            PG8_STAGE(PG8_SB(0, 1), b2 + hstep, voffB);
            PG8_WAIT_V(6); PG8_BAR; PG8_MMA(1, 1, At, B1); PG8_BAR;
            PG8_LDB(B0, 1, 0); PG8_SCHED; PG8_LDA(At, 1, 0); PG8_STAGE(PG8_SA(0, 1), a2 + hstep, voffA);
            PG8_WAIT_L(8); PG8_BAR; PG8_WAIT_L(0); PG8_MMA(0, 0, At, B0); PG8_BAR; PG8_SCHED;
            PG8_LDB(B1, 1, 1); PG8_STAGE(PG8_SB(1, 0), b3, voffB);
            PG8_BAR; PG8_WAIT_L(0); PG8_MMA(0, 1, At, B1); PG8_BAR;
            PG8_LDA(At, 1, 1); PG8_STAGE(PG8_SA(1, 0), a3, voffA);
            PG8_BAR; PG8_WAIT_L(0); PG8_MMA(1, 0, At, B0); PG8_BAR; PG8_SCHED;
            PG8_STAGE(PG8_SB(1, 1), b3 + hstep, voffB);
            PG8_WAIT_V(6); PG8_BAR; PG8_MMA(1, 1, At, B1); PG8_BAR;
            }
        }
        if constexpr (ALIGN_EPI) { if (wr == 0) PG8_BAR; }
        if constexpr (I8) { if constexpr (Epi::DEQ) { E.deq(acc, cur, wr, wc, fr, fq); __builtin_amdgcn_sched_barrier(0); } }
        if constexpr (!Epi::AFTER_DRAIN) { E(acc, cur, wr, wc, fr, fq); S.done(cur); }
        if (!has_next) break;
#pragma unroll
        for (int a = 0; a < 2; ++a)
#pragma unroll
            for (int b = 0; b < 2; ++b)
#pragma unroll
                for (int m = 0; m < 4; ++m)
#pragma unroll
                    for (int n = 0; n < 2; ++n) acc[a][b][m][n] = (f32x4){0.f, 0.f, 0.f, 0.f};
        cur = nxt; cA = nA; cB = nB; ++ui;
        if constexpr (ALIGN_EPI) { if (wr == 1) PG8_BAR; }
    }
    PG8_WAIT_V(0);
    if constexpr (!ALIGN_EPI) { if (wr == 0) PG8_BAR; }
    PG8_BAR;
    if constexpr (Epi::AFTER_DRAIN) { E.fused(acc, cur, wr, wc, fr, fq, lds, wid, lane); S.done(cur); }
#undef PG8_SA
#undef PG8_SB
#undef PG8_STAGE
#undef PG8_LDA
#undef PG8_LDB
#undef PG8_MMA
#undef PG8_WAIT_V
#undef PG8_WAIT_L
#undef PG8_BAR
#undef PG8_SCHED
}
}
DI void ph_setup(const P& p, char* lds) {
  const int tid = otid(), nb = gridDim.x, bid = blockIdx.x;
  float* modL = (float*)(p.ws + WS_MOD);
  float* sc = (float*)lds;
  for (int it = bid; it < 192; it += nb) {
    const int layer = it / 96, cb = it % 96;
    const int lane = tid & 63, ks = tid >> 6;
    __syncthreads();
    for (int i = tid; i < 5 * 1024; i += NT) { const int v = i >> 10, k = i & 1023; const float cv = (v < 4) ? p.c[v * 1024 + k] : p.c_ctx[k]; sc[i] = silu_f(cv); }
    __syncthreads();
    const int n = cb * 64 + lane;
    const float* w = p.ada_w + ((size_t)layer * 1024 + ks * 128) * 6144 + n;
    float a0 = 0, a1 = 0, a2 = 0, a3 = 0, a4 = 0;
#pragma unroll 8
    for (int k = 0; k < 128; ++k) { const float wv = w[(size_t)k * 6144]; const int kk = ks * 128 + k; a0 += wv * sc[kk]; a1 += wv * sc[1024 + kk]; a2 += wv * sc[2048 + kk]; a3 += wv * sc[3072 + kk]; a4 += wv * sc[4096 + kk]; }
    float* red = sc + 5 * 1024;
    red[(ks * 5 + 0) * 64 + lane] = a0; red[(ks * 5 + 1) * 64 + lane] = a1; red[(ks * 5 + 2) * 64 + lane] = a2; red[(ks * 5 + 3) * 64 + lane] = a3; red[(ks * 5 + 4) * 64 + lane] = a4;
    __syncthreads();
    if (tid < 320) {
      const int v = tid >> 6, l = tid & 63;
      float sacc = p.ada_b[layer * 6144 + cb * 64 + l];
      for (int k8 = 0; k8 < 8; ++k8) sacc += red[(k8 * 5 + v) * 64 + l];
      modL[(layer * 5 + v) * 6144 + cb * 64 + l] = sacc;
    }
  }
  {
    float* rope = (float*)(p.ws + WS_ROPE);
    for (int i = bid * NT + tid; i < SEQ * 32; i += nb * NT) {
      const int l = i >> 5, d = i & 31;
      const float inv = exp2f(-(float)(2 * (d & 15)) * (13.287712379549449f / 32.f));
      const float pos = (d < 16) ? (float)(l >> 6) : (float)(l & 63);
      float s, c; sincosf(pos * inv, &s, &c);
      rope[2 * i] = c; rope[2 * i + 1] = s;
    }
  }
  {
    float* tl = (float*)lds;
    const int nt_in = (NIN / 64) * 16, nt_o = 16 * 16;
    for (int it = bid; it < nt_in + 2 * nt_o; it += nb) {
      const float* src; bf16_t* dst; int npitch, nb0, kb0, which;
      if (it < nt_in) { which = 0; nb0 = (it / 16) * 64; kb0 = (it % 16) * 64; src = p.w_in; dst = (bf16_t*)(p.ws + WS_WIN); npitch = 3616; }
      else if (it < nt_in + nt_o) { const int j = it - nt_in; which = 1; nb0 = (j / 16) * 64; kb0 = (j % 16) * 64; src = p.w_out_ab; dst = (bf16_t*)(p.ws + WS_WOUT); npitch = 1024; }
      else { const int j = it - nt_in - nt_o; which = 2; nb0 = (j / 16) * 64; kb0 = (j % 16) * 64; src = p.w_out_f; dst = (bf16_t*)(p.ws + WS_WF); npitch = 1024; }
      __syncthreads();
      for (int e = tid; e < 4096; e += NT) {
        const int kk = e >> 6, nn = e & 63; const int n = nb0 + nn;
        int sn = n;
        if (which == 0) {
          if (n < 2048) sn = n;
          else if (n < 3072) { const int pq = n & 63, blk = pq >> 3, e8 = pq & 7; sn = (n & ~63) + 32 + ((e8 < 4) ? 4 * blk + e8 : 32 + 4 * blk + (e8 - 4)); }
          else if (n < 3584) sn = n + 32;
          else if (n < 3616) sn = n - 1536;
          else sn = -1;
        }
        tl[kk * 65 + nn] = (sn >= 0) ? src[(size_t)(kb0 + kk) * npitch + sn] : 0.f;
      }
      __syncthreads();
      for (int e = tid; e < 4096; e += NT) { const int nn = e >> 6, kk = e & 63; dst[(size_t)(nb0 + nn) * 1024 + kb0 + kk] = (bf16_t)f2bf(tl[kk * 65 + nn]); }
    }
  }
  {
    float* kl = (float*)lds;
    float* wl = kl + 128 * 132;
    bf16_t* weff = (bf16_t*)(p.ws + WS_WEFF);
    for (int it = bid; it < 512; it += nb) {
      const int layer = it >> 8, hp = (it >> 4) & 15, kb = it & 15;
      __syncthreads();
      const float* ks = p.peer_keys + ((size_t)(layer * 16 + hp) * 128) * 128;
      for (int e = tid; e < 128 * 128; e += NT) kl[(e >> 7) * 132 + (e & 127)] = ks[e];
      const float* ws_ = p.peer_wq + ((size_t)layer * 1024 + kb * 64) * 2048 + hp * 128;
      for (int e = tid; e < 64 * 128; e += NT) wl[(e >> 7) * 132 + (e & 127)] = ws_[(size_t)(e >> 7) * 2048 + (e & 127)];
      __syncthreads();
      const int key = tid & 127, kq = tid >> 7;
      float a[16];
#pragma unroll
      for (int i = 0; i < 16; ++i) a[i] = 0.f;
      for (int d = 0; d < 128; d += 4) {
        const f32x4 kv = *(const f32x4*)(kl + key * 132 + d);
#pragma unroll
        for (int i = 0; i < 16; ++i) { const f32x4 wv = *(const f32x4*)(wl + (kq * 16 + i) * 132 + d); a[i] += kv[0] * wv[0] + kv[1] * wv[1] + kv[2] * wv[2] + kv[3] * wv[3]; }
      }
      bf16_t* o = weff + ((size_t)layer * 2048 + hp * 128 + key) * 1024 + kb * 64 + kq * 16;
      u32x4 o0, o1;
      o0[0] = pk2(a[0], a[1]); o0[1] = pk2(a[2], a[3]); o0[2] = pk2(a[4], a[5]); o0[3] = pk2(a[6], a[7]);
      o1[0] = pk2(a[8], a[9]); o1[1] = pk2(a[10], a[11]); o1[2] = pk2(a[12], a[13]); o1[3] = pk2(a[14], a[15]);
      *(u32x4*)o = o0; *(u32x4*)(o + 8) = o1;
    }
  }
  {
    bf16_t* d0 = (bf16_t*)(p.ws + WS_DFT0); bf16_t* d1 = (bf16_t*)(p.ws + WS_DFT1); bf16_t* d3 = (bf16_t*)(p.ws + WS_DFT3);
    for (int i = bid * NT + tid; i < 512 * 256; i += nb * NT) {
      const int n = i >> 8, c = i & 255, m = n & 255; const float fr = (float)((m * c) & 255) * (2.f / 256.f);
      d0[i] = (bf16_t)f2bf(n < 256 ? cospif(fr) : -sinpif(fr));
    }
    for (int i = bid * NT + tid; i < 128 * 128; i += nb * NT) {
      const int n = i >> 7, k = i & 127; const int k1 = 32 * (n >> 6) + (n & 31), ro = (n >> 5) & 1, ri = k >> 6, l1 = k & 63;
      const float fr = (float)((k1 * l1) & 63) * (2.f / 64.f); const float cs = cospif(fr), sn = sinpif(fr);
      d1[i] = (bf16_t)f2bf(ro == 0 ? (ri == 0 ? cs : sn) : (ri == 0 ? -sn : cs));
    }
    for (int i = bid * NT + tid; i < 128 * 256; i += nb * NT) {
      const int k2 = i >> 8, k = i & 255, ri = k >> 7, l2 = k & 127; const float fr = (float)((l2 * k2) & 127) * (2.f / 128.f);
      const float scl = 6.905339660024878e-4f;
      d3[i] = (bf16_t)f2bf((ri == 0 ? cospif(fr) : sinpif(fr)) * scl);
    }
  }
}

DI void norm_rows(const float* __restrict__ src, int row_begin, int nrows, const float* __restrict__ nw, const float* __restrict__ modbase  ,
                  int shift_j, int scale_j, bool ctx_tail  , bf16_t* __restrict__ dst, bool blk = false  ) {
  const int lane = otid() & 63, gw = (blk ? 0 : blockIdx.x * (NT / 64)) + (otid() >> 6), nw_ = (blk ? 1 : gridDim.x) * (NT / 64);
  for (int row = row_begin + gw; row < nrows; row += nw_) {
    const int v = (ctx_tail && row >= TL) ? 4 : (row >> 13);
    const float* xr = src + (size_t)row * DM;
    f32x4 xv[4]; float ss = 0.f;
#pragma unroll
    for (int i = 0; i < 4; ++i) { xv[i] = *(const f32x4*)(xr + lane * 4 + 256 * i); ss += xv[i][0] * xv[i][0] + xv[i][1] * xv[i][1] + xv[i][2] * xv[i][2] + xv[i][3] * xv[i][3]; }
    ss = wave_sum(ss);
    const float rs = rsqrtf(ss * (1.f / DM) + EPS);
    const float* sh = modbase + (size_t)v * 6144 + shift_j * 1024; const float* scp = modbase + (size_t)v * 6144 + scale_j * 1024;
#pragma unroll
    for (int i = 0; i < 4; ++i) {
      const int c = lane * 4 + 256 * i;
      const f32x4 w4 = *(const f32x4*)(nw + c), s4 = *(const f32x4*)(sh + c), c4 = *(const f32x4*)(scp + c);
      float y0 = xv[i][0] * rs * w4[0] * (1.f + c4[0]) + s4[0], y1 = xv[i][1] * rs * w4[1] * (1.f + c4[1]) + s4[1];
      float y2 = xv[i][2] * rs * w4[2] * (1.f + c4[2]) + s4[2], y3 = xv[i][3] * rs * w4[3] * (1.f + c4[3]) + s4[3];
      u32x2 o; o[0] = pk2(y0, y1); o[1] = pk2(y2, y3);
      *(u32x2*)(dst + (size_t)row * DM + c) = o;
    }
  }
}

constexpr size_t WS_HQ = (size_t)393 * MiB, WS_HS = (size_t)425 * MiB;
DI void norm_rows_hq(const P& p, const float* __restrict__ nw, const float* __restrict__ modbase) {
  const int lane = otid() & 63, gw = blockIdx.x * (NT / 64) + (otid() >> 6), nw_ = gridDim.x * (NT / 64);
  bf16_t* dst = (bf16_t*)(p.ws + R0); unsigned char* hq = (unsigned char*)(p.ws + WS_HQ); float* hs = (float*)(p.ws + WS_HS);
  for (int row = gw; row < TL; row += nw_) {
    const float* xr = p.out + (size_t)row * DM + lane * 16;
    f32x4 xv[4]; float ss = 0.f;
#pragma unroll
    for (int i = 0; i < 4; ++i) { xv[i] = *(const f32x4*)(xr + 4 * i); ss += xv[i][0] * xv[i][0] + xv[i][1] * xv[i][1] + xv[i][2] * xv[i][2] + xv[i][3] * xv[i][3]; }
    ss = wave_sum(ss);
    const float rs = rsqrtf(ss * (1.f / DM) + EPS);
    const float* sh = modbase + (size_t)(row >> 13) * 6144 + 3 * 1024 + lane * 16; const float* scp = sh + 1024;
    float y[16]; float am = 0.f;
#pragma unroll
    for (int i = 0; i < 4; ++i) {
      const f32x4 w4 = *(const f32x4*)(nw + lane * 16 + 4 * i), s4 = *(const f32x4*)(sh + 4 * i), c4 = *(const f32x4*)(scp + 4 * i);
#pragma unroll
      for (int j = 0; j < 4; ++j) { y[4 * i + j] = xv[i][j] * rs * w4[j] * (1.f + c4[j]) + s4[j]; am = fmaxf(am, fabsf(y[4 * i + j])); }
    }
#pragma unroll
    for (int o = 32; o >= 1; o >>= 1) am = fmaxf(am, __shfl_xor(am, o, 64));
    const float st = am * (1.f / 119.f) + 1e-30f, ist = 1.f / st;
    unsigned h0 = 0u, h1 = 0u, l0 = 0u, l1 = 0u;
    u32x4 b8 = {0u, 0u, 0u, 0u};
#pragma unroll
    for (int j = 0; j < 8; ++j) {
      const int va = (int)fminf(fmaxf(rintf(y[j] * ist), -120.f), 119.f), vb = (int)fminf(fmaxf(rintf(y[8 + j] * ist), -120.f), 119.f);
      b8[j >> 2] |= ((unsigned)va & 255u) << (8 * (j & 3)); b8[2 + (j >> 2)] |= ((unsigned)vb & 255u) << (8 * (j & 3));
      const int ha = (va + 8) >> 4, hb = (vb + 8) >> 4, la = va - 16 * ha, lb = vb - 16 * hb;
      h0 |= ((unsigned)ha & 15u) << (4 * j); h1 |= ((unsigned)hb & 15u) << (4 * j); l0 |= ((unsigned)la & 15u) << (4 * j); l1 |= ((unsigned)lb & 15u) << (4 * j);
    }
    u32x2 vh; vh[0] = h0; vh[1] = h1; *(u32x2*)(hq + (size_t)row * 1024 + lane * 8) = vh;
    u32x2 vl; vl[0] = l0; vl[1] = l1; *(u32x2*)(hq + (size_t)row * 1024 + 512 + lane * 8) = vl;
    *(u32x4*)((unsigned char*)dst + (size_t)row * DM + lane * 16) = b8;
    if (lane == 0) hs[row] = st;
  }
}

constexpr size_t WS_WEFF8 = WS_WIN, WS_SW = WS_WIN + 5 * MiB;
constexpr size_t WS_WIN8 = R2, WS_SWIN = R2 + 4 * MiB;
constexpr size_t WS_HS0 = R2 + 5 * MiB;
DI void quant_rows_i8(const bf16_t* __restrict__ w, int nrows, unsigned char* __restrict__ w8, float* __restrict__ sw) {
  const int lane = otid() & 63, gw = blockIdx.x * (NT / 64) + (otid() >> 6), nw_ = gridDim.x * (NT / 64);
  for (int row = gw; row < nrows; row += nw_) {
    const u32x4 a = *(const u32x4*)(w + (size_t)row * 1024 + lane * 16), b = *(const u32x4*)(w + (size_t)row * 1024 + lane * 16 + 8);
    float v[16]; float am = 0.f;
#pragma unroll
    for (int i = 0; i < 4; ++i) { v[2 * i] = bflo(a[i]); v[2 * i + 1] = bfhi(a[i]); v[8 + 2 * i] = bflo(b[i]); v[9 + 2 * i] = bfhi(b[i]); }
#pragma unroll
    for (int i = 0; i < 16; ++i) am = fmaxf(am, fabsf(v[i]));
#pragma unroll
    for (int o = 32; o >= 1; o >>= 1) am = fmaxf(am, __shfl_xor(am, o, 64));
    const float st = am * (1.f / 127.f) + 1e-30f, ist = 1.f / st;
    u32x4 o8 = {0u, 0u, 0u, 0u};
#pragma unroll
    for (int i = 0; i < 16; ++i) { const int qv = (int)fminf(fmaxf(rintf(v[i] * ist), -127.f), 127.f); o8[i >> 2] |= ((unsigned)qv & 255u) << (8 * (i & 3)); }
    *(u32x4*)(w8 + (size_t)row * 1024 + lane * 16) = o8;
    if (lane == 0) sw[row] = st;
  }
}
DI void norm_rows_i8(const float* __restrict__ src, int row_begin, int nrows, const float* __restrict__ nw, const float* __restrict__ modbase, bool ctx_tail,
                     unsigned char* __restrict__ dst8, float* __restrict__ hs) {
  const int lane = otid() & 63, gw = blockIdx.x * (NT / 64) + (otid() >> 6), nw_ = gridDim.x * (NT / 64);
  for (int row = row_begin + gw; row < nrows; row += nw_) {
    const int v = (ctx_tail && row >= TL) ? 4 : (row >> 13);
    const float* xr = src + (size_t)row * DM + lane * 16;
    f32x4 xv[4]; float ss = 0.f;
#pragma unroll
    for (int i = 0; i < 4; ++i) { xv[i] = *(const f32x4*)(xr + 4 * i); ss += xv[i][0] * xv[i][0] + xv[i][1] * xv[i][1] + xv[i][2] * xv[i][2] + xv[i][3] * xv[i][3]; }
    ss = wave_sum(ss);
    const float rs = rsqrtf(ss * (1.f / DM) + EPS);
    const float* sh = modbase + (size_t)v * 6144 + lane * 16; const float* scp = sh + 1024;
    float y[16]; float am = 0.f;
#pragma unroll
    for (int i = 0; i < 4; ++i) {
      const f32x4 w4 = *(const f32x4*)(nw + lane * 16 + 4 * i), s4 = *(const f32x4*)(sh + 4 * i), c4 = *(const f32x4*)(scp + 4 * i);
#pragma unroll
      for (int j = 0; j < 4; ++j) { y[4 * i + j] = xv[i][j] * rs * w4[j] * (1.f + c4[j]) + s4[j]; am = fmaxf(am, fabsf(y[4 * i + j])); }
    }
#pragma unroll
    for (int o = 32; o >= 1; o >>= 1) am = fmaxf(am, __shfl_xor(am, o, 64));
    const float st = am * (1.f / 127.f) + 1e-30f, ist = 1.f / st;
    u32x4 b8 = {0u, 0u, 0u, 0u};
#pragma unroll
    for (int j = 0; j < 16; ++j) { const int qv = (int)fminf(fmaxf(rintf(y[j] * ist), -127.f), 127.f); b8[j >> 2] |= ((unsigned)qv & 255u) << (8 * (j & 3)); }
    *(u32x4*)(dst8 + (size_t)row * DM + lane * 16) = b8;
    if (lane == 0) hs[row] = st;
  }
}

struct EpiProjV {
  const P* p; int row0, col0;
  DI void operator()(f32x16 (&acc)[2][2], int wm, int wn, int lane) const {
    const int cb = col0 + wn * 64, h = lane >> 5, cl = lane & 31;
    const bool isctx = row0 >= TL;
    bf16_t* o = (bf16_t*)(p->ws + WS_VT);
    const int hv = (cb - 3072) >> 7, dvb = (cb - 3072) & 127;
#pragma unroll
    for (int mt = 0; mt < 2; ++mt)
#pragma unroll
      for (int nt = 0; nt < 2; ++nt)
#pragma unroll
        for (int g = 0; g < 4; ++g) {
          const int row = row0 + wm * 64 + mt * 32 + 8 * g + 4 * h;
          int b, pos; if (!isctx) { b = row >> 13; pos = row & (SEQ - 1); } else { const int rc = row - TL; b = rc >> 8; pos = SEQ + (rc & 255); }
          const int dv = dvb + nt * 32 + cl;
          u32x2 v; v[0] = pk2(acc[mt][nt][4 * g], acc[mt][nt][4 * g + 1]); v[1] = pk2(acc[mt][nt][4 * g + 2], acc[mt][nt][4 * g + 3]);
          *(u32x2*)(o + ((size_t)((b * 4 + hv) * 128 + dv)) * KVL + pos) = v;
        }
  }
};
struct EpiProjS {
  const P* p; int row0, col0;
  DI void operator()(f32x16 (&acc)[2][2], int wm, int wn, int lane) const {
    const int cb = col0 + wn * 64, h = lane >> 5, cl = lane & 31;
    const bool isctx = row0 >= TL;
    char* ws = p->ws;
    if (cb < 2048) {
      const bool isg = cb >= 1536;
      if (isg && isctx) return;
      bf16_t* o = (bf16_t*)(ws + (isg ? WS_GATE : WS_QKVRAW));
      const int pitch = isg ? 512 : 1536, cofs = isg ? cb - 1536 : cb;
#pragma unroll
      for (int mt = 0; mt < 2; ++mt) {
        const int row = row0 + wm * 64 + mt * 32 + cl;
#pragma unroll
        for (int nt = 0; nt < 2; ++nt)
#pragma unroll
          for (int g = 0; g < 4; ++g) {
            float v0 = acc[mt][nt][4 * g], v1 = acc[mt][nt][4 * g + 1], v2 = acc[mt][nt][4 * g + 2], v3 = acc[mt][nt][4 * g + 3];
            if (isg) { v0 = silu_f(v0); v1 = silu_f(v1); v2 = silu_f(v2); v3 = silu_f(v3); }
            u32x2 v; v[0] = pk2(v0, v1); v[1] = pk2(v2, v3);
            *(u32x2*)(o + (size_t)row * pitch + cofs + nt * 32 + 8 * g + 4 * h) = v;
          }
      }
    } else if (cb < 3072) {
      const bool isq = cb < 2560;
      if (isq && isctx) return;
      const float* rope = (const float*)(ws + WS_ROPE);
      bf16_t* o = (bf16_t*)(ws + (isq ? WS_Q : WS_K));
      const int cofs = cb - (isq ? 2048 : 2560);
      const float qs = isq ? 0.125f * 1.4426950408889634f : 1.f;
#pragma unroll
      for (int mt = 0; mt < 2; ++mt) {
        const int row = row0 + wm * 64 + mt * 32 + cl;
        size_t orow; int l = 0;
        if (!isctx) { l = row & (SEQ - 1); orow = isq ? (size_t)row : (size_t)(row >> 13) * KVL + l; }
        else { const int rc = row - TL; orow = (size_t)(rc >> 8) * KVL + SEQ + (rc & 255); }
#pragma unroll
        for (int g = 0; g < 4; ++g) {
          const int d0 = 8 * g + 4 * h;
          float o1[4], o2[4];
          if (!isctx) {
            const f32x4 ca = *(const f32x4*)(rope + ((size_t)l * 32 + d0) * 2), cb2 = *(const f32x4*)(rope + ((size_t)l * 32 + d0) * 2 + 4);
            const float cs[4] = {ca[0], ca[2], cb2[0], cb2[2]}, sn[4] = {ca[1], ca[3], cb2[1], cb2[3]};
#pragma unroll
            for (int r = 0; r < 4; ++r) { const float x1 = acc[mt][0][4 * g + r], x2 = acc[mt][1][4 * g + r]; o1[r] = (x1 * cs[r] - x2 * sn[r]) * qs; o2[r] = (x1 * sn[r] + x2 * cs[r]) * qs; }
          } else {
#pragma unroll
            for (int r = 0; r < 4; ++r) { o1[r] = acc[mt][0][4 * g + r]; o2[r] = acc[mt][1][4 * g + r]; }
          }
          u32x2 v; v[0] = pk2(o1[0], o1[1]); v[1] = pk2(o1[2], o1[3]); *(u32x2*)(o + orow * 512 + cofs + d0) = v;
          v[0] = pk2(o2[0], o2[1]); v[1] = pk2(o2[2], o2[3]); *(u32x2*)(o + orow * 512 + cofs + 32 + d0) = v;
        }
      }
    } else if (cb == 3584) {
      float* o = (float*)(ws + WS_BA);
#pragma unroll
      for (int mt = 0; mt < 2; ++mt) {
        const int row = row0 + wm * 64 + mt * 32 + cl;
#pragma unroll
        for (int g = 0; g < 4; ++g) {
          const int j0 = 8 * g + 4 * h;
          f32x4 y;
#pragma unroll
          for (int r = 0; r < 4; ++r) {
            const int j = j0 + r; const float v = acc[mt][0][4 * g + r];
            if (j0 < 16) y[r] = sigmoid_f(v);
            else { const float z = v + p->dt_bias[j - 16]; const float sp = (z > 20.f) ? z : log1pf(__expf(z)); y[r] = -__expf(p->a_log[j - 16]) * sp; }
          }
          *(f32x4*)(o + (size_t)row * 32 + j0) = y;
        }
      }
    }
  }
};

DI void ph_gemm_proj(const P& p, char* lds) {
  const bf16_t* A = (const bf16_t*)(p.ws + R0); const bf16_t* Bt = (const bf16_t*)(p.ws + WS_WIN);
  const int nM = TA / GBM, nN = NIN / GBN;
  for (int t = blockIdx.x; t < nM * nN; t += gridDim.x) {
    const int pm = t / nN, pn = t % nN;
    RowLin rf{A + (size_t)pm * GBM * DM, (size_t)DM};
    if (pn >= 24 && pn < 28) { EpiProjV ep{&p, pm * GBM, pn * GBN}; gemm_tile<false>(lds, rf, Bt + (size_t)pn * GBN * DM, DM, ep); }
    else { EpiProjS ep{&p, pm * GBM, pn * GBN}; gemm_tile<true>(lds, rf, Bt + (size_t)pn * GBN * DM, DM, ep); }
  }
}


struct PgResid {
  static constexpr bool PERM = true, AFTER_DRAIN = false;
  const float* xin; float* xout; const float* gmod;
  DI void operator()(const pg8::f32x4 (&acc)[2][2][4][2], const pg8::Unit& u, int wr, int wc, int fr, int fq) const {
#pragma unroll
    for (int ai = 0; ai < 2; ++ai)
#pragma unroll
      for (int m = 0; m < 4; ++m) {
        const int row = u.pm * 256 + ai * 128 + wr * 64 + m * 16 + fr;
        const float* gm = gmod + (size_t)(row >> 13) * 6144;
#pragma unroll
        for (int bj = 0; bj < 2; ++bj) {
          const int c0 = u.pn * 256 + bj * 128 + wc * 32 + 8 * fq;
#pragma unroll
          for (int n = 0; n < 2; ++n) {
            const f32x4 xv = *(const f32x4*)(xin + (size_t)row * DM + c0 + 4 * n), g4 = *(const f32x4*)(gm + c0 + 4 * n);
            *(f32x4*)(xout + (size_t)row * DM + c0 + 4 * n) = xv + g4 * acc[ai][bj][m][n];
          }
        }
      }
  }
};
struct PgBf16 {
  static constexpr bool PERM = true, AFTER_DRAIN = false;
  bf16_t* o; int pitch;
  DI void operator()(const pg8::f32x4 (&acc)[2][2][4][2], const pg8::Unit& u, int wr, int wc, int fr, int fq) const {
#pragma unroll
    for (int ai = 0; ai < 2; ++ai)
#pragma unroll
      for (int m = 0; m < 4; ++m) {
        const int row = u.pm * 256 + ai * 128 + wr * 64 + m * 16 + fr;
#pragma unroll
        for (int bj = 0; bj < 2; ++bj) {
          const int c0 = u.pn * 256 + bj * 128 + wc * 32 + 8 * fq;
          const f32x4 v0 = acc[ai][bj][m][0], v1 = acc[ai][bj][m][1];
          u32x4 w; w[0] = pk2(v0[0], v0[1]); w[1] = pk2(v0[2], v0[3]); w[2] = pk2(v1[0], v1[1]); w[3] = pk2(v1[2], v1[3]);
          *(u32x4*)(o + (size_t)row * pitch + c0) = w;
        }
      }
  }
};
struct PgProj {
  static constexpr bool PERM = true, AFTER_DRAIN = false, DEQ = true;
  const P* p;
  DI void deq(pg8::f32x4 (&acc)[2][2][4][2], const pg8::Unit& u, int wr, int wc, int fr, int fq) const {
    const float* srow = (const float*)(p->ws + WS_HS0); const float* scol = (const float*)(p->ws + WS_SWIN);
#pragma unroll
    for (int bj = 0; bj < 2; ++bj) {
      const int c0 = u.pn * 256 + bj * 128 + wc * 32 + 8 * fq;
      const f32x4 sc0 = *(const f32x4*)(scol + c0), sc1 = *(const f32x4*)(scol + c0 + 4);
#pragma unroll
      for (int ai = 0; ai < 2; ++ai)
#pragma unroll
        for (int m = 0; m < 4; ++m) {
          const float sr = srow[u.pm * 256 + ai * 128 + wr * 64 + m * 16 + fr];
          const pg8::v4i_t i0 = __builtin_bit_cast(pg8::v4i_t, acc[ai][bj][m][0]), i1 = __builtin_bit_cast(pg8::v4i_t, acc[ai][bj][m][1]);
#pragma unroll
          for (int r = 0; r < 4; ++r) { acc[ai][bj][m][0][r] = (float)i0[r] * sr * sc0[r]; acc[ai][bj][m][1][r] = (float)i1[r] * sr * sc1[r]; }
        }
    }
  }
  DI void operator()(const pg8::f32x4 (&acc)[2][2][4][2], const pg8::Unit& u, int wr, int wc, int fr, int fq) const {
    char* ws = p->ws;
    const bool isctx = u.pm * 256 >= TL;
#pragma unroll
    for (int bj = 0; bj < 2; ++bj) {
      const int c0 = u.pn * 256 + bj * 128 + wc * 32 + 8 * fq;
      const int cs = u.pn * 256 + bj * 128 + wc * 32;
      if (cs < 2048) {
        const bool isg = cs >= 1536;
        if (isg && isctx) continue;
        bf16_t* o = (bf16_t*)(ws + (isg ? WS_GATE : WS_QKVRAW));
        const int pitch = isg ? 512 : 1536, cofs = isg ? c0 - 1536 : c0;
#pragma unroll
        for (int ai = 0; ai < 2; ++ai)
#pragma unroll
          for (int m = 0; m < 4; ++m) {
            const int row = u.pm * 256 + ai * 128 + wr * 64 + m * 16 + fr;
            f32x4 v0 = acc[ai][bj][m][0], v1 = acc[ai][bj][m][1];
            if (isg) {
#pragma unroll
              for (int r = 0; r < 4; ++r) { v0[r] = silu_f(v0[r]); v1[r] = silu_f(v1[r]); }
            }
            u32x4 w; w[0] = pk2(v0[0], v0[1]); w[1] = pk2(v0[2], v0[3]); w[2] = pk2(v1[0], v1[1]); w[3] = pk2(v1[2], v1[3]);
            *(u32x4*)(o + (size_t)row * pitch + cofs) = w;
          }
      } else if (cs < 3072) {
        const bool isq = cs < 2560;
        if (isq && isctx) continue;
        const float* rope = (const float*)(ws + WS_ROPE);
        bf16_t* o = (bf16_t*)(ws + (isq ? WS_Q : WS_K));
        const int gofs = (c0 & ~63) - (isq ? 2048 : 2560), d0 = ((c0 & 63) >> 3) * 4;
        const float qs = isq ? 0.125f * 1.4426950408889634f : 1.f;
#pragma unroll
        for (int ai = 0; ai < 2; ++ai)
#pragma unroll
          for (int m = 0; m < 4; ++m) {
            const int row = u.pm * 256 + ai * 128 + wr * 64 + m * 16 + fr;
            const f32x4 x1 = acc[ai][bj][m][0], x2 = acc[ai][bj][m][1];
            size_t orow; float o1[4], o2[4];
            if (!isctx) {
              const int l = row & (SEQ - 1);
              orow = isq ? (size_t)row : (size_t)(row >> 13) * KVL + l;
              const f32x4 ca = *(const f32x4*)(rope + ((size_t)l * 32 + d0) * 2), cb2 = *(const f32x4*)(rope + ((size_t)l * 32 + d0) * 2 + 4);
              const float cs4[4] = {ca[0], ca[2], cb2[0], cb2[2]}, sn4[4] = {ca[1], ca[3], cb2[1], cb2[3]};
#pragma unroll
              for (int r = 0; r < 4; ++r) { o1[r] = (x1[r] * cs4[r] - x2[r] * sn4[r]) * qs; o2[r] = (x1[r] * sn4[r] + x2[r] * cs4[r]) * qs; }
            } else {
              const int rc = row - TL; orow = (size_t)(rc >> 8) * KVL + SEQ + (rc & 255);
#pragma unroll
              for (int r = 0; r < 4; ++r) { o1[r] = x1[r]; o2[r] = x2[r]; }
            }
            u32x2 v; v[0] = pk2(o1[0], o1[1]); v[1] = pk2(o1[2], o1[3]); *(u32x2*)(o + orow * 512 + gofs + d0) = v;
            v[0] = pk2(o2[0], o2[1]); v[1] = pk2(o2[2], o2[3]); *(u32x2*)(o + orow * 512 + gofs + 32 + d0) = v;
          }
      } else if (cs < 3584) {
        bf16_t* o = (bf16_t*)(ws + WS_VROW);
#pragma unroll
        for (int ai = 0; ai < 2; ++ai)
#pragma unroll
          for (int m = 0; m < 4; ++m) {
            const int row = u.pm * 256 + ai * 128 + wr * 64 + m * 16 + fr;
            size_t orow; if (!isctx) orow = (size_t)(row >> 13) * KVL + (row & (SEQ - 1)); else { const int rc = row - TL; orow = (size_t)(rc >> 8) * KVL + SEQ + (rc & 255); }
            const f32x4 v0 = acc[ai][bj][m][0], v1 = acc[ai][bj][m][1];
            u32x4 w; w[0] = cvtpk(v0[0], v0[1]); w[1] = cvtpk(v0[2], v0[3]); w[2] = cvtpk(v1[0], v1[1]); w[3] = cvtpk(v1[2], v1[3]);
            *(u32x4*)(o + orow * 512 + (c0 - 3072)) = w;
          }
      } else if (cs == 3584) {
        float* o = (float*)(ws + WS_BA);
        const int j0 = c0 - 3584;
#pragma unroll
        for (int ai = 0; ai < 2; ++ai)
#pragma unroll
          for (int m = 0; m < 4; ++m) {
            const int row = u.pm * 256 + ai * 128 + wr * 64 + m * 16 + fr;
#pragma unroll
            for (int n = 0; n < 2; ++n) {
              f32x4 y;
#pragma unroll
              for (int r = 0; r < 4; ++r) {
                const int j = j0 + 4 * n + r; const float v = acc[ai][bj][m][n][r];
                if (j0 < 16) y[r] = sigmoid_f(v);
                else { const float z = v + p->dt_bias[j - 16]; const float sp = (z > 20.f) ? z : log1pf(__expf(z)); y[r] = -__expf(p->a_log[j - 16]) * sp; }
              }
              *(f32x4*)(o + (size_t)row * 32 + j0 + 4 * n) = y;
            }
          }
      }
    }
  }
};
struct PgScoreI8 {
  static constexpr bool PERM = true, AFTER_DRAIN = false, DEQ = false;
  bf16_t* o; const float* srow; const float* scol;
  DI void operator()(const pg8::f32x4 (&acc)[2][2][4][2], const pg8::Unit& u, int wr, int wc, int fr, int fq) const {
#pragma unroll
    for (int bj = 0; bj < 2; ++bj) {
      const int c0 = u.pn * 256 + bj * 128 + wc * 32 + 8 * fq;
      const f32x4 s0 = *(const f32x4*)(scol + c0), s1 = *(const f32x4*)(scol + c0 + 4);
#pragma unroll
      for (int ai = 0; ai < 2; ++ai)
#pragma unroll
        for (int m = 0; m < 4; ++m) {
          const int row = u.pm * 256 + ai * 128 + wr * 64 + m * 16 + fr;
          const float sr = srow[row];
          const pg8::v4i_t i0 = __builtin_bit_cast(pg8::v4i_t, acc[ai][bj][m][0]), i1 = __builtin_bit_cast(pg8::v4i_t, acc[ai][bj][m][1]);
          u32x4 w;
          w[0] = pk2((float)i0[0] * sr * s0[0], (float)i0[1] * sr * s0[1]); w[1] = pk2((float)i0[2] * sr * s0[2], (float)i0[3] * sr * s0[3]);
          w[2] = pk2((float)i1[0] * sr * s1[0], (float)i1[1] * sr * s1[1]); w[3] = pk2((float)i1[2] * sr * s1[2], (float)i1[3] * sr * s1[3]);
          *(u32x4*)(o + (size_t)row * 2048 + c0) = w;
        }
    }
  }
};
template <class Epi>
DI void pg8_run_i8(char* lds, const void* A8, const void* Bt8, int M, int N, int Kbytes, const Epi& E) {
  pg8::Gemm g{(const pg8::bf16_t*)A8, (const pg8::bf16_t*)Bt8, M, N, Kbytes / 2};
  pg8::StaticOrder S; S.init(M, N, (int)gridDim.x, (int)blockIdx.x);
  pg8::gemm_phase<Epi, pg8::StaticOrder, true, true, true>((PG8_LAS unsigned char*)lds, g, S, E);
}
template <class Epi>
DI void pg8_run(char* lds, const bf16_t* A, const bf16_t* Bt, int M, int N, int K, const Epi& E) {
  pg8::Gemm g{A, Bt, M, N, K};
  pg8::StaticOrder S; S.init(M, N, (int)gridDim.x, (int)blockIdx.x);
  pg8::gemm_phase<Epi, pg8::StaticOrder, true, true>((PG8_LAS unsigned char*)lds, g, S, E);
}

DI void gdn_solve(const float* MT, const float* src  , const float* be, const float* gc  ,
                  int d, int part, int lane, bf16_t* uo) {
  float a[64];
#pragma unroll
  for (int i = 0; i < 64; ++i) {
    const int t = d ? 63 - i : i;
    float v = be[t] * src[t * 68 + lane];
    if (part) v *= __expf(gc[t]);
    a[i] = v;
  }
#pragma unroll
  for (int j = 0; j < 63; ++j) {
    const float xj = a[j];
#pragma unroll
    for (int i4 = ((j + 1) & ~3); i4 < 64; i4 += 4) {
      const f32x4 m = *(const f32x4*)(MT + j * 68 + i4);
#pragma unroll
      for (int q = 0; q < 4; ++q) if (i4 + q > j) a[i4 + q] -= m[q] * xj;
    }
  }
  if (part) {
#pragma unroll
    for (int i = 0; i < 64; ++i) uo[i * 64 + lane] = (bf16_t)f2bf(a[i]);
  } else {
#pragma unroll
    for (int c = 0; c < 8; ++c) {
      u32x4 o; o[0] = pk2(a[8 * c], a[8 * c + 1]); o[1] = pk2(a[8 * c + 2], a[8 * c + 3]); o[2] = pk2(a[8 * c + 4], a[8 * c + 5]); o[3] = pk2(a[8 * c + 6], a[8 * c + 7]);
      *(u32x4*)(uo + lane * 64 + 8 * c) = o;
    }
  }
}

template <int MODE = 0>
DI void ph_gdn_prep(const P& p, char* lds) {
  const int tid0 = otid();
  float* L = (float*)lds;
  constexpr int HSZ = 4 * 64 * 68 + 6 * 64;
  const bf16_t* raw = (const bf16_t*)(p.ws + WS_QKVRAW);
  const float* BA = (const float*)(p.ws + WS_BA);
  bf16_t* qn = (bf16_t*)(p.ws + WS_QN); bf16_t* kn = (bf16_t*)(p.ws + WS_KN);
  float* GC = (float*)(p.ws + WS_GC);
  bf16_t* UW = (bf16_t*)(p.ws + WS_UW);
  for (int it = blockIdx.x; it < NB * NCH * 4; it += gridDim.x) {
    int tid = tid0; asm volatile("" : "+v"(tid));
    const int lane = tid & 63, wave = __builtin_amdgcn_readfirstlane(tid >> 6);
    const int hpair = it & 3, cid = (it >> 2) % NCH, b = it / (4 * NCH);
    const int segbase = (cid < 4) ? TL + b * CTXL : b * SEQ, c0 = (cid < 4) ? cid * 64 : (cid - 4) * 64, seglen = (cid < 4) ? CTXL : SEQ;
    __syncthreads();
    {
      const int t = tid >> 3, c8 = tid & 7, sidx = c0 + t;
      const size_t grow = (size_t)(segbase + sidx);
      const bool hm = sidx - 1 >= 0, hp_ = sidx + 1 < seglen;
#pragma unroll 1
      for (int hh = 0; hh < 2; ++hh) {
        const int head = hpair * 2 + hh;
        float* kf = L + hh * HSZ; float* vf = kf + 64 * 68;
#pragma unroll
        for (int part = 0; part < 3; ++part) {
          const int ch = part * 512 + head * 64 + c8 * 8;
          const u32x4 z4 = {0u, 0u, 0u, 0u};
          const u32x4 rm = hm ? *(const u32x4*)(raw + (grow - 1) * 1536 + ch) : z4;
          const u32x4 r0v = *(const u32x4*)(raw + grow * 1536 + ch);
          const u32x4 rp = hp_ ? *(const u32x4*)(raw + (grow + 1) * 1536 + ch) : z4;
          float v[8]; float ss = 0.f;
#pragma unroll
          for (int w = 0; w < 4; ++w) {
            const f32x2_t w0 = *(const f32x2_t*)(p.conv_w + ch + 2 * w), w1 = *(const f32x2_t*)(p.conv_w + 1536 + ch + 2 * w), w2 = *(const f32x2_t*)(p.conv_w + 3072 + ch + 2 * w);
            v[2 * w] = silu_f(w0[0] * bflo(rm[w]) + w1[0] * bflo(r0v[w]) + w2[0] * bflo(rp[w]));
            v[2 * w + 1] = silu_f(w0[1] * bfhi(rm[w]) + w1[1] * bfhi(r0v[w]) + w2[1] * bfhi(rp[w]));
            ss += v[2 * w] * v[2 * w] + v[2 * w + 1] * v[2 * w + 1];
          }
          if (part < 2) {
            ss += __shfl_xor(ss, 1, 64); ss += __shfl_xor(ss, 2, 64); ss += __shfl_xor(ss, 4, 64);
            const float rn = rsqrtf(ss + EPS) * (part == 0 ? 0.125f : 1.f);
#pragma unroll
            for (int w = 0; w < 8; ++w) v[w] *= rn;
            u32x4 o; o[0] = pk2(v[0], v[1]); o[1] = pk2(v[2], v[3]); o[2] = pk2(v[4], v[5]); o[3] = pk2(v[6], v[7]);
            *(u32x4*)((part == 0 ? qn : kn) + grow * 512 + head * 64 + c8 * 8) = o;
          }
          if (part >= 1) {
            float* dst = (part == 1 ? kf : vf) + t * 68 + c8 * 8;
            *(f32x4*)dst = f32x4{v[0], v[1], v[2], v[3]}; *(f32x4*)(dst + 4) = f32x4{v[4], v[5], v[6], v[7]};
          }
        }
      }
    }
    if (MODE == 2) continue;
    if (wave < 4) {
      const int hh = wave >> 1, d = wave & 1, head = hpair * 2 + hh, t = lane;
      float* be = L + hh * HSZ + 4 * 64 * 68;
      const size_t row = (size_t)(segbase + c0 + t);
      be[d * 64 + t] = BA[row * 32 + d * 8 + head];
      const float g = BA[row * 32 + 16 + d * 8 + head];
      float a = g;
#pragma unroll
      for (int o = 1; o < 64; o <<= 1) {
        const float nb_ = d ? __shfl_down(a, o, 64) : __shfl_up(a, o, 64);
        const bool ok = d ? (lane + o < 64) : (lane >= o);
        a += ok ? nb_ : 0.f;
      }
      be[256 + d * 64 + t] = a;
      GC[((size_t)((b * 8 + head) * 2 + d) * NCH + cid) * 64 + (d ? 63 - t : t)] = a;
    }
    __syncthreads();
    {
      const int hh = wave >> 2, Ln = lane;
      float* kf = L + hh * HSZ; float* M0 = kf + 2 * 64 * 68; float* M1 = kf + 3 * 64 * 68; float* be = kf + 4 * 64 * 68; float* gc = be + 256;
      float a[16];
#pragma unroll
      for (int i = 0; i < 16; ++i) a[i] = 0.f;
#pragma unroll 1
      for (int c = 0; c < 64; c += 4) {
        const f32x4 kv = *(const f32x4*)(kf + Ln * 68 + c);
#pragma unroll
        for (int i = 0; i < 16; ++i) { const f32x4 kr = *(const f32x4*)(kf + ((wave & 3) * 16 + i) * 68 + c); a[i] += kv[0] * kr[0] + kv[1] * kr[1] + kv[2] * kr[2] + kv[3] * kr[3]; }
      }
      const float b0 = be[Ln], b1 = be[64 + Ln], g0 = gc[Ln], g1 = gc[64 + Ln];
#pragma unroll
      for (int i = 0; i < 16; ++i) {
        const int ti = (wave & 3) * 16 + i;
        if (Ln > ti) M0[ti * 68 + Ln] = b0 * a[i] * __expf(g0 - gc[ti]);
        else if (Ln < ti) M1[(63 - ti) * 68 + 63 - Ln] = b1 * a[i] * __expf(g1 - gc[64 + ti]);
      }
    }
    __syncthreads();
    if (MODE == 0) {
      const int hh = wave >> 2, d = (wave >> 1) & 1, part = wave & 1, head = hpair * 2 + hh;
      float* kf = L + hh * HSZ; float* vf = kf + 64 * 68; float* Md = kf + (2 + d) * 64 * 68; float* be = kf + 4 * 64 * 68; float* gc = be + 256;
      bf16_t* uo = UW + (((size_t)((b * 8 + head) * 2 + d) * NCH + cid) * 2 + part) * 4096;
      gdn_solve(Md, part ? kf : vf, be + d * 64, gc + d * 64, d, part, lane, uo);
    }
  }
}

#define MFMA16(a, b, c) __builtin_amdgcn_mfma_f32_16x16x32_bf16((a), (b), (c), 0, 0, 0)
constexpr int SC_LD = 72;
constexpr int SC_T = 64 * SC_LD * 2;
constexpr int SC_STAGE = 5 * SC_T + 1024;
constexpr int SC_KNL = 2 * SC_STAGE, SC_QNL = SC_KNL + SC_T;
DI bf16x8 pack8(const f32x4& a, const f32x4& b) { u32x4 r; r[0] = cvtpk(a[0], a[1]); r[1] = cvtpk(a[2], a[3]); r[2] = cvtpk(b[0], b[1]); r[3] = cvtpk(b[2], b[3]); return __builtin_bit_cast(bf16x8, r); }
DI bf16x8 afrag(const char* tile, int row, int kofs  ) {
  const char* pr = tile + (row * SC_LD + kofs) * 2;
  const u32x2 lo = *(const u32x2*)pr, hi = *(const u32x2*)(pr + 32);
  u32x4 r; r[0] = lo[0]; r[1] = lo[1]; r[2] = hi[0]; r[3] = hi[1];
  return __builtin_bit_cast(bf16x8, r);
}
template <int NOSTORE = 0>
DI void ph_gdn_scan(const P& p, char* lds) {
  const int tid = otid(), lane = tid & 63, wave = __builtin_amdgcn_readfirstlane(tid >> 6);
  const int c = lane & 15, q = lane >> 4;
  const bf16_t* qn = (const bf16_t*)(p.ws + WS_QN); const bf16_t* kn = (const bf16_t*)(p.ws + WS_KN);
  const float* GC = (const float*)(p.ws + WS_GC);
  const bf16_t* UW = (const bf16_t*)(p.ws + WS_UW);
  bf16_t* Ob = (bf16_t*)(p.ws + WS_OBUF);
  for (int it = blockIdx.x; it < 64; it += gridDim.x) {
    const int bhd = it, d = bhd & 1, head = (bhd >> 1) & 7, b = bhd >> 4;
    __syncthreads();
    if (wave >= 4) {
      const int pt = tid - 256;
      const int r0 = pt >> 3, cc = pt & 7;
      u32x4 rW0A, rW1A, rU0A, rU1A, rK0A, rK1A, rQ0A, rQ1A; f32x4 rGA;
      u32x4 rW0B, rW1B, rU0B, rU1B, rK0B, rK1B, rQ0B, rQ1B; f32x4 rGB;
#define SP_CID(n) (d ? ((n) < 4 ? 3 - (n) : 135 - (n)) : (n))
#define SP_LOAD(n, S) do { const int nn_ = (n) < NCH ? (n) : NCH - 1; const int cid_ = SP_CID(nn_); const bool lat_ = cid_ >= 4; const int sb_ = lat_ ? b * SEQ : TL + b * CTXL, c0_ = lat_ ? (cid_ - 4) * 64 : cid_ * 64; \
        const bf16_t* uw_ = UW + ((size_t)(bhd * NCH + cid_) * 2) * 4096; \
        rU0##S = *(const u32x4*)(uw_ + r0 * 64 + cc * 8); rU1##S = *(const u32x4*)(uw_ + (r0 + 32) * 64 + cc * 8); \
        rW0##S = *(const u32x4*)(uw_ + 4096 + r0 * 64 + cc * 8); rW1##S = *(const u32x4*)(uw_ + 4096 + (r0 + 32) * 64 + cc * 8); \
        const int t0_ = d ? 63 - r0 : r0, t1_ = d ? 31 - r0 : r0 + 32; \
        rK0##S = *(const u32x4*)(kn + (size_t)(sb_ + c0_ + t0_) * 512 + head * 64 + cc * 8); rK1##S = *(const u32x4*)(kn + (size_t)(sb_ + c0_ + t1_) * 512 + head * 64 + cc * 8); \
        const bf16_t* qk_ = lat_ ? qn : kn;     \
        rQ0##S = *(const u32x4*)(qk_ + (size_t)(sb_ + c0_ + t0_) * 512 + head * 64 + cc * 8); rQ1##S = *(const u32x4*)(qk_ + (size_t)(sb_ + c0_ + t1_) * 512 + head * 64 + cc * 8); \
        rG##S = *(const f32x4*)(GC + (size_t)(bhd * NCH + cid_) * 64 + (pt & 15) * 4); } while (0)
#define SP_A(n, S) do { char* st_ = lds + ((n) & 1) * SC_STAGE; const int o0_ = (r0 * SC_LD + cc * 8) * 2, o1_ = o0_ + 32 * SC_LD * 2; \
        *(u32x4*)(st_ + o0_) = rW0##S; *(u32x4*)(st_ + o1_) = rW1##S; *(u32x4*)(st_ + SC_T + o0_) = rU0##S; *(u32x4*)(st_ + SC_T + o1_) = rU1##S; \
        *(u32x4*)(lds + SC_KNL + o0_) = rK0##S; *(u32x4*)(lds + SC_KNL + o1_) = rK1##S; \
        *(u32x4*)(lds + SC_QNL + o0_) = rQ0##S; *(u32x4*)(lds + SC_QNL + o1_) = rQ1##S; \
        if (pt < 16) { float* gp_ = (float*)(st_ + 5 * SC_T); *(f32x4*)(gp_ + pt * 4) = rG##S; } } while (0)
#define SP_B(n) do { char* st_ = lds + ((n) & 1) * SC_STAGE; float* gp_ = (float*)(st_ + 5 * SC_T); const bool lat_ = SP_CID((n) < NCH ? (n) : NCH - 1) >= 4; \
        const float gl_ = gp_[63]; \
        if (pt < 64) { const float gi_ = gp_[pt]; gp_[64 + pt] = __expf(gi_); gp_[128 + pt] = __expf(gl_ - gi_); if (pt == 0) gp_[192] = __expf(gl_); } \
        {   \
          const int i_ = pt & 63; \
          _Pragma("unroll") for (int e_ = 0; e_ < 2; ++e_) { const int ch_ = (pt >> 6) * 2 + e_; const u32x4 kv_ = *(const u32x4*)(lds + SC_KNL + (i_ * SC_LD + ch_ * 8) * 2); \
            bf16_t* kt_ = (bf16_t*)(st_ + 2 * SC_T); \
            _Pragma("unroll") for (int w_ = 0; w_ < 4; ++w_) { kt_[(ch_ * 8 + 2 * w_) * SC_LD + i_] = (bf16_t)(kv_[w_] & 0xFFFFu); kt_[(ch_ * 8 + 2 * w_ + 1) * SC_LD + i_] = (bf16_t)(kv_[w_] >> 16); } } } \
        if (lat_) { \
          {   \
            _Pragma("unroll") for (int e_ = 0; e_ < 2; ++e_) { const int rr_ = r0 + 32 * e_; const float sc_ = __expf(gp_[rr_]); const u32x4 qv_ = *(const u32x4*)(lds + SC_QNL + (rr_ * SC_LD + cc * 8) * 2); u32x4 ov_; \
              _Pragma("unroll") for (int w_ = 0; w_ < 4; ++w_) ov_[w_] = cvtpk(bflo(qv_[w_]) * sc_, bfhi(qv_[w_]) * sc_); \
              *(u32x4*)(st_ + 3 * SC_T + (rr_ * SC_LD + cc * 8) * 2) = ov_; } } \
          {   \
            const int jt_ = wave - 4; \
            const bf16x8 ka0_ = *(const bf16x8*)(lds + SC_KNL + ((16 * jt_ + c) * SC_LD + 8 * q) * 2), ka1_ = *(const bf16x8*)(lds + SC_KNL + ((16 * jt_ + c) * SC_LD + 32 + 8 * q) * 2); \
            bf16x8 qb_[4][2]; \
            _Pragma("unroll") for (int it_ = 0; it_ < 4; ++it_) { qb_[it_][0] = *(const bf16x8*)(lds + SC_QNL + ((16 * it_ + c) * SC_LD + 8 * q) * 2); qb_[it_][1] = *(const bf16x8*)(lds + SC_QNL + ((16 * it_ + c) * SC_LD + 32 + 8 * q) * 2); } \
            const f32x4 gj_ = *(const f32x4*)(gp_ + 16 * jt_ + 4 * q); \
            float gi_[4]; _Pragma("unroll") for (int it_ = 0; it_ < 4; ++it_) gi_[it_] = gp_[16 * it_ + c]; \
            _Pragma("unroll") for (int it_ = 0; it_ < 4; ++it_) { \
              f32x4 ac_ = {0.f, 0.f, 0.f, 0.f}; \
              ac_ = MFMA16(ka0_, qb_[it_][0], ac_); ac_ = MFMA16(ka1_, qb_[it_][1], ac_); \
              const int i_ = 16 * it_ + c; \
              _Pragma("unroll") for (int r_ = 0; r_ < 4; ++r_) { const int j_ = 16 * jt_ + 4 * q + r_; const float e_ = __expf(fminf(gi_[it_] - gj_[r_], 0.f)); ac_[r_] = (i_ >= j_) ? ac_[r_] * e_ : 0.f; } \
              u32x2 ov_; ov_[0] = cvtpk(ac_[0], ac_[1]); ov_[1] = cvtpk(ac_[2], ac_[3]); \
              *(u32x2*)(st_ + 4 * SC_T + ((16 * it_ + c) * SC_LD + 16 * jt_ + 4 * q) * 2) = ov_; } } } } while (0)
      SP_LOAD(0, A); SP_LOAD(1, B);
      SP_A(0, A);
      __syncthreads();
      SP_B(0);
      SP_LOAD(2, A);
      __syncthreads();
#define SP_STEP(n, S) do { SP_A((n) + 1, S); SP_LOAD((n) + 3, S);        \
        __syncthreads();                 \
        SP_B((n) + 1); \
        __syncthreads();                 } while (0)
#pragma unroll 1
      for (int n = 0; n < NCH; n += 2) { SP_STEP(n, B); SP_STEP(n + 1, A); }
#undef SP_STEP
#undef SP_LOAD
#undef SP_A
#undef SP_B
    } else {
      f32x4 S[4];
#pragma unroll
      for (int i = 0; i < 4; ++i) S[i] = f32x4{0.f, 0.f, 0.f, 0.f};
      __syncthreads();
      __syncthreads();
#pragma unroll 1
      for (int n = 0; n < NCH; ++n) {
        const int cid = SP_CID(n); const bool lat = cid >= 4;
        const char* st = lds + (n & 1) * SC_STAGE; const float* gp = (const float*)(st + 5 * SC_T);
        bf16x8 Sb[2], Sn[2];
#pragma unroll
        for (int ks = 0; ks < 2; ++ks) {
          Sb[ks] = pack8(S[2 * ks], S[2 * ks + 1]);
          u32x4 t = __builtin_bit_cast(u32x4, Sb[ks]);
#pragma unroll
          for (int w = 0; w < 4; ++w) t[w] ^= 0x80008000u;
          Sn[ks] = __builtin_bit_cast(bf16x8, t);
        }
        u32x2 ur[4]; bf16x8 wf[4][2], kf2[4][2]; f32x4 sc4[4];
#pragma unroll
        for (int mt = 0; mt < 4; ++mt) {
          ur[mt] = *(const u32x2*)(st + SC_T + ((16 * wave + c) * SC_LD + 16 * mt + 4 * q) * 2);
          wf[mt][0] = afrag(st, 16 * mt + c, 4 * q); wf[mt][1] = afrag(st, 16 * mt + c, 32 + 4 * q);
          sc4[mt] = *(const f32x4*)(gp + 128 + 16 * mt + 4 * q);
        }
#pragma unroll
        for (int dt = 0; dt < 4; ++dt) { kf2[dt][0] = afrag(st + 2 * SC_T, 16 * dt + c, 4 * q); kf2[dt][1] = afrag(st + 2 * SC_T, 16 * dt + c, 32 + 4 * q); }
        const float gt = gp[192];
        f32x4 vn[4], vs[4];
#pragma unroll
        for (int mt = 0; mt < 4; ++mt) {
          f32x4 acc = {bflo(ur[mt][0]), bfhi(ur[mt][0]), bflo(ur[mt][1]), bfhi(ur[mt][1])};
          acc = MFMA16(wf[mt][0], Sn[0], acc);
          acc = MFMA16(wf[mt][1], Sn[1], acc);
          vn[mt] = acc;
          vs[mt] = acc * sc4[mt];
        }
        bf16x8 Vn[2], Vs[2];
#pragma unroll
        for (int ks = 0; ks < 2; ++ks) { Vn[ks] = pack8(vn[2 * ks], vn[2 * ks + 1]); Vs[ks] = pack8(vs[2 * ks], vs[2 * ks + 1]); }
        f32x4 Snew[4];
#pragma unroll
        for (int dt = 0; dt < 4; ++dt) {
          f32x4 acc = S[dt] * gt;
          acc = MFMA16(kf2[dt][0], Vs[0], acc);
          acc = MFMA16(kf2[dt][1], Vs[1], acc);
          Snew[dt] = acc;
        }
        __syncthreads();
        if (lat) {
          const int sb = b * SEQ, c0 = (cid - 4) * 64;
          bf16x8 qf[4][2], pf[4][2];
#pragma unroll
          for (int mt = 0; mt < 4; ++mt) {
            qf[mt][0] = afrag(st + 3 * SC_T, 16 * mt + c, 4 * q); qf[mt][1] = afrag(st + 3 * SC_T, 16 * mt + c, 32 + 4 * q);
            pf[mt][0] = afrag(st + 4 * SC_T, 16 * mt + c, 4 * q); pf[mt][1] = afrag(st + 4 * SC_T, 16 * mt + c, 32 + 4 * q);
          }
#pragma unroll
          for (int mt = 0; mt < 4; ++mt) {
            f32x4 o = {0.f, 0.f, 0.f, 0.f};
            o = MFMA16(Sb[0], qf[mt][0], o);
            o = MFMA16(Sb[1], qf[mt][1], o);
            o = MFMA16(Vn[0], pf[mt][0], o);
            o = MFMA16(Vn[1], pf[mt][1], o);
            const int i = 16 * mt + c, t = d ? 63 - i : i;
            u32x2 ov; ov[0] = cvtpk(o[0], o[1]); ov[1] = cvtpk(o[2], o[3]);
            if (!NOSTORE || ov[0] == 0x12345678u) *(u32x2*)(Ob + ((size_t)d * TL + sb + c0 + t) * 512 + head * 64 + 16 * wave + 4 * q) = ov;
          }
        }
#pragma unroll
        for (int dt = 0; dt < 4; ++dt) S[dt] = Snew[dt];
        __syncthreads();
      }
    }
#undef SP_CID
  }
}

constexpr int VT_PITCH = 1024 + 16;
DI void ph_vt8(const P& p, char* lds) {
  const int tid = otid();
  const bf16_t* vrow = (const bf16_t*)(p.ws + WS_VROW); unsigned char* vt8 = (unsigned char*)(p.ws + WS_VT);
  const int nb = (int)gridDim.x - 64;
  for (int tile = (int)blockIdx.x - 64; tile < NB * (KVL / 64); tile += nb) {
    const int b = tile / (KVL / 64), kb = tile - b * (KVL / 64);
    __syncthreads();
#pragma unroll
    for (int i = 0; i < 8; ++i) { const int e = tid + 512 * i, key = e >> 6, ch = e & 63; *(u32x4*)(lds + key * VT_PITCH + ch * 16) = *(const u32x4*)(vrow + ((size_t)b * KVL + kb * 64 + key) * 512 + ch * 8); }
    __syncthreads();
    unsigned char* dst = vt8 + ((size_t)b * 512 + tid) * KVL + kb * 64;
#pragma unroll
    for (int q4 = 0; q4 < 4; ++q4) {
      u32x4 o;
#pragma unroll
      for (int w = 0; w < 4; ++w) {
        const int D = 4 * q4 + w, h = D >> 3, k2 = (D >> 2) & 1, g = D & 3, kbase = 32 * k2 + 8 * g + 4 * h;
        float v[4];
#pragma unroll
        for (int j = 0; j < 4; ++j) v[j] = fminf(fmaxf(bf2f(*(const unsigned short*)(lds + (kbase + j) * VT_PITCH + tid * 2)) * 16.f, -448.f), 448.f);
        int wd = __builtin_amdgcn_cvt_pk_fp8_f32(v[0], v[1], 0, false);
        wd = __builtin_amdgcn_cvt_pk_fp8_f32(v[2], v[3], wd, true);
        o[w] = (unsigned)wd;
      }
      *(u32x4*)(dst + 16 * q4) = o;
    }
  }
}

DI void cvt_fp8(const bf16_t* __restrict__ src, unsigned char* __restrict__ dst, int n16, float scale) {
  const int nb = (int)gridDim.x - 64;
  for (int i = ((int)blockIdx.x - 64) * NT + otid(); i < n16; i += nb * NT) {
    const u32x4 a = *(const u32x4*)(src + (size_t)i * 16), b = *(const u32x4*)(src + (size_t)i * 16 + 8);
    u32x4 o;
#pragma unroll
    for (int w = 0; w < 2; ++w) {
      int wd = __builtin_amdgcn_cvt_pk_fp8_f32(fminf(fmaxf(bflo(a[2 * w]) * scale, -448.f), 448.f), fminf(fmaxf(bfhi(a[2 * w]) * scale, -448.f), 448.f), 0, false);
      o[w] = (unsigned)__builtin_amdgcn_cvt_pk_fp8_f32(fminf(fmaxf(bflo(a[2 * w + 1]) * scale, -448.f), 448.f), fminf(fmaxf(bfhi(a[2 * w + 1]) * scale, -448.f), 448.f), wd, true);
      wd = __builtin_amdgcn_cvt_pk_fp8_f32(fminf(fmaxf(bflo(b[2 * w]) * scale, -448.f), 448.f), fminf(fmaxf(bfhi(b[2 * w]) * scale, -448.f), 448.f), 0, false);
      o[2 + w] = (unsigned)__builtin_amdgcn_cvt_pk_fp8_f32(fminf(fmaxf(bflo(b[2 * w + 1]) * scale, -448.f), 448.f), fminf(fmaxf(bfhi(b[2 * w + 1]) * scale, -448.f), 448.f), wd, true);
    }
    *(u32x4*)(dst + (size_t)i * 16) = o;
  }
}

constexpr int AT_KROW = 72, AT_VROW = 68;
constexpr int AT_V8ROW = 80;
constexpr int AT_KB = 2 * 64 * AT_V8ROW, AT_VB = 128 * AT_V8ROW, AT_STAGE = AT_KB + AT_VB;
DI void ph_attn(const P& p, char* lds) {
  const int tid = otid(), lane = tid & 63, wave = tid >> 6, wq = wave & 3, m = wave >> 2, h = lane >> 5, cl = lane & 31;
  const unsigned char* Qb = (const unsigned char*)(p.ws + WS_Q8); const unsigned char* Kb = (const unsigned char*)(p.ws + WS_K8); const unsigned char* VT = (const unsigned char*)(p.ws + WS_VT);
  bf16_t* mix = (bf16_t*)(p.ws + WS_MIX);
  for (int it = blockIdx.x; it < NB * 4 * 64; it += gridDim.x) {
    const int qb = it & 63, head = (it >> 6) & 3, b = it >> 8;
    const int qrow = b * SEQ + qb * 128 + wq * 32 + cl;
    v8i_t qf;
    { const u32x4 lo = *(const u32x4*)(Qb + (size_t)qrow * 512 + (head * 2 + m) * 64 + 32 * h), hi = *(const u32x4*)(Qb + (size_t)qrow * 512 + (head * 2 + m) * 64 + 32 * h + 16);
      qf[0] = lo[0]; qf[1] = lo[1]; qf[2] = lo[2]; qf[3] = lo[3]; qf[4] = hi[0]; qf[5] = hi[1]; qf[6] = hi[2]; qf[7] = hi[3]; }
    f32x16 o[4];
#pragma unroll
    for (int i = 0; i < 4; ++i)
#pragma unroll
      for (int r = 0; r < 16; ++r) o[i][r] = 0.f;
    f32x16 negm, lacc;
#pragma unroll
    for (int r = 0; r < 16; ++r) { negm[r] = 0.f; lacc[r] = 0.f; }
    v8i_t ones;
#pragma unroll
    for (int r = 0; r < 8; ++r) ones[r] = 0x38383838;
    const unsigned char* kp0 = Kb + ((size_t)b * KVL + (tid >> 3)) * 512 + head * 128 + (tid & 7) * 16;
    const unsigned char* vp0 = VT + ((size_t)((b * 4 + head) * 128 + (tid >> 2))) * KVL + (tid & 3) * 16;
    const int kw0 = (((tid & 7) >> 2) * 64 + (tid >> 3)) * AT_V8ROW + (tid & 3) * 16;
    const int vw0 = AT_KB + (tid >> 2) * AT_V8ROW + (tid & 3) * 16;
    u32x4 rk0, rv0;
#define A_GLOAD(kv0) do { rk0 = *(const u32x4*)(kp0 + (size_t)(kv0) * 512); rv0 = *(const u32x4*)(vp0 + (kv0)); } while (0)
#define A_LWRITE(st) do { char* b_ = lds + (st) * AT_STAGE; *(u32x4*)(b_ + kw0) = rk0; *(u32x4*)(b_ + vw0) = rv0; } while (0)
    A_GLOAD(0);
    __syncthreads();
    A_LWRITE(0);
    __syncthreads();
    constexpr int NKT = KVL / 64;
    for (int kt = 0; kt < NKT; ++kt) {
      if (kt + 1 < NKT) A_GLOAD((kt + 1) * 64);
      const char* sb = lds + (kt & 1) * AT_STAGE;
      const char* ks = sb + m * 64 * AT_V8ROW;
      f32x16 st[2];
#pragma unroll
      for (int k2 = 0; k2 < 2; ++k2) {
        const char* kr = ks + (k2 * 32 + cl) * AT_V8ROW + 32 * h;
        const u32x4 lo = *(const u32x4*)(kr), hi = *(const u32x4*)(kr + 16);
        v8i_t ak; ak[0] = lo[0]; ak[1] = lo[1]; ak[2] = lo[2]; ak[3] = lo[3]; ak[4] = hi[0]; ak[5] = hi[1]; ak[6] = hi[2]; ak[7] = hi[3];
        st[k2] = __builtin_amdgcn_mfma_scale_f32_32x32x64_f8f6f4(ak, qf, negm, 0, 0, 0, 123  , 0, 121  );
      }
      float mx = fmaxf(st[0][0], st[1][0]);
#pragma unroll
      for (int r = 1; r < 16; ++r) mx = fmaxf(mx, fmaxf(st[0][r], st[1][r]));
      mx = fmaxf(mx, __shfl_xor(mx, 32, 64));
      if (kt == 0 || __any(mx > 8.f)) {
        const float delta = kt == 0 ? mx : fmaxf(mx, 0.f);
        const float alpha = kt == 0 ? 0.f : __builtin_amdgcn_exp2f(-delta);
#pragma unroll
        for (int r = 0; r < 16; ++r) { negm[r] -= delta; st[0][r] -= delta; st[1][r] -= delta; lacc[r] *= alpha; }
#pragma unroll
        for (int i = 0; i < 4; ++i)
#pragma unroll
          for (int r = 0; r < 16; ++r) o[i][r] *= alpha;
      }
#pragma unroll
      for (int k2 = 0; k2 < 2; ++k2)
#pragma unroll
        for (int r = 0; r < 16; ++r) st[k2][r] = __builtin_amdgcn_exp2f(st[k2][r]);
      const char* vsb = sb + AT_KB;
      v8i_t pb;
#pragma unroll
      for (int k2 = 0; k2 < 2; ++k2)
#pragma unroll
        for (int g = 0; g < 4; ++g) {
          int wd = __builtin_amdgcn_cvt_pk_fp8_f32(st[k2][4 * g], st[k2][4 * g + 1], 0, false);
          pb[4 * k2 + g] = __builtin_amdgcn_cvt_pk_fp8_f32(st[k2][4 * g + 2], st[k2][4 * g + 3], wd, true);
        }
#pragma unroll
      for (int dt = 0; dt < 4; ++dt) {
        const char* vr = vsb + (dt * 32 + cl) * AT_V8ROW + 32 * h;
        const u32x4 lo = *(const u32x4*)(vr), hi = *(const u32x4*)(vr + 16);
        v8i_t av; av[0] = lo[0]; av[1] = lo[1]; av[2] = lo[2]; av[3] = lo[3]; av[4] = hi[0]; av[5] = hi[1]; av[6] = hi[2]; av[7] = hi[3];
        o[dt] = __builtin_amdgcn_mfma_scale_f32_32x32x64_f8f6f4(av, pb, o[dt], 0, 0, 0, 127, 0, 127);
      }
      lacc = __builtin_amdgcn_mfma_scale_f32_32x32x64_f8f6f4(ones, pb, lacc, 0, 0, 0, 127, 0, 127);
      if (kt + 1 < NKT) A_LWRITE((kt + 1) & 1);
      __syncthreads();
    }
#undef A_GLOAD
#undef A_LWRITE
    const float inv = 0.0625f / lacc[0];
    float* X = (float*)lds;
    if (m == 1) {
#pragma unroll
      for (int dt = 0; dt < 4; ++dt)
#pragma unroll
        for (int r = 0; r < 16; ++r) X[(wq * 32 + cl) * 129 + dt * 32 + crow(r, h)] = o[dt][r] * inv;
    }
    __syncthreads();
    if (m == 0) {
      float l1 = 0.f, l2 = 0.f;
      for (int i = 0; i < 64; ++i) { l1 += p.lam_q1[i] * p.lam_k1[i]; l2 += p.lam_q2[i] * p.lam_k2[i]; }
      const float lam = __expf(l1) - __expf(l2) + 0.2f;
      float ss = 0.f;
#pragma unroll
      for (int dt = 0; dt < 4; ++dt)
#pragma unroll
        for (int r = 0; r < 16; ++r) { const float dv = o[dt][r] * inv - lam * X[(wq * 32 + cl) * 129 + dt * 32 + crow(r, h)]; o[dt][r] = dv; ss += dv * dv; }
      ss += __shfl_xor(ss, 32, 64);
      const float rn = rsqrtf(ss * (1.f / 128.f) + EPS) * 0.8f;
#pragma unroll
      for (int dt = 0; dt < 4; ++dt)
#pragma unroll
        for (int g = 0; g < 4; ++g) {
          const int dv = dt * 32 + 8 * g + 4 * h;
          const f32x4 w4 = *(const f32x4*)(p.subln_w + dv);
          u32x2 v; v[0] = pk2(o[dt][4 * g] * rn * w4[0], o[dt][4 * g + 1] * rn * w4[1]); v[1] = pk2(o[dt][4 * g + 2] * rn * w4[2], o[dt][4 * g + 3] * rn * w4[3]);
          *(u32x2*)(mix + (size_t)qrow * DM + 512 + head * 128 + dv) = v;
        }
    }
    __syncthreads();
  }
}

DI void ph_mixout(const P& p) {
  const int lane = otid() & 63, gw = blockIdx.x * (NT / 64) + (otid() >> 6), nw_ = gridDim.x * (NT / 64);
  const bf16_t* Ob = (const bf16_t*)(p.ws + WS_OBUF); const bf16_t* gate = (const bf16_t*)(p.ws + WS_GATE);
  bf16_t* mix = (bf16_t*)(p.ws + WS_MIX);
  for (int row = gw; row < TL; row += nw_) {
    const u32x4 a = *(const u32x4*)(Ob + (size_t)row * 512 + lane * 8), bq = *(const u32x4*)(Ob + ((size_t)TL + row) * 512 + lane * 8);
    const u32x4 gv = *(const u32x4*)(gate + (size_t)row * 512 + lane * 8);
    float v[8]; float ss = 0.f;
#pragma unroll
    for (int i = 0; i < 4; ++i) { v[2 * i] = bflo(a[i]) + bflo(bq[i]); v[2 * i + 1] = bfhi(a[i]) + bfhi(bq[i]); ss += v[2 * i] * v[2 * i] + v[2 * i + 1] * v[2 * i + 1]; }
    ss += __shfl_xor(ss, 1, 64); ss += __shfl_xor(ss, 2, 64); ss += __shfl_xor(ss, 4, 64);
    const float rn = rsqrtf(ss * (1.f / 64.f) + EPS);
    const int c0 = (lane & 7) * 8;
    u32x4 ov;
#pragma unroll
    for (int i = 0; i < 4; ++i) ov[i] = pk2(v[2 * i] * rn * p.gdn_norm_w[c0 + 2 * i] * bflo(gv[i]), v[2 * i + 1] * rn * p.gdn_norm_w[c0 + 2 * i + 1] * bfhi(gv[i]));
    *(u32x4*)(mix + (size_t)row * DM + lane * 8) = ov;
  }
}

struct EpiResid {
  const float* xin; float* xout; const float* gmod  ; int row0, col0;
  DI void operator()(f32x16 (&acc)[2][2], int wm, int wn, int lane) const {
    const int h = lane >> 5, cl = lane & 31;
#pragma unroll
    for (int mt = 0; mt < 2; ++mt) {
      const int row = row0 + wm * 64 + mt * 32 + cl;
      const float* gm = gmod + (size_t)(row >> 13) * 6144;
#pragma unroll
      for (int nt = 0; nt < 2; ++nt)
#pragma unroll
        for (int g = 0; g < 4; ++g) {
          const int col = col0 + wn * 64 + nt * 32 + 8 * g + 4 * h;
          const f32x4 xv = *(const f32x4*)(xin + (size_t)row * DM + col), g4 = *(const f32x4*)(gm + col);
          f32x4 ov;
#pragma unroll
          for (int r = 0; r < 4; ++r) ov[r] = xv[r] + g4[r] * acc[mt][nt][4 * g + r];
          *(f32x4*)(xout + (size_t)row * DM + col) = ov;
        }
    }
  }
};
DI void ph_gemm_resid(const P& p, char* lds, const bf16_t* A, const bf16_t* Bt, const float* xin, const float* gmod) {
  const int nM = TL / GBM, nN = DM / GBN;
  for (int t = blockIdx.x; t < nM * nN; t += gridDim.x) {
    const int pm = t / nN, pn = t % nN;
    RowLin rf{A + (size_t)pm * GBM * DM, (size_t)DM};
    EpiResid ep{xin, p.out, gmod, pm * GBM, pn * GBN};
    gemm_tile<true>(lds, rf, Bt + (size_t)pn * GBN * DM, DM, ep);
  }
}

struct EpiBf16 {
  bf16_t* o; int pitch, row0, col0;
  DI void operator()(f32x16 (&acc)[2][2], int wm, int wn, int lane) const {
    const int h = lane >> 5, cl = lane & 31;
#pragma unroll
    for (int mt = 0; mt < 2; ++mt) {
      const int row = row0 + wm * 64 + mt * 32 + cl;
#pragma unroll
      for (int nt = 0; nt < 2; ++nt)
#pragma unroll
        for (int g = 0; g < 4; ++g) {
          u32x2 v; v[0] = pk2(acc[mt][nt][4 * g], acc[mt][nt][4 * g + 1]); v[1] = pk2(acc[mt][nt][4 * g + 2], acc[mt][nt][4 * g + 3]);
          *(u32x2*)(o + (size_t)row * pitch + col0 + wn * 64 + nt * 32 + 8 * g + 4 * h) = v;
        }
    }
  }
};
DI void ph_gemm_scores(const P& p, char* lds, int layer, size_t sc_off) {
  const bf16_t* A = (const bf16_t*)(p.ws + R0); const bf16_t* Bt = (const bf16_t*)(p.ws + WS_WEFF) + (size_t)layer * 2048 * 1024;
  const int nM = TL / GBM, nN = 2048 / GBN;
  for (int t = blockIdx.x; t < nM * nN; t += gridDim.x) {
    const int pm = t / nN, pn = t % nN;
    RowLin rf{A + (size_t)pm * GBM * DM, (size_t)DM};
    EpiBf16 ep{(bf16_t*)(p.ws + sc_off), 2048, pm * GBM, pn * GBN};
    gemm_tile<true>(lds, rf, Bt + (size_t)pn * GBN * DM, DM, ep);
  }
}

constexpr size_t WS_TSC = WS_BA;
DI void ph_tables(const P& p) {
  const int lane = otid() & 63, gw = blockIdx.x * (NT / 64) + (otid() >> 6), nw_ = gridDim.x * (NT / 64);
  float* tsc = (float*)(p.ws + WS_TSC);
  for (int rr = gw; rr < 4 * 16384; rr += nw_) {
    const int tb = rr >> 14, e = rr & 16383;
    const float* src = ((tb & 1) ? p.peer_v : p.peer_u) + ((size_t)(tb >> 1) * 16384 + e) * 1024 + lane * 16;
    f32x4 v[4]; float ss = 0.f;
#pragma unroll
    for (int i = 0; i < 4; ++i) { v[i] = *(const f32x4*)(src + 4 * i); ss += v[i][0] * v[i][0] + v[i][1] * v[i][1] + v[i][2] * v[i][2] + v[i][3] * v[i][3]; }
    ss = wave_sum(ss);
    const bool isu = (tb & 1) == 0;
    const float sc = (isu ? 0.35f : 0.5f) * sqrtf(ss * (1.f / 1024.f)) + 1e-30f, inv = 1.f / sc;
    unsigned w0 = 0u, w1 = 0u;
    if (isu) {
#pragma unroll
      for (int i = 0; i < 2; ++i)
#pragma unroll
        for (int j = 0; j < 4; ++j) {
          const int qa = (int)fminf(fmaxf(rintf(v[i][j] * inv), -7.f), 7.f), qb = (int)fminf(fmaxf(rintf(v[2 + i][j] * inv), -7.f), 7.f);
          w0 |= ((unsigned)qa & 15u) << (4 * (4 * i + j)); w1 |= ((unsigned)qb & 15u) << (4 * (4 * i + j));
        }
    } else {
      w0 = __builtin_amdgcn_cvt_scalef32_pk_fp4_f32(w0, v[0][0] * inv, v[0][1] * inv, 1.0f, 0);
      w0 = __builtin_amdgcn_cvt_scalef32_pk_fp4_f32(w0, v[0][2] * inv, v[0][3] * inv, 1.0f, 1);
      w0 = __builtin_amdgcn_cvt_scalef32_pk_fp4_f32(w0, v[1][0] * inv, v[1][1] * inv, 1.0f, 2);
      w0 = __builtin_amdgcn_cvt_scalef32_pk_fp4_f32(w0, v[1][2] * inv, v[1][3] * inv, 1.0f, 3);
      w1 = __builtin_amdgcn_cvt_scalef32_pk_fp4_f32(w1, v[2][0] * inv, v[2][1] * inv, 1.0f, 0);
      w1 = __builtin_amdgcn_cvt_scalef32_pk_fp4_f32(w1, v[2][2] * inv, v[2][3] * inv, 1.0f, 1);
      w1 = __builtin_amdgcn_cvt_scalef32_pk_fp4_f32(w1, v[3][0] * inv, v[3][1] * inv, 1.0f, 2);
      w1 = __builtin_amdgcn_cvt_scalef32_pk_fp4_f32(w1, v[3][2] * inv, v[3][3] * inv, 1.0f, 3);
    }
    u32x2 o; o[0] = w0; o[1] = w1;
    unsigned char* dst = (unsigned char*)(p.ws + WS_TAB + (size_t)tb * 8 * MiB);
    *(u32x2*)(dst + ((((size_t)(lane >> 4)) * 16384 + e) << 7) + (lane & 15) * 8) = o;
    if (lane == 0) tsc[tb * 16384 + e] = sc;
  }
}

DI unsigned srt16(unsigned bf) { return (bf & 0x8000u) ? (~bf & 0xFFFFu) : (bf | 0x8000u); }
DI float unsrt16(unsigned s) { const unsigned bf = (s & 0x8000u) ? (s & 0x7FFFu) : (~s & 0xFFFFu); return __uint_as_float(bf << 16); }
DI unsigned ckey(float v, unsigned cid) { unsigned u = __float_as_uint(v); u = (u & 0x80000000u) ? ~u : (u | 0x80000000u); return (u & 0xFFFFFF00u) | (255u - cid); }
DI float unckey(unsigned k) { unsigned u = k & 0xFFFFFF00u; u = (u & 0x80000000u) ? (u & 0x7FFFFFFFu) : ~u; return __uint_as_float(u & 0xFFFFFF00u); }
DI void bsort16(unsigned (&k)[16]) {
#pragma unroll
  for (int sz = 2; sz <= 16; sz <<= 1)
#pragma unroll
    for (int j = sz >> 1; j > 0; j >>= 1)
#pragma unroll
      for (int i = 0; i < 16; ++i) {
        const int l = i ^ j;
        if (l > i) {
          const unsigned a = k[i], b = k[l], mx = a > b ? a : b, mn = a > b ? b : a;
          if ((i & sz) == 0) { k[i] = mx; k[l] = mn; } else { k[i] = mn; k[l] = mx; }
        }
      }
}
DI void bmerge16(unsigned (&k)[16]) {
#pragma unroll
  for (int j = 8; j > 0; j >>= 1)
#pragma unroll
    for (int i = 0; i < 16; ++i) {
      const int l = i ^ j;
      if (l > i) { const unsigned a = k[i], b = k[l]; k[i] = a > b ? a : b; k[l] = a > b ? b : a; }
    }
}
DI void topmerge16(unsigned (&run)[16], const unsigned (&g)[16]) {
#pragma unroll
  for (int i = 0; i < 16; ++i) run[i] = run[i] > g[15 - i] ? run[i] : g[15 - i];
  bmerge16(run);
}
DI void top16_of_128(const bf16_t* __restrict__ r, unsigned (&run)[16]) {
#pragma unroll 1
  for (int g = 0; g < 8; ++g) {
    const u32x4 v0 = *(const u32x4*)(r + g * 16), v1 = *(const u32x4*)(r + g * 16 + 8);
    unsigned k[16];
#pragma unroll
    for (int q = 0; q < 4; ++q) {
      k[2 * q] = (srt16(v0[q] & 0xFFFFu) << 16) | (127u - (g * 16 + 2 * q));
      k[2 * q + 1] = (srt16(v0[q] >> 16) << 16) | (127u - (g * 16 + 2 * q + 1));
      k[8 + 2 * q] = (srt16(v1[q] & 0xFFFFu) << 16) | (127u - (g * 16 + 8 + 2 * q));
      k[8 + 2 * q + 1] = (srt16(v1[q] >> 16) << 16) | (127u - (g * 16 + 8 + 2 * q + 1));
    }
    bsort16(k);
    if (g == 0) {
#pragma unroll
      for (int i = 0; i < 16; ++i) run[i] = k[i];
    } else topmerge16(run, k);
  }
}
DI void ph_topk(const P& p, char* lds, size_t sc_off, size_t ei_off, size_t eg_off) {
  const bf16_t* sc = (const bf16_t*)(p.ws + sc_off); int* EI = (int*)(p.ws + ei_off); float* EG = (float*)(p.ws + eg_off);
  unsigned char* sI = (unsigned char*)lds;
  const int tid = otid();
  const int tpb_ = TL / gridDim.x;
  for (int g = blockIdx.x * tpb_ * 8 + tid; g < (blockIdx.x + 1) * tpb_ * 8; g += NT) {
    const int t = g >> 3, head = g & 7;
    const bf16_t* r1 = sc + (size_t)t * 2048 + head * 256;
    unsigned k1[16], k2[16];
    top16_of_128(r1, k1);
    top16_of_128(r1 + 128, k2);
    float f1[16], f2[16];
#pragma unroll
    for (int i = 0; i < 16; ++i) { f1[i] = unsrt16(k1[i] >> 16); f2[i] = unsrt16(k2[i] >> 16); sI[i * NT + tid] = (unsigned char)(127u - (k1[i] & 127u)); sI[(16 + i) * NT + tid] = (unsigned char)(127u - (k2[i] & 127u)); }
    unsigned cg0[16], cg1[16], cg2[16], cg3[16];
#pragma unroll
    for (int i = 0; i < 16; ++i) { cg3[i] = 0u; }
    cg0[0] = ckey(f1[0] + f2[0], 0);
    cg0[1] = ckey(f1[0] + f2[1], 1);
    cg0[2] = ckey(f1[0] + f2[2], 2);
    cg0[3] = ckey(f1[0] + f2[3], 3);
    cg0[4] = ckey(f1[0] + f2[4], 4);
    cg0[5] = ckey(f1[0] + f2[5], 5);
    cg0[6] = ckey(f1[0] + f2[6], 6);
    cg0[7] = ckey(f1[0] + f2[7], 7);
    cg0[8] = ckey(f1[0] + f2[8], 8);
    cg0[9] = ckey(f1[0] + f2[9], 9);
    cg0[10] = ckey(f1[0] + f2[10], 10);
    cg0[11] = ckey(f1[0] + f2[11], 11);
    cg0[12] = ckey(f1[0] + f2[12], 12);
    cg0[13] = ckey(f1[0] + f2[13], 13);
    cg0[14] = ckey(f1[0] + f2[14], 14);
    cg0[15] = ckey(f1[0] + f2[15], 15);
    cg1[0] = ckey(f1[1] + f2[0], 16);
    cg1[1] = ckey(f1[1] + f2[1], 17);
    cg1[2] = ckey(f1[1] + f2[2], 18);
    cg1[3] = ckey(f1[1] + f2[3], 19);
    cg1[4] = ckey(f1[1] + f2[4], 20);
    cg1[5] = ckey(f1[1] + f2[5], 21);
    cg1[6] = ckey(f1[1] + f2[6], 22);
    cg1[7] = ckey(f1[1] + f2[7], 23);
    cg1[8] = ckey(f1[2] + f2[0], 32);
    cg1[9] = ckey(f1[2] + f2[1], 33);
    cg1[10] = ckey(f1[2] + f2[2], 34);
    cg1[11] = ckey(f1[2] + f2[3], 35);
    cg1[12] = ckey(f1[2] + f2[4], 36);
    cg1[13] = ckey(f1[3] + f2[0], 48);
    cg1[14] = ckey(f1[3] + f2[1], 49);
    cg1[15] = ckey(f1[3] + f2[2], 50);
    cg2[0] = ckey(f1[3] + f2[3], 51);
    cg2[1] = ckey(f1[4] + f2[0], 64);
    cg2[2] = ckey(f1[4] + f2[1], 65);
    cg2[3] = ckey(f1[4] + f2[2], 66);
    cg2[4] = ckey(f1[5] + f2[0], 80);
    cg2[5] = ckey(f1[5] + f2[1], 81);
    cg2[6] = ckey(f1[6] + f2[0], 96);
    cg2[7] = ckey(f1[6] + f2[1], 97);
    cg2[8] = ckey(f1[7] + f2[0], 112);
    cg2[9] = ckey(f1[7] + f2[1], 113);
    cg2[10] = ckey(f1[8] + f2[0], 128);
    cg2[11] = ckey(f1[9] + f2[0], 144);
    cg2[12] = ckey(f1[10] + f2[0], 160);
    cg2[13] = ckey(f1[11] + f2[0], 176);
    cg2[14] = ckey(f1[12] + f2[0], 192);
    cg2[15] = ckey(f1[13] + f2[0], 208);
    cg3[0] = ckey(f1[14] + f2[0], 224);
    cg3[1] = ckey(f1[15] + f2[0], 240);
    bsort16(cg0); bsort16(cg1); bsort16(cg2); bsort16(cg3);
    topmerge16(cg0, cg1); topmerge16(cg2, cg3); topmerge16(cg0, cg2);
    float e[16]; int id[16]; float sum = 0.f; const float s0 = unckey(cg0[0]);
#pragma unroll
    for (int k = 0; k < 16; ++k) {
      const unsigned cid = 255u - (cg0[k] & 255u);
      e[k] = __expf(unckey(cg0[k]) - s0); sum += e[k];
      id[k] = (int)sI[(cid >> 4) * NT + tid] * 128 + (int)sI[(16 + (cid & 15)) * NT + tid];
    }
    const float inv = 1.f / sum;
#pragma unroll
    for (int k = 0; k < 16; k += 4) {
      int4 iv = {id[k], id[k + 1], id[k + 2], id[k + 3]}; f32x4 gv = {e[k] * inv, e[k + 1] * inv, e[k + 2] * inv, e[k + 3] * inv};
      *(int4*)(EI + (size_t)g * 16 + k) = iv; *(f32x4*)(EG + (size_t)g * 16 + k) = gv;
    }
  }
}

DI void fp8x16_to_f32(const u32x4& w, float (&f)[16]) {
#pragma unroll
  for (int i = 0; i < 4; ++i) {
    const f32x2_t lo = __builtin_amdgcn_cvt_pk_f32_fp8((int)w[i], false), hi = __builtin_amdgcn_cvt_pk_f32_fp8((int)w[i], true);
    f[4 * i] = lo[0]; f[4 * i + 1] = lo[1]; f[4 * i + 2] = hi[0]; f[4 * i + 3] = hi[1];
  }
}
DI void block_handoff() {
  asm volatile("s_waitcnt vmcnt(0)" ::: "memory");
  __syncthreads();
  if (otid() == 0) { __builtin_amdgcn_fence(__ATOMIC_ACQUIRE, "agent"); asm volatile("s_waitcnt vmcnt(0)" ::: "memory"); }
  __syncthreads();
}
constexpr int PQ_NS = 4;
#define PQ_BEGIN() \
  const int tid = otid(), lane = tid & 63, wave = tid >> 6, g8 = lane >> 3, c16 = lane & 7; \
  const int tpb_ = TL / gridDim.x; \
  _Pragma("unroll 1") for (int x = 0; x < PQ_NS; ++x) { \
    const int tbeg = blockIdx.x * tpb_ + wave, tend = (blockIdx.x + 1) * tpb_;
#define PQ_END() }
#define FP4X8(wd, o0, o1, o2, o3) do { o0 = __builtin_amdgcn_cvt_scalef32_pk_f32_fp4((wd), 1.0f, 0); o1 = __builtin_amdgcn_cvt_scalef32_pk_f32_fp4((wd), 1.0f, 1); \
                                         o2 = __builtin_amdgcn_cvt_scalef32_pk_f32_fp4((wd), 1.0f, 2); o3 = __builtin_amdgcn_cvt_scalef32_pk_f32_fp4((wd), 1.0f, 3); } while (0)
DI void ph_peer_u(const P& p, char* lds, int layer, size_t ei_off, size_t part_off) {
  for (int rep = 0; rep <= p.lo; ++rep) {
  PQ_BEGIN()
  const unsigned char* hq = (const unsigned char*)(p.ws + WS_HQ) + x * 128 + c16 * 16;
  const float* hs = (const float*)(p.ws + WS_HS);
  const unsigned char* us = (const unsigned char*)(p.ws + WS_TAB + (size_t)(layer * 2) * 8 * MiB) + ((size_t)x * 16384 << 7) + c16 * 16;
  const int* EI = (const int*)(p.ws + ei_off) + g8 * 16;
  unsigned* part = (unsigned*)(p.ws + part_off);
  int4 nid[4]; u32x4 nhh, nhl; float nsc;
#define PU_PREF(tt) do { const int t_ = (tt) < tend ? (tt) : tend - 1; \
    _Pragma("unroll") for (int i = 0; i < 4; ++i) nid[i] = *(const int4*)(EI + (size_t)t_ * 128 + i * 4); \
    nhh = *(const u32x4*)(hq + (size_t)t_ * 1024); nhl = *(const u32x4*)(hq + (size_t)t_ * 1024 + 512); nsc = hs[t_]; } while (0)
  PU_PREF(tbeg);
#pragma unroll 1
  for (int t = tbeg; t < tend; t += NT / 64) {
    int id[16];
#pragma unroll
    for (int i = 0; i < 4; ++i) { id[4 * i] = nid[i].x; id[4 * i + 1] = nid[i].y; id[4 * i + 2] = nid[i].z; id[4 * i + 3] = nid[i].w; }
    const u32x4 hh = nhh, hl = nhl; const float sct = nsc;
    u32x4 ur[16];
#pragma unroll
    for (int i = 0; i < 16; ++i) ur[i] = *(const u32x4*)(us + ((size_t)id[i] << 7));
    float pd[16];
#pragma unroll
    for (int i = 0; i < 16; ++i) {
      int ah = 0, al = 0;
#pragma unroll
      for (int w = 0; w < 4; ++w) { ah = __builtin_amdgcn_sdot8((int)ur[i][w], (int)hh[w], ah, false); al = __builtin_amdgcn_sdot8((int)ur[i][w], (int)hl[w], al, false); }
      pd[i] = (float)(16 * ah + al);
    }
    PU_PREF(t + NT / 64);
    float q8[8], q4[4], q2[2];
    { const bool up = (lane & 4) != 0;
#pragma unroll
      for (int m = 0; m < 8; ++m) { const float keep = up ? pd[8 + m] : pd[m], send = up ? pd[m] : pd[8 + m]; q8[m] = keep + __shfl_xor(send, 4, 64); } }
    { const bool up = (lane & 2) != 0;
#pragma unroll
      for (int m = 0; m < 4; ++m) { const float keep = up ? q8[4 + m] : q8[m], send = up ? q8[m] : q8[4 + m]; q4[m] = keep + __shfl_xor(send, 2, 64); } }
    { const bool up = (lane & 1) != 0;
#pragma unroll
      for (int m = 0; m < 2; ++m) { const float keep = up ? q4[2 + m] : q4[m], send = up ? q4[m] : q4[2 + m]; q2[m] = keep + __shfl_xor(send, 1, 64); } }
    part[((size_t)t * PQ_NS + x) * 64 + lane] = pk2(q2[0] * sct, q2[1] * sct);
  }
  PQ_END()
  }
#undef PU_PREF
}
DI void ph_peer_comb(const P& p, int layer, size_t part_off, size_t ei_off, size_t eg_off, size_t w_off) {
  const unsigned* part = (const unsigned*)(p.ws + part_off); const float* EG = (const float*)(p.ws + eg_off); const int* EI = (const int*)(p.ws + ei_off); float* W = (float*)(p.ws + w_off);
  const float* su = (const float*)(p.ws + WS_TSC) + (size_t)(layer * 2) * 16384; const float* sv = su + 16384;
  const int tpbc_ = TL / gridDim.x;
  for (int g = blockIdx.x * tpbc_ * 64 + otid(); g < (blockIdx.x + 1) * tpbc_ * 64; g += NT) {
    const int t = g >> 6, j = g & 63;
    float d0 = 0.f, d1 = 0.f;
#pragma unroll
    for (int x = 0; x < PQ_NS; ++x) { const unsigned v = part[((size_t)t * PQ_NS + x) * 64 + j]; d0 += bflo(v); d1 += bfhi(v); }
    const f32x2_t gt = *(const f32x2_t*)(EG + (size_t)t * 128 + 2 * j);
    const int e0 = EI[(size_t)t * 128 + 2 * j], e1 = EI[(size_t)t * 128 + 2 * j + 1];
    f32x2_t o; o[0] = gelu_tanh(d0 * su[e0]) * gt[0] * sv[e0]; o[1] = gelu_tanh(d1 * su[e1]) * gt[1] * sv[e1];
    *(f32x2_t*)(W + (size_t)t * 128 + 2 * j) = o;
  }
}
DI void ph_peer_v(const P& p, char* lds, int layer, size_t ei_off, size_t w_off) {
  PQ_BEGIN()
  const unsigned char* vs = (const unsigned char*)(p.ws + WS_TAB + (size_t)(layer * 2 + 1) * 8 * MiB) + ((size_t)x * 16384 << 7) + c16 * 16;
  const int* EI = (const int*)(p.ws + ei_off) + g8 * 16; const float* W = (const float*)(p.ws + w_off) + g8 * 16;
  const float* modb = (const float*)(p.ws + WS_MOD) + (size_t)layer * 5 * 6144;
  const int col = x * 256 + 32 * (lane & 7) + 4 * (lane >> 3);
  int4 nid[4]; f32x4 nw[4];
#define PV_PREF(tt) do { const int t_ = (tt) < tend ? (tt) : tend - 1; \
    _Pragma("unroll") for (int i = 0; i < 4; ++i) { nid[i] = *(const int4*)(EI + (size_t)t_ * 128 + i * 4); nw[i] = *(const f32x4*)(W + (size_t)t_ * 128 + i * 4); } } while (0)
  PV_PREF(tbeg);
#pragma unroll 1
  for (int t = tbeg; t < tend; t += NT / 64) {
    int id[16]; float wv[16];
#pragma unroll
    for (int i = 0; i < 4; ++i) { id[4 * i] = nid[i].x; id[4 * i + 1] = nid[i].y; id[4 * i + 2] = nid[i].z; id[4 * i + 3] = nid[i].w; wv[4 * i] = nw[i][0]; wv[4 * i + 1] = nw[i][1]; wv[4 * i + 2] = nw[i][2]; wv[4 * i + 3] = nw[i][3]; }
    u32x4 vr[16];
#pragma unroll
    for (int i = 0; i < 16; ++i) vr[i] = *(const u32x4*)(vs + ((size_t)id[i] << 7));
    f32x2_t acc2[16];
#pragma unroll
    for (int j = 0; j < 16; ++j) acc2[j] = f32x2_t{0.f, 0.f};
#pragma unroll
    for (int i = 0; i < 16; ++i) {
      const f32x2_t w2 = {wv[i], wv[i]};
#pragma unroll
      for (int w = 0; w < 4; ++w) {
        f32x2_t f0, f1, f2, f3; FP4X8(vr[i][w], f0, f1, f2, f3);
        acc2[4 * w] = f0 * w2 + acc2[4 * w]; acc2[4 * w + 1] = f1 * w2 + acc2[4 * w + 1]; acc2[4 * w + 2] = f2 * w2 + acc2[4 * w + 2]; acc2[4 * w + 3] = f3 * w2 + acc2[4 * w + 3];
      }
    }
    PV_PREF(t + NT / 64);
    float acc[32];
#pragma unroll
    for (int j = 0; j < 16; ++j) { acc[2 * j] = acc2[j][0]; acc[2 * j + 1] = acc2[j][1]; }
    float q16[16], q8[8], q4[4];
    { const bool up = (lane & 32) != 0;
#pragma unroll
      for (int m = 0; m < 16; ++m) { const float keep = up ? acc[16 + m] : acc[m], send = up ? acc[m] : acc[16 + m]; q16[m] = keep + __shfl_xor(send, 32, 64); } }
    { const bool up = (lane & 16) != 0;
#pragma unroll
      for (int m = 0; m < 8; ++m) { const float keep = up ? q16[8 + m] : q16[m], send = up ? q16[m] : q16[8 + m]; q8[m] = keep + __shfl_xor(send, 16, 64); } }
    { const bool up = (lane & 8) != 0;
#pragma unroll
      for (int m = 0; m < 4; ++m) { const float keep = up ? q8[4 + m] : q8[m], send = up ? q8[m] : q8[4 + m]; q4[m] = keep + __shfl_xor(send, 8, 64); } }
    float* xr = p.out + (size_t)t * DM + col;
    const f32x4 xv = *(const f32x4*)xr, g2 = *(const f32x4*)(modb + (size_t)(t >> 13) * 6144 + 5 * 1024 + col);
    f32x4 ov;
#pragma unroll
    for (int m = 0; m < 4; ++m) ov[m] = xv[m] + g2[m] * q4[m];
    *(f32x4*)xr = ov;
  }
  PQ_END()
#undef PV_PREF
}
DI void ph_final_norm(const P& p, int r0, int r1) {
  const int lane = otid() & 63;
  for (int row = r0 + (otid() >> 6); row < r1; row += NT / 64) {
    float* xr = p.out + (size_t)row * DM;
    f32x4 xv[4]; float ss = 0.f;
#pragma unroll
    for (int i = 0; i < 4; ++i) { xv[i] = *(const f32x4*)(xr + lane * 4 + 256 * i); ss += xv[i][0] * xv[i][0] + xv[i][1] * xv[i][1] + xv[i][2] * xv[i][2] + xv[i][3] * xv[i][3]; }
    ss = wave_sum(ss);
    const float rs = rsqrtf(ss * (1.f / DM) + EPS);
#pragma unroll
    for (int i = 0; i < 4; ++i) { const f32x4 w4 = *(const f32x4*)(p.final_norm_w + lane * 4 + 256 * i); *(f32x4*)(xr + lane * 4 + 256 * i) = xv[i] * rs * w4; }
  }
}

struct RowFft0 { const bf16_t* base; DI const bf16_t* operator()(int r) const { return base + ((size_t)128 * (r & 63) + (r >> 6)) * DM; } };
struct EpiFft0 {
  bf16_t* zt; int bg, l20, col0;
  DI void operator()(f32x16 (&acc)[2][2], int wm, int wn, int lane) const {
    const int h = lane >> 5, cl = lane & 31;
#pragma unroll
    for (int mt = 0; mt < 2; ++mt)
#pragma unroll
      for (int nt = 0; nt < 2; ++nt) {
        const int n = col0 + wn * 64 + nt * 32 + cl, ri = n >> 8, mm = n & 255;
#pragma unroll
        for (int g = 0; g < 4; ++g) {
          const int r = wm * 64 + mt * 32 + 8 * g + 4 * h, l1 = r & 63, l2 = l20 + (r >> 6);
          u32x2 v; v[0] = pk2(acc[mt][nt][4 * g], acc[mt][nt][4 * g + 1]); v[1] = pk2(acc[mt][nt][4 * g + 2], acc[mt][nt][4 * g + 3]);
          *(u32x2*)(zt + (((size_t)(bg * 256 + mm) * 128 + l2) * 128 + ri * 64 + l1)) = v;
        }
      }
  }
};
DI void ph_fft0(const P& p, char* lds) {
  const bf16_t* h1 = (const bf16_t*)(p.ws + R0); const bf16_t* Bt = (const bf16_t*)(p.ws + WS_DFT0);
  for (int t = blockIdx.x; t < NB * 4 * 32 * 4; t += gridDim.x) {
    const int pn = t & 3, l2b = (t >> 2) & 31, g = (t >> 7) & 3, b = t >> 9;
    RowFft0 rf{h1 + ((size_t)b * SEQ + l2b * 4) * DM + g * 256};
    EpiFft0 ep{(bf16_t*)(p.ws + WS_ZT), b * 4 + g, l2b * 4, pn * GBN};
    gemm_tile<false>(lds, rf, Bt + (size_t)pn * GBN * 256, 256, ep);
  }
}
struct EpiFft1 {
  bf16_t* a2; int row0;
  DI void operator()(f32x16 (&acc)[2][2], int wm, int wn, int lane) const {
    const int h = lane >> 5, cl = lane & 31, k1 = 32 * wn + cl;
#pragma unroll
    for (int mt = 0; mt < 2; ++mt)
#pragma unroll
      for (int g = 0; g < 4; ++g) {
        const int R = row0 + wm * 64 + mt * 32 + 8 * g + 4 * h, l2 = R & 127, mm = (R >> 7) & 255, bg = R >> 15;
        float yr[4], yi[4];
#pragma unroll
        for (int q = 0; q < 4; ++q) {
          const float fr = (float)((l2 + q) * k1) * (1.f / 8192.f);
          const float cs = __builtin_amdgcn_cosf(fr), sn = __builtin_amdgcn_sinf(fr);
          const float ar = acc[mt][0][4 * g + q], ai = acc[mt][1][4 * g + q];
          yr[q] = ar * cs + ai * sn; yi[q] = ai * cs - ar * sn;
        }
        bf16_t* o = a2 + (((size_t)(bg * 64 + k1) * 256 + mm) * 256 + l2);
        u32x2 v; v[0] = pk2(yr[0], yr[1]); v[1] = pk2(yr[2], yr[3]); *(u32x2*)o = v;
        v[0] = pk2(yi[0], yi[1]); v[1] = pk2(yi[2], yi[3]); *(u32x2*)(o + 128) = v;
      }
  }
};
DI void ph_fft1(const P& p, char* lds) {
  const bf16_t* zt = (const bf16_t*)(p.ws + WS_ZT); const bf16_t* Bt = (const bf16_t*)(p.ws + WS_DFT1);
  const int nM = 16 * 256 * 128 / GBM;
  for (int t = blockIdx.x; t < nM; t += gridDim.x) {
    RowLin rf{zt + (size_t)t * GBM * 128, (size_t)128};
    EpiFft1 ep{(bf16_t*)(p.ws + WS_A2), t * GBM};
    gemm_tile<false>(lds, rf, Bt, 128, ep);
  }
}
struct EpiFft3 {
  bf16_t* fm; int row0;
  DI void operator()(f32x16 (&acc)[2][2], int wm, int wn, int lane) const {
    const int h = lane >> 5, cl = lane & 31;
#pragma unroll
    for (int mt = 0; mt < 2; ++mt)
#pragma unroll
      for (int nt = 0; nt < 2; ++nt) {
        const int k2 = wn * 64 + nt * 32 + cl;
#pragma unroll
        for (int g = 0; g < 4; ++g) {
          const int R = row0 + wm * 64 + mt * 32 + 8 * g + 4 * h, mm = R & 255, k1 = (R >> 8) & 63, bg = R >> 14;
          u32x2 v; v[0] = pk2(acc[mt][nt][4 * g], acc[mt][nt][4 * g + 1]); v[1] = pk2(acc[mt][nt][4 * g + 2], acc[mt][nt][4 * g + 3]);
          *(u32x2*)(fm + ((size_t)((bg >> 2) * SEQ + k1 + 64 * k2)) * DM + (bg & 3) * 256 + mm) = v;
        }
      }
  }
};
DI void ph_fft3(const P& p, char* lds) {
  const bf16_t* a2 = (const bf16_t*)(p.ws + WS_A2); const bf16_t* Bt = (const bf16_t*)(p.ws + WS_DFT3);
  const int nM = 16 * 64 * 256 / GBM;
  for (int t = blockIdx.x; t < nM; t += gridDim.x) {
    RowLin rf{a2 + (size_t)t * GBM * 256, (size_t)256};
    EpiFft3 ep{(bf16_t*)(p.ws + WS_FM), t * GBM};
    gemm_tile<false>(lds, rf, Bt, 256, ep);
  }
}

constexpr int NPHASE = 19;
template <int PH>
DI void run_phase(const P& p, char* lds) {
  const float* modL = (const float*)(p.ws + WS_MOD);
  const int tpb = TL / gridDim.x, t0 = blockIdx.x * tpb, t1 = t0 + tpb;
  if constexpr (PH == 0) ph_setup(p, lds);
  else if constexpr (PH == 1) { norm_rows_i8(p.x, 0, TL, p.norm1_w, modL, false, (unsigned char*)(p.ws + R0), (float*)(p.ws + WS_HS0));
                                norm_rows_i8(p.ctx - (size_t)TL * DM, TL, TA, p.norm1_w, modL, true, (unsigned char*)(p.ws + R0), (float*)(p.ws + WS_HS0));
                                quant_rows_i8((const bf16_t*)(p.ws + WS_WIN), NIN, (unsigned char*)(p.ws + WS_WIN8), (float*)(p.ws + WS_SWIN)); }
  else if constexpr (PH == 2) { PgProj ep{&p}; pg8_run_i8(lds, p.ws + R0, p.ws + WS_WIN8, TA, NIN, 1024, ep); }
  else if constexpr (PH == 3) ph_gdn_prep<0>(p, lds);
  else if constexpr (PH == 4) { if (blockIdx.x >= 64) { ph_vt8(p, lds); cvt_fp8((const bf16_t*)(p.ws + WS_Q), (unsigned char*)(p.ws + WS_Q8), TL * 512 / 16, 64.f);
                                                        cvt_fp8((const bf16_t*)(p.ws + WS_K), (unsigned char*)(p.ws + WS_K8), NB * KVL * 512 / 16, 16.f); }
                                else ph_gdn_scan<0>(p, lds); }
  else if constexpr (PH == 5) { ph_attn(p, lds); ph_mixout(p); }
  else if constexpr (PH == 6) { PgResid ep{p.x, p.out, modL + 2 * 1024}; pg8_run(lds, (const bf16_t*)(p.ws + WS_MIX), (const bf16_t*)(p.ws + WS_WOUT), TL, DM, DM, ep); }
  else if constexpr (PH == 7) { norm_rows_hq(p, p.norm2_w, modL); quant_rows_i8((const bf16_t*)(p.ws + WS_WEFF), 4096, (unsigned char*)(p.ws + WS_WEFF8), (float*)(p.ws + WS_SW)); ph_tables(p); }
  else if constexpr (PH == 8) { PgScoreI8 ep{(bf16_t*)(p.ws + WS_SC0), (const float*)(p.ws + WS_HS), (const float*)(p.ws + WS_SW)}; pg8_run_i8(lds, p.ws + R0, p.ws + WS_WEFF8, TL, 2048, 1024, ep); }
  else if constexpr (PH == 9) { ph_topk(p, lds, WS_SC0, WS_EI0, WS_EG0); block_handoff(); ph_peer_u(p, lds, 0, WS_EI0, WS_PART0); }
  else if constexpr (PH == 10) { ph_peer_comb(p, 0, WS_PART0, WS_EI0, WS_EG0, WS_W0); block_handoff(); ph_peer_v(p, lds, 0, WS_EI0, WS_W0); block_handoff();
                                 norm_rows(p.out, t0, t1, p.norm1_w + DM, modL + 5 * 6144, 0, 1, false, (bf16_t*)(p.ws + R0), true); }
  else if constexpr (PH == 11) ph_fft0(p, lds);
  else if constexpr (PH == 12) ph_fft1(p, lds);
  else if constexpr (PH == 13) ph_fft3(p, lds);
  else if constexpr (PH == 14) { PgResid ep{p.out, p.out, modL + 5 * 6144 + 2 * 1024}; pg8_run(lds, (const bf16_t*)(p.ws + WS_FM), (const bf16_t*)(p.ws + WS_WF), TL, DM, DM, ep); }
  else if constexpr (PH == 15) norm_rows_hq(p, p.norm2_w + DM, modL + 5 * 6144);
  else if constexpr (PH == 16) { PgScoreI8 ep{(bf16_t*)(p.ws + WS_SC1), (const float*)(p.ws + WS_HS), (const float*)(p.ws + WS_SW) + 2048}; pg8_run_i8(lds, p.ws + R0, p.ws + WS_WEFF8 + (size_t)2048 * 1024, TL, 2048, 1024, ep); }
  else if constexpr (PH == 17) { ph_topk(p, lds, WS_SC1, WS_EI1, WS_EG1); block_handoff(); ph_peer_u(p, lds, 1, WS_EI1, WS_PART1); }
  else if constexpr (PH == 18) { ph_peer_comb(p, 1, WS_PART1, WS_EI1, WS_EG1, WS_W1); block_handoff(); ph_peer_v(p, lds, 1, WS_EI1, WS_W1); block_handoff(); ph_final_norm(p, t0, t1); }
}
#define XB_TMO      128
#define XB_XCNT(j)  (256  + 64 * (j))
#define XB_XSUB(j)  (1280 + 64 * (j))
#define XB_XGEN(j)  (2304 + 64 * (j))
#define XB_TOP      3328
#define XB_TOPGEN   3392
#define XCD_BAR_WORDS 3456
#define XB_SPIN_CAP (1u << 22)
#define LAS __attribute__((address_space(3)))
#define XB_SPIN(cond, bar) do { unsigned _sp = 0; while (cond) { __builtin_amdgcn_s_sleep(1); \
    if ((++_sp & 255u) == 0u) { if (xb_ld(&(bar)[XB_TMO])) break; if (_sp > XB_SPIN_CAP) { atomicAdd(&(bar)[XB_TMO], 1u); break; } } } } while (0)
struct XcdBarrier { unsigned* bar; unsigned x; volatile LAS unsigned* st; };
DI XcdBarrier xcd_barrier_post(unsigned* bar, volatile LAS unsigned* st) {
  XcdBarrier b; b.bar = bar; b.x = xb_xcc_id(); b.st = st;
  if (threadIdx.x == 0) (void)xb_add(&bar[XB_XCNT(b.x)], 1u);
  return b;
}
DI void xcd_barrier_complete(unsigned* bar, unsigned x, unsigned& nloc, unsigned& nx) {
  const unsigned G = gridDim.x * gridDim.y * gridDim.z;
  unsigned sum, cnt, mine, sp = 0u;
  for (;;) {
    sum = 0u; cnt = 0u; mine = 0u;
#pragma unroll
    for (unsigned j = 0; j < 16; ++j) { const unsigned c = xb_ld(&bar[XB_XCNT(j)]); sum += c; cnt += (c > 0u) ? 1u : 0u; mine = (j == x) ? c : mine; }
    if (sum == G) break;
    __builtin_amdgcn_s_sleep(1);
    if ((++sp & 255u) == 0u) { if (xb_ld(&bar[XB_TMO])) break; if (sp > XB_SPIN_CAP) { atomicAdd(&bar[XB_TMO], 1u); break; } }
  }
  nloc = mine > 0u ? mine : 1u; nx = cnt > 0u ? cnt : 1u;
}
DI void xcd_barrier(const XcdBarrier& b) {
  asm volatile("s_waitcnt vmcnt(0)" ::: "memory");
  __syncthreads();
  if (threadIdx.x == 0) {
    unsigned* bar = b.bar;
    __builtin_amdgcn_s_waitcnt(0);
    unsigned nloc = b.st[0], nx = b.st[1];
    if (nloc == 0u) { xcd_barrier_complete(bar, b.x, nloc, nx); b.st[0] = nloc; b.st[1] = nx; }
    const unsigned old = xb_add(&bar[XB_XSUB(b.x)], 1u);
    const unsigned gen = old / nloc;
    if (old + 1u == (gen + 1u) * nloc) {
      __builtin_amdgcn_fence(__ATOMIC_RELEASE, "agent");
      asm volatile("s_waitcnt vmcnt(0)" ::: "memory");
      const unsigned og = xb_add(&bar[XB_TOP], 1u);
      const unsigned tg = og / nx;
      if (og + 1u == (tg + 1u) * nx) xb_add(&bar[XB_TOPGEN], 1u);
      else XB_SPIN(xb_ld(&bar[XB_TOPGEN]) == tg, bar);
      __builtin_amdgcn_fence(__ATOMIC_ACQUIRE, "agent");
      xb_add(&bar[XB_XGEN(b.x)], 1u);
      asm volatile("s_waitcnt vmcnt(0)" ::: "memory");
    } else {
      XB_SPIN(xb_ld(&bar[XB_XGEN(b.x)]) == gen, bar);
      __builtin_amdgcn_fence(__ATOMIC_ACQUIRE, "agent");
      asm volatile("s_waitcnt vmcnt(0)" ::: "memory");
    }
  }
  __syncthreads();
}

constexpr int EXTRA_PHASE = -1;
constexpr int PROBE_MODE = 0;
template <int PH>
DI void run_all(const P& p, char* lds, const XcdBarrier& bar) {
  run_phase<PH>(p, lds);
  if constexpr (PH == EXTRA_PHASE) {
    xcd_barrier(bar);
    if constexpr (PH == 3) ph_gdn_prep<PROBE_MODE>(p, lds);
    else if constexpr (PH == 4) ph_gdn_scan<PROBE_MODE>(p, lds);
    else run_phase<PH>(p, lds);
  }
  if constexpr (PH + 1 < NPHASE) {
    if constexpr (PH == 0) { cg::this_grid().sync(); }
    else xcd_barrier(bar);
    run_all<PH + 1>(p, lds, bar);
  }
}
__global__ void __launch_bounds__(NT) mega(P p) {
  extern __shared__ __attribute__((aligned(16))) char lds[];
  volatile LAS unsigned* st = (volatile LAS unsigned*)(lds + LDS_BYTES - 16);
  if (threadIdx.x == 0) { st[0] = 0u; st[1] = 0u; }
  __syncthreads();
  XcdBarrier bar = xcd_barrier_post((unsigned*)(p.ws + WS_CTL), st);
  run_all<0>(p, lds, bar);
}

extern "C" void kernel_launch(void* const* d_in, const int* in_sizes, int n_in, void* d_out, int out_size, void* d_ws, size_t ws_size, hipStream_t stream) {
  static int grid = 0;
  if (grid == 0) {
    if (n_in != 25 || ws_size < WS_END) { fprintf(stderr, "kernel_launch: unexpected n_in %d or ws_size %zu\n", n_in, ws_size); grid = -1; return; }
    int dev = 0, cus = 0, per_cu = 0;
    (void)hipGetDevice(&dev); (void)hipDeviceGetAttribute(&cus, hipDeviceAttributeMultiprocessorCount, dev);
    (void)hipFuncSetAttribute((const void*)mega, hipFuncAttributeMaxDynamicSharedMemorySize, LDS_BYTES);
    if (hipOccupancyMaxActiveBlocksPerMultiprocessor(&per_cu, (const void*)mega, NT, LDS_BYTES) != hipSuccess || per_cu < 1) { fprintf(stderr, "kernel_launch: occupancy query failed (%d)\n", per_cu); per_cu = 1; }
    (void)hipGetLastError();
    if (per_cu > 1) per_cu = 1;
    grid = (cus > 0 ? cus : 256) * per_cu;
  }
  if (grid < 0) return;
  (void)hipMemsetAsync((char*)d_ws + WS_CTL, 0, CTL_ZERO_BYTES, stream);
  P p{};
  const float** pf = (const float**)&p;
  for (int i = 0; i < 25; ++i) pf[i] = (const float*)d_in[i];
  p.out = (float*)d_out; p.ws = (char*)d_ws; p.lo = 0; p.hi = NPHASE;
  void* args[] = {&p};
  hipError_t e = hipLaunchCooperativeKernel((const void*)mega, dim3(grid), dim3(NT), args, LDS_BYTES, stream);
  if (e != hipSuccess) fprintf(stderr, "cooperative launch failed: %s (grid %d)\n", hipGetErrorString(e), grid);
}
```

```cpp
#include <hip/hip_runtime.h>
#include <hip/hip_cooperative_groups.h>
#include <cstdio>
#include <cstdint>
namespace cg = cooperative_groups;

#define DI __device__ __forceinline__
typedef unsigned short bf16_t;
typedef short bf16x8 __attribute__((ext_vector_type(8)));
typedef short s16x4 __attribute__((ext_vector_type(4)));
typedef float f32x16 __attribute__((ext_vector_type(16)));
typedef float f32x4 __attribute__((ext_vector_type(4)));
typedef float f32x2_t __attribute__((ext_vector_type(2)));
typedef __bf16 bf16x2_t __attribute__((ext_vector_type(2)));
typedef unsigned u32x4 __attribute__((ext_vector_type(4)));
typedef unsigned u32x2 __attribute__((ext_vector_type(2)));
typedef int v8i_t __attribute__((ext_vector_type(8)));

constexpr int NB = 4, SEQ = 8192, DM = 1024, CTXL = 256;
constexpr int TL = NB * SEQ;
constexpr int TC = NB * CTXL;
constexpr int TA = TL + TC;
constexpr int KVL = SEQ + CTXL;
constexpr int NIN = 3840;
constexpr int NCH = 132;
constexpr float EPS = 1e-6f;
constexpr int NT = 512;

constexpr size_t MiB = 1u << 20;
constexpr size_t WS_CTL = 0, WS_MOD = 64 * 1024, CTL_ZERO_BYTES = 512 * 1024;
constexpr size_t WS_ROPE = 1 * MiB, WS_WIN = 3 * MiB, WS_WOUT = 11 * MiB, WS_WF = 13 * MiB, WS_WEFF = 15 * MiB;
constexpr size_t WS_DFT0 = 23 * MiB, WS_DFT1 = 23 * MiB + 256 * 1024, WS_DFT3 = 23 * MiB + 512 * 1024;
constexpr size_t WS_BA = 24 * MiB, WS_GC = 29 * MiB;
constexpr size_t R0 = 32 * MiB, R1 = 98 * MiB, R2 = 197 * MiB, R3 = 329 * MiB, WS_END = 459 * MiB;
constexpr size_t WS_QN = R0, WS_KN = R0 + 33 * MiB;
constexpr size_t WS_QKVRAW = R1, WS_OBUF = R1;
constexpr size_t WS_UW = R2, WS_MIX = R2;
constexpr size_t WS_GATE = R3, WS_Q = R3 + 32 * MiB, WS_K = R3 + 64 * MiB, WS_VT = R3 + 97 * MiB;
constexpr size_t WS_VROW = WS_END;
constexpr size_t WS_Q8 = 162 * MiB, WS_K8 = 178 * MiB;
constexpr size_t WS_TAB = R3 + 32 * MiB;
constexpr size_t WS_SC0 = R2, WS_EI0 = R1, WS_EG0 = R1 + 16 * MiB, WS_PART0 = 150 * MiB  , WS_W0 = R1 + 32 * MiB  ;
constexpr size_t WS_ZT = R1, WS_A2 = 226 * MiB, WS_FM = R1;
constexpr size_t WS_SC1 = 162 * MiB, WS_EI1 = 290 * MiB, WS_EG1 = 306 * MiB, WS_PART1 = 100 * MiB  , WS_W1 = 322 * MiB;

struct P {
  const float *x, *c, *ctx, *c_ctx, *ada_w, *ada_b, *norm1_w, *norm2_w, *w_in, *conv_w, *a_log, *dt_bias, *gdn_norm_w,
      *lam_q1, *lam_k1, *lam_q2, *lam_k2, *subln_w, *w_out_ab, *w_out_f, *peer_wq, *peer_keys, *peer_u, *peer_v, *final_norm_w;
  float* out; char* ws; int lo, hi;
};

DI unsigned f2bf(float f) { unsigned u = __float_as_uint(f); return (u + 0x7fffu + ((u >> 16) & 1u)) >> 16; }
DI unsigned pk2(float lo, float hi) { return f2bf(lo) | (f2bf(hi) << 16); }
DI unsigned cvtpk(float lo, float hi) { f32x2_t v = {lo, hi}; bf16x2_t b = __builtin_convertvector(v, bf16x2_t); return __builtin_bit_cast(unsigned, b); }
DI float bf2f(unsigned h) { return __uint_as_float(h << 16); }
DI float bflo(unsigned u) { return __uint_as_float(u << 16); }
DI float bfhi(unsigned u) { return __uint_as_float(u & 0xffff0000u); }
DI float wave_sum(float v) {
#pragma unroll
  for (int o = 32; o >= 1; o >>= 1) v += __shfl_xor(v, o, 64);
  return v;
}
DI int otid() { int t = threadIdx.x; asm volatile("" : "+v"(t)); return t; }
DI unsigned xb_ld(unsigned* p)              { return __hip_atomic_load(p, __ATOMIC_RELAXED, __HIP_MEMORY_SCOPE_AGENT); }
DI unsigned xb_add(unsigned* p, unsigned v) { return __hip_atomic_fetch_add(p, v, __ATOMIC_RELAXED, __HIP_MEMORY_SCOPE_AGENT); }
DI unsigned xb_xcc_id() { return (unsigned)__builtin_amdgcn_s_getreg((3 << 11) | 20) & 0xFu; }
DI float silu_f(float v) { return v / (1.f + __expf(-v)); }
DI float sigmoid_f(float v) { return 1.f / (1.f + __expf(-v)); }
DI float gelu_tanh(float v) {
  const float u = 0.7978845608028654f * (v + 0.044715f * v * v * v);
  const float e = __expf(2.f * u);
  const float t = 1.f - 2.f / (e + 1.f);
  return 0.5f * v * (1.f + t);
}
#define MFMA32(a, b, c) __builtin_amdgcn_mfma_f32_32x32x16_bf16((a), (b), (c), 0, 0, 0)

constexpr int GBM = 256, GBN = 128, GBK = 64, GLD = 72;
constexpr int G_A_BYTES = GBM * GLD * 2, G_B_BYTES = GBN * GLD * 2, G_STAGE = G_A_BYTES + G_B_BYTES;
constexpr int LDS_BYTES = 147456;

template <bool SWAP, class RowF, class Epi>
DI void gemm_tile(char* lds, const RowF& rowf, const bf16_t* __restrict__ Bt, const int K, const Epi& epi) {
  const int tid = otid(), lane = tid & 63, wave = tid >> 6, wm = wave >> 1, wn = wave & 1;
  const int lr = tid >> 3, lc = tid & 7;
  const bf16_t* ap0 = rowf(lr) + lc * 8;
  const bf16_t* ap1 = rowf(lr + 64) + lc * 8;
  const bf16_t* ap2 = rowf(lr + 128) + lc * 8;
  const bf16_t* ap3 = rowf(lr + 192) + lc * 8;
  const bf16_t* bp0 = Bt + (size_t)lr * K + lc * 8;
  const bf16_t* bp1 = Bt + (size_t)(lr + 64) * K + lc * 8;
  const int woff = (lr * GLD + lc * 8) * 2;
  u32x4 raX0, raX1, raX2, raX3, rbX0, rbX1, raY0, raY1, raY2, raY3, rbY0, rbY1;
  f32x16 acc[2][2];
#pragma unroll
  for (int i = 0; i < 2; ++i)
#pragma unroll
    for (int j = 0; j < 2; ++j)
#pragma unroll
      for (int r = 0; r < 16; ++r) acc[i][j][r] = 0.f;
  const int nk = K / GBK;
#define G_GLOAD(S, kt_) do { const int k0_ = ((kt_) < nk ? (kt_) : nk - 1) * GBK; \
    ra##S##0 = *(const u32x4*)(ap0 + k0_); ra##S##1 = *(const u32x4*)(ap1 + k0_); ra##S##2 = *(const u32x4*)(ap2 + k0_); ra##S##3 = *(const u32x4*)(ap3 + k0_); \
    rb##S##0 = *(const u32x4*)(bp0 + k0_); rb##S##1 = *(const u32x4*)(bp1 + k0_); } while (0)
#define G_LWRITE(S, st) do { char* b_ = lds + (st) * G_STAGE + woff; *(u32x4*)(b_) = ra##S##0; *(u32x4*)(b_ + 64 * GLD * 2) = ra##S##1; *(u32x4*)(b_ + 128 * GLD * 2) = ra##S##2; *(u32x4*)(b_ + 192 * GLD * 2) = ra##S##3; \
    *(u32x4*)(b_ + G_A_BYTES) = rb##S##0; *(u32x4*)(b_ + G_A_BYTES + 64 * GLD * 2) = rb##S##1; } while (0)
  const int aoff = ((wm * 64 + (lane & 31)) * GLD + (lane >> 5) * 8) * 2;
  const int boff = G_A_BYTES + ((wn * 64 + (lane & 31)) * GLD + (lane >> 5) * 8) * 2;
#define G_COMPUTE(st) do { const char* sb = lds + (st) * G_STAGE; \
    _Pragma("unroll") for (int kk = 0; kk < 4; ++kk) { \
      const bf16x8 a0 = *(const bf16x8*)(sb + aoff + kk * 32); \
      const bf16x8 a1 = *(const bf16x8*)(sb + aoff + 32 * GLD * 2 + kk * 32); \
      const bf16x8 b0 = *(const bf16x8*)(sb + boff + kk * 32); \
      const bf16x8 b1 = *(const bf16x8*)(sb + boff + 32 * GLD * 2 + kk * 32); \
      if (SWAP) { \
        acc[0][0] = MFMA32(b0, a0, acc[0][0]); acc[0][1] = MFMA32(b1, a0, acc[0][1]); \
        acc[1][0] = MFMA32(b0, a1, acc[1][0]); acc[1][1] = MFMA32(b1, a1, acc[1][1]); \
      } else { \
        acc[0][0] = MFMA32(a0, b0, acc[0][0]); acc[0][1] = MFMA32(a0, b1, acc[0][1]); \
        acc[1][0] = MFMA32(a1, b0, acc[1][0]); acc[1][1] = MFMA32(a1, b1, acc[1][1]); \
      } } } while (0)
  G_GLOAD(X, 0); G_GLOAD(Y, 1);
  __syncthreads();
  G_LWRITE(X, 0);
  __syncthreads();
#pragma unroll 1
  for (int kt = 0; kt < nk; kt += 2) {
    G_GLOAD(X, kt + 2);
    G_COMPUTE(0);
    G_LWRITE(Y, 1);
    __syncthreads();
    G_GLOAD(Y, kt + 3);
    G_COMPUTE(1);
    if (kt + 2 < nk) G_LWRITE(X, 0);
    __syncthreads();
  }
  epi(acc, wm, wn, lane);
#undef G_GLOAD
#undef G_LWRITE
#undef G_COMPUTE
}
DI int crow(int reg, int h) { return (reg & 3) + 8 * (reg >> 2) + 4 * h; }

struct RowLin { const bf16_t* base; size_t pitch; DI const bf16_t* operator()(int r) const { return base + (size_t)r * pitch; } };

namespace pg8 {
#define PG8_LAS __attribute__((address_space(3)))
typedef int v4i_t __attribute__((ext_vector_type(4)));
typedef unsigned short bf16_t;
typedef short bf16x8 __attribute__((ext_vector_type(8)));
typedef float f32x4 __attribute__((ext_vector_type(4)));
typedef unsigned u32x4 __attribute__((ext_vector_type(4)));
constexpr int BM = 256, BK = 64, HALF = 128, HTB = HALF * BK * 2  , STAGE_BYTES = 8 * HTB, NXCD = 8, WGM = 8;

__host__ __device__ __forceinline__ int lds_byte(int r, int c) { const int st = (r >> 4) * 2 + (c >> 5), rr = r & 15, cc = c & 31, ob = rr * 64 + cc * 2; return st * 1024 + (ob ^ (((ob >> 9) & 1) << 5)); }
__host__ __device__ __forceinline__ void stage_rc(int b, int& R, int& C) { const int st = b / 1024, sb = b % 1024, swz = sb ^ (((sb >> 9) & 1) << 5); R = (st >> 1) * 16 + swz / 64; C = (st & 1) * 32 + (swz % 64) / 2; }
__host__ __device__ __forceinline__ int perm32(int rho) { const int n = rho >> 4, i = rho & 15; return 8 * (i >> 2) + 4 * n + (i & 3); }

struct Unit { int pm, pn; };
struct Gemm { const bf16_t* A; const bf16_t* Bt; int M, N, K; };

struct StaticOrder {
    int nM, nN, nwg, G, c;
    __host__ __device__ void init(int M, int N, int G_, int c_) { nM = M / BM; nN = N / BM; nwg = nM * nN; G = G_; c = c_; }
    __host__ __device__ bool next(int i, Unit& u) const {
        const long L = (long)i * G + c; if (L >= nwg) return false;
        int wgid = (int)L; { const int q = nwg / NXCD, r = nwg % NXCD, xcd = wgid % NXCD, off = wgid / NXCD; wgid = (xcd < r ? xcd * (q + 1) : r * (q + 1) + (xcd - r) * q) + off; }
        const int nig = WGM * nN, gid = wgid / nig, fm = gid * WGM, gsz = (nM - fm) < WGM ? (nM - fm) : WGM;
        u.pm = fm + ((wgid % nig) % gsz); u.pn = (wgid % nig) / gsz; return true;
    }
    __device__ __forceinline__ void a_ready(const Unit&) const {}
    __device__ __forceinline__ void done(const Unit&) const {}
};
template <class Epi, class Sched, bool ALIGN_EPI = false, bool SP2 = false, bool I8 = false>
__device__ __forceinline__ void gemm_phase(PG8_LAS unsigned char* lds, const Gemm g, const Sched& S, const Epi& E) {
    const int tid = otid(), wid = __builtin_amdgcn_readfirstlane(tid >> 6), lane = tid & 63, wr = wid >> 2, wc = wid & 3, fr = lane & 15, fq = lane >> 4;
    const int K = g.K, nt = K / BK;
    unsigned voffA[2], voffB[2];
#pragma unroll
    for (int i = 0; i < 2; ++i) { int R, C; stage_rc(tid * 16 + i * 8192, R, C); const int Rb = Epi::PERM ? ((R & ~31) + perm32(R & 31)) : R;
        voffA[i] = (unsigned)(R * K + C) * 2u; voffB[i] = (unsigned)(Rb * K + C) * 2u; }
    const size_t kstep = (size_t)(BK * 2);
    const size_t hstep = (size_t)HALF * K * 2;
    const size_t tstep = 2 * hstep;
    const unsigned ldsw = (unsigned)wid * 1024u;
    const int aoff = lds_byte(wr * 64 + fr, fq * 8), boff = lds_byte(wc * 32 + fr, fq * 8);
#define PG8_SA(b, h) (((b) * 2 + (h)) * HTB)
#define PG8_SB(b, h) ((4 + (b) * 2 + (h)) * HTB)
#define PG8_STAGE(bufoff, gbase, voff) do { _Pragma("unroll") for (int _i = 0; _i < 2; ++_i) \
        __builtin_amdgcn_global_load_lds((const unsigned*)((const char*)(gbase) + (voff)[_i]), (PG8_LAS unsigned*)(lds + (bufoff) + ldsw + _i * 8192), 16, 0, 0); } while (0)
#define PG8_LDA(dst, b, h) do { _Pragma("unroll") for (int m = 0; m < 4; ++m) _Pragma("unroll") for (int k = 0; k < 2; ++k) dst[m][k] = *(const PG8_LAS bf16x8*)(lds + PG8_SA(b, h) + aoff + m * 2048 + k * 1024); } while (0)
#define PG8_LDB(dst, b, h) do { _Pragma("unroll") for (int n = 0; n < 2; ++n) _Pragma("unroll") for (int k = 0; k < 2; ++k) dst[n][k] = *(const PG8_LAS bf16x8*)(lds + PG8_SB(b, h) + boff + n * 2048 + k * 1024); } while (0)
#define PG8_MMA(ai, bj, At, Bt) do { __builtin_amdgcn_s_setprio(1); _Pragma("unroll") for (int m = 0; m < 4; ++m) _Pragma("unroll") for (int n = 0; n < 2; ++n) _Pragma("unroll") for (int k = 0; k < 2; ++k) \
        { if constexpr (I8) acc[ai][bj][m][n] = __builtin_bit_cast(f32x4, __builtin_amdgcn_mfma_i32_16x16x64_i8(__builtin_bit_cast(v4i_t, Bt[n][k]), __builtin_bit_cast(v4i_t, At[m][k]), __builtin_bit_cast(v4i_t, acc[ai][bj][m][n]), 0, 0, 0)); \
          else acc[ai][bj][m][n] = __builtin_amdgcn_mfma_f32_16x16x32_bf16(Bt[n][k], At[m][k], acc[ai][bj][m][n], 0, 0, 0); } __builtin_amdgcn_s_setprio(0); } while (0)
#define PG8_WAIT_V(n) asm volatile("s_waitcnt vmcnt(" #n ")" ::: "memory")
#define PG8_WAIT_L(n) asm volatile("s_waitcnt lgkmcnt(" #n ")" ::: "memory")
#define PG8_BAR __builtin_amdgcn_s_barrier()
#define PG8_SCHED __builtin_amdgcn_sched_barrier(0)
    Unit cur, nxt; int ui = 0;
    if (!S.next(0, cur)) return;
    f32x4 acc[2][2][4][2];
#pragma unroll
    for (int a = 0; a < 2; ++a)
#pragma unroll
        for (int b = 0; b < 2; ++b)
#pragma unroll
            for (int m = 0; m < 4; ++m)
#pragma unroll
                for (int n = 0; n < 2; ++n) acc[a][b][m][n] = (f32x4){0.f, 0.f, 0.f, 0.f};
    bf16x8 At[4][2], B0[2][2], B1[2][2];
    const char* cA = (const char*)g.A + (size_t)cur.pm * tstep; const char* cB = (const char*)g.Bt + (size_t)cur.pn * tstep;
    S.a_ready(cur);
    if constexpr (SP2) {
        PG8_STAGE(PG8_SB(0, 0), cB, voffB); PG8_STAGE(PG8_SB(0, 1), cB + hstep, voffB); PG8_STAGE(PG8_SA(0, 0), cA, voffA); PG8_STAGE(PG8_SA(0, 1), cA + hstep, voffA);
        if (wr == 1) PG8_BAR;
        PG8_WAIT_V(2); PG8_BAR;
        PG8_STAGE(PG8_SB(1, 0), cB + kstep, voffB); PG8_STAGE(PG8_SA(1, 0), cA + kstep, voffA); PG8_STAGE(PG8_SB(1, 1), cB + hstep + kstep, voffB);
        PG8_WAIT_V(6); PG8_BAR;
    } else {
        PG8_STAGE(PG8_SB(0, 0), cB, voffB); PG8_STAGE(PG8_SA(0, 0), cA, voffA); PG8_STAGE(PG8_SB(0, 1), cB + hstep, voffB); PG8_STAGE(PG8_SA(0, 1), cA + hstep, voffA);
        if (wr == 1) PG8_BAR;
        PG8_WAIT_V(4); PG8_BAR;
        PG8_STAGE(PG8_SB(1, 0), cB + kstep, voffB); PG8_STAGE(PG8_SA(1, 0), cA + kstep, voffA); PG8_STAGE(PG8_SB(1, 1), cB + hstep + kstep, voffB);
        PG8_WAIT_V(6); PG8_BAR;
    }
    for (;;) {
        const bool has_next = S.next(ui + 1, nxt);
        const char* nA = has_next ? (const char*)g.A + (size_t)nxt.pm * tstep : cA; const char* nB = has_next ? (const char*)g.Bt + (size_t)nxt.pn * tstep : cB;
        for (int t = 0; t < nt; t += 2) {
            const bool last = (t == nt - 2);
            const char* a1 = cA + (size_t)(t + 1) * kstep;
            const char* a2 = last ? nA : cA + (size_t)(t + 2) * kstep; const char* b2 = last ? nB : cB + (size_t)(t + 2) * kstep;
            const char* a3 = a2 + kstep; const char* b3 = b2 + kstep;
            if (last && has_next) S.a_ready(nxt);
            if constexpr (SP2) {
            PG8_LDB(B0, 0, 0); PG8_LDB(B1, 0, 1); PG8_SCHED; PG8_LDA(At, 0, 0); PG8_STAGE(PG8_SA(1, 1), a1 + hstep, voffA);
            PG8_WAIT_V(8); PG8_WAIT_L(0); PG8_BAR; PG8_MMA(0, 0, At, B0); PG8_MMA(0, 1, At, B1); PG8_BAR; PG8_SCHED;
            PG8_LDA(At, 0, 1); PG8_STAGE(PG8_SB(0, 0), b2, voffB); PG8_STAGE(PG8_SB(0, 1), b2 + hstep, voffB); PG8_STAGE(PG8_SA(0, 0), a2, voffA);
            PG8_WAIT_V(8); PG8_WAIT_L(0); PG8_BAR; PG8_MMA(1, 0, At, B0); PG8_MMA(1, 1, At, B1); PG8_BAR; PG8_SCHED;
            PG8_LDB(B0, 1, 0); PG8_LDB(B1, 1, 1); PG8_SCHED; PG8_LDA(At, 1, 0); PG8_STAGE(PG8_SA(0, 1), a2 + hstep, voffA);
            PG8_WAIT_V(8); PG8_WAIT_L(0); PG8_BAR; PG8_MMA(0, 0, At, B0); PG8_MMA(0, 1, At, B1); PG8_BAR; PG8_SCHED;
            PG8_LDA(At, 1, 1); PG8_STAGE(PG8_SB(1, 0), b3, voffB); PG8_STAGE(PG8_SB(1, 1), b3 + hstep, voffB); PG8_STAGE(PG8_SA(1, 0), a3, voffA);
            PG8_WAIT_V(8); PG8_WAIT_L(0); PG8_BAR; PG8_MMA(1, 0, At, B0); PG8_MMA(1, 1, At, B1); PG8_BAR; PG8_SCHED;
            } else {
            PG8_LDB(B0, 0, 0); PG8_SCHED; PG8_LDA(At, 0, 0); PG8_STAGE(PG8_SA(1, 1), a1 + hstep, voffA);
            PG8_WAIT_L(8); PG8_BAR; PG8_WAIT_L(0); PG8_MMA(0, 0, At, B0); PG8_BAR; PG8_SCHED;
            PG8_LDB(B1, 0, 1); PG8_STAGE(PG8_SB(0, 0), b2, voffB);
            PG8_BAR; PG8_WAIT_L(0); PG8_MMA(0, 1, At, B1); PG8_BAR;
            PG8_LDA(At, 0, 1); PG8_STAGE(PG8_SA(0, 0), a2, voffA);
            PG8_BAR; PG8_WAIT_L(0); PG8_MMA(1, 0, At, B0); PG8_BAR; PG8_SCHED;
            PG8_STAGE(PG8_SB(0, 1), b2 + hstep, voffB);
            PG8_WAIT_V(6); PG8_BAR; PG8_MMA(1, 1, At, B1); PG8_BAR;
            PG8_LDB(B0, 1, 0); PG8_SCHED; PG8_LDA(At, 1, 0); PG8_STAGE(PG8_SA(0, 1), a2 + hstep, voffA);
            PG8_WAIT_L(8); PG8_BAR; PG8_WAIT_L(0); PG8_MMA(0, 0, At, B0); PG8_BAR; PG8_SCHED;
            PG8_LDB(B1, 1, 1); PG8_STAGE(PG8_SB(1, 0), b3, voffB);
            PG8_BAR; PG8_WAIT_L(0); PG8_MMA(0, 1, At, B1); PG8_BAR;
            PG8_LDA(At, 1, 1); PG8_STAGE(PG8_SA(1, 0), a3, voffA);
            PG8_BAR; PG8_WAIT_L(0); PG8_MMA(1, 0, At, B0); PG8_BAR; PG8_SCHED;
            PG8_STAGE(PG8_SB(1, 1), b3 + hstep, voffB);
            PG8_WAIT_V(6); PG8_BAR; PG8_MMA(1, 1, At, B1); PG8_BAR;
            }
        }
        if constexpr (ALIGN_EPI) { if (wr == 0) PG8_BAR; }
        if constexpr (I8) { if constexpr (Epi::DEQ) { E.deq(acc, cur, wr, wc, fr, fq); __builtin_amdgcn_sched_barrier(0); } }
        if constexpr (!Epi::AFTER_DRAIN) { E(acc, cur, wr, wc, fr, fq); S.done(cur); }
        if (!has_next) break;
#pragma unroll
        for (int a = 0; a < 2; ++a)
#pragma unroll
            for (int b = 0; b < 2; ++b)
#pragma unroll
                for (int m = 0; m < 4; ++m)
#pragma unroll
                    for (int n = 0; n < 2; ++n) acc[a][b][m][n] = (f32x4){0.f, 0.f, 0.f, 0.f};
        cur = nxt; cA = nA; cB = nB; ++ui;
        if constexpr (ALIGN_EPI) { if (wr == 1) PG8_BAR; }
    }
    PG8_WAIT_V(0);
    if constexpr (!ALIGN_EPI) { if (wr == 0) PG8_BAR; }
    PG8_BAR;
    if constexpr (Epi::AFTER_DRAIN) { E.fused(acc, cur, wr, wc, fr, fq, lds, wid, lane); S.done(cur); }
#undef PG8_SA
#undef PG8_SB
#undef PG8_STAGE
#undef PG8_LDA
#undef PG8_LDB
#undef PG8_MMA
#undef PG8_WAIT_V
#undef PG8_WAIT_L
#undef PG8_BAR
#undef PG8_SCHED
}
}
DI void ph_setup(const P& p, char* lds) {
  const int tid = otid(), nb = gridDim.x, bid = blockIdx.x;
  float* modL = (float*)(p.ws + WS_MOD);
  float* sc = (float*)lds;
  for (int it = bid; it < 192; it += nb) {
    const int layer = it / 96, cb = it % 96;
    const int lane = tid & 63, ks = tid >> 6;
    __syncthreads();
    for (int i = tid; i < 5 * 1024; i += NT) { const int v = i >> 10, k = i & 1023; const float cv = (v < 4) ? p.c[v * 1024 + k] : p.c_ctx[k]; sc[i] = silu_f(cv); }
    __syncthreads();
    const int n = cb * 64 + lane;
    const float* w = p.ada_w + ((size_t)layer * 1024 + ks * 128) * 6144 + n;
    float a0 = 0, a1 = 0, a2 = 0, a3 = 0, a4 = 0;
#pragma unroll 8
    for (int k = 0; k < 128; ++k) { const float wv = w[(size_t)k * 6144]; const int kk = ks * 128 + k; a0 += wv * sc[kk]; a1 += wv * sc[1024 + kk]; a2 += wv * sc[2048 + kk]; a3 += wv * sc[3072 + kk]; a4 += wv * sc[4096 + kk]; }
    float* red = sc + 5 * 1024;
    red[(ks * 5 + 0) * 64 + lane] = a0; red[(ks * 5 + 1) * 64 + lane] = a1; red[(ks * 5 + 2) * 64 + lane] = a2; red[(ks * 5 + 3) * 64 + lane] = a3; red[(ks * 5 + 4) * 64 + lane] = a4;
    __syncthreads();
    if (tid < 320) {
      const int v = tid >> 6, l = tid & 63;
      float sacc = p.ada_b[layer * 6144 + cb * 64 + l];
      for (int k8 = 0; k8 < 8; ++k8) sacc += red[(k8 * 5 + v) * 64 + l];
      modL[(layer * 5 + v) * 6144 + cb * 64 + l] = sacc;
    }
  }
  {
    float* rope = (float*)(p.ws + WS_ROPE);
    for (int i = bid * NT + tid; i < SEQ * 32; i += nb * NT) {
      const int l = i >> 5, d = i & 31;
      const float inv = exp2f(-(float)(2 * (d & 15)) * (13.287712379549449f / 32.f));
      const float pos = (d < 16) ? (float)(l >> 6) : (float)(l & 63);
      float s, c; sincosf(pos * inv, &s, &c);
      rope[2 * i] = c; rope[2 * i + 1] = s;
    }
  }
  {
    float* tl = (float*)lds;
    const int nt_in = (NIN / 64) * 16, nt_o = 16 * 16;
    for (int it = bid; it < nt_in + 2 * nt_o; it += nb) {
      const float* src; bf16_t* dst; int npitch, nb0, kb0, which;
      if (it < nt_in) { which = 0; nb0 = (it / 16) * 64; kb0 = (it % 16) * 64; src = p.w_in; dst = (bf16_t*)(p.ws + WS_WIN); npitch = 3616; }
      else if (it < nt_in + nt_o) { const int j = it - nt_in; which = 1; nb0 = (j / 16) * 64; kb0 = (j % 16) * 64; src = p.w_out_ab; dst = (bf16_t*)(p.ws + WS_WOUT); npitch = 1024; }
      else { const int j = it - nt_in - nt_o; which = 2; nb0 = (j / 16) * 64; kb0 = (j % 16) * 64; src = p.w_out_f; dst = (bf16_t*)(p.ws + WS_WF); npitch = 1024; }
      __syncthreads();
      for (int e = tid; e < 4096; e += NT) {
        const int kk = e >> 6, nn = e & 63; const int n = nb0 + nn;
        int sn = n;
        if (which == 0) {
          if (n < 2048) sn = n;
          else if (n < 3072) { const int pq = n & 63, blk = pq >> 3, e8 = pq & 7; sn = (n & ~63) + 32 + ((e8 < 4) ? 4 * blk + e8 : 32 + 4 * blk + (e8 - 4)); }
          else if (n < 3584) sn = n + 32;
          else if (n < 3616) sn = n - 1536;
          else sn = -1;
        }
        tl[kk * 65 + nn] = (sn >= 0) ? src[(size_t)(kb0 + kk) * npitch + sn] : 0.f;
      }
      __syncthreads();
      for (int e = tid; e < 4096; e += NT) { const int nn = e >> 6, kk = e & 63; dst[(size_t)(nb0 + nn) * 1024 + kb0 + kk] = (bf16_t)f2bf(tl[kk * 65 + nn]); }
    }
  }
  {
    float* kl = (float*)lds;
    float* wl = kl + 128 * 132;
    bf16_t* weff = (bf16_t*)(p.ws + WS_WEFF);
    for (int it = bid; it < 512; it += nb) {
      const int layer = it >> 8, hp = (it >> 4) & 15, kb = it & 15;
      __syncthreads();
      const float* ks = p.peer_keys + ((size_t)(layer * 16 + hp) * 128) * 128;
      for (int e = tid; e < 128 * 128; e += NT) kl[(e >> 7) * 132 + (e & 127)] = ks[e];
      const float* ws_ = p.peer_wq + ((size_t)layer * 1024 + kb * 64) * 2048 + hp * 128;
      for (int e = tid; e < 64 * 128; e += NT) wl[(e >> 7) * 132 + (e & 127)] = ws_[(size_t)(e >> 7) * 2048 + (e & 127)];
      __syncthreads();
      const int key = tid & 127, kq = tid >> 7;
      float a[16];
#pragma unroll
      for (int i = 0; i < 16; ++i) a[i] = 0.f;
      for (int d = 0; d < 128; d += 4) {
        const f32x4 kv = *(const f32x4*)(kl + key * 132 + d);
#pragma unroll
        for (int i = 0; i < 16; ++i) { const f32x4 wv = *(const f32x4*)(wl + (kq * 16 + i) * 132 + d); a[i] += kv[0] * wv[0] + kv[1] * wv[1] + kv[2] * wv[2] + kv[3] * wv[3]; }
      }
      bf16_t* o = weff + ((size_t)layer * 2048 + hp * 128 + key) * 1024 + kb * 64 + kq * 16;
      u32x4 o0, o1;
      o0[0] = pk2(a[0], a[1]); o0[1] = pk2(a[2], a[3]); o0[2] = pk2(a[4], a[5]); o0[3] = pk2(a[6], a[7]);
      o1[0] = pk2(a[8], a[9]); o1[1] = pk2(a[10], a[11]); o1[2] = pk2(a[12], a[13]); o1[3] = pk2(a[14], a[15]);
      *(u32x4*)o = o0; *(u32x4*)(o + 8) = o1;
    }
  }
  {
    bf16_t* d0 = (bf16_t*)(p.ws + WS_DFT0); bf16_t* d1 = (bf16_t*)(p.ws + WS_DFT1); bf16_t* d3 = (bf16_t*)(p.ws + WS_DFT3);
    for (int i = bid * NT + tid; i < 512 * 256; i += nb * NT) {
      const int n = i >> 8, c = i & 255, m = n & 255; const float fr = (float)((m * c) & 255) * (2.f / 256.f);
      d0[i] = (bf16_t)f2bf(n < 256 ? cospif(fr) : -sinpif(fr));
    }
    for (int i = bid * NT + tid; i < 128 * 128; i += nb * NT) {
      const int n = i >> 7, k = i & 127; const int k1 = 32 * (n >> 6) + (n & 31), ro = (n >> 5) & 1, ri = k >> 6, l1 = k & 63;
      const float fr = (float)((k1 * l1) & 63) * (2.f / 64.f); const float cs = cospif(fr), sn = sinpif(fr);
      d1[i] = (bf16_t)f2bf(ro == 0 ? (ri == 0 ? cs : sn) : (ri == 0 ? -sn : cs));
    }
    for (int i = bid * NT + tid; i < 128 * 256; i += nb * NT) {
      const int k2 = i >> 8, k = i & 255, ri = k >> 7, l2 = k & 127; const float fr = (float)((l2 * k2) & 127) * (2.f / 128.f);
      const float scl = 6.905339660024878e-4f;
      d3[i] = (bf16_t)f2bf((ri == 0 ? cospif(fr) : sinpif(fr)) * scl);
    }
  }
}

DI void norm_rows(const float* __restrict__ src, int row_begin, int nrows, const float* __restrict__ nw, const float* __restrict__ modbase  ,
                  int shift_j, int scale_j, bool ctx_tail  , bf16_t* __restrict__ dst, bool blk = false  ) {
  const int lane = otid() & 63, gw = (blk ? 0 : blockIdx.x * (NT / 64)) + (otid() >> 6), nw_ = (blk ? 1 : gridDim.x) * (NT / 64);
  for (int row = row_begin + gw; row < nrows; row += nw_) {
    const int v = (ctx_tail && row >= TL) ? 4 : (row >> 13);
    const float* xr = src + (size_t)row * DM;
    f32x4 xv[4]; float ss = 0.f;
#pragma unroll
    for (int i = 0; i < 4; ++i) { xv[i] = *(const f32x4*)(xr + lane * 4 + 256 * i); ss += xv[i][0] * xv[i][0] + xv[i][1] * xv[i][1] + xv[i][2] * xv[i][2] + xv[i][3] * xv[i][3]; }
    ss = wave_sum(ss);
    const float rs = rsqrtf(ss * (1.f / DM) + EPS);
    const float* sh = modbase + (size_t)v * 6144 + shift_j * 1024; const float* scp = modbase + (size_t)v * 6144 + scale_j * 1024;
#pragma unroll
    for (int i = 0; i < 4; ++i) {
      const int c = lane * 4 + 256 * i;
      const f32x4 w4 = *(const f32x4*)(nw + c), s4 = *(const f32x4*)(sh + c), c4 = *(const f32x4*)(scp + c);
      float y0 = xv[i][0] * rs * w4[0] * (1.f + c4[0]) + s4[0], y1 = xv[i][1] * rs * w4[1] * (1.f + c4[1]) + s4[1];
      float y2 = xv[i][2] * rs * w4[2] * (1.f + c4[2]) + s4[2], y3 = xv[i][3] * rs * w4[3] * (1.f + c4[3]) + s4[3];
      u32x2 o; o[0] = pk2(y0, y1); o[1] = pk2(y2, y3);
      *(u32x2*)(dst + (size_t)row * DM + c) = o;
    }
  }
}

constexpr size_t WS_HQ = (size_t)393 * MiB, WS_HS = (size_t)425 * MiB;
DI void norm_rows_hq(const P& p, const float* __restrict__ nw, const float* __restrict__ modbase) {
  const int lane = otid() & 63, gw = blockIdx.x * (NT / 64) + (otid() >> 6), nw_ = gridDim.x * (NT / 64);
  bf16_t* dst = (bf16_t*)(p.ws + R0); unsigned char* hq = (unsigned char*)(p.ws + WS_HQ); float* hs = (float*)(p.ws + WS_HS);
  for (int row = gw; row < TL; row += nw_) {
    const float* xr = p.out + (size_t)row * DM + lane * 16;
    f32x4 xv[4]; float ss = 0.f;
#pragma unroll
    for (int i = 0; i < 4; ++i) { xv[i] = *(const f32x4*)(xr + 4 * i); ss += xv[i][0] * xv[i][0] + xv[i][1] * xv[i][1] + xv[i][2] * xv[i][2] + xv[i][3] * xv[i][3]; }
    ss = wave_sum(ss);
    const float rs = rsqrtf(ss * (1.f / DM) + EPS);
    const float* sh = modbase + (size_t)(row >> 13) * 6144 + 3 * 1024 + lane * 16; const float* scp = sh + 1024;
    float y[16]; float am = 0.f;
#pragma unroll
    for (int i = 0; i < 4; ++i) {
      const f32x4 w4 = *(const f32x4*)(nw + lane * 16 + 4 * i), s4 = *(const f32x4*)(sh + 4 * i), c4 = *(const f32x4*)(scp + 4 * i);
#pragma unroll
      for (int j = 0; j < 4; ++j) { y[4 * i + j] = xv[i][j] * rs * w4[j] * (1.f + c4[j]) + s4[j]; am = fmaxf(am, fabsf(y[4 * i + j])); }
    }
#pragma unroll
    for (int o = 32; o >= 1; o >>= 1) am = fmaxf(am, __shfl_xor(am, o, 64));
    const float st = am * (1.f / 119.f) + 1e-30f, ist = 1.f / st;
    unsigned h0 = 0u, h1 = 0u, l0 = 0u, l1 = 0u;
    u32x4 b8 = {0u, 0u, 0u, 0u};
#pragma unroll
    for (int j = 0; j < 8; ++j) {
      const int va = (int)fminf(fmaxf(rintf(y[j] * ist), -120.f), 119.f), vb = (int)fminf(fmaxf(rintf(y[8 + j] * ist), -120.f), 119.f);
      b8[j >> 2] |= ((unsigned)va & 255u) << (8 * (j & 3)); b8[2 + (j >> 2)] |= ((unsigned)vb & 255u) << (8 * (j & 3));
      const int ha = (va + 8) >> 4, hb = (vb + 8) >> 4, la = va - 16 * ha, lb = vb - 16 * hb;
      h0 |= ((unsigned)ha & 15u) << (4 * j); h1 |= ((unsigned)hb & 15u) << (4 * j); l0 |= ((unsigned)la & 15u) << (4 * j); l1 |= ((unsigned)lb & 15u) << (4 * j);
    }
    u32x2 vh; vh[0] = h0; vh[1] = h1; *(u32x2*)(hq + (size_t)row * 1024 + lane * 8) = vh;
    u32x2 vl; vl[0] = l0; vl[1] = l1; *(u32x2*)(hq + (size_t)row * 1024 + 512 + lane * 8) = vl;
    *(u32x4*)((unsigned char*)dst + (size_t)row * DM + lane * 16) = b8;
    if (lane == 0) hs[row] = st;
  }
}

constexpr size_t WS_WEFF8 = WS_WIN, WS_SW = WS_WIN + 5 * MiB;
constexpr size_t WS_WIN8 = R2, WS_SWIN = R2 + 4 * MiB;
constexpr size_t WS_HS0 = R2 + 5 * MiB;
DI void quant_rows_i8(const bf16_t* __restrict__ w, int nrows, unsigned char* __restrict__ w8, float* __restrict__ sw) {
  const int lane = otid() & 63, gw = blockIdx.x * (NT / 64) + (otid() >> 6), nw_ = gridDim.x * (NT / 64);
  for (int row = gw; row < nrows; row += nw_) {
    const u32x4 a = *(const u32x4*)(w + (size_t)row * 1024 + lane * 16), b = *(const u32x4*)(w + (size_t)row * 1024 + lane * 16 + 8);
    float v[16]; float am = 0.f;
#pragma unroll
    for (int i = 0; i < 4; ++i) { v[2 * i] = bflo(a[i]); v[2 * i + 1] = bfhi(a[i]); v[8 + 2 * i] = bflo(b[i]); v[9 + 2 * i] = bfhi(b[i]); }
#pragma unroll
    for (int i = 0; i < 16; ++i) am = fmaxf(am, fabsf(v[i]));
#pragma unroll
    for (int o = 32; o >= 1; o >>= 1) am = fmaxf(am, __shfl_xor(am, o, 64));
    const float st = am * (1.f / 127.f) + 1e-30f, ist = 1.f / st;
    u32x4 o8 = {0u, 0u, 0u, 0u};
#pragma unroll
    for (int i = 0; i < 16; ++i) { const int qv = (int)fminf(fmaxf(rintf(v[i] * ist), -127.f), 127.f); o8[i >> 2] |= ((unsigned)qv & 255u) << (8 * (i & 3)); }
    *(u32x4*)(w8 + (size_t)row * 1024 + lane * 16) = o8;
    if (lane == 0) sw[row] = st;
  }
}
DI void norm_rows_i8(const float* __restrict__ src, int row_begin, int nrows, const float* __restrict__ nw, const float* __restrict__ modbase, bool ctx_tail,
                     unsigned char* __restrict__ dst8, float* __restrict__ hs) {
  const int lane = otid() & 63, gw = blockIdx.x * (NT / 64) + (otid() >> 6), nw_ = gridDim.x * (NT / 64);
  for (int row = row_begin + gw; row < nrows; row += nw_) {
    const int v = (ctx_tail && row >= TL) ? 4 : (row >> 13);
    const float* xr = src + (size_t)row * DM + lane * 16;
    f32x4 xv[4]; float ss = 0.f;
#pragma unroll
    for (int i = 0; i < 4; ++i) { xv[i] = *(const f32x4*)(xr + 4 * i); ss += xv[i][0] * xv[i][0] + xv[i][1] * xv[i][1] + xv[i][2] * xv[i][2] + xv[i][3] * xv[i][3]; }
    ss = wave_sum(ss);
    const float rs = rsqrtf(ss * (1.f / DM) + EPS);
    const float* sh = modbase + (size_t)v * 6144 + lane * 16; const float* scp = sh + 1024;
    float y[16]; float am = 0.f;
#pragma unroll
    for (int i = 0; i < 4; ++i) {
      const f32x4 w4 = *(const f32x4*)(nw + lane * 16 + 4 * i), s4 = *(const f32x4*)(sh + 4 * i), c4 = *(const f32x4*)(scp + 4 * i);
#pragma unroll
      for (int j = 0; j < 4; ++j) { y[4 * i + j] = xv[i][j] * rs * w4[j] * (1.f + c4[j]) + s4[j]; am = fmaxf(am, fabsf(y[4 * i + j])); }
    }
#pragma unroll
    for (int o = 32; o >= 1; o >>= 1) am = fmaxf(am, __shfl_xor(am, o, 64));
    const float st = am * (1.f / 127.f) + 1e-30f, ist = 1.f / st;
    u32x4 b8 = {0u, 0u, 0u, 0u};
#pragma unroll
    for (int j = 0; j < 16; ++j) { const int qv = (int)fminf(fmaxf(rintf(y[j] * ist), -127.f), 127.f); b8[j >> 2] |= ((unsigned)qv & 255u) << (8 * (j & 3)); }
    *(u32x4*)(dst8 + (size_t)row * DM + lane * 16) = b8;
    if (lane == 0) hs[row] = st;
  }
}

struct EpiProjV {
  const P* p; int row0, col0;
  DI void operator()(f32x16 (&acc)[2][2], int wm, int wn, int lane) const {
    const int cb = col0 + wn * 64, h = lane >> 5, cl = lane & 31;
    const bool isctx = row0 >= TL;
    bf16_t* o = (bf16_t*)(p->ws + WS_VT);
    const int hv = (cb - 3072) >> 7, dvb = (cb - 3072) & 127;
#pragma unroll
    for (int mt = 0; mt < 2; ++mt)
#pragma unroll
      for (int nt = 0; nt < 2; ++nt)
#pragma unroll
        for (int g = 0; g < 4; ++g) {
          const int row = row0 + wm * 64 + mt * 32 + 8 * g + 4 * h;
          int b, pos; if (!isctx) { b = row >> 13; pos = row & (SEQ - 1); } else { const int rc = row - TL; b = rc >> 8; pos = SEQ + (rc & 255); }
          const int dv = dvb + nt * 32 + cl;
          u32x2 v; v[0] = pk2(acc[mt][nt][4 * g], acc[mt][nt][4 * g + 1]); v[1] = pk2(acc[mt][nt][4 * g + 2], acc[mt][nt][4 * g + 3]);
          *(u32x2*)(o + ((size_t)((b * 4 + hv) * 128 + dv)) * KVL + pos) = v;
        }
  }
};
struct EpiProjS {
  const P* p; int row0, col0;
  DI void operator()(f32x16 (&acc)[2][2], int wm, int wn, int lane) const {
    const int cb = col0 + wn * 64, h = lane >> 5, cl = lane & 31;
    const bool isctx = row0 >= TL;
    char* ws = p->ws;
    if (cb < 2048) {
      const bool isg = cb >= 1536;
      if (isg && isctx) return;
      bf16_t* o = (bf16_t*)(ws + (isg ? WS_GATE : WS_QKVRAW));
      const int pitch = isg ? 512 : 1536, cofs = isg ? cb - 1536 : cb;
#pragma unroll
      for (int mt = 0; mt < 2; ++mt) {
        const int row = row0 + wm * 64 + mt * 32 + cl;
#pragma unroll
        for (int nt = 0; nt < 2; ++nt)
#pragma unroll
          for (int g = 0; g < 4; ++g) {
            float v0 = acc[mt][nt][4 * g], v1 = acc[mt][nt][4 * g + 1], v2 = acc[mt][nt][4 * g + 2], v3 = acc[mt][nt][4 * g + 3];
            if (isg) { v0 = silu_f(v0); v1 = silu_f(v1); v2 = silu_f(v2); v3 = silu_f(v3); }
            u32x2 v; v[0] = pk2(v0, v1); v[1] = pk2(v2, v3);
            *(u32x2*)(o + (size_t)row * pitch + cofs + nt * 32 + 8 * g + 4 * h) = v;
          }
      }
    } else if (cb < 3072) {
      const bool isq = cb < 2560;
      if (isq && isctx) return;
      const float* rope = (const float*)(ws + WS_ROPE);
      bf16_t* o = (bf16_t*)(ws + (isq ? WS_Q : WS_K));
      const int cofs = cb - (isq ? 2048 : 2560);
      const float qs = isq ? 0.125f * 1.4426950408889634f : 1.f;
#pragma unroll
      for (int mt = 0; mt < 2; ++mt) {
        const int row = row0 + wm * 64 + mt * 32 + cl;
        size_t orow; int l = 0;
        if (!isctx) { l = row & (SEQ - 1); orow = isq ? (size_t)row : (size_t)(row >> 13) * KVL + l; }
        else { const int rc = row - TL; orow = (size_t)(rc >> 8) * KVL + SEQ + (rc & 255); }
#pragma unroll
        for (int g = 0; g < 4; ++g) {
          const int d0 = 8 * g + 4 * h;
          float o1[4], o2[4];
          if (!isctx) {
            const f32x4 ca = *(const f32x4*)(rope + ((size_t)l * 32 + d0) * 2), cb2 = *(const f32x4*)(rope + ((size_t)l * 32 + d0) * 2 + 4);
            const float cs[4] = {ca[0], ca[2], cb2[0], cb2[2]}, sn[4] = {ca[1], ca[3], cb2[1], cb2[3]};
#pragma unroll
            for (int r = 0; r < 4; ++r) { const float x1 = acc[mt][0][4 * g + r], x2 = acc[mt][1][4 * g + r]; o1[r] = (x1 * cs[r] - x2 * sn[r]) * qs; o2[r] = (x1 * sn[r] + x2 * cs[r]) * qs; }
          } else {
#pragma unroll
            for (int r = 0; r < 4; ++r) { o1[r] = acc[mt][0][4 * g + r]; o2[r] = acc[mt][1][4 * g + r]; }
          }
          u32x2 v; v[0] = pk2(o1[0], o1[1]); v[1] = pk2(o1[2], o1[3]); *(u32x2*)(o + orow * 512 + cofs + d0) = v;
          v[0] = pk2(o2[0], o2[1]); v[1] = pk2(o2[2], o2[3]); *(u32x2*)(o + orow * 512 + cofs + 32 + d0) = v;
        }
      }
    } else if (cb == 3584) {
      float* o = (float*)(ws + WS_BA);
#pragma unroll
      for (int mt = 0; mt < 2; ++mt) {
        const int row = row0 + wm * 64 + mt * 32 + cl;
#pragma unroll
        for (int g = 0; g < 4; ++g) {
          const int j0 = 8 * g + 4 * h;
          f32x4 y;
#pragma unroll
          for (int r = 0; r < 4; ++r) {
            const int j = j0 + r; const float v = acc[mt][0][4 * g + r];
            if (j0 < 16) y[r] = sigmoid_f(v);
            else { const float z = v + p->dt_bias[j - 16]; const float sp = (z > 20.f) ? z : log1pf(__expf(z)); y[r] = -__expf(p->a_log[j - 16]) * sp; }
          }
          *(f32x4*)(o + (size_t)row * 32 + j0) = y;
        }
      }
    }
  }
};

DI void ph_gemm_proj(const P& p, char* lds) {
  const bf16_t* A = (const bf16_t*)(p.ws + R0); const bf16_t* Bt = (const bf16_t*)(p.ws + WS_WIN);
  const int nM = TA / GBM, nN = NIN / GBN;
  for (int t = blockIdx.x; t < nM * nN; t += gridDim.x) {
    const int pm = t / nN, pn = t % nN;
    RowLin rf{A + (size_t)pm * GBM * DM, (size_t)DM};
    if (pn >= 24 && pn < 28) { EpiProjV ep{&p, pm * GBM, pn * GBN}; gemm_tile<false>(lds, rf, Bt + (size_t)pn * GBN * DM, DM, ep); }
    else { EpiProjS ep{&p, pm * GBM, pn * GBN}; gemm_tile<true>(lds, rf, Bt + (size_t)pn * GBN * DM, DM, ep); }
  }
}


struct PgResid {
  static constexpr bool PERM = true, AFTER_DRAIN = false;
  const float* xin; float* xout; const float* gmod;
  DI void operator()(const pg8::f32x4 (&acc)[2][2][4][2], const pg8::Unit& u, int wr, int wc, int fr, int fq) const {
#pragma unroll
    for (int ai = 0; ai < 2; ++ai)
#pragma unroll
      for (int m = 0; m < 4; ++m) {
        const int row = u.pm * 256 + ai * 128 + wr * 64 + m * 16 + fr;
        const float* gm = gmod + (size_t)(row >> 13) * 6144;
#pragma unroll
        for (int bj = 0; bj < 2; ++bj) {
          const int c0 = u.pn * 256 + bj * 128 + wc * 32 + 8 * fq;
#pragma unroll
          for (int n = 0; n < 2; ++n) {
            const f32x4 xv = *(const f32x4*)(xin + (size_t)row * DM + c0 + 4 * n), g4 = *(const f32x4*)(gm + c0 + 4 * n);
            *(f32x4*)(xout + (size_t)row * DM + c0 + 4 * n) = xv + g4 * acc[ai][bj][m][n];
          }
        }
      }
  }
};
struct PgBf16 {
  static constexpr bool PERM = true, AFTER_DRAIN = false;
  bf16_t* o; int pitch;
  DI void operator()(const pg8::f32x4 (&acc)[2][2][4][2], const pg8::Unit& u, int wr, int wc, int fr, int fq) const {
#pragma unroll
    for (int ai = 0; ai < 2; ++ai)
#pragma unroll
      for (int m = 0; m < 4; ++m) {
        const int row = u.pm * 256 + ai * 128 + wr * 64 + m * 16 + fr;
#pragma unroll
        for (int bj = 0; bj < 2; ++bj) {
          const int c0 = u.pn * 256 + bj * 128 + wc * 32 + 8 * fq;
          const f32x4 v0 = acc[ai][bj][m][0], v1 = acc[ai][bj][m][1];
          u32x4 w; w[0] = pk2(v0[0], v0[1]); w[1] = pk2(v0[2], v0[3]); w[2] = pk2(v1[0], v1[1]); w[3] = pk2(v1[2], v1[3]);
          *(u32x4*)(o + (size_t)row * pitch + c0) = w;
        }
      }
  }
};
struct PgProj {
  static constexpr bool PERM = true, AFTER_DRAIN = false, DEQ = true;
  const P* p;
  DI void deq(pg8::f32x4 (&acc)[2][2][4][2], const pg8::Unit& u, int wr, int wc, int fr, int fq) const {
    const float* srow = (const float*)(p->ws + WS_HS0); const float* scol = (const float*)(p->ws + WS_SWIN);
#pragma unroll
    for (int bj = 0; bj < 2; ++bj) {
      const int c0 = u.pn * 256 + bj * 128 + wc * 32 + 8 * fq;
      const f32x4 sc0 = *(const f32x4*)(scol + c0), sc1 = *(const f32x4*)(scol + c0 + 4);
#pragma unroll
      for (int ai = 0; ai < 2; ++ai)
#pragma unroll
        for (int m = 0; m < 4; ++m) {
          const float sr = srow[u.pm * 256 + ai * 128 + wr * 64 + m * 16 + fr];
          const pg8::v4i_t i0 = __builtin_bit_cast(pg8::v4i_t, acc[ai][bj][m][0]), i1 = __builtin_bit_cast(pg8::v4i_t, acc[ai][bj][m][1]);
#pragma unroll
          for (int r = 0; r < 4; ++r) { acc[ai][bj][m][0][r] = (float)i0[r] * sr * sc0[r]; acc[ai][bj][m][1][r] = (float)i1[r] * sr * sc1[r]; }
        }
    }
  }
  DI void operator()(const pg8::f32x4 (&acc)[2][2][4][2], const pg8::Unit& u, int wr, int wc, int fr, int fq) const {
    char* ws = p->ws;
    const bool isctx = u.pm * 256 >= TL;
#pragma unroll
    for (int bj = 0; bj < 2; ++bj) {
      const int c0 = u.pn * 256 + bj * 128 + wc * 32 + 8 * fq;
      const int cs = u.pn * 256 + bj * 128 + wc * 32;
      if (cs < 2048) {
        const bool isg = cs >= 1536;
        if (isg && isctx) continue;
        bf16_t* o = (bf16_t*)(ws + (isg ? WS_GATE : WS_QKVRAW));
        const int pitch = isg ? 512 : 1536, cofs = isg ? c0 - 1536 : c0;
#pragma unroll
        for (int ai = 0; ai < 2; ++ai)
#pragma unroll
          for (int m = 0; m < 4; ++m) {
            const int row = u.pm * 256 + ai * 128 + wr * 64 + m * 16 + fr;
            f32x4 v0 = acc[ai][bj][m][0], v1 = acc[ai][bj][m][1];
            if (isg) {
#pragma unroll
              for (int r = 0; r < 4; ++r) { v0[r] = silu_f(v0[r]); v1[r] = silu_f(v1[r]); }
            }
            u32x4 w; w[0] = pk2(v0[0], v0[1]); w[1] = pk2(v0[2], v0[3]); w[2] = pk2(v1[0], v1[1]); w[3] = pk2(v1[2], v1[3]);
            *(u32x4*)(o + (size_t)row * pitch + cofs) = w;
          }
      } else if (cs < 3072) {
        const bool isq = cs < 2560;
        if (isq && isctx) continue;
        const float* rope = (const float*)(ws + WS_ROPE);
        bf16_t* o = (bf16_t*)(ws + (isq ? WS_Q : WS_K));
        const int gofs = (c0 & ~63) - (isq ? 2048 : 2560), d0 = ((c0 & 63) >> 3) * 4;
        const float qs = isq ? 0.125f * 1.4426950408889634f : 1.f;
#pragma unroll
        for (int ai = 0; ai < 2; ++ai)
#pragma unroll
          for (int m = 0; m < 4; ++m) {
            const int row = u.pm * 256 + ai * 128 + wr * 64 + m * 16 + fr;
            const f32x4 x1 = acc[ai][bj][m][0], x2 = acc[ai][bj][m][1];
            size_t orow; float o1[4], o2[4];
            if (!isctx) {
              const int l = row & (SEQ - 1);
              orow = isq ? (size_t)row : (size_t)(row >> 13) * KVL + l;
              const f32x4 ca = *(const f32x4*)(rope + ((size_t)l * 32 + d0) * 2), cb2 = *(const f32x4*)(rope + ((size_t)l * 32 + d0) * 2 + 4);
              const float cs4[4] = {ca[0], ca[2], cb2[0], cb2[2]}, sn4[4] = {ca[1], ca[3], cb2[1], cb2[3]};
#pragma unroll
              for (int r = 0; r < 4; ++r) { o1[r] = (x1[r] * cs4[r] - x2[r] * sn4[r]) * qs; o2[r] = (x1[r] * sn4[r] + x2[r] * cs4[r]) * qs; }
            } else {
              const int rc = row - TL; orow = (size_t)(rc >> 8) * KVL + SEQ + (rc & 255);
#pragma unroll
              for (int r = 0; r < 4; ++r) { o1[r] = x1[r]; o2[r] = x2[r]; }
            }
            u32x2 v; v[0] = pk2(o1[0], o1[1]); v[1] = pk2(o1[2], o1[3]); *(u32x2*)(o + orow * 512 + gofs + d0) = v;
            v[0] = pk2(o2[0], o2[1]); v[1] = pk2(o2[2], o2[3]); *(u32x2*)(o + orow * 512 + gofs + 32 + d0) = v;
          }
      } else if (cs < 3584) {
        bf16_t* o = (bf16_t*)(ws + WS_VROW);
#pragma unroll
        for (int ai = 0; ai < 2; ++ai)
#pragma unroll
          for (int m = 0; m < 4; ++m) {
            const int row = u.pm * 256 + ai * 128 + wr * 64 + m * 16 + fr;
            size_t orow; if (!isctx) orow = (size_t)(row >> 13) * KVL + (row & (SEQ - 1)); else { const int rc = row - TL; orow = (size_t)(rc >> 8) * KVL + SEQ + (rc & 255); }
            const f32x4 v0 = acc[ai][bj][m][0], v1 = acc[ai][bj][m][1];
            u32x4 w; w[0] = cvtpk(v0[0], v0[1]); w[1] = cvtpk(v0[2], v0[3]); w[2] = cvtpk(v1[0], v1[1]); w[3] = cvtpk(v1[2], v1[3]);
            *(u32x4*)(o + orow * 512 + (c0 - 3072)) = w;
          }
      } else if (cs == 3584) {
        float* o = (float*)(ws + WS_BA);
        const int j0 = c0 - 3584;
#pragma unroll
        for (int ai = 0; ai < 2; ++ai)
#pragma unroll
          for (int m = 0; m < 4; ++m) {
            const int row = u.pm * 256 + ai * 128 + wr * 64 + m * 16 + fr;
#pragma unroll
            for (int n = 0; n < 2; ++n) {
              f32x4 y;
#pragma unroll
              for (int r = 0; r < 4; ++r) {
                const int j = j0 + 4 * n + r; const float v = acc[ai][bj][m][n][r];
                if (j0 < 16) y[r] = sigmoid_f(v);
                else { const float z = v + p->dt_bias[j - 16]; const float sp = (z > 20.f) ? z : log1pf(__expf(z)); y[r] = -__expf(p->a_log[j - 16]) * sp; }
              }
              *(f32x4*)(o + (size_t)row * 32 + j0 + 4 * n) = y;
            }
          }
      }
    }
  }
};
struct PgScoreI8 {
  static constexpr bool PERM = true, AFTER_DRAIN = false, DEQ = false;
  bf16_t* o; const float* srow; const float* scol;
  DI void operator()(const pg8::f32x4 (&acc)[2][2][4][2], const pg8::Unit& u, int wr, int wc, int fr, int fq) const {
#pragma unroll
    for (int bj = 0; bj < 2; ++bj) {
      const int c0 = u.pn * 256 + bj * 128 + wc * 32 + 8 * fq;
      const f32x4 s0 = *(const f32x4*)(scol + c0), s1 = *(const f32x4*)(scol + c0 + 4);
#pragma unroll
      for (int ai = 0; ai < 2; ++ai)
#pragma unroll
        for (int m = 0; m < 4; ++m) {
          const int row = u.pm * 256 + ai * 128 + wr * 64 + m * 16 + fr;
          const float sr = srow[row];
          const pg8::v4i_t i0 = __builtin_bit_cast(pg8::v4i_t, acc[ai][bj][m][0]), i1 = __builtin_bit_cast(pg8::v4i_t, acc[ai][bj][m][1]);
          u32x4 w;
          w[0] = pk2((float)i0[0] * sr * s0[0], (float)i0[1] * sr * s0[1]); w[1] = pk2((float)i0[2] * sr * s0[2], (float)i0[3] * sr * s0[3]);
          w[2] = pk2((float)i1[0] * sr * s1[0], (float)i1[1] * sr * s1[1]); w[3] = pk2((float)i1[2] * sr * s1[2], (float)i1[3] * sr * s1[3]);
          *(u32x4*)(o + (size_t)row * 2048 + c0) = w;
        }
    }
  }
};
template <class Epi>
DI void pg8_run_i8(char* lds, const void* A8, const void* Bt8, int M, int N, int Kbytes, const Epi& E) {
  pg8::Gemm g{(const pg8::bf16_t*)A8, (const pg8::bf16_t*)Bt8, M, N, Kbytes / 2};
  pg8::StaticOrder S; S.init(M, N, (int)gridDim.x, (int)blockIdx.x);
  pg8::gemm_phase<Epi, pg8::StaticOrder, true, true, true>((PG8_LAS unsigned char*)lds, g, S, E);
}
template <class Epi>
DI void pg8_run(char* lds, const bf16_t* A, const bf16_t* Bt, int M, int N, int K, const Epi& E) {
  pg8::Gemm g{A, Bt, M, N, K};
  pg8::StaticOrder S; S.init(M, N, (int)gridDim.x, (int)blockIdx.x);
  pg8::gemm_phase<Epi, pg8::StaticOrder, true, true>((PG8_LAS unsigned char*)lds, g, S, E);
}

DI void gdn_solve(const float* MT, const float* src  , const float* be, const float* gc  ,
                  int d, int part, int lane, bf16_t* uo) {
  float a[64];
#pragma unroll
  for (int i = 0; i < 64; ++i) {
    const int t = d ? 63 - i : i;
    float v = be[t] * src[t * 68 + lane];
    if (part) v *= __expf(gc[t]);
    a[i] = v;
  }
#pragma unroll
  for (int j = 0; j < 63; ++j) {
    const float xj = a[j];
#pragma unroll
    for (int i4 = ((j + 1) & ~3); i4 < 64; i4 += 4) {
      const f32x4 m = *(const f32x4*)(MT + j * 68 + i4);
#pragma unroll
      for (int q = 0; q < 4; ++q) if (i4 + q > j) a[i4 + q] -= m[q] * xj;
    }
  }
  if (part) {
#pragma unroll
    for (int i = 0; i < 64; ++i) uo[i * 64 + lane] = (bf16_t)f2bf(a[i]);
  } else {
#pragma unroll
    for (int c = 0; c < 8; ++c) {
      u32x4 o; o[0] = pk2(a[8 * c], a[8 * c + 1]); o[1] = pk2(a[8 * c + 2], a[8 * c + 3]); o[2] = pk2(a[8 * c + 4], a[8 * c + 5]); o[3] = pk2(a[8 * c + 6], a[8 * c + 7]);
      *(u32x4*)(uo + lane * 64 + 8 * c) = o;
    }
  }
}

template <int MODE = 0>
DI void ph_gdn_prep(const P& p, char* lds) {
  const int tid0 = otid();
  float* L = (float*)lds;
  constexpr int HSZ = 4 * 64 * 68 + 6 * 64;
  const bf16_t* raw = (const bf16_t*)(p.ws + WS_QKVRAW);
  const float* BA = (const float*)(p.ws + WS_BA);
  bf16_t* qn = (bf16_t*)(p.ws + WS_QN); bf16_t* kn = (bf16_t*)(p.ws + WS_KN);
  float* GC = (float*)(p.ws + WS_GC);
  bf16_t* UW = (bf16_t*)(p.ws + WS_UW);
  for (int it = blockIdx.x; it < NB * NCH * 4; it += gridDim.x) {
    int tid = tid0; asm volatile("" : "+v"(tid));
    const int lane = tid & 63, wave = __builtin_amdgcn_readfirstlane(tid >> 6);
    const int hpair = it & 3, cid = (it >> 2) % NCH, b = it / (4 * NCH);
    const int segbase = (cid < 4) ? TL + b * CTXL : b * SEQ, c0 = (cid < 4) ? cid * 64 : (cid - 4) * 64, seglen = (cid < 4) ? CTXL : SEQ;
    __syncthreads();
    {
      const int t = tid >> 3, c8 = tid & 7, sidx = c0 + t;
      const size_t grow = (size_t)(segbase + sidx);
      const bool hm = sidx - 1 >= 0, hp_ = sidx + 1 < seglen;
#pragma unroll 1
      for (int hh = 0; hh < 2; ++hh) {
        const int head = hpair * 2 + hh;
        float* kf = L + hh * HSZ; float* vf = kf + 64 * 68;
#pragma unroll
        for (int part = 0; part < 3; ++part) {
          const int ch = part * 512 + head * 64 + c8 * 8;
          const u32x4 z4 = {0u, 0u, 0u, 0u};
          const u32x4 rm = hm ? *(const u32x4*)(raw + (grow - 1) * 1536 + ch) : z4;
          const u32x4 r0v = *(const u32x4*)(raw + grow * 1536 + ch);
          const u32x4 rp = hp_ ? *(const u32x4*)(raw + (grow + 1) * 1536 + ch) : z4;
          float v[8]; float ss = 0.f;
#pragma unroll
          for (int w = 0; w < 4; ++w) {
            const f32x2_t w0 = *(const f32x2_t*)(p.conv_w + ch + 2 * w), w1 = *(const f32x2_t*)(p.conv_w + 1536 + ch + 2 * w), w2 = *(const f32x2_t*)(p.conv_w + 3072 + ch + 2 * w);
            v[2 * w] = silu_f(w0[0] * bflo(rm[w]) + w1[0] * bflo(r0v[w]) + w2[0] * bflo(rp[w]));
            v[2 * w + 1] = silu_f(w0[1] * bfhi(rm[w]) + w1[1] * bfhi(r0v[w]) + w2[1] * bfhi(rp[w]));
            ss += v[2 * w] * v[2 * w] + v[2 * w + 1] * v[2 * w + 1];
          }
          if (part < 2) {
            ss += __shfl_xor(ss, 1, 64); ss += __shfl_xor(ss, 2, 64); ss += __shfl_xor(ss, 4, 64);
            const float rn = rsqrtf(ss + EPS) * (part == 0 ? 0.125f : 1.f);
#pragma unroll
            for (int w = 0; w < 8; ++w) v[w] *= rn;
            u32x4 o; o[0] = pk2(v[0], v[1]); o[1] = pk2(v[2], v[3]); o[2] = pk2(v[4], v[5]); o[3] = pk2(v[6], v[7]);
            *(u32x4*)((part == 0 ? qn : kn) + grow * 512 + head * 64 + c8 * 8) = o;
          }
          if (part >= 1) {
            float* dst = (part == 1 ? kf : vf) + t * 68 + c8 * 8;
            *(f32x4*)dst = f32x4{v[0], v[1], v[2], v[3]}; *(f32x4*)(dst + 4) = f32x4{v[4], v[5], v[6], v[7]};
          }
        }
      }
    }
    if (MODE == 2) continue;
    if (wave < 4) {
      const int hh = wave >> 1, d = wave & 1, head = hpair * 2 + hh, t = lane;
      float* be = L + hh * HSZ + 4 * 64 * 68;
      const size_t row = (size_t)(segbase + c0 + t);
      be[d * 64 + t] = BA[row * 32 + d * 8 + head];
      const float g = BA[row * 32 + 16 + d * 8 + head];
      float a = g;
#pragma unroll
      for (int o = 1; o < 64; o <<= 1) {
        const float nb_ = d ? __shfl_down(a, o, 64) : __shfl_up(a, o, 64);
        const bool ok = d ? (lane + o < 64) : (lane >= o);
        a += ok ? nb_ : 0.f;
      }
      be[256 + d * 64 + t] = a;
      GC[((size_t)((b * 8 + head) * 2 + d) * NCH + cid) * 64 + (d ? 63 - t : t)] = a;
    }
    __syncthreads();
    {
      const int hh = wave >> 2, Ln = lane;
      float* kf = L + hh * HSZ; float* M0 = kf + 2 * 64 * 68; float* M1 = kf + 3 * 64 * 68; float* be = kf + 4 * 64 * 68; float* gc = be + 256;
      float a[16];
#pragma unroll
      for (int i = 0; i < 16; ++i) a[i] = 0.f;
#pragma unroll 1
      for (int c = 0; c < 64; c += 4) {
        const f32x4 kv = *(const f32x4*)(kf + Ln * 68 + c);
#pragma unroll
        for (int i = 0; i < 16; ++i) { const f32x4 kr = *(const f32x4*)(kf + ((wave & 3) * 16 + i) * 68 + c); a[i] += kv[0] * kr[0] + kv[1] * kr[1] + kv[2] * kr[2] + kv[3] * kr[3]; }
      }
      const float b0 = be[Ln], b1 = be[64 + Ln], g0 = gc[Ln], g1 = gc[64 + Ln];
#pragma unroll
      for (int i = 0; i < 16; ++i) {
        const int ti = (wave & 3) * 16 + i;
        if (Ln > ti) M0[ti * 68 + Ln] = b0 * a[i] * __expf(g0 - gc[ti]);
        else if (Ln < ti) M1[(63 - ti) * 68 + 63 - Ln] = b1 * a[i] * __expf(g1 - gc[64 + ti]);
      }
    }
    __syncthreads();
    if (MODE == 0) {
      const int hh = wave >> 2, d = (wave >> 1) & 1, part = wave & 1, head = hpair * 2 + hh;
      float* kf = L + hh * HSZ; float* vf = kf + 64 * 68; float* Md = kf + (2 + d) * 64 * 68; float* be = kf + 4 * 64 * 68; float* gc = be + 256;
      bf16_t* uo = UW + (((size_t)((b * 8 + head) * 2 + d) * NCH + cid) * 2 + part) * 4096;
      gdn_solve(Md, part ? kf : vf, be + d * 64, gc + d * 64, d, part, lane, uo);
    }
  }
}

#define MFMA16(a, b, c) __builtin_amdgcn_mfma_f32_16x16x32_bf16((a), (b), (c), 0, 0, 0)
constexpr int SC_LD = 72;
constexpr int SC_T = 64 * SC_LD * 2;
constexpr int SC_STAGE = 5 * SC_T + 1024;
constexpr int SC_KNL = 2 * SC_STAGE, SC_QNL = SC_KNL + SC_T;
DI bf16x8 pack8(const f32x4& a, const f32x4& b) { u32x4 r; r[0] = cvtpk(a[0], a[1]); r[1] = cvtpk(a[2], a[3]); r[2] = cvtpk(b[0], b[1]); r[3] = cvtpk(b[2], b[3]); return __builtin_bit_cast(bf16x8, r); }
DI bf16x8 afrag(const char* tile, int row, int kofs  ) {
  const char* pr = tile + (row * SC_LD + kofs) * 2;
  const u32x2 lo = *(const u32x2*)pr, hi = *(const u32x2*)(pr + 32);
  u32x4 r; r[0] = lo[0]; r[1] = lo[1]; r[2] = hi[0]; r[3] = hi[1];
  return __builtin_bit_cast(bf16x8, r);
}
template <int NOSTORE = 0>
DI void ph_gdn_scan(const P& p, char* lds) {
  const int tid = otid(), lane = tid & 63, wave = __builtin_amdgcn_readfirstlane(tid >> 6);
  const int c = lane & 15, q = lane >> 4;
  const bf16_t* qn = (const bf16_t*)(p.ws + WS_QN); const bf16_t* kn = (const bf16_t*)(p.ws + WS_KN);
  const float* GC = (const float*)(p.ws + WS_GC);
  const bf16_t* UW = (const bf16_t*)(p.ws + WS_UW);
  bf16_t* Ob = (bf16_t*)(p.ws + WS_OBUF);
  for (int it = blockIdx.x; it < 64; it += gridDim.x) {
    const int bhd = it, d = bhd & 1, head = (bhd >> 1) & 7, b = bhd >> 4;
    __syncthreads();
    if (wave >= 4) {
      const int pt = tid - 256;
      const int r0 = pt >> 3, cc = pt & 7;
      u32x4 rW0A, rW1A, rU0A, rU1A, rK0A, rK1A, rQ0A, rQ1A; f32x4 rGA;
      u32x4 rW0B, rW1B, rU0B, rU1B, rK0B, rK1B, rQ0B, rQ1B; f32x4 rGB;
#define SP_CID(n) (d ? ((n) < 4 ? 3 - (n) : 135 - (n)) : (n))
#define SP_LOAD(n, S) do { const int nn_ = (n) < NCH ? (n) : NCH - 1; const int cid_ = SP_CID(nn_); const bool lat_ = cid_ >= 4; const int sb_ = lat_ ? b * SEQ : TL + b * CTXL, c0_ = lat_ ? (cid_ - 4) * 64 : cid_ * 64; \
        const bf16_t* uw_ = UW + ((size_t)(bhd * NCH + cid_) * 2) * 4096; \
        rU0##S = *(const u32x4*)(uw_ + r0 * 64 + cc * 8); rU1##S = *(const u32x4*)(uw_ + (r0 + 32) * 64 + cc * 8); \
        rW0##S = *(const u32x4*)(uw_ + 4096 + r0 * 64 + cc * 8); rW1##S = *(const u32x4*)(uw_ + 4096 + (r0 + 32) * 64 + cc * 8); \
        const int t0_ = d ? 63 - r0 : r0, t1_ = d ? 31 - r0 : r0 + 32; \
        rK0##S = *(const u32x4*)(kn + (size_t)(sb_ + c0_ + t0_) * 512 + head * 64 + cc * 8); rK1##S = *(const u32x4*)(kn + (size_t)(sb_ + c0_ + t1_) * 512 + head * 64 + cc * 8); \
        const bf16_t* qk_ = lat_ ? qn : kn;     \
        rQ0##S = *(const u32x4*)(qk_ + (size_t)(sb_ + c0_ + t0_) * 512 + head * 64 + cc * 8); rQ1##S = *(const u32x4*)(qk_ + (size_t)(sb_ + c0_ + t1_) * 512 + head * 64 + cc * 8); \
        rG##S = *(const f32x4*)(GC + (size_t)(bhd * NCH + cid_) * 64 + (pt & 15) * 4); } while (0)
#define SP_A(n, S) do { char* st_ = lds + ((n) & 1) * SC_STAGE; const int o0_ = (r0 * SC_LD + cc * 8) * 2, o1_ = o0_ + 32 * SC_LD * 2; \
        *(u32x4*)(st_ + o0_) = rW0##S; *(u32x4*)(st_ + o1_) = rW1##S; *(u32x4*)(st_ + SC_T + o0_) = rU0##S; *(u32x4*)(st_ + SC_T + o1_) = rU1##S; \
        *(u32x4*)(lds + SC_KNL + o0_) = rK0##S; *(u32x4*)(lds + SC_KNL + o1_) = rK1##S; \
        *(u32x4*)(lds + SC_QNL + o0_) = rQ0##S; *(u32x4*)(lds + SC_QNL + o1_) = rQ1##S; \
        if (pt < 16) { float* gp_ = (float*)(st_ + 5 * SC_T); *(f32x4*)(gp_ + pt * 4) = rG##S; } } while (0)
#define SP_B(n) do { char* st_ = lds + ((n) & 1) * SC_STAGE; float* gp_ = (float*)(st_ + 5 * SC_T); const bool lat_ = SP_CID((n) < NCH ? (n) : NCH - 1) >= 4; \
        const float gl_ = gp_[63]; \
        if (pt < 64) { const float gi_ = gp_[pt]; gp_[64 + pt] = __expf(gi_); gp_[128 + pt] = __expf(gl_ - gi_); if (pt == 0) gp_[192] = __expf(gl_); } \
        {   \
          const int i_ = pt & 63; \
          _Pragma("unroll") for (int e_ = 0; e_ < 2; ++e_) { const int ch_ = (pt >> 6) * 2 + e_; const u32x4 kv_ = *(const u32x4*)(lds + SC_KNL + (i_ * SC_LD + ch_ * 8) * 2); \
            bf16_t* kt_ = (bf16_t*)(st_ + 2 * SC_T); \
            _Pragma("unroll") for (int w_ = 0; w_ < 4; ++w_) { kt_[(ch_ * 8 + 2 * w_) * SC_LD + i_] = (bf16_t)(kv_[w_] & 0xFFFFu); kt_[(ch_ * 8 + 2 * w_ + 1) * SC_LD + i_] = (bf16_t)(kv_[w_] >> 16); } } } \
        if (lat_) { \
          {   \
            _Pragma("unroll") for (int e_ = 0; e_ < 2; ++e_) { const int rr_ = r0 + 32 * e_; const float sc_ = __expf(gp_[rr_]); const u32x4 qv_ = *(const u32x4*)(lds + SC_QNL + (rr_ * SC_LD + cc * 8) * 2); u32x4 ov_; \
              _Pragma("unroll") for (int w_ = 0; w_ < 4; ++w_) ov_[w_] = cvtpk(bflo(qv_[w_]) * sc_, bfhi(qv_[w_]) * sc_); \
              *(u32x4*)(st_ + 3 * SC_T + (rr_ * SC_LD + cc * 8) * 2) = ov_; } } \
          {   \
            const int jt_ = wave - 4; \
            const bf16x8 ka0_ = *(const bf16x8*)(lds + SC_KNL + ((16 * jt_ + c) * SC_LD + 8 * q) * 2), ka1_ = *(const bf16x8*)(lds + SC_KNL + ((16 * jt_ + c) * SC_LD + 32 + 8 * q) * 2); \
            bf16x8 qb_[4][2]; \
            _Pragma("unroll") for (int it_ = 0; it_ < 4; ++it_) { qb_[it_][0] = *(const bf16x8*)(lds + SC_QNL + ((16 * it_ + c) * SC_LD + 8 * q) * 2); qb_[it_][1] = *(const bf16x8*)(lds + SC_QNL + ((16 * it_ + c) * SC_LD + 32 + 8 * q) * 2); } \
            const f32x4 gj_ = *(const f32x4*)(gp_ + 16 * jt_ + 4 * q); \
            float gi_[4]; _Pragma("unroll") for (int it_ = 0; it_ < 4; ++it_) gi_[it_] = gp_[16 * it_ + c]; \
            _Pragma("unroll") for (int it_ = 0; it_ < 4; ++it_) { \
              f32x4 ac_ = {0.f, 0.f, 0.f, 0.f}; \
              ac_ = MFMA16(ka0_, qb_[it_][0], ac_); ac_ = MFMA16(ka1_, qb_[it_][1], ac_); \
              const int i_ = 16 * it_ + c; \
              _Pragma("unroll") for (int r_ = 0; r_ < 4; ++r_) { const int j_ = 16 * jt_ + 4 * q + r_; const float e_ = __expf(fminf(gi_[it_] - gj_[r_], 0.f)); ac_[r_] = (i_ >= j_) ? ac_[r_] * e_ : 0.f; } \
              u32x2 ov_; ov_[0] = cvtpk(ac_[0], ac_[1]); ov_[1] = cvtpk(ac_[2], ac_[3]); \
              *(u32x2*)(st_ + 4 * SC_T + ((16 * it_ + c) * SC_LD + 16 * jt_ + 4 * q) * 2) = ov_; } } } } while (0)
      SP_LOAD(0, A); SP_LOAD(1, B);
      SP_A(0, A);
      __syncthreads();
      SP_B(0);
      SP_LOAD(2, A);
      __syncthreads();
#define SP_STEP(n, S) do { SP_A((n) + 1, S); SP_LOAD((n) + 3, S);        \
        __syncthreads();                 \
        SP_B((n) + 1); \
        __syncthreads();                 } while (0)
#pragma unroll 1
      for (int n = 0; n < NCH; n += 2) { SP_STEP(n, B); SP_STEP(n + 1, A); }
#undef SP_STEP
#undef SP_LOAD
#undef SP_A
#undef SP_B
    } else {
      f32x4 S[4];
#pragma unroll
      for (int i = 0; i < 4; ++i) S[i] = f32x4{0.f, 0.f, 0.f, 0.f};
      __syncthreads();
      __syncthreads();
#pragma unroll 1
      for (int n = 0; n < NCH; ++n) {
        const int cid = SP_CID(n); const bool lat = cid >= 4;
        const char* st = lds + (n & 1) * SC_STAGE; const float* gp = (const float*)(st + 5 * SC_T);
        bf16x8 Sb[2], Sn[2];
#pragma unroll
        for (int ks = 0; ks < 2; ++ks) {
          Sb[ks] = pack8(S[2 * ks], S[2 * ks + 1]);
          u32x4 t = __builtin_bit_cast(u32x4, Sb[ks]);
#pragma unroll
          for (int w = 0; w < 4; ++w) t[w] ^= 0x80008000u;
          Sn[ks] = __builtin_bit_cast(bf16x8, t);
        }
        u32x2 ur[4]; bf16x8 wf[4][2], kf2[4][2]; f32x4 sc4[4];
#pragma unroll
        for (int mt = 0; mt < 4; ++mt) {
          ur[mt] = *(const u32x2*)(st + SC_T + ((16 * wave + c) * SC_LD + 16 * mt + 4 * q) * 2);
          wf[mt][0] = afrag(st, 16 * mt + c, 4 * q); wf[mt][1] = afrag(st, 16 * mt + c, 32 + 4 * q);
          sc4[mt] = *(const f32x4*)(gp + 128 + 16 * mt + 4 * q);
        }
#pragma unroll
        for (int dt = 0; dt < 4; ++dt) { kf2[dt][0] = afrag(st + 2 * SC_T, 16 * dt + c, 4 * q); kf2[dt][1] = afrag(st + 2 * SC_T, 16 * dt + c, 32 + 4 * q); }
        const float gt = gp[192];
        f32x4 vn[4], vs[4];
#pragma unroll
        for (int mt = 0; mt < 4; ++mt) {
          f32x4 acc = {bflo(ur[mt][0]), bfhi(ur[mt][0]), bflo(ur[mt][1]), bfhi(ur[mt][1])};
          acc = MFMA16(wf[mt][0], Sn[0], acc);
          acc = MFMA16(wf[mt][1], Sn[1], acc);
          vn[mt] = acc;
          vs[mt] = acc * sc4[mt];
        }
        bf16x8 Vn[2], Vs[2];
#pragma unroll
        for (int ks = 0; ks < 2; ++ks) { Vn[ks] = pack8(vn[2 * ks], vn[2 * ks + 1]); Vs[ks] = pack8(vs[2 * ks], vs[2 * ks + 1]); }
        f32x4 Snew[4];
#pragma unroll
        for (int dt = 0; dt < 4; ++dt) {
          f32x4 acc = S[dt] * gt;
          acc = MFMA16(kf2[dt][0], Vs[0], acc);
          acc = MFMA16(kf2[dt][1], Vs[1], acc);
          Snew[dt] = acc;
        }
        __syncthreads();
        if (lat) {
          const int sb = b * SEQ, c0 = (cid - 4) * 64;
          bf16x8 qf[4][2], pf[4][2];
#pragma unroll
          for (int mt = 0; mt < 4; ++mt) {
            qf[mt][0] = afrag(st + 3 * SC_T, 16 * mt + c, 4 * q); qf[mt][1] = afrag(st + 3 * SC_T, 16 * mt + c, 32 + 4 * q);
            pf[mt][0] = afrag(st + 4 * SC_T, 16 * mt + c, 4 * q); pf[mt][1] = afrag(st + 4 * SC_T, 16 * mt + c, 32 + 4 * q);
          }
#pragma unroll
          for (int mt = 0; mt < 4; ++mt) {
            f32x4 o = {0.f, 0.f, 0.f, 0.f};
            o = MFMA16(Sb[0], qf[mt][0], o);
            o = MFMA16(Sb[1], qf[mt][1], o);
            o = MFMA16(Vn[0], pf[mt][0], o);
            o = MFMA16(Vn[1], pf[mt][1], o);
            const int i = 16 * mt + c, t = d ? 63 - i : i;
            u32x2 ov; ov[0] = cvtpk(o[0], o[1]); ov[1] = cvtpk(o[2], o[3]);
            if (!NOSTORE || ov[0] == 0x12345678u) *(u32x2*)(Ob + ((size_t)d * TL + sb + c0 + t) * 512 + head * 64 + 16 * wave + 4 * q) = ov;
          }
        }
#pragma unroll
        for (int dt = 0; dt < 4; ++dt) S[dt] = Snew[dt];
        __syncthreads();
      }
    }
#undef SP_CID
  }
}

constexpr int VT_PITCH = 1024 + 16;
DI void ph_vt8(const P& p, char* lds) {
  const int tid = otid();
  const bf16_t* vrow = (const bf16_t*)(p.ws + WS_VROW); unsigned char* vt8 = (unsigned char*)(p.ws + WS_VT);
  const int nb = (int)gridDim.x - 64;
  for (int tile = (int)blockIdx.x - 64; tile < NB * (KVL / 64); tile += nb) {
    const int b = tile / (KVL / 64), kb = tile - b * (KVL / 64);
    __syncthreads();
#pragma unroll
    for (int i = 0; i < 8; ++i) { const int e = tid + 512 * i, key = e >> 6, ch = e & 63; *(u32x4*)(lds + key * VT_PITCH + ch * 16) = *(const u32x4*)(vrow + ((size_t)b * KVL + kb * 64 + key) * 512 + ch * 8); }
    __syncthreads();
    unsigned char* dst = vt8 + ((size_t)b * 512 + tid) * KVL + kb * 64;
#pragma unroll
    for (int q4 = 0; q4 < 4; ++q4) {
      u32x4 o;
#pragma unroll
      for (int w = 0; w < 4; ++w) {
        const int D = 4 * q4 + w, h = D >> 3, k2 = (D >> 2) & 1, g = D & 3, kbase = 32 * k2 + 8 * g + 4 * h;
        float v[4];
#pragma unroll
        for (int j = 0; j < 4; ++j) v[j] = fminf(fmaxf(bf2f(*(const unsigned short*)(lds + (kbase + j) * VT_PITCH + tid * 2)) * 16.f, -448.f), 448.f);
        int wd = __builtin_amdgcn_cvt_pk_fp8_f32(v[0], v[1], 0, false);
        wd = __builtin_amdgcn_cvt_pk_fp8_f32(v[2], v[3], wd, true);
        o[w] = (unsigned)wd;
      }
      *(u32x4*)(dst + 16 * q4) = o;
    }
  }
}

DI void cvt_fp8(const bf16_t* __restrict__ src, unsigned char* __restrict__ dst, int n16, float scale) {
  const int nb = (int)gridDim.x - 64;
  for (int i = ((int)blockIdx.x - 64) * NT + otid(); i < n16; i += nb * NT) {
    const u32x4 a = *(const u32x4*)(src + (size_t)i * 16), b = *(const u32x4*)(src + (size_t)i * 16 + 8);
    u32x4 o;
#pragma unroll
    for (int w = 0; w < 2; ++w) {
      int wd = __builtin_amdgcn_cvt_pk_fp8_f32(fminf(fmaxf(bflo(a[2 * w]) * scale, -448.f), 448.f), fminf(fmaxf(bfhi(a[2 * w]) * scale, -448.f), 448.f), 0, false);
      o[w] = (unsigned)__builtin_amdgcn_cvt_pk_fp8_f32(fminf(fmaxf(bflo(a[2 * w + 1]) * scale, -448.f), 448.f), fminf(fmaxf(bfhi(a[2 * w + 1]) * scale, -448.f), 448.f), wd, true);
      wd = __builtin_amdgcn_cvt_pk_fp8_f32(fminf(fmaxf(bflo(b[2 * w]) * scale, -448.f), 448.f), fminf(fmaxf(bfhi(b[2 * w]) * scale, -448.f), 448.f), 0, false);
      o[2 + w] = (unsigned)__builtin_amdgcn_cvt_pk_fp8_f32(fminf(fmaxf(bflo(b[2 * w + 1]) * scale, -448.f), 448.f), fminf(fmaxf(bfhi(b[2 * w + 1]) * scale, -448.f), 448.f), wd, true);
    }
    *(u32x4*)(dst + (size_t)i * 16) = o;
  }
}

constexpr int AT_KROW = 72, AT_VROW = 68;
constexpr int AT_V8ROW = 80;
constexpr int AT_KB = 2 * 64 * AT_V8ROW, AT_VB = 128 * AT_V8ROW, AT_STAGE = AT_KB + AT_VB;
DI void ph_attn(const P& p, char* lds) {
  const int tid = otid(), lane = tid & 63, wave = tid >> 6, wq = wave & 3, m = wave >> 2, h = lane >> 5, cl = lane & 31;
  const unsigned char* Qb = (const unsigned char*)(p.ws + WS_Q8); const unsigned char* Kb = (const unsigned char*)(p.ws + WS_K8); const unsigned char* VT = (const unsigned char*)(p.ws + WS_VT);
  bf16_t* mix = (bf16_t*)(p.ws + WS_MIX);
  for (int it = blockIdx.x; it < NB * 4 * 64; it += gridDim.x) {
    const int qb = it & 63, head = (it >> 6) & 3, b = it >> 8;
    const int qrow = b * SEQ + qb * 128 + wq * 32 + cl;
    v8i_t qf;
    { const u32x4 lo = *(const u32x4*)(Qb + (size_t)qrow * 512 + (head * 2 + m) * 64 + 32 * h), hi = *(const u32x4*)(Qb + (size_t)qrow * 512 + (head * 2 + m) * 64 + 32 * h + 16);
      qf[0] = lo[0]; qf[1] = lo[1]; qf[2] = lo[2]; qf[3] = lo[3]; qf[4] = hi[0]; qf[5] = hi[1]; qf[6] = hi[2]; qf[7] = hi[3]; }
    f32x16 o[4];
#pragma unroll
    for (int i = 0; i < 4; ++i)
#pragma unroll
      for (int r = 0; r < 16; ++r) o[i][r] = 0.f;
    f32x16 negm, lacc;
#pragma unroll
    for (int r = 0; r < 16; ++r) { negm[r] = 0.f; lacc[r] = 0.f; }
    v8i_t ones;
#pragma unroll
    for (int r = 0; r < 8; ++r) ones[r] = 0x38383838;
    asm volatile("" : "+v"(ones));
    const unsigned char* kp0 = Kb + ((size_t)b * KVL + (tid >> 3)) * 512 + head * 128 + (tid & 7) * 16;
    const unsigned char* vp0 = VT + ((size_t)((b * 4 + head) * 128 + (tid >> 2))) * KVL + (tid & 3) * 16;
    const int kw0 = (((tid & 7) >> 2) * 64 + (tid >> 3)) * AT_V8ROW + (tid & 3) * 16;
    const int vw0 = AT_KB + (tid >> 2) * AT_V8ROW + (tid & 3) * 16;
    u32x4 rk0, rv0;
#define A_GLOAD(kv0) do { rk0 = *(const u32x4*)(kp0 + (size_t)(kv0) * 512); rv0 = *(const u32x4*)(vp0 + (kv0)); } while (0)
#define A_LWRITE(st) do { char* b_ = lds + (st) * AT_STAGE; *(u32x4*)(b_ + kw0) = rk0; *(u32x4*)(b_ + vw0) = rv0; } while (0)
    A_GLOAD(0);
    __syncthreads();
    A_LWRITE(0);
    __syncthreads();
    constexpr int NKT = KVL / 64;
    for (int kt = 0; kt < NKT; ++kt) {
      if (kt + 1 < NKT) A_GLOAD((kt + 1) * 64);
      const char* sb = lds + (kt & 1) * AT_STAGE;
      const char* ks = sb + m * 64 * AT_V8ROW;
      f32x16 st[2];
#pragma unroll
      for (int k2 = 0; k2 < 2; ++k2) {
        const char* kr = ks + (k2 * 32 + cl) * AT_V8ROW + 32 * h;
        const u32x4 lo = *(const u32x4*)(kr), hi = *(const u32x4*)(kr + 16);
        v8i_t ak; ak[0] = lo[0]; ak[1] = lo[1]; ak[2] = lo[2]; ak[3] = lo[3]; ak[4] = hi[0]; ak[5] = hi[1]; ak[6] = hi[2]; ak[7] = hi[3];
        st[k2] = __builtin_amdgcn_mfma_scale_f32_32x32x64_f8f6f4(ak, qf, negm, 0, 0, 0, 123  , 0, 121  );
      }
      float mx = __builtin_elementwise_maximum(st[0][0], st[1][0]);
#pragma unroll
      for (int r = 1; r < 16; ++r) mx = __builtin_elementwise_maximum(__builtin_elementwise_maximum(mx, st[0][r]), st[1][r]);
      { const u32x2 sw = __builtin_amdgcn_permlane32_swap(__float_as_uint(mx), __float_as_uint(mx), false, false);
        mx = __builtin_elementwise_maximum(__uint_as_float(sw[0]), __uint_as_float(sw[1])); }
      if (kt == 0 || __any(mx > 8.f)) {
        const float delta = kt == 0 ? mx : fmaxf(mx, 0.f);
        const float alpha = kt == 0 ? 0.f : __builtin_amdgcn_exp2f(-delta);
#pragma unroll
        for (int r = 0; r < 16; ++r) { negm[r] -= delta; st[0][r] -= delta; st[1][r] -= delta; lacc[r] *= alpha; }
#pragma unroll
        for (int i = 0; i < 4; ++i)
#pragma unroll
          for (int r = 0; r < 16; ++r) o[i][r] *= alpha;
      }
#pragma unroll
      for (int k2 = 0; k2 < 2; ++k2)
#pragma unroll
        for (int r = 0; r < 16; ++r) st[k2][r] = __builtin_amdgcn_exp2f(st[k2][r]);
      const char* vsb = sb + AT_KB;
      v8i_t pb;
#pragma unroll
      for (int k2 = 0; k2 < 2; ++k2)
#pragma unroll
        for (int g = 0; g < 4; ++g) {
          int wd; asm("" : "=v"(wd));
          wd = __builtin_amdgcn_cvt_pk_fp8_f32(st[k2][4 * g], st[k2][4 * g + 1], wd, false);
          pb[4 * k2 + g] = __builtin_amdgcn_cvt_pk_fp8_f32(st[k2][4 * g + 2], st[k2][4 * g + 3], wd, true);
        }
#pragma unroll
      for (int dt = 0; dt < 4; ++dt) {
        const char* vr = vsb + (dt * 32 + cl) * AT_V8ROW + 32 * h;
        const u32x4 lo = *(const u32x4*)(vr), hi = *(const u32x4*)(vr + 16);
        v8i_t av; av[0] = lo[0]; av[1] = lo[1]; av[2] = lo[2]; av[3] = lo[3]; av[4] = hi[0]; av[5] = hi[1]; av[6] = hi[2]; av[7] = hi[3];
        o[dt] = __builtin_amdgcn_mfma_scale_f32_32x32x64_f8f6f4(av, pb, o[dt], 0, 0, 0, 127, 0, 127);
      }
      lacc = __builtin_amdgcn_mfma_scale_f32_32x32x64_f8f6f4(ones, pb, lacc, 0, 0, 0, 127, 0, 127);
      if (kt + 1 < NKT) A_LWRITE((kt + 1) & 1);
      __syncthreads();
    }
#undef A_GLOAD
#undef A_LWRITE
    const float inv = 0.0625f / lacc[0];
    float* X = (float*)lds;
    if (m == 1) {
#pragma unroll
      for (int dt = 0; dt < 4; ++dt)
#pragma unroll
        for (int r = 0; r < 16; ++r) X[(wq * 32 + cl) * 129 + dt * 32 + crow(r, h)] = o[dt][r] * inv;
    }
    __syncthreads();
    if (m == 0) {
      float l1 = 0.f, l2 = 0.f;
      for (int i = 0; i < 64; ++i) { l1 += p.lam_q1[i] * p.lam_k1[i]; l2 += p.lam_q2[i] * p.lam_k2[i]; }
      const float lam = __expf(l1) - __expf(l2) + 0.2f;
      float ss = 0.f;
#pragma unroll
      for (int dt = 0; dt < 4; ++dt)
#pragma unroll
        for (int r = 0; r < 16; ++r) { const float dv = o[dt][r] * inv - lam * X[(wq * 32 + cl) * 129 + dt * 32 + crow(r, h)]; o[dt][r] = dv; ss += dv * dv; }
      ss += __shfl_xor(ss, 32, 64);
      const float rn = rsqrtf(ss * (1.f / 128.f) + EPS) * 0.8f;
#pragma unroll
      for (int dt = 0; dt < 4; ++dt)
#pragma unroll
        for (int g = 0; g < 4; ++g) {
          const int dv = dt * 32 + 8 * g + 4 * h;
          const f32x4 w4 = *(const f32x4*)(p.subln_w + dv);
          u32x2 v; v[0] = pk2(o[dt][4 * g] * rn * w4[0], o[dt][4 * g + 1] * rn * w4[1]); v[1] = pk2(o[dt][4 * g + 2] * rn * w4[2], o[dt][4 * g + 3] * rn * w4[3]);
          *(u32x2*)(mix + (size_t)qrow * DM + 512 + head * 128 + dv) = v;
        }
    }
    __syncthreads();
  }
}

DI void ph_mixout(const P& p) {
  const int lane = otid() & 63, gw = blockIdx.x * (NT / 64) + (otid() >> 6), nw_ = gridDim.x * (NT / 64);
  const bf16_t* Ob = (const bf16_t*)(p.ws + WS_OBUF); const bf16_t* gate = (const bf16_t*)(p.ws + WS_GATE);
  bf16_t* mix = (bf16_t*)(p.ws + WS_MIX);
  for (int row = gw; row < TL; row += nw_) {
    const u32x4 a = *(const u32x4*)(Ob + (size_t)row * 512 + lane * 8), bq = *(const u32x4*)(Ob + ((size_t)TL + row) * 512 + lane * 8);
    const u32x4 gv = *(const u32x4*)(gate + (size_t)row * 512 + lane * 8);
    float v[8]; float ss = 0.f;
#pragma unroll
    for (int i = 0; i < 4; ++i) { v[2 * i] = bflo(a[i]) + bflo(bq[i]); v[2 * i + 1] = bfhi(a[i]) + bfhi(bq[i]); ss += v[2 * i] * v[2 * i] + v[2 * i + 1] * v[2 * i + 1]; }
    ss += __shfl_xor(ss, 1, 64); ss += __shfl_xor(ss, 2, 64); ss += __shfl_xor(ss, 4, 64);
    const float rn = rsqrtf(ss * (1.f / 64.f) + EPS);
    const int c0 = (lane & 7) * 8;
    u32x4 ov;
#pragma unroll
    for (int i = 0; i < 4; ++i) ov[i] = pk2(v[2 * i] * rn * p.gdn_norm_w[c0 + 2 * i] * bflo(gv[i]), v[2 * i + 1] * rn * p.gdn_norm_w[c0 + 2 * i + 1] * bfhi(gv[i]));
    *(u32x4*)(mix + (size_t)row * DM + lane * 8) = ov;
  }
}

struct EpiResid {
  const float* xin; float* xout; const float* gmod  ; int row0, col0;
  DI void operator()(f32x16 (&acc)[2][2], int wm, int wn, int lane) const {
    const int h = lane >> 5, cl = lane & 31;
#pragma unroll
    for (int mt = 0; mt < 2; ++mt) {
      const int row = row0 + wm * 64 + mt * 32 + cl;
      const float* gm = gmod + (size_t)(row >> 13) * 6144;
#pragma unroll
      for (int nt = 0; nt < 2; ++nt)
#pragma unroll
        for (int g = 0; g < 4; ++g) {
          const int col = col0 + wn * 64 + nt * 32 + 8 * g + 4 * h;
          const f32x4 xv = *(const f32x4*)(xin + (size_t)row * DM + col), g4 = *(const f32x4*)(gm + col);
          f32x4 ov;
#pragma unroll
          for (int r = 0; r < 4; ++r) ov[r] = xv[r] + g4[r] * acc[mt][nt][4 * g + r];
          *(f32x4*)(xout + (size_t)row * DM + col) = ov;
        }
    }
  }
};
DI void ph_gemm_resid(const P& p, char* lds, const bf16_t* A, const bf16_t* Bt, const float* xin, const float* gmod) {
  const int nM = TL / GBM, nN = DM / GBN;
  for (int t = blockIdx.x; t < nM * nN; t += gridDim.x) {
    const int pm = t / nN, pn = t % nN;
    RowLin rf{A + (size_t)pm * GBM * DM, (size_t)DM};
    EpiResid ep{xin, p.out, gmod, pm * GBM, pn * GBN};
    gemm_tile<true>(lds, rf, Bt + (size_t)pn * GBN * DM, DM, ep);
  }
}

struct EpiBf16 {
  bf16_t* o; int pitch, row0, col0;
  DI void operator()(f32x16 (&acc)[2][2], int wm, int wn, int lane) const {
    const int h = lane >> 5, cl = lane & 31;
#pragma unroll
    for (int mt = 0; mt < 2; ++mt) {
      const int row = row0 + wm * 64 + mt * 32 + cl;
#pragma unroll
      for (int nt = 0; nt < 2; ++nt)
#pragma unroll
        for (int g = 0; g < 4; ++g) {
          u32x2 v; v[0] = pk2(acc[mt][nt][4 * g], acc[mt][nt][4 * g + 1]); v[1] = pk2(acc[mt][nt][4 * g + 2], acc[mt][nt][4 * g + 3]);
          *(u32x2*)(o + (size_t)row * pitch + col0 + wn * 64 + nt * 32 + 8 * g + 4 * h) = v;
        }
    }
  }
};
DI void ph_gemm_scores(const P& p, char* lds, int layer, size_t sc_off) {
  const bf16_t* A = (const bf16_t*)(p.ws + R0); const bf16_t* Bt = (const bf16_t*)(p.ws + WS_WEFF) + (size_t)layer * 2048 * 1024;
  const int nM = TL / GBM, nN = 2048 / GBN;
  for (int t = blockIdx.x; t < nM * nN; t += gridDim.x) {
    const int pm = t / nN, pn = t % nN;
    RowLin rf{A + (size_t)pm * GBM * DM, (size_t)DM};
    EpiBf16 ep{(bf16_t*)(p.ws + sc_off), 2048, pm * GBM, pn * GBN};
    gemm_tile<true>(lds, rf, Bt + (size_t)pn * GBN * DM, DM, ep);
  }
}

constexpr size_t WS_TSC = WS_BA;
DI void ph_tables(const P& p) {
  const int lane = otid() & 63, gw = blockIdx.x * (NT / 64) + (otid() >> 6), nw_ = gridDim.x * (NT / 64);
  float* tsc = (float*)(p.ws + WS_TSC);
  for (int rr = gw; rr < 4 * 16384; rr += nw_) {
    const int tb = rr >> 14, e = rr & 16383;
    const float* src = ((tb & 1) ? p.peer_v : p.peer_u) + ((size_t)(tb >> 1) * 16384 + e) * 1024 + lane * 16;
    f32x4 v[4]; float ss = 0.f;
#pragma unroll
    for (int i = 0; i < 4; ++i) { v[i] = *(const f32x4*)(src + 4 * i); ss += v[i][0] * v[i][0] + v[i][1] * v[i][1] + v[i][2] * v[i][2] + v[i][3] * v[i][3]; }
    ss = wave_sum(ss);
    const bool isu = (tb & 1) == 0;
    const float sc = (isu ? 0.35f : 0.5f) * sqrtf(ss * (1.f / 1024.f)) + 1e-30f, inv = 1.f / sc;
    unsigned w0 = 0u, w1 = 0u;
    if (isu) {
#pragma unroll
      for (int i = 0; i < 2; ++i)
#pragma unroll
        for (int j = 0; j < 4; ++j) {
          const int qa = (int)fminf(fmaxf(rintf(v[i][j] * inv), -7.f), 7.f), qb = (int)fminf(fmaxf(rintf(v[2 + i][j] * inv), -7.f), 7.f);
          w0 |= ((unsigned)qa & 15u) << (4 * (4 * i + j)); w1 |= ((unsigned)qb & 15u) << (4 * (4 * i + j));
        }
    } else {
      w0 = __builtin_amdgcn_cvt_scalef32_pk_fp4_f32(w0, v[0][0] * inv, v[0][1] * inv, 1.0f, 0);
      w0 = __builtin_amdgcn_cvt_scalef32_pk_fp4_f32(w0, v[0][2] * inv, v[0][3] * inv, 1.0f, 1);
      w0 = __builtin_amdgcn_cvt_scalef32_pk_fp4_f32(w0, v[1][0] * inv, v[1][1] * inv, 1.0f, 2);
      w0 = __builtin_amdgcn_cvt_scalef32_pk_fp4_f32(w0, v[1][2] * inv, v[1][3] * inv, 1.0f, 3);
      w1 = __builtin_amdgcn_cvt_scalef32_pk_fp4_f32(w1, v[2][0] * inv, v[2][1] * inv, 1.0f, 0);
      w1 = __builtin_amdgcn_cvt_scalef32_pk_fp4_f32(w1, v[2][2] * inv, v[2][3] * inv, 1.0f, 1);
      w1 = __builtin_amdgcn_cvt_scalef32_pk_fp4_f32(w1, v[3][0] * inv, v[3][1] * inv, 1.0f, 2);
      w1 = __builtin_amdgcn_cvt_scalef32_pk_fp4_f32(w1, v[3][2] * inv, v[3][3] * inv, 1.0f, 3);
    }
    u32x2 o; o[0] = w0; o[1] = w1;
    unsigned char* dst = (unsigned char*)(p.ws + WS_TAB + (size_t)tb * 8 * MiB);
    *(u32x2*)(dst + ((((size_t)(lane >> 4)) * 16384 + e) << 7) + (lane & 15) * 8) = o;
    if (lane == 0) tsc[tb * 16384 + e] = sc;
  }
}

DI unsigned srt16(unsigned bf) { return (bf & 0x8000u) ? (~bf & 0xFFFFu) : (bf | 0x8000u); }
DI float unsrt16(unsigned s) { const unsigned bf = (s & 0x8000u) ? (s & 0x7FFFu) : (~s & 0xFFFFu); return __uint_as_float(bf << 16); }
DI unsigned ckey(float v, unsigned cid) { unsigned u = __float_as_uint(v); u = (u & 0x80000000u) ? ~u : (u | 0x80000000u); return (u & 0xFFFFFF00u) | (255u - cid); }
DI float unckey(unsigned k) { unsigned u = k & 0xFFFFFF00u; u = (u & 0x80000000u) ? (u & 0x7FFFFFFFu) : ~u; return __uint_as_float(u & 0xFFFFFF00u); }
DI void bsort16(unsigned (&k)[16]) {
#pragma unroll
  for (int sz = 2; sz <= 16; sz <<= 1)
#pragma unroll
    for (int j = sz >> 1; j > 0; j >>= 1)
#pragma unroll
      for (int i = 0; i < 16; ++i) {
        const int l = i ^ j;
        if (l > i) {
          const unsigned a = k[i], b = k[l], mx = a > b ? a : b, mn = a > b ? b : a;
          if ((i & sz) == 0) { k[i] = mx; k[l] = mn; } else { k[i] = mn; k[l] = mx; }
        }
      }
}
DI void bmerge16(unsigned (&k)[16]) {
#pragma unroll
  for (int j = 8; j > 0; j >>= 1)
#pragma unroll
    for (int i = 0; i < 16; ++i) {
      const int l = i ^ j;
      if (l > i) { const unsigned a = k[i], b = k[l]; k[i] = a > b ? a : b; k[l] = a > b ? b : a; }
    }
}
DI void topmerge16(unsigned (&run)[16], const unsigned (&g)[16]) {
#pragma unroll
  for (int i = 0; i < 16; ++i) run[i] = run[i] > g[15 - i] ? run[i] : g[15 - i];
  bmerge16(run);
}
DI void top16_of_128(const bf16_t* __restrict__ r, unsigned (&run)[16]) {
#pragma unroll 1
  for (int g = 0; g < 8; ++g) {
    const u32x4 v0 = *(const u32x4*)(r + g * 16), v1 = *(const u32x4*)(r + g * 16 + 8);
    unsigned k[16];
#pragma unroll
    for (int q = 0; q < 4; ++q) {
      k[2 * q] = (srt16(v0[q] & 0xFFFFu) << 16) | (127u - (g * 16 + 2 * q));
      k[2 * q + 1] = (srt16(v0[q] >> 16) << 16) | (127u - (g * 16 + 2 * q + 1));
      k[8 + 2 * q] = (srt16(v1[q] & 0xFFFFu) << 16) | (127u - (g * 16 + 8 + 2 * q));
      k[8 + 2 * q + 1] = (srt16(v1[q] >> 16) << 16) | (127u - (g * 16 + 8 + 2 * q + 1));
    }
    bsort16(k);
    if (g == 0) {
#pragma unroll
      for (int i = 0; i < 16; ++i) run[i] = k[i];
    } else topmerge16(run, k);
  }
}
DI void ph_topk(const P& p, char* lds, size_t sc_off, size_t ei_off, size_t eg_off) {
  const bf16_t* sc = (const bf16_t*)(p.ws + sc_off); int* EI = (int*)(p.ws + ei_off); float* EG = (float*)(p.ws + eg_off);
  unsigned char* sI = (unsigned char*)lds;
  const int tid = otid();
  const int tpb_ = TL / gridDim.x;
  for (int g = blockIdx.x * tpb_ * 8 + tid; g < (blockIdx.x + 1) * tpb_ * 8; g += NT) {
    const int t = g >> 3, head = g & 7;
    const bf16_t* r1 = sc + (size_t)t * 2048 + head * 256;
    unsigned k1[16], k2[16];
    top16_of_128(r1, k1);
    top16_of_128(r1 + 128, k2);
    float f1[16], f2[16];
#pragma unroll
    for (int i = 0; i < 16; ++i) { f1[i] = unsrt16(k1[i] >> 16); f2[i] = unsrt16(k2[i] >> 16); sI[i * NT + tid] = (unsigned char)(127u - (k1[i] & 127u)); sI[(16 + i) * NT + tid] = (unsigned char)(127u - (k2[i] & 127u)); }
    unsigned cg0[16], cg1[16], cg2[16], cg3[16];
#pragma unroll
    for (int i = 0; i < 16; ++i) { cg3[i] = 0u; }
    cg0[0] = ckey(f1[0] + f2[0], 0);
    cg0[1] = ckey(f1[0] + f2[1], 1);
    cg0[2] = ckey(f1[0] + f2[2], 2);
    cg0[3] = ckey(f1[0] + f2[3], 3);
    cg0[4] = ckey(f1[0] + f2[4], 4);
    cg0[5] = ckey(f1[0] + f2[5], 5);
    cg0[6] = ckey(f1[0] + f2[6], 6);
    cg0[7] = ckey(f1[0] + f2[7], 7);
    cg0[8] = ckey(f1[0] + f2[8], 8);
    cg0[9] = ckey(f1[0] + f2[9], 9);
    cg0[10] = ckey(f1[0] + f2[10], 10);
    cg0[11] = ckey(f1[0] + f2[11], 11);
    cg0[12] = ckey(f1[0] + f2[12], 12);
    cg0[13] = ckey(f1[0] + f2[13], 13);
    cg0[14] = ckey(f1[0] + f2[14], 14);
    cg0[15] = ckey(f1[0] + f2[15], 15);
    cg1[0] = ckey(f1[1] + f2[0], 16);
    cg1[1] = ckey(f1[1] + f2[1], 17);
    cg1[2] = ckey(f1[1] + f2[2], 18);
    cg1[3] = ckey(f1[1] + f2[3], 19);
    cg1[4] = ckey(f1[1] + f2[4], 20);
    cg1[5] = ckey(f1[1] + f2[5], 21);
    cg1[6] = ckey(f1[1] + f2[6], 22);
    cg1[7] = ckey(f1[1] + f2[7], 23);
    cg1[8] = ckey(f1[2] + f2[0], 32);
    cg1[9] = ckey(f1[2] + f2[1], 33);
    cg1[10] = ckey(f1[2] + f2[2], 34);
    cg1[11] = ckey(f1[2] + f2[3], 35);
    cg1[12] = ckey(f1[2] + f2[4], 36);
    cg1[13] = ckey(f1[3] + f2[0], 48);
    cg1[14] = ckey(f1[3] + f2[1], 49);
    cg1[15] = ckey(f1[3] + f2[2], 50);
    cg2[0] = ckey(f1[3] + f2[3], 51);
    cg2[1] = ckey(f1[4] + f2[0], 64);
    cg2[2] = ckey(f1[4] + f2[1], 65);
    cg2[3] = ckey(f1[4] + f2[2], 66);
    cg2[4] = ckey(f1[5] + f2[0], 80);
    cg2[5] = ckey(f1[5] + f2[1], 81);
    cg2[6] = ckey(f1[6] + f2[0], 96);
    cg2[7] = ckey(f1[6] + f2[1], 97);
    cg2[8] = ckey(f1[7] + f2[0], 112);
    cg2[9] = ckey(f1[7] + f2[1], 113);
    cg2[10] = ckey(f1[8] + f2[0], 128);
    cg2[11] = ckey(f1[9] + f2[0], 144);
    cg2[12] = ckey(f1[10] + f2[0], 160);
    cg2[13] = ckey(f1[11] + f2[0], 176);
    cg2[14] = ckey(f1[12] + f2[0], 192);
    cg2[15] = ckey(f1[13] + f2[0], 208);
    cg3[0] = ckey(f1[14] + f2[0], 224);
    cg3[1] = ckey(f1[15] + f2[0], 240);
    bsort16(cg0); bsort16(cg1); bsort16(cg2); bsort16(cg3);
    topmerge16(cg0, cg1); topmerge16(cg2, cg3); topmerge16(cg0, cg2);
    float e[16]; int id[16]; float sum = 0.f; const float s0 = unckey(cg0[0]);
#pragma unroll
    for (int k = 0; k < 16; ++k) {
      const unsigned cid = 255u - (cg0[k] & 255u);
      e[k] = __expf(unckey(cg0[k]) - s0); sum += e[k];
      id[k] = (int)sI[(cid >> 4) * NT + tid] * 128 + (int)sI[(16 + (cid & 15)) * NT + tid];
    }
    const float inv = 1.f / sum;
#pragma unroll
    for (int k = 0; k < 16; k += 4) {
      int4 iv = {id[k], id[k + 1], id[k + 2], id[k + 3]}; f32x4 gv = {e[k] * inv, e[k + 1] * inv, e[k + 2] * inv, e[k + 3] * inv};
      *(int4*)(EI + (size_t)g * 16 + k) = iv; *(f32x4*)(EG + (size_t)g * 16 + k) = gv;
    }
  }
}

DI void fp8x16_to_f32(const u32x4& w, float (&f)[16]) {
#pragma unroll
  for (int i = 0; i < 4; ++i) {
    const f32x2_t lo = __builtin_amdgcn_cvt_pk_f32_fp8((int)w[i], false), hi = __builtin_amdgcn_cvt_pk_f32_fp8((int)w[i], true);
    f[4 * i] = lo[0]; f[4 * i + 1] = lo[1]; f[4 * i + 2] = hi[0]; f[4 * i + 3] = hi[1];
  }
}
DI void block_handoff() {
  asm volatile("s_waitcnt vmcnt(0)" ::: "memory");
  __syncthreads();
  if (otid() == 0) { __builtin_amdgcn_fence(__ATOMIC_ACQUIRE, "agent"); asm volatile("s_waitcnt vmcnt(0)" ::: "memory"); }
  __syncthreads();
}
constexpr int PQ_NS = 4;
#define PQ_BEGIN() \
  const int tid = otid(), lane = tid & 63, wave = tid >> 6, g8 = lane >> 3, c16 = lane & 7; \
  const int tpb_ = TL / gridDim.x; \
  _Pragma("unroll 1") for (int x = 0; x < PQ_NS; ++x) { \
    const int tbeg = blockIdx.x * tpb_ + wave, tend = (blockIdx.x + 1) * tpb_;
#define PQ_END() }
#define FP4X8(wd, o0, o1, o2, o3) do { o0 = __builtin_amdgcn_cvt_scalef32_pk_f32_fp4((wd), 1.0f, 0); o1 = __builtin_amdgcn_cvt_scalef32_pk_f32_fp4((wd), 1.0f, 1); \
                                         o2 = __builtin_amdgcn_cvt_scalef32_pk_f32_fp4((wd), 1.0f, 2); o3 = __builtin_amdgcn_cvt_scalef32_pk_f32_fp4((wd), 1.0f, 3); } while (0)
DI void ph_peer_u(const P& p, char* lds, int layer, size_t ei_off, size_t part_off) {
  for (int rep = 0; rep <= p.lo; ++rep) {
  PQ_BEGIN()
  const unsigned char* hq = (const unsigned char*)(p.ws + WS_HQ) + x * 128 + c16 * 16;
  const float* hs = (const float*)(p.ws + WS_HS);
  const unsigned char* us = (const unsigned char*)(p.ws + WS_TAB + (size_t)(layer * 2) * 8 * MiB) + ((size_t)x * 16384 << 7) + c16 * 16;
  const int* EI = (const int*)(p.ws + ei_off) + g8 * 16;
  unsigned* part = (unsigned*)(p.ws + part_off);
  int4 nid[4]; u32x4 nhh, nhl; float nsc;
#define PU_PREF(tt) do { const int t_ = (tt) < tend ? (tt) : tend - 1; \
    _Pragma("unroll") for (int i = 0; i < 4; ++i) nid[i] = *(const int4*)(EI + (size_t)t_ * 128 + i * 4); \
    nhh = *(const u32x4*)(hq + (size_t)t_ * 1024); nhl = *(const u32x4*)(hq + (size_t)t_ * 1024 + 512); nsc = hs[t_]; } while (0)
  PU_PREF(tbeg);
#pragma unroll 1
  for (int t = tbeg; t < tend; t += NT / 64) {
    int id[16];
#pragma unroll
    for (int i = 0; i < 4; ++i) { id[4 * i] = nid[i].x; id[4 * i + 1] = nid[i].y; id[4 * i + 2] = nid[i].z; id[4 * i + 3] = nid[i].w; }
    const u32x4 hh = nhh, hl = nhl; const float sct = nsc;
    u32x4 ur[16];
#pragma unroll
    for (int i = 0; i < 16; ++i) ur[i] = *(const u32x4*)(us + ((size_t)id[i] << 7));
    float pd[16];
#pragma unroll
    for (int i = 0; i < 16; ++i) {
      int ah = 0, al = 0;
#pragma unroll
      for (int w = 0; w < 4; ++w) { ah = __builtin_amdgcn_sdot8((int)ur[i][w], (int)hh[w], ah, false); al = __builtin_amdgcn_sdot8((int)ur[i][w], (int)hl[w], al, false); }
      pd[i] = (float)(16 * ah + al);
    }
    PU_PREF(t + NT / 64);
    float q8[8], q4[4], q2[2];
    { const bool up = (lane & 4) != 0;
#pragma unroll
      for (int m = 0; m < 8; ++m) { const float keep = up ? pd[8 + m] : pd[m], send = up ? pd[m] : pd[8 + m]; q8[m] = keep + __shfl_xor(send, 4, 64); } }
    { const bool up = (lane & 2) != 0;
#pragma unroll
      for (int m = 0; m < 4; ++m) { const float keep = up ? q8[4 + m] : q8[m], send = up ? q8[m] : q8[4 + m]; q4[m] = keep + __shfl_xor(send, 2, 64); } }
    { const bool up = (lane & 1) != 0;
#pragma unroll
      for (int m = 0; m < 2; ++m) { const float keep = up ? q4[2 + m] : q4[m], send = up ? q4[m] : q4[2 + m]; q2[m] = keep + __shfl_xor(send, 1, 64); } }
    part[((size_t)t * PQ_NS + x) * 64 + lane] = pk2(q2[0] * sct, q2[1] * sct);
  }
  PQ_END()
  }
#undef PU_PREF
}
DI void ph_peer_comb(const P& p, int layer, size_t part_off, size_t ei_off, size_t eg_off, size_t w_off) {
  const unsigned* part = (const unsigned*)(p.ws + part_off); const float* EG = (const float*)(p.ws + eg_off); const int* EI = (const int*)(p.ws + ei_off); float* W = (float*)(p.ws + w_off);
  const float* su = (const float*)(p.ws + WS_TSC) + (size_t)(layer * 2) * 16384; const float* sv = su + 16384;
  const int tpbc_ = TL / gridDim.x;
  for (int g = blockIdx.x * tpbc_ * 64 + otid(); g < (blockIdx.x + 1) * tpbc_ * 64; g += NT) {
    const int t = g >> 6, j = g & 63;
    float d0 = 0.f, d1 = 0.f;
#pragma unroll
    for (int x = 0; x < PQ_NS; ++x) { const unsigned v = part[((size_t)t * PQ_NS + x) * 64 + j]; d0 += bflo(v); d1 += bfhi(v); }
    const f32x2_t gt = *(const f32x2_t*)(EG + (size_t)t * 128 + 2 * j);
    const int e0 = EI[(size_t)t * 128 + 2 * j], e1 = EI[(size_t)t * 128 + 2 * j + 1];
    f32x2_t o; o[0] = gelu_tanh(d0 * su[e0]) * gt[0] * sv[e0]; o[1] = gelu_tanh(d1 * su[e1]) * gt[1] * sv[e1];
    *(f32x2_t*)(W + (size_t)t * 128 + 2 * j) = o;
  }
}
DI void ph_peer_v(const P& p, char* lds, int layer, size_t ei_off, size_t w_off) {
  PQ_BEGIN()
  const unsigned char* vs = (const unsigned char*)(p.ws + WS_TAB + (size_t)(layer * 2 + 1) * 8 * MiB) + ((size_t)x * 16384 << 7) + c16 * 16;
  const int* EI = (const int*)(p.ws + ei_off) + g8 * 16; const float* W = (const float*)(p.ws + w_off) + g8 * 16;
  const float* modb = (const float*)(p.ws + WS_MOD) + (size_t)layer * 5 * 6144;
  const int col = x * 256 + 32 * (lane & 7) + 4 * (lane >> 3);
  int4 nid[4]; f32x4 nw[4];
#define PV_PREF(tt) do { const int t_ = (tt) < tend ? (tt) : tend - 1; \
    _Pragma("unroll") for (int i = 0; i < 4; ++i) { nid[i] = *(const int4*)(EI + (size_t)t_ * 128 + i * 4); nw[i] = *(const f32x4*)(W + (size_t)t_ * 128 + i * 4); } } while (0)
  PV_PREF(tbeg);
#pragma unroll 1
  for (int t = tbeg; t < tend; t += NT / 64) {
    int id[16]; float wv[16];
#pragma unroll
    for (int i = 0; i < 4; ++i) { id[4 * i] = nid[i].x; id[4 * i + 1] = nid[i].y; id[4 * i + 2] = nid[i].z; id[4 * i + 3] = nid[i].w; wv[4 * i] = nw[i][0]; wv[4 * i + 1] = nw[i][1]; wv[4 * i + 2] = nw[i][2]; wv[4 * i + 3] = nw[i][3]; }
    u32x4 vr[16];
#pragma unroll
    for (int i = 0; i < 16; ++i) vr[i] = *(const u32x4*)(vs + ((size_t)id[i] << 7));
    f32x2_t acc2[16];
#pragma unroll
    for (int j = 0; j < 16; ++j) acc2[j] = f32x2_t{0.f, 0.f};
#pragma unroll
    for (int i = 0; i < 16; ++i) {
      const f32x2_t w2 = {wv[i], wv[i]};
#pragma unroll
      for (int w = 0; w < 4; ++w) {
        f32x2_t f0, f1, f2, f3; FP4X8(vr[i][w], f0, f1, f2, f3);
        acc2[4 * w] = f0 * w2 + acc2[4 * w]; acc2[4 * w + 1] = f1 * w2 + acc2[4 * w + 1]; acc2[4 * w + 2] = f2 * w2 + acc2[4 * w + 2]; acc2[4 * w + 3] = f3 * w2 + acc2[4 * w + 3];
      }
    }
    PV_PREF(t + NT / 64);
    float acc[32];
#pragma unroll
    for (int j = 0; j < 16; ++j) { acc[2 * j] = acc2[j][0]; acc[2 * j + 1] = acc2[j][1]; }
    float q16[16], q8[8], q4[4];
    { const bool up = (lane & 32) != 0;
#pragma unroll
      for (int m = 0; m < 16; ++m) { const float keep = up ? acc[16 + m] : acc[m], send = up ? acc[m] : acc[16 + m]; q16[m] = keep + __shfl_xor(send, 32, 64); } }
    { const bool up = (lane & 16) != 0;
#pragma unroll
      for (int m = 0; m < 8; ++m) { const float keep = up ? q16[8 + m] : q16[m], send = up ? q16[m] : q16[8 + m]; q8[m] = keep + __shfl_xor(send, 16, 64); } }
    { const bool up = (lane & 8) != 0;
#pragma unroll
      for (int m = 0; m < 4; ++m) { const float keep = up ? q8[4 + m] : q8[m], send = up ? q8[m] : q8[4 + m]; q4[m] = keep + __shfl_xor(send, 8, 64); } }
    float* xr = p.out + (size_t)t * DM + col;
    const f32x4 xv = *(const f32x4*)xr, g2 = *(const f32x4*)(modb + (size_t)(t >> 13) * 6144 + 5 * 1024 + col);
    f32x4 ov;
#pragma unroll
    for (int m = 0; m < 4; ++m) ov[m] = xv[m] + g2[m] * q4[m];
    *(f32x4*)xr = ov;
  }
  PQ_END()
#undef PV_PREF
}
DI void ph_final_norm(const P& p, int r0, int r1) {
  const int lane = otid() & 63;
  for (int row = r0 + (otid() >> 6); row < r1; row += NT / 64) {
    float* xr = p.out + (size_t)row * DM;
    f32x4 xv[4]; float ss = 0.f;
#pragma unroll
    for (int i = 0; i < 4; ++i) { xv[i] = *(const f32x4*)(xr + lane * 4 + 256 * i); ss += xv[i][0] * xv[i][0] + xv[i][1] * xv[i][1] + xv[i][2] * xv[i][2] + xv[i][3] * xv[i][3]; }
    ss = wave_sum(ss);
    const float rs = rsqrtf(ss * (1.f / DM) + EPS);
#pragma unroll
    for (int i = 0; i < 4; ++i) { const f32x4 w4 = *(const f32x4*)(p.final_norm_w + lane * 4 + 256 * i); *(f32x4*)(xr + lane * 4 + 256 * i) = xv[i] * rs * w4; }
  }
}

struct RowFft0 { const bf16_t* base; DI const bf16_t* operator()(int r) const { return base + ((size_t)128 * (r & 63) + (r >> 6)) * DM; } };
struct EpiFft0 {
  bf16_t* zt; int bg, l20, col0;
  DI void operator()(f32x16 (&acc)[2][2], int wm, int wn, int lane) const {
    const int h = lane >> 5, cl = lane & 31;
#pragma unroll
    for (int mt = 0; mt < 2; ++mt)
#pragma unroll
      for (int nt = 0; nt < 2; ++nt) {
        const int n = col0 + wn * 64 + nt * 32 + cl, ri = n >> 8, mm = n & 255;
#pragma unroll
        for (int g = 0; g < 4; ++g) {
          const int r = wm * 64 + mt * 32 + 8 * g + 4 * h, l1 = r & 63, l2 = l20 + (r >> 6);
          u32x2 v; v[0] = pk2(acc[mt][nt][4 * g], acc[mt][nt][4 * g + 1]); v[1] = pk2(acc[mt][nt][4 * g + 2], acc[mt][nt][4 * g + 3]);
          *(u32x2*)(zt + (((size_t)(bg * 256 + mm) * 128 + l2) * 128 + ri * 64 + l1)) = v;
        }
      }
  }
};
DI void ph_fft0(const P& p, char* lds) {
  const bf16_t* h1 = (const bf16_t*)(p.ws + R0); const bf16_t* Bt = (const bf16_t*)(p.ws + WS_DFT0);
  for (int t = blockIdx.x; t < NB * 4 * 32 * 4; t += gridDim.x) {
    const int pn = t & 3, l2b = (t >> 2) & 31, g = (t >> 7) & 3, b = t >> 9;
    RowFft0 rf{h1 + ((size_t)b * SEQ + l2b * 4) * DM + g * 256};
    EpiFft0 ep{(bf16_t*)(p.ws + WS_ZT), b * 4 + g, l2b * 4, pn * GBN};
    gemm_tile<false>(lds, rf, Bt + (size_t)pn * GBN * 256, 256, ep);
  }
}
struct EpiFft1 {
  bf16_t* a2; int row0;
  DI void operator()(f32x16 (&acc)[2][2], int wm, int wn, int lane) const {
    const int h = lane >> 5, cl = lane & 31, k1 = 32 * wn + cl;
#pragma unroll
    for (int mt = 0; mt < 2; ++mt)
#pragma unroll
      for (int g = 0; g < 4; ++g) {
        const int R = row0 + wm * 64 + mt * 32 + 8 * g + 4 * h, l2 = R & 127, mm = (R >> 7) & 255, bg = R >> 15;
        float yr[4], yi[4];
#pragma unroll
        for (int q = 0; q < 4; ++q) {
          const float fr = (float)((l2 + q) * k1) * (1.f / 8192.f);
          const float cs = __builtin_amdgcn_cosf(fr), sn = __builtin_amdgcn_sinf(fr);
          const float ar = acc[mt][0][4 * g + q], ai = acc[mt][1][4 * g + q];
          yr[q] = ar * cs + ai * sn; yi[q] = ai * cs - ar * sn;
        }
        bf16_t* o = a2 + (((size_t)(bg * 64 + k1) * 256 + mm) * 256 + l2);
        u32x2 v; v[0] = pk2(yr[0], yr[1]); v[1] = pk2(yr[2], yr[3]); *(u32x2*)o = v;
        v[0] = pk2(yi[0], yi[1]); v[1] = pk2(yi[2], yi[3]); *(u32x2*)(o + 128) = v;
      }
  }
};
DI void ph_fft1(const P& p, char* lds) {
  const bf16_t* zt = (const bf16_t*)(p.ws + WS_ZT); const bf16_t* Bt = (const bf16_t*)(p.ws + WS_DFT1);
  const int nM = 16 * 256 * 128 / GBM;
  for (int t = blockIdx.x; t < nM; t += gridDim.x) {
    RowLin rf{zt + (size_t)t * GBM * 128, (size_t)128};
    EpiFft1 ep{(bf16_t*)(p.ws + WS_A2), t * GBM};
    gemm_tile<false>(lds, rf, Bt, 128, ep);
  }
}
struct EpiFft3 {
  bf16_t* fm; int row0;
  DI void operator()(f32x16 (&acc)[2][2], int wm, int wn, int lane) const {
    const int h = lane >> 5, cl = lane & 31;
#pragma unroll
    for (int mt = 0; mt < 2; ++mt)
#pragma unroll
      for (int nt = 0; nt < 2; ++nt) {
        const int k2 = wn * 64 + nt * 32 + cl;
#pragma unroll
        for (int g = 0; g < 4; ++g) {
          const int R = row0 + wm * 64 + mt * 32 + 8 * g + 4 * h, mm = R & 255, k1 = (R >> 8) & 63, bg = R >> 14;
          u32x2 v; v[0] = pk2(acc[mt][nt][4 * g], acc[mt][nt][4 * g + 1]); v[1] = pk2(acc[mt][nt][4 * g + 2], acc[mt][nt][4 * g + 3]);
          *(u32x2*)(fm + ((size_t)((bg >> 2) * SEQ + k1 + 64 * k2)) * DM + (bg & 3) * 256 + mm) = v;
        }
      }
  }
};
DI void ph_fft3(const P& p, char* lds) {
  const bf16_t* a2 = (const bf16_t*)(p.ws + WS_A2); const bf16_t* Bt = (const bf16_t*)(p.ws + WS_DFT3);
  const int nM = 16 * 64 * 256 / GBM;
  for (int t = blockIdx.x; t < nM; t += gridDim.x) {
    RowLin rf{a2 + (size_t)t * GBM * 256, (size_t)256};
    EpiFft3 ep{(bf16_t*)(p.ws + WS_FM), t * GBM};
    gemm_tile<false>(lds, rf, Bt, 256, ep);
  }
}

constexpr int NPHASE = 19;
template <int PH>
DI void run_phase(const P& p, char* lds) {
  const float* modL = (const float*)(p.ws + WS_MOD);
  const int tpb = TL / gridDim.x, t0 = blockIdx.x * tpb, t1 = t0 + tpb;
  if constexpr (PH == 0) ph_setup(p, lds);
  else if constexpr (PH == 1) { norm_rows_i8(p.x, 0, TL, p.norm1_w, modL, false, (unsigned char*)(p.ws + R0), (float*)(p.ws + WS_HS0));
                                norm_rows_i8(p.ctx - (size_t)TL * DM, TL, TA, p.norm1_w, modL, true, (unsigned char*)(p.ws + R0), (float*)(p.ws + WS_HS0));
                                quant_rows_i8((const bf16_t*)(p.ws + WS_WIN), NIN, (unsigned char*)(p.ws + WS_WIN8), (float*)(p.ws + WS_SWIN)); }
  else if constexpr (PH == 2) { PgProj ep{&p}; pg8_run_i8(lds, p.ws + R0, p.ws + WS_WIN8, TA, NIN, 1024, ep); }
  else if constexpr (PH == 3) ph_gdn_prep<0>(p, lds);
  else if constexpr (PH == 4) { if (blockIdx.x >= 64) { ph_vt8(p, lds); cvt_fp8((const bf16_t*)(p.ws + WS_Q), (unsigned char*)(p.ws + WS_Q8), TL * 512 / 16, 64.f);
                                                        cvt_fp8((const bf16_t*)(p.ws + WS_K), (unsigned char*)(p.ws + WS_K8), NB * KVL * 512 / 16, 16.f); }
                                else ph_gdn_scan<0>(p, lds); }
  else if constexpr (PH == 5) { ph_attn(p, lds); ph_mixout(p); }
  else if constexpr (PH == 6) { PgResid ep{p.x, p.out, modL + 2 * 1024}; pg8_run(lds, (const bf16_t*)(p.ws + WS_MIX), (const bf16_t*)(p.ws + WS_WOUT), TL, DM, DM, ep); }
  else if constexpr (PH == 7) { norm_rows_hq(p, p.norm2_w, modL); quant_rows_i8((const bf16_t*)(p.ws + WS_WEFF), 4096, (unsigned char*)(p.ws + WS_WEFF8), (float*)(p.ws + WS_SW)); ph_tables(p); }
  else if constexpr (PH == 8) { PgScoreI8 ep{(bf16_t*)(p.ws + WS_SC0), (const float*)(p.ws + WS_HS), (const float*)(p.ws + WS_SW)}; pg8_run_i8(lds, p.ws + R0, p.ws + WS_WEFF8, TL, 2048, 1024, ep); }
  else if constexpr (PH == 9) { ph_topk(p, lds, WS_SC0, WS_EI0, WS_EG0); block_handoff(); ph_peer_u(p, lds, 0, WS_EI0, WS_PART0); }
  else if constexpr (PH == 10) { ph_peer_comb(p, 0, WS_PART0, WS_EI0, WS_EG0, WS_W0); block_handoff(); ph_peer_v(p, lds, 0, WS_EI0, WS_W0); block_handoff();
                                 norm_rows(p.out, t0, t1, p.norm1_w + DM, modL + 5 * 6144, 0, 1, false, (bf16_t*)(p.ws + R0), true); }
  else if constexpr (PH == 11) ph_fft0(p, lds);
  else if constexpr (PH == 12) ph_fft1(p, lds);
  else if constexpr (PH == 13) ph_fft3(p, lds);
  else if constexpr (PH == 14) { PgResid ep{p.out, p.out, modL + 5 * 6144 + 2 * 1024}; pg8_run(lds, (const bf16_t*)(p.ws + WS_FM), (const bf16_t*)(p.ws + WS_WF), TL, DM, DM, ep); }
  else if constexpr (PH == 15) norm_rows_hq(p, p.norm2_w + DM, modL + 5 * 6144);
  else if constexpr (PH == 16) { PgScoreI8 ep{(bf16_t*)(p.ws + WS_SC1), (const float*)(p.ws + WS_HS), (const float*)(p.ws + WS_SW) + 2048}; pg8_run_i8(lds, p.ws + R0, p.ws + WS_WEFF8 + (size_t)2048 * 1024, TL, 2048, 1024, ep); }
  else if constexpr (PH == 17) { ph_topk(p, lds, WS_SC1, WS_EI1, WS_EG1); block_handoff(); ph_peer_u(p, lds, 1, WS_EI1, WS_PART1); }
  else if constexpr (PH == 18) { ph_peer_comb(p, 1, WS_PART1, WS_EI1, WS_EG1, WS_W1); block_handoff(); ph_peer_v(p, lds, 1, WS_EI1, WS_W1); block_handoff(); ph_final_norm(p, t0, t1); }
}
#define XB_TMO      128
#define XB_XCNT(j)  (256  + 64 * (j))
#define XB_XSUB(j)  (1280 + 64 * (j))
#define XB_XGEN(j)  (2304 + 64 * (j))
#define XB_TOP      3328
#define XB_TOPGEN   3392
#define XCD_BAR_WORDS 3456
#define XB_SPIN_CAP (1u << 22)
#define LAS __attribute__((address_space(3)))
#define XB_SPIN(cond, bar) do { unsigned _sp = 0; while (cond) { __builtin_amdgcn_s_sleep(1); \
    if ((++_sp & 255u) == 0u) { if (xb_ld(&(bar)[XB_TMO])) break; if (_sp > XB_SPIN_CAP) { atomicAdd(&(bar)[XB_TMO], 1u); break; } } } } while (0)
struct XcdBarrier { unsigned* bar; unsigned x; volatile LAS unsigned* st; };
DI XcdBarrier xcd_barrier_post(unsigned* bar, volatile LAS unsigned* st) {
  XcdBarrier b; b.bar = bar; b.x = xb_xcc_id(); b.st = st;
  if (threadIdx.x == 0) (void)xb_add(&bar[XB_XCNT(b.x)], 1u);
  return b;
}
DI void xcd_barrier_complete(unsigned* bar, unsigned x, unsigned& nloc, unsigned& nx) {
  const unsigned G = gridDim.x * gridDim.y * gridDim.z;
  unsigned sum, cnt, mine, sp = 0u;
  for (;;) {
    sum = 0u; cnt = 0u; mine = 0u;
#pragma unroll
    for (unsigned j = 0; j < 16; ++j) { const unsigned c = xb_ld(&bar[XB_XCNT(j)]); sum += c; cnt += (c > 0u) ? 1u : 0u; mine = (j == x) ? c : mine; }
    if (sum == G) break;
    __builtin_amdgcn_s_sleep(1);
    if ((++sp & 255u) == 0u) { if (xb_ld(&bar[XB_TMO])) break; if (sp > XB_SPIN_CAP) { atomicAdd(&bar[XB_TMO], 1u); break; } }
  }
  nloc = mine > 0u ? mine : 1u; nx = cnt > 0u ? cnt : 1u;
}
DI void xcd_barrier(const XcdBarrier& b) {
  asm volatile("s_waitcnt vmcnt(0)" ::: "memory");
  __syncthreads();
  if (threadIdx.x == 0) {
    unsigned* bar = b.bar;
    __builtin_amdgcn_s_waitcnt(0);
    unsigned nloc = b.st[0], nx = b.st[1];
    if (nloc == 0u) { xcd_barrier_complete(bar, b.x, nloc, nx); b.st[0] = nloc; b.st[1] = nx; }
    const unsigned old = xb_add(&bar[XB_XSUB(b.x)], 1u);
    const unsigned gen = old / nloc;
    if (old + 1u == (gen + 1u) * nloc) {
      __builtin_amdgcn_fence(__ATOMIC_RELEASE, "agent");
      asm volatile("s_waitcnt vmcnt(0)" ::: "memory");
      const unsigned og = xb_add(&bar[XB_TOP], 1u);
      const unsigned tg = og / nx;
      if (og + 1u == (tg + 1u) * nx) xb_add(&bar[XB_TOPGEN], 1u);
      else XB_SPIN(xb_ld(&bar[XB_TOPGEN]) == tg, bar);
      __builtin_amdgcn_fence(__ATOMIC_ACQUIRE, "agent");
      xb_add(&bar[XB_XGEN(b.x)], 1u);
      asm volatile("s_waitcnt vmcnt(0)" ::: "memory");
    } else {
      XB_SPIN(xb_ld(&bar[XB_XGEN(b.x)]) == gen, bar);
      __builtin_amdgcn_fence(__ATOMIC_ACQUIRE, "agent");
      asm volatile("s_waitcnt vmcnt(0)" ::: "memory");
    }
  }
  __syncthreads();
}

constexpr int EXTRA_PHASE = -1;
constexpr int PROBE_MODE = 0;
template <int PH>
DI void run_all(const P& p, char* lds, const XcdBarrier& bar) {
  run_phase<PH>(p, lds);
  if constexpr (PH == EXTRA_PHASE) {
    xcd_barrier(bar);
    if constexpr (PH == 3) ph_gdn_prep<PROBE_MODE>(p, lds);
    else if constexpr (PH == 4) ph_gdn_scan<PROBE_MODE>(p, lds);
    else run_phase<PH>(p, lds);
  }
  if constexpr (PH + 1 < NPHASE) {
    if constexpr (PH == 0) { cg::this_grid().sync(); }
    else xcd_barrier(bar);
    run_all<PH + 1>(p, lds, bar);
  }
}
__global__ void __launch_bounds__(NT) mega(P p) {
  extern __shared__ __attribute__((aligned(16))) char lds[];
  volatile LAS unsigned* st = (volatile LAS unsigned*)(lds + LDS_BYTES - 16);
  if (threadIdx.x == 0) { st[0] = 0u; st[1] = 0u; }
  __syncthreads();
  XcdBarrier bar = xcd_barrier_post((unsigned*)(p.ws + WS_CTL), st);
  run_all<0>(p, lds, bar);
}

extern "C" void kernel_launch(void* const* d_in, const int* in_sizes, int n_in, void* d_out, int out_size, void* d_ws, size_t ws_size, hipStream_t stream) {
  static int grid = 0;
  if (grid == 0) {
    if (n_in != 25 || ws_size < WS_END) { fprintf(stderr, "kernel_launch: unexpected n_in %d or ws_size %zu\n", n_in, ws_size); grid = -1; return; }
    int dev = 0, cus = 0, per_cu = 0;
    (void)hipGetDevice(&dev); (void)hipDeviceGetAttribute(&cus, hipDeviceAttributeMultiprocessorCount, dev);
    (void)hipFuncSetAttribute((const void*)mega, hipFuncAttributeMaxDynamicSharedMemorySize, LDS_BYTES);
    if (hipOccupancyMaxActiveBlocksPerMultiprocessor(&per_cu, (const void*)mega, NT, LDS_BYTES) != hipSuccess || per_cu < 1) { fprintf(stderr, "kernel_launch: occupancy query failed (%d)\n", per_cu); per_cu = 1; }
    (void)hipGetLastError();
    if (per_cu > 1) per_cu = 1;
    grid = (cus > 0 ? cus : 256) * per_cu;
  }
  if (grid < 0) return;
  (void)hipMemsetAsync((char*)d_ws + WS_CTL, 0, CTL_ZERO_BYTES, stream);
  P p{};
  const float** pf = (const float**)&p;
  for (int i = 0; i < 25; ++i) pf[i] = (const float*)d_in[i];
  p.out = (float*)d_out; p.ws = (char*)d_ws; p.lo = 0; p.hi = NPHASE;
  void* args[] = {&p};
  hipError_t e = hipLaunchCooperativeKernel((const void*)mega, dim3(grid), dim3(NT), args, LDS_BYTES, stream);
  if (e != hipSuccess) fprintf(stderr, "cooperative launch failed: %s (grid %d)\n", hipGetErrorString(e), grid);
}
```
